# Optimizing an MI355X kernel written in HIP

```python
import math
import jax, jax.numpy as jnp
from jax import lax
import numpy as np

D_MODEL = 1024
BATCH = 4
SEQ = 4096
DEPTH = 2

GRID_W = 64
CTX_LEN = 256
Q_BLOCK = 128
ROPE_THETA = 10000.0
EPS = 1e-6

A_HEADS = 8
A_KV_HEADS = 2
A_GROUP = A_HEADS // A_KV_HEADS
A_HEAD_DIM = 64
A_WIDTH = A_HEADS * A_HEAD_DIM

S5_CH = 512
S5_GROUP_CH = 16
S5_GROUPS = S5_CH // S5_GROUP_CH
S5_STATE = 64

C_HEADS = 8
C_NOPE = 64
C_ROPE = 32
C_VDIM = 64
C_Q_RANK = 768
C_KV_RANK = 256
C_QK_DIM = C_NOPE + C_ROPE
C_WIDTH = C_HEADS * C_VDIM

D_FF = 4 * D_MODEL
N_BRANCH = 3
N_MOD = 6
DEEPNORM_ALPHA = (2.0 * DEPTH) ** 0.25
DEEPNORM_BETA = (8.0 * DEPTH) ** -0.25

OFF_AK = 0
OFF_AV = OFF_AK + A_KV_HEADS * A_HEAD_DIM
OFF_CKV = OFF_AV + A_KV_HEADS * A_HEAD_DIM
OFF_CKR = OFF_CKV + C_KV_RANK
OFF_U = OFF_CKR + C_ROPE
N_STATE_COLS = OFF_U + S5_CH
OFF_AQ = N_STATE_COLS
OFF_CQ = OFF_AQ + A_WIDTH
OFF_GATE = OFF_CQ + C_Q_RANK
N_IN_COLS = OFF_GATE + N_BRANCH * D_MODEL

kernel_name = 'hybrid_gqa_s5_mla_dit_block'


def layer_norm(x, g=None, b=None):
    x32 = x.astype(jnp.float32)
    mu = jnp.mean(x32, axis=-1, keepdims=True)
    var = jnp.mean(jnp.square(x32 - mu), axis=-1, keepdims=True)
    y = (x32 - mu) * lax.rsqrt(var + EPS)
    if g is not None:
        y = y * g.astype(jnp.float32) + b.astype(jnp.float32)
    return y.astype(x.dtype)


def rms_norm(x, g):
    x32 = x.astype(jnp.float32)
    y = x32 * lax.rsqrt(jnp.mean(jnp.square(x32), axis=-1, keepdims=True) + EPS)
    return (y * g.astype(jnp.float32)).astype(x.dtype)


def modulate(x, shift, scale):
    return layer_norm(x) * (1.0 + scale) + shift


def post_norm(x, y, g, b):
    return layer_norm(DEEPNORM_ALPHA * x + y, g, b)


def axial_rope_tables(rows, dim):
    half = dim // 2
    inv = ROPE_THETA ** (-jnp.arange(0, half, 2, dtype=jnp.float32) / half)
    row = jnp.repeat(jnp.arange(rows, dtype=jnp.float32), GRID_W)
    col = jnp.tile(jnp.arange(GRID_W, dtype=jnp.float32), rows)
    ang_r = row[:, None] * inv
    ang_c = col[:, None] * inv
    ang = jnp.concatenate([ang_r, ang_r, ang_c, ang_c], axis=-1)
    return jnp.cos(ang), jnp.sin(ang)


def apply_rope(x, cos, sin):
    half = x.shape[-1] // 2
    q = half // 2

    def rot(v):
        return jnp.concatenate([-v[..., q:], v[..., :q]], axis=-1)

    xr = jnp.concatenate([rot(x[..., :half]), rot(x[..., half:])], axis=-1)
    out = x.astype(jnp.float32) * cos[:, None, :] + xr.astype(jnp.float32) * sin[:, None, :]
    return out.astype(x.dtype)


def block_attention(q, k, v, scale):
    bsz, kvh, grp, lq, dk = q.shape
    nb = lq // Q_BLOCK
    qb = jnp.moveaxis(q.reshape(bsz, kvh, grp, nb, Q_BLOCK, dk), 3, 0)

    def one_block(qblk):
        s = jnp.einsum('bhgqd,bhkd->bhgqk', qblk, k, preferred_element_type=jnp.float32) * scale
        p = jax.nn.softmax(s, axis=-1).astype(v.dtype)
        return jnp.einsum('bhgqk,bhkd->bhgqd', p, v)

    o = lax.map(one_block, qb)
    return jnp.moveaxis(o, 0, 3).reshape(bsz, kvh, grp, lq, v.shape[-1])


def gqa_kv(proj, k_gain, rope):
    bsz, L = proj.shape[:2]
    k = rms_norm(proj[..., OFF_AK:OFF_AV].reshape(bsz, L, A_KV_HEADS, A_HEAD_DIM), k_gain)
    v = proj[..., OFF_AV:OFF_CKV].reshape(bsz, L, A_KV_HEADS, A_HEAD_DIM)
    if rope is not None:
        k = apply_rope(k, *rope)
    return k.transpose(0, 2, 1, 3), v.transpose(0, 2, 1, 3)


def mla_kv(proj, kv_a_gain, w_kvb, rope):
    bsz, L = proj.shape[:2]
    c_kv = rms_norm(proj[..., OFF_CKV:OFF_CKR], kv_a_gain)
    kv = (c_kv @ w_kvb).reshape(bsz, L, C_HEADS, C_NOPE + C_VDIM)
    k_nope, v = kv[..., :C_NOPE], kv[..., C_NOPE:]
    k_rope = proj[..., OFF_CKR:OFF_U][:, :, None, :]
    if rope is not None:
        k_rope = apply_rope(k_rope, *rope)
    k = jnp.concatenate([k_nope, jnp.broadcast_to(k_rope, (bsz, L, C_HEADS, C_ROPE))], axis=-1)
    return k.transpose(0, 2, 1, 3), v.transpose(0, 2, 1, 3)


def attend_queries(proj, ka, va, kc, vc, lp, rope_a, rope_c):
    bsz, L = proj.shape[:2]
    qa = rms_norm(proj[..., OFF_AQ:OFF_CQ].reshape(bsz, L, A_HEADS, A_HEAD_DIM), lp['a_q_gain'])
    if rope_a is not None:
        qa = apply_rope(qa, *rope_a)
    qa = qa.reshape(bsz, L, A_KV_HEADS, A_GROUP, A_HEAD_DIM).transpose(0, 2, 3, 1, 4)
    oa = block_attention(qa, ka, va, A_HEAD_DIM ** -0.5)
    ya = oa.transpose(0, 3, 1, 2, 4).reshape(bsz, L, A_WIDTH)
    cq = rms_norm(proj[..., OFF_CQ:OFF_GATE], lp['c_q_a_gain'])
    qc = (cq @ lp['c_w_qb']).reshape(bsz, L, C_HEADS, C_QK_DIM)
    q_nope, q_rope = qc[..., :C_NOPE], qc[..., C_NOPE:]
    if rope_c is not None:
        q_rope = apply_rope(q_rope, *rope_c)
    qc = jnp.concatenate([q_nope, q_rope], axis=-1).transpose(0, 2, 1, 3)[:, :, None]
    oc = block_attention(qc, kc, vc, C_QK_DIM ** -0.5)
    yc = oc[:, :, 0].transpose(0, 2, 1, 3).reshape(bsz, L, C_WIDTH)
    return ya, yc


def s5_discretize(a_re, a_im, log_dt, b_re, b_im):
    f32 = jnp.float32
    a_re, a_im = a_re.astype(f32), a_im.astype(f32)
    dt = jnp.exp(log_dt.astype(f32))[:, None]
    mag = jnp.exp(a_re * dt)
    abar_r = mag * jnp.cos(a_im * dt)
    abar_i = mag * jnp.sin(a_im * dt)
    den = a_re * a_re + a_im * a_im
    nr = abar_r - 1.0
    coef_r = (nr * a_re + abar_i * a_im) / den
    coef_i = (abar_i * a_re - nr * a_im) / den
    b_re, b_im = b_re.astype(f32), b_im.astype(f32)
    bbar_r = coef_r[..., None] * b_re - coef_i[..., None] * b_im
    bbar_i = coef_r[..., None] * b_im + coef_i[..., None] * b_re
    return abar_r, abar_i, bbar_r, bbar_i


def _complex_affine_combine(earlier, later):
    a1r, a1i, b1r, b1i = earlier
    a2r, a2i, b2r, b2i = later
    return (a1r * a2r - a1i * a2i,
            a1r * a2i + a1i * a2r,
            a2r * b1r - a2i * b1i + b2r,
            a2r * b1i + a2i * b1r + b2i)


def s5_states(u, disc, x0, reverse):
    abar_r, abar_i, bbar_r, bbar_i = disc
    u32 = u.astype(jnp.float32)
    bu_r = jnp.einsum('blgc,gpc->blgp', u32, bbar_r)
    bu_i = jnp.einsum('blgc,gpc->blgp', u32, bbar_i)
    L = u.shape[1]
    ar = jnp.broadcast_to(abar_r, (1, L) + abar_r.shape)
    ai = jnp.broadcast_to(abar_i, (1, L) + abar_i.shape)
    cum_r, cum_i, s_r, s_i = lax.associative_scan(
        _complex_affine_combine, (ar, ai, bu_r, bu_i), axis=1, reverse=reverse)
    if x0 is not None:
        x0r, x0i = x0[0][:, None], x0[1][:, None]
        s_r = s_r + cum_r * x0r - cum_i * x0i
        s_i = s_i + cum_r * x0i + cum_i * x0r
    return s_r, s_i


def s5_readout(s_r, s_i, c_re, c_im):
    return (jnp.einsum('gcp,blgp->blgc', c_re.astype(jnp.float32), s_r)
            - jnp.einsum('gcp,blgp->blgc', c_im.astype(jnp.float32), s_i))


def s5_input(proj):
    return proj[..., OFF_U:N_STATE_COLS].reshape(proj.shape[0], proj.shape[1], S5_GROUPS, S5_GROUP_CH)


def s5_glu(ys, u, d, w_glu):
    y = ys + d.astype(jnp.float32).reshape(S5_GROUPS, S5_GROUP_CH) * u.astype(jnp.float32)
    y = y.reshape(u.shape[0], u.shape[1], S5_CH).astype(u.dtype)
    h = jax.nn.gelu(y) @ w_glu
    a, g = jnp.split(h, 2, axis=-1)
    return a * jax.nn.sigmoid(g)


def merge_branches(proj, ya, ys, yc, lp):
    bsz, L = proj.shape[:2]
    g = jax.nn.sigmoid(proj[..., OFF_GATE:]).reshape(bsz, L, N_BRANCH, D_MODEL)
    merged = (g[..., 0, :] * (ya @ lp['w_branch_a'])
              + g[..., 1, :] * (ys @ lp['w_branch_s5'])
              + g[..., 2, :] * (yc @ lp['w_branch_c']))
    return merged @ lp['w_out']


def squared_relu_mlp(h, w_up, w_down):
    return jnp.square(jax.nn.relu(h @ w_up)) @ w_down


def setup_inputs(seed: int = 0) -> dict:
    key = jax.random.key(seed)
    ks = iter(jax.random.split(key, 64))

    def nrm(shape, scale):
        return scale * jax.random.normal(next(ks), shape, jnp.float32)

    G, P, CH = S5_GROUPS, S5_STATE, S5_GROUP_CH
    return {
        'x': nrm((BATCH, SEQ, D_MODEL), 1.0),
        'c': nrm((BATCH, D_MODEL), 1.0),
        'ctx': nrm((BATCH, CTX_LEN, D_MODEL), 1.0),
        'c_ctx': nrm((D_MODEL,), 1.0),
        'w_mod': nrm((DEPTH, D_MODEL, N_MOD * D_MODEL), 0.5 * D_MODEL ** -0.5),
        'b_mod': nrm((DEPTH, N_MOD * D_MODEL), 0.01),
        'w_in': nrm((DEPTH, D_MODEL, N_IN_COLS), D_MODEL ** -0.5),
        'a_q_gain': 1.0 + nrm((DEPTH, A_HEAD_DIM), 0.02),
        'a_k_gain': 1.0 + nrm((DEPTH, A_HEAD_DIM), 0.02),
        'c_q_a_gain': 1.0 + nrm((DEPTH, C_Q_RANK), 0.02),
        'c_kv_a_gain': 1.0 + nrm((DEPTH, C_KV_RANK), 0.02),
        'c_w_qb': nrm((DEPTH, C_Q_RANK, C_HEADS * C_QK_DIM), C_Q_RANK ** -0.5),
        'c_w_kvb': nrm((DEPTH, C_KV_RANK, C_HEADS * (C_NOPE + C_VDIM)), C_KV_RANK ** -0.5),
        's5_a_re': -0.5 + nrm((DEPTH, 2, G, P), 0.01),
        's5_a_im': jnp.pi * jnp.arange(P, dtype=jnp.float32) + nrm((DEPTH, 2, G, P), 0.01),
        's5_log_dt': jax.random.uniform(next(ks), (DEPTH, 2, G), jnp.float32, math.log(1e-3), math.log(1e-1)),
        's5_b_re': nrm((DEPTH, 2, G, P, CH), (2.0 * CH) ** -0.5),
        's5_b_im': nrm((DEPTH, 2, G, P, CH), (2.0 * CH) ** -0.5),
        's5_c_re': nrm((DEPTH, 2, G, CH, P), P ** -0.5),
        's5_c_im': nrm((DEPTH, 2, G, CH, P), P ** -0.5),
        's5_d': nrm((DEPTH, S5_CH), 1.0),
        's5_w_glu': nrm((DEPTH, S5_CH, 2 * S5_CH), S5_CH ** -0.5),
        'w_branch_a': nrm((DEPTH, A_WIDTH, D_MODEL), A_WIDTH ** -0.5),
        'w_branch_s5': nrm((DEPTH, S5_CH, D_MODEL), S5_CH ** -0.5),
        'w_branch_c': nrm((DEPTH, C_WIDTH, D_MODEL), C_WIDTH ** -0.5),
        'w_out': nrm((DEPTH, D_MODEL, D_MODEL), DEEPNORM_BETA * D_MODEL ** -0.5),
        'ln1_g': 1.0 + nrm((DEPTH, D_MODEL), 0.02),
        'ln1_b': nrm((DEPTH, D_MODEL), 0.02),
        'w_up': nrm((DEPTH, D_MODEL, D_FF), D_MODEL ** -0.5),
        'w_down': nrm((DEPTH, D_FF, D_MODEL), DEEPNORM_BETA * D_FF ** -0.5),
        'ln2_g': 1.0 + nrm((DEPTH, D_MODEL), 0.02),
        'ln2_b': nrm((DEPTH, D_MODEL), 0.02),
    }


def reference(x, c, ctx, c_ctx, w_mod, b_mod, w_in, a_q_gain, a_k_gain, c_q_a_gain, c_kv_a_gain,
              c_w_qb, c_w_kvb, s5_a_re, s5_a_im, s5_log_dt, s5_b_re, s5_b_im, s5_c_re, s5_c_im,
              s5_d, s5_w_glu, w_branch_a, w_branch_s5, w_branch_c, w_out, ln1_g, ln1_b,
              w_up, w_down, ln2_g, ln2_b):
    rows = x.shape[1] // GRID_W
    rope_a = axial_rope_tables(rows, A_HEAD_DIM)
    rope_c = axial_rope_tables(rows, C_ROPE)
    for l in range(DEPTH):
        last = l == DEPTH - 1
        lp = {'a_q_gain': a_q_gain[l], 'a_k_gain': a_k_gain[l],
              'c_q_a_gain': c_q_a_gain[l], 'c_kv_a_gain': c_kv_a_gain[l],
              'c_w_qb': c_w_qb[l], 'c_w_kvb': c_w_kvb[l],
              'w_branch_a': w_branch_a[l], 'w_branch_s5': w_branch_s5[l],
              'w_branch_c': w_branch_c[l], 'w_out': w_out[l]}
        disc = [s5_discretize(s5_a_re[l, dr], s5_a_im[l, dr], s5_log_dt[l, dr],
                              s5_b_re[l, dr], s5_b_im[l, dr]) for dr in range(2)]

        mod = jax.nn.silu(c) @ w_mod[l] + b_mod[l]
        sh1, sc1, g1, sh2, sc2, g2 = jnp.split(mod[:, None, :], N_MOD, axis=-1)
        n_ctx_mod = 2 if last else N_MOD
        mod_c = jax.nn.silu(c_ctx) @ w_mod[l][:, :n_ctx_mod * D_MODEL] + b_mod[l][:n_ctx_mod * D_MODEL]
        mods_c = jnp.split(mod_c, n_ctx_mod)

        h = modulate(x, sh1, sc1)
        hc = modulate(ctx, mods_c[0], mods_c[1])
        proj = h @ w_in[l]
        proj_c = hc @ (w_in[l][:, :N_STATE_COLS] if last else w_in[l])

        ka_c, va_c = gqa_kv(proj_c, lp['a_k_gain'], None)
        kc_c, vc_c = mla_kv(proj_c, lp['c_kv_a_gain'], lp['c_w_kvb'], None)
        u_c = s5_input(proj_c)
        st_f = s5_states(u_c, disc[0], None, False)
        st_b = s5_states(u_c, disc[1], None, True)

        ka, va = gqa_kv(proj, lp['a_k_gain'], rope_a)
        kc, vc = mla_kv(proj, lp['c_kv_a_gain'], lp['c_w_kvb'], rope_c)
        ya, yc = attend_queries(proj,
                                jnp.concatenate([ka_c, ka], axis=2), jnp.concatenate([va_c, va], axis=2),
                                jnp.concatenate([kc_c, kc], axis=2), jnp.concatenate([vc_c, vc], axis=2),
                                lp, rope_a, rope_c)
        u = s5_input(proj)
        ys = (s5_readout(*s5_states(u, disc[0], (st_f[0][:, -1], st_f[1][:, -1]), False), s5_c_re[l, 0], s5_c_im[l, 0])
              + s5_readout(*s5_states(u, disc[1], (st_b[0][:, 0], st_b[1][:, 0]), True), s5_c_re[l, 1], s5_c_im[l, 1]))
        ys = s5_glu(ys, u, s5_d[l], s5_w_glu[l])
        mix = merge_branches(proj, ya, ys, yc, lp)
        x_mid = post_norm(x, g1 * mix, ln1_g[l], ln1_b[l])
        ff = squared_relu_mlp(modulate(x_mid, sh2, sc2), w_up[l], w_down[l])
        x_next = post_norm(x_mid, g2 * ff, ln2_g[l], ln2_b[l])

        if not last:
            ya_c, yc_c = attend_queries(proj_c, ka_c, va_c, kc_c, vc_c, lp, None, None)
            ys_c = (s5_readout(*st_f, s5_c_re[l, 0], s5_c_im[l, 0])
                    + s5_readout(*st_b, s5_c_re[l, 1], s5_c_im[l, 1]))
            ys_c = s5_glu(ys_c, u_c, s5_d[l], s5_w_glu[l])
            mix_c = merge_branches(proj_c, ya_c, ys_c, yc_c, lp)
            ctx_mid = post_norm(ctx, mods_c[2] * mix_c, ln1_g[l], ln1_b[l])
            ff_c = squared_relu_mlp(modulate(ctx_mid, mods_c[3], mods_c[4]), w_up[l], w_down[l])
            ctx = post_norm(ctx_mid, mods_c[5] * ff_c, ln2_g[l], ln2_b[l])
        x = x_next
    return x
```

```cpp
#include <hip/hip_runtime.h>
#include <hip/hip_cooperative_groups.h>
#include <cstdio>
#include <cstdint>
#include <cmath>

namespace cg = cooperative_groups;

#define LAS __attribute__((address_space(3)))
typedef _Float16 f16;
typedef _Float16 f16x8 __attribute__((ext_vector_type(8)));
typedef _Float16 f16x4 __attribute__((ext_vector_type(4)));
typedef float f32x4 __attribute__((ext_vector_type(4)));
typedef float f32x16 __attribute__((ext_vector_type(16)));

constexpr int D = 1024, NB = 4, SEQ = 4096, CTX = 256, NLAT = NB * SEQ, NCTX = NB * CTX, MALL = NLAT + NCTX;
constexpr int NKEY = CTX + SEQ;
constexpr int OFF_AK = 0, OFF_AV = 128, OFF_CKV = 256, OFF_CKR = 512, OFF_U = 544, OFF_AQ = 1056, OFF_CQ = 1568, OFF_GATE = 2336, N_IN = 5408;
constexpr int PLD = 2560;
constexpr int DFF = 4096;
constexpr float EPS = 1e-6f;
constexpr float ALPHA = 1.4142135623730951f;
constexpr float LOG2E = 1.4426950408889634f;
constexpr float QSCALE_A = 0.125f * LOG2E;
constexpr float QSCALE_C = 0.10206207261596575f * LOG2E;

constexpr size_t MiB = 1u << 20;
constexpr size_t WS_CTL = 0;
constexpr size_t WS_MOD = 1 * MiB;
constexpr size_t WS_ROPE = 1 * MiB + 512 * 1024;
constexpr size_t WS_W16 = 2 * MiB;
constexpr size_t W_INA = WS_W16;
constexpr size_t W_GATE = W_INA + (size_t)2560 * 1024 * 2;
constexpr size_t W_QB = W_GATE + (size_t)3072 * 1024 * 2;
constexpr size_t W_KVB = W_QB + (size_t)768 * 768 * 2;
constexpr size_t W_GLU = W_KVB + (size_t)1024 * 256 * 2;
constexpr size_t W_BR = W_GLU + (size_t)1024 * 512 * 2;
constexpr size_t W_OUT = W_BR + (size_t)3 * 1024 * 512 * 2;
constexpr size_t W_UP = W_OUT + (size_t)1024 * 1024 * 2;
constexpr size_t W_DOWN = W_UP + (size_t)4096 * 1024 * 2;
constexpr size_t W_END = W_DOWN + (size_t)1024 * 4096 * 2;
constexpr size_t WS_TACTX = 37 * MiB;
constexpr size_t WS_ACT = 41 * MiB;
static_assert(W_END <= WS_TACTX, "weights fit");
constexpr size_t A_H = WS_ACT + 0 * MiB;
constexpr size_t A_QC = WS_ACT + 0 * MiB;
constexpr size_t A_PROJ = WS_ACT + 34 * MiB;
constexpr size_t A_YA = WS_ACT + 34 * MiB;
constexpr size_t A_YC = WS_ACT + 51 * MiB;
constexpr size_t A_YSF = WS_ACT + 68 * MiB;
constexpr size_t A_G = WS_ACT + 102 * MiB;
constexpr size_t A_QA = WS_ACT + 119 * MiB;
constexpr size_t A_YS = WS_ACT + 119 * MiB;
constexpr size_t A_KA = WS_ACT + 136 * MiB;
constexpr size_t A_VA = A_KA + (size_t)NB * 2 * NKEY * 64 * 2;
constexpr size_t A_U = WS_ACT + 145 * MiB;
constexpr size_t A_KC = WS_ACT + 162 * MiB;
constexpr size_t A_VC = WS_ACT + 188 * MiB;
constexpr size_t A_GATE = WS_ACT + 136 * MiB;
constexpr size_t A_MERGED = WS_ACT + 170 * MiB;
constexpr size_t A_HID = WS_ACT + 34 * MiB;
constexpr size_t WS_NEED = WS_ACT + 205 * MiB;
static_assert(A_VA + (size_t)NB * 2 * NKEY * 64 * 2 <= A_U && A_VC + 17 * MiB <= WS_NEED && A_MERGED + 34 * MiB <= WS_NEED && A_HID + 136 * MiB <= WS_NEED, "ws map");
static_assert(WS_NEED <= 256 * MiB, "ws budget");

constexpr int LDS_BYTES = 147456;
constexpr int NTHREADS = 512, NWAVES = 8;

struct Args {
    const float* in[32];
    float* out;
    unsigned char* ws;
    int ph_lo, ph_hi;
};
enum { I_X = 0, I_C, I_CTX, I_CCTX, I_WMOD, I_BMOD, I_WIN, I_AQG, I_AKG, I_CQG, I_CKVG, I_WQB, I_WKVB, I_SARE, I_SAIM, I_SLDT, I_SBRE, I_SBIM, I_SCRE, I_SCIM,
       I_SD, I_WGLU, I_WBA, I_WBS, I_WBC, I_WOUT, I_LN1G, I_LN1B, I_WUP, I_WDOWN, I_LN2G, I_LN2B };

__device__ __forceinline__ float wave_sum(float v) {
#pragma unroll
    for (int o = 1; o < 64; o <<= 1) v += __shfl_xor(v, o);
    return v;
}
__device__ __forceinline__ float wave_max(float v) {
#pragma unroll
    for (int o = 1; o < 64; o <<= 1) v = fmaxf(v, __shfl_xor(v, o));
    return v;
}
__device__ __forceinline__ float sigmoidf_(float x) { return 1.0f / (1.0f + __expf(-x)); }
__device__ __forceinline__ float gelu_tanh(float x) {
    const float u = 0.7978845608028654f * (x + 0.044715f * x * x * x);
    const float e = __expf(2.0f * u);
    const float t = 1.0f - 2.0f / (e + 1.0f);
    return 0.5f * x * (1.0f + t);
}
__device__ __forceinline__ f16x8 pack8(f32x4 lo, f32x4 hi) {
    f16x8 r; r[0] = (f16)lo[0]; r[1] = (f16)lo[1]; r[2] = (f16)lo[2]; r[3] = (f16)lo[3]; r[4] = (f16)hi[0]; r[5] = (f16)hi[1]; r[6] = (f16)hi[2]; r[7] = (f16)hi[3]; return r;
}
__device__ __forceinline__ f16x4 pack4(f32x4 v) { f16x4 r; r[0] = (f16)v[0]; r[1] = (f16)v[1]; r[2] = (f16)v[2]; r[3] = (f16)v[3]; return r; }

struct RowInfo { int b, t, pos, lat, mrow; };
__device__ __forceinline__ RowInfo row_info(int r) {
    RowInfo o;
    if (r < NLAT) { o.lat = 1; o.b = r >> 12; o.t = r & 4095; o.pos = CTX + o.t; o.mrow = o.b; }
    else { const int rr = r - NLAT; o.lat = 0; o.b = rr >> 8; o.t = rr & 255; o.pos = o.t; o.mrow = 4; }
    return o;
}

struct Ctx {
    const Args& A; LAS unsigned char* lds;
    int tid, lane, wid, nblk, bid;
    __device__ __forceinline__ Ctx(const Args& a) : A(a) {}
    __device__ __forceinline__ const float* mod(int l, int mrow, int which) const { return (const float*)(A.ws + WS_MOD) + ((size_t)(l * 5 + mrow) * 6 + which) * D; }
    __device__ __forceinline__ const float* xsrc(int l, int r) const {
        if (l == 0) return r < NLAT ? A.in[I_X] + (size_t)r * D : A.in[I_CTX] + (size_t)(r - NLAT) * D;
        return r < NLAT ? A.out + (size_t)r * D : (const float*)(A.ws + WS_TACTX) + (size_t)(r - NLAT) * D;
    }
    __device__ __forceinline__ float* ta(int r) const { return r < NLAT ? A.out + (size_t)r * D : (float*)(A.ws + WS_TACTX) + (size_t)(r - NLAT) * D; }
};

__device__ __forceinline__ void phase_setup(const Ctx& C) {
    LAS float* sv = (LAS float*)C.lds;
    LAS float* red = sv + 5 * 1024;
    for (int i = C.tid; i < 5 * 1024; i += NTHREADS) {
        const int mr = i >> 10, k = i & 1023;
        const float v = mr < 4 ? C.A.in[I_C][mr * D + k] : C.A.in[I_CCTX][k];
        sv[i] = v / (1.0f + __expf(-v));
    }
    __syncthreads();
    for (int u = C.bid; u < 192; u += C.nblk) {
        const int l = u / 96, n0 = (u % 96) * 64;
        const float* W = C.A.in[I_WMOD] + (size_t)l * D * 6144 + n0 + C.lane;
        float acc[5] = {0.f, 0.f, 0.f, 0.f, 0.f};
        const int kb = C.wid * 128;
#pragma unroll 8
        for (int k = 0; k < 128; ++k) {
            const float w = W[(size_t)(kb + k) * 6144];
#pragma unroll
            for (int m = 0; m < 5; ++m) acc[m] += sv[m * 1024 + kb + k] * w;
        }
#pragma unroll
        for (int m = 0; m < 5; ++m) red[(C.wid * 5 + m) * 64 + C.lane] = acc[m];
        __syncthreads();
        if (C.tid < 320) {
            const int m = C.tid >> 6, c = C.tid & 63; float s = 0.f;
#pragma unroll
            for (int w = 0; w < 8; ++w) s += red[(w * 5 + m) * 64 + c];
            ((float*)(C.A.ws + WS_MOD))[(size_t)(l * 5 + m) * 6144 + n0 + c] = s + C.A.in[I_BMOD][l * 6144 + n0 + c];
        }
        __syncthreads();
    }
    if (C.bid == C.nblk - 1) {
        float* ra = (float*)(C.A.ws + WS_ROPE);
        for (int i = C.tid; i < 1024; i += NTHREADS) {
            const int pos = i >> 4, f = i & 15;
            const float inv = powf(10000.0f, -(float)(2 * f) / 32.0f);
            const float ang = (float)pos * inv;
            ra[i] = cosf(ang); ra[1024 + i] = sinf(ang);
        }
        for (int i = C.tid; i < 512; i += NTHREADS) {
            const int pos = i >> 3, f = i & 7;
            const float inv = powf(10000.0f, -(float)(2 * f) / 16.0f);
            const float ang = (float)pos * inv;
            ra[2048 + i] = cosf(ang); ra[2048 + 512 + i] = sinf(ang);
        }
    }
}

__device__ __forceinline__ int glu_row(int n) { const int isg = n >= 512, j = n & 511; return 8 * (j >> 2) + 4 * isg + (j & 3); }
__device__ __forceinline__ void cvt_item(const float* W, int ldw, int coff, int K, int nblk, f16* WT, int mode, LAS float* scr, int item, int lane) {
    const int kb = item / nblk, nb = item % nblk, k0 = 64 * kb, n0 = 32 * nb;
#pragma unroll 8
    for (int i = 0; i < 32; ++i) { const int kk = 2 * i + (lane >> 5); scr[kk * 33 + (lane & 31)] = W[(size_t)(k0 + kk) * ldw + coff + n0 + (lane & 31)]; }
    asm volatile("s_waitcnt lgkmcnt(0)" ::: "memory");
    const int c = lane & 7;
#pragma unroll
    for (int j = 0; j < 4; ++j) {
        const int n = (lane >> 3) + 8 * j; const LAS float* s = scr + (8 * c) * 33 + n;
        f16x8 o;
#pragma unroll
        for (int e = 0; e < 8; ++e) o[e] = (f16)s[e * 33];
        const int nn = n0 + n; const int row = mode ? glu_row(nn) : nn;
        *(f16x8*)(WT + (size_t)row * K + k0 + 8 * c) = o;
    }
    asm volatile("s_waitcnt lgkmcnt(0)" ::: "memory");
}
__device__ __forceinline__ void cvt_mat(const Ctx& C, const float* src, int ldw, int coff, int K, int N, size_t dst, int mode, int& base) {
    LAS float* scr = (LAS float*)C.lds + C.wid * (64 * 33);
    const int gw = C.bid * NWAVES + C.wid, ngw = C.nblk * NWAVES;
    const int nblk = N / 32, items = (K / 64) * nblk;
    int first = gw - (base % ngw); if (first < 0) first += ngw;
    for (int it = first; it < items; it += ngw) cvt_item(src, ldw, coff, K, nblk, (f16*)(C.A.ws + dst), mode, scr, it, C.lane);
    base += items;
}
__device__ __forceinline__ void phase_cvt(const Ctx& C, int l) {
    int base = 0;
    cvt_mat(C, C.A.in[I_WIN] + (size_t)l * D * N_IN, N_IN, 0, D, OFF_GATE, W_INA, 0, base);
    cvt_mat(C, C.A.in[I_WIN] + (size_t)l * D * N_IN, N_IN, OFF_GATE, D, 3072, W_GATE, 0, base);
    cvt_mat(C, C.A.in[I_WQB] + (size_t)l * 768 * 768, 768, 0, 768, 768, W_QB, 0, base);
    cvt_mat(C, C.A.in[I_WKVB] + (size_t)l * 256 * 1024, 1024, 0, 256, 1024, W_KVB, 0, base);
    cvt_mat(C, C.A.in[I_WGLU] + (size_t)l * 512 * 1024, 1024, 0, 512, 1024, W_GLU, 1, base);
    cvt_mat(C, C.A.in[I_WBA] + (size_t)l * 512 * 1024, 1024, 0, 512, 1024, W_BR, 0, base);
    cvt_mat(C, C.A.in[I_WBS] + (size_t)l * 512 * 1024, 1024, 0, 512, 1024, W_BR + (size_t)1024 * 512 * 2, 0, base);
    cvt_mat(C, C.A.in[I_WBC] + (size_t)l * 512 * 1024, 1024, 0, 512, 1024, W_BR + (size_t)2 * 1024 * 512 * 2, 0, base);
    cvt_mat(C, C.A.in[I_WOUT] + (size_t)l * 1024 * 1024, 1024, 0, 1024, 1024, W_OUT, 0, base);
    cvt_mat(C, C.A.in[I_WUP] + (size_t)l * 1024 * 4096, 4096, 0, 1024, 4096, W_UP, 0, base);
    cvt_mat(C, C.A.in[I_WDOWN] + (size_t)l * 4096 * 1024, 1024, 0, 4096, 1024, W_DOWN, 0, base);
    f16* pad = (f16*)(C.A.ws + W_INA) + (size_t)OFF_GATE * 1024;
    const f16x8 z = {0, 0, 0, 0, 0, 0, 0, 0};
    for (int i = C.bid * NTHREADS + C.tid; i < (2560 - OFF_GATE) * 1024 / 8; i += C.nblk * NTHREADS) ((f16x8*)pad)[i] = z;
}

__device__ __forceinline__ void row_load(const float* p, int lane, f32x4 (&v)[4]) {
#pragma unroll
    for (int j = 0; j < 4; ++j) v[j] = ((const f32x4*)p)[lane + 64 * j];
}
__device__ __forceinline__ void row_ln(f32x4 (&v)[4]) {
    float s = 0.f;
#pragma unroll
    for (int j = 0; j < 4; ++j) s += (v[j][0] + v[j][1]) + (v[j][2] + v[j][3]);
    const float mean = wave_sum(s) * (1.0f / D);
    float q = 0.f;
#pragma unroll
    for (int j = 0; j < 4; ++j) { v[j] = v[j] - mean; q += (v[j][0] * v[j][0] + v[j][1] * v[j][1]) + (v[j][2] * v[j][2] + v[j][3] * v[j][3]); }
    const float rstd = 1.0f / sqrtf(wave_sum(q) * (1.0f / D) + EPS);
#pragma unroll
    for (int j = 0; j < 4; ++j) v[j] = v[j] * rstd;
}
__device__ __forceinline__ void row_modulate_store(const f32x4 (&v)[4], const float* sh, const float* sc, f16* o, int lane) {
#pragma unroll
    for (int j = 0; j < 4; ++j) {
        const f32x4 s = ((const f32x4*)sc)[lane + 64 * j], t = ((const f32x4*)sh)[lane + 64 * j];
        const f32x4 y = v[j] * (s + 1.0f) + t;
        ((f16x4*)o)[lane + 64 * j] = pack4(y);
    }
}
__device__ __forceinline__ void phase_p1(const Ctx& C, int l) {
    f16* H = (f16*)(C.A.ws + A_H);
    for (int r = C.bid * NWAVES + C.wid; r < MALL; r += C.nblk * NWAVES) {
        const RowInfo ri = row_info(r);
        f32x4 v[4]; row_load(C.xsrc(l, r), C.lane, v); row_ln(v);
        row_modulate_store(v, C.mod(l, ri.mrow, 0), C.mod(l, ri.mrow, 1), H + (size_t)r * D, C.lane);
    }
}
__device__ __forceinline__ void phase_p10(const Ctx& C, int l, int nrows) {
    f16* H = (f16*)(C.A.ws + A_H);
    const float* g = C.A.in[I_LN1G] + l * D; const float* bb = C.A.in[I_LN1B] + l * D;
    for (int r = C.bid * NWAVES + C.wid; r < nrows; r += C.nblk * NWAVES) {
        const RowInfo ri = row_info(r);
        float* t = C.ta(r);
        f32x4 v[4]; row_load(t, C.lane, v); row_ln(v);
#pragma unroll
        for (int j = 0; j < 4; ++j) { v[j] = v[j] * ((const f32x4*)g)[C.lane + 64 * j] + ((const f32x4*)bb)[C.lane + 64 * j]; ((f32x4*)t)[C.lane + 64 * j] = v[j]; }
        row_ln(v);
        row_modulate_store(v, C.mod(l, ri.mrow, 3), C.mod(l, ri.mrow, 4), H + (size_t)r * D, C.lane);
    }
}
__device__ __forceinline__ void phase_p13(const Ctx& C, int l, int nrows) {
    const float* g = C.A.in[I_LN2G] + l * D; const float* bb = C.A.in[I_LN2B] + l * D;
    for (int r = C.bid * NWAVES + C.wid; r < nrows; r += C.nblk * NWAVES) {
        float* t = C.ta(r);
        f32x4 v[4]; row_load(t, C.lane, v); row_ln(v);
#pragma unroll
        for (int j = 0; j < 4; ++j) { v[j] = v[j] * ((const f32x4*)g)[C.lane + 64 * j] + ((const f32x4*)bb)[C.lane + 64 * j]; ((f32x4*)t)[C.lane + 64 * j] = v[j]; }
    }
}
__device__ __forceinline__ void phase_hre(const Ctx& C, int l, int nrows) {
    f16* H = (f16*)(C.A.ws + A_H);
    for (int r = C.bid * NWAVES + C.wid; r < nrows; r += C.nblk * NWAVES) {
        const RowInfo ri = row_info(r);
        f32x4 v[4]; row_load(C.xsrc(l, r), C.lane, v); row_ln(v);
        row_modulate_store(v, C.mod(l, ri.mrow, 0), C.mod(l, ri.mrow, 1), H + (size_t)r * D, C.lane);
    }
}

__device__ __forceinline__ void phase_p3(const Ctx& C, int l) {
    f16* PROJ = (f16*)(C.A.ws + A_PROJ);
    f16* KA = (f16*)(C.A.ws + A_KA); f16* VA = (f16*)(C.A.ws + A_VA); f16* KC = (f16*)(C.A.ws + A_KC); f16* U = (f16*)(C.A.ws + A_U);
    f16* QA = (f16*)(C.A.ws + A_QA);
    const float* ropeA = (const float*)(C.A.ws + WS_ROPE); const float* ropeC = ropeA + 2048;
    const float* akg = C.A.in[I_AKG] + l * 64; const float* aqg = C.A.in[I_AQG] + l * 64;
    const float* ckvg = C.A.in[I_CKVG] + l * 256; const float* cqg = C.A.in[I_CQG] + l * 768;
    const int lane = C.lane;
    for (int r = C.bid * NWAVES + C.wid; r < MALL; r += C.nblk * NWAVES) {
        const RowInfo ri = row_info(r);
        f16* prow = PROJ + (size_t)r * PLD;
        const int prow_i = ri.t >> 6, pcol_i = ri.t & 63;
        float cA = 1.f, sA = 0.f;
        if (ri.lat) { const int part = lane >> 5, j = lane & 15, pi = part ? pcol_i : prow_i; cA = ropeA[pi * 16 + j]; sA = ropeA[1024 + pi * 16 + j]; if (!((lane >> 4) & 1)) sA = -sA; }
#pragma unroll
        for (int hd = 0; hd < 2; ++hd) {
            const float x = (float)prow[OFF_AK + hd * 64 + lane];
            const float ss = wave_sum(x * x);
            float y = x * (1.0f / sqrtf(ss * (1.0f / 64.0f) + EPS)) * akg[lane];
            const float p = __shfl_xor(y, 16);
            y = y * cA + p * sA;
            KA[((size_t)(ri.b * 2 + hd) * NKEY + ri.pos) * 64 + lane] = (f16)y;
            VA[((size_t)(ri.b * 2 + hd) * NKEY + ri.pos) * 64 + lane] = prow[OFF_AV + hd * 64 + lane];
        }
        {
            f16x4 x4 = *(f16x4*)(prow + OFF_CKV + 4 * lane);
            float xf[4]; float ss = 0.f;
#pragma unroll
            for (int e = 0; e < 4; ++e) { xf[e] = (float)x4[e]; ss += xf[e] * xf[e]; }
            ss = wave_sum(ss);
            const float rs = 1.0f / sqrtf(ss * (1.0f / 256.0f) + EPS);
#pragma unroll
            for (int e = 0; e < 4; ++e) x4[e] = (f16)(xf[e] * rs * ckvg[4 * lane + e]);
            *(f16x4*)(prow + OFF_CKV + 4 * lane) = x4;
        }
        {
            const int d = lane & 31;
            float x = (float)prow[OFF_CKR + d];
            float cc = 1.f, sc = 0.f;
            if (ri.lat) { const int part = d >> 4, j = d & 7, pi = part ? pcol_i : prow_i; cc = ropeC[pi * 8 + j]; sc = ropeC[512 + pi * 8 + j]; if (!((d >> 3) & 1)) sc = -sc; }
            const float p = __shfl_xor(x, 8);
            x = x * cc + p * sc;
            if (lane < 32) {
#pragma unroll
                for (int h = 0; h < 8; ++h) KC[((size_t)(ri.b * 8 + h) * NKEY + ri.pos) * 96 + 64 + d] = (f16)x;
            }
        }
        *(f16x8*)(U + (size_t)r * 512 + 8 * lane) = *(const f16x8*)(prow + OFF_U + 8 * lane);
        if (ri.lat || l == 0) {
            f16* qdst = ri.lat ? QA + ((size_t)(ri.b * 8) * SEQ + ri.t) * 64 : QA + (size_t)NB * 8 * SEQ * 64 + ((size_t)(ri.b * 8) * CTX + ri.t) * 64;
            const size_t hstride = ri.lat ? (size_t)SEQ * 64 : (size_t)CTX * 64;
#pragma unroll
            for (int h = 0; h < 8; ++h) {
                const float x = (float)prow[OFF_AQ + h * 64 + lane];
                const float ss = wave_sum(x * x);
                float y = x * (1.0f / sqrtf(ss * (1.0f / 64.0f) + EPS)) * aqg[lane];
                const float p = __shfl_xor(y, 16);
                y = (y * cA + p * sA) * QSCALE_A;
                qdst[h * hstride + lane] = (f16)y;
            }
            f16x4 x4[3]; float ss = 0.f;
#pragma unroll
            for (int i = 0; i < 3; ++i) { x4[i] = *(f16x4*)(prow + OFF_CQ + 256 * i + 4 * lane);
#pragma unroll
                for (int e = 0; e < 4; ++e) { const float f = (float)x4[i][e]; ss += f * f; } }
            ss = wave_sum(ss);
            const float rs = 1.0f / sqrtf(ss * (1.0f / 768.0f) + EPS);
#pragma unroll
            for (int i = 0; i < 3; ++i) {
#pragma unroll
                for (int e = 0; e < 4; ++e) x4[i][e] = (f16)((float)x4[i][e] * rs * cqg[256 * i + 4 * lane + e]);
                *(f16x4*)(prow + OFF_CQ + 256 * i + 4 * lane) = x4[i]; }
        }
    }
}

template <class Epi>
__device__ __forceinline__ void gemm_simple(const Ctx& C, const f16* A, int lda, const f16* Bt, int ldb, int M, int N, int K, const Epi& E, int mskip_from = 1 << 30, int nskip_from = 1 << 30) {
    const int wr = C.wid >> 2, wc = C.wid & 3, fr = C.lane & 15, fq = C.lane >> 4;
    const int tilesN = N / 256, tilesM = M / 64;
    for (int tile = C.bid; tile < tilesM * tilesN; tile += C.nblk) {
        const int tm = tile / tilesN, tn = tile % tilesN;
        if (tm * 64 >= mskip_from && tn * 256 >= nskip_from) continue;
        const int m0 = tm * 64 + wr * 32, n0 = tn * 256 + wc * 64;
        f32x4 acc[2][2][2];
#pragma unroll
        for (int a = 0; a < 2; ++a)
#pragma unroll
            for (int g = 0; g < 2; ++g)
#pragma unroll
                for (int n = 0; n < 2; ++n) acc[a][g][n] = (f32x4){0.f, 0.f, 0.f, 0.f};
        const f16* ap[2]; const f16* bp[2][2];
#pragma unroll
        for (int a = 0; a < 2; ++a) ap[a] = A + (size_t)(m0 + a * 16 + fr) * lda + fq * 8;
#pragma unroll
        for (int g = 0; g < 2; ++g)
#pragma unroll
            for (int n = 0; n < 2; ++n) bp[g][n] = Bt + (size_t)(n0 + g * 32 + 8 * (fr >> 2) + 4 * n + (fr & 3)) * ldb + fq * 8;
        for (int k0 = 0; k0 < K; k0 += 32) {
            f16x8 av[2], bv[2][2];
#pragma unroll
            for (int a = 0; a < 2; ++a) av[a] = *(const f16x8*)(ap[a] + k0);
#pragma unroll
            for (int g = 0; g < 2; ++g)
#pragma unroll
                for (int n = 0; n < 2; ++n) bv[g][n] = *(const f16x8*)(bp[g][n] + k0);
#pragma unroll
            for (int a = 0; a < 2; ++a)
#pragma unroll
                for (int g = 0; g < 2; ++g)
#pragma unroll
                    for (int n = 0; n < 2; ++n) acc[a][g][n] = __builtin_amdgcn_mfma_f32_16x16x32_f16(bv[g][n], av[a], acc[a][g][n], 0, 0, 0);
        }
#pragma unroll
        for (int a = 0; a < 2; ++a)
#pragma unroll
            for (int g = 0; g < 2; ++g) E(m0 + a * 16 + fr, n0 + g * 32 + 8 * fq, acc[a][g][0], acc[a][g][1]);
    }
}

struct EpiStore { f16* O; int ldo;
    __device__ __forceinline__ void operator()(int row, int col, f32x4 lo, f32x4 hi) const { *(f16x8*)(O + (size_t)row * ldo + col) = pack8(lo, hi); } };
struct EpiKvUp { f16* KC; f16* VC;
    __device__ __forceinline__ void operator()(int row, int col, f32x4 lo, f32x4 hi) const {
        const RowInfo ri = row_info(row); const int h = col >> 7, w = col & 127;
        if (w < 64) *(f16x8*)(KC + ((size_t)(ri.b * 8 + h) * NKEY + ri.pos) * 96 + w) = pack8(lo, hi);
        else *(f16x8*)(VC + ((size_t)(ri.b * 8 + h) * NKEY + ri.pos) * 64 + (w - 64)) = pack8(lo, hi);
    } };
struct EpiQUp { f16* QC; const float* ropeC;
    __device__ __forceinline__ void operator()(int row, int col, f32x4 lo, f32x4 hi) const {
        const RowInfo ri = row_info(row); const int h = col / 96, w = col - h * 96;
        if (w >= 64) {
            f32x4 plo, phi;
#pragma unroll
            for (int e = 0; e < 4; ++e) { plo[e] = __shfl_xor(lo[e], 16); phi[e] = __shfl_xor(hi[e], 16); }
            if (ri.lat) {
                const int j0 = w - 64, part = j0 >> 4, second = (j0 >> 3) & 1, pi = part ? (ri.t & 63) : (ri.t >> 6);
                const float* cc = ropeC + pi * 8; const float* ss = ropeC + 512 + pi * 8;
#pragma unroll
                for (int e = 0; e < 4; ++e) {
                    const float s0 = second ? ss[e] : -ss[e], s1 = second ? ss[4 + e] : -ss[4 + e];
                    lo[e] = lo[e] * cc[e] + plo[e] * s0; hi[e] = hi[e] * cc[4 + e] + phi[e] * s1; }
            }
        }
        lo = lo * QSCALE_C; hi = hi * QSCALE_C;
        f16* dst = ri.lat ? QC + ((size_t)(ri.b * 8 + h) * SEQ + ri.t) * 96 + w : QC + (size_t)NB * 8 * SEQ * 96 + ((size_t)(ri.b * 8 + h) * CTX + ri.t) * 96 + w;
        *(f16x8*)dst = pack8(lo, hi);
    } };
struct EpiGlu { f16* YS;
    __device__ __forceinline__ void operator()(int row, int col, f32x4 lo, f32x4 hi) const {
        f32x4 o;
#pragma unroll
        for (int e = 0; e < 4; ++e) o[e] = lo[e] * sigmoidf_(hi[e]);
        *(f16x4*)(YS + (size_t)row * 512 + (col >> 1)) = pack4(o);
    } };
struct EpiGate { f16* G;
    __device__ __forceinline__ void operator()(int row, int col, f32x4 lo, f32x4 hi) const {
#pragma unroll
        for (int e = 0; e < 4; ++e) { lo[e] = sigmoidf_(lo[e]); hi[e] = sigmoidf_(hi[e]); }
        *(f16x8*)(G + (size_t)row * 1024 + col) = pack8(lo, hi);
    } };
struct EpiBranch { const f16* G; f16* Mg; int first;
    __device__ __forceinline__ void operator()(int row, int col, f32x4 lo, f32x4 hi) const {
        const f16x8 g = *(const f16x8*)(G + (size_t)row * 1024 + col);
        f16x8 m = {0, 0, 0, 0, 0, 0, 0, 0};
        if (!first) m = *(const f16x8*)(Mg + (size_t)row * 1024 + col);
#pragma unroll
        for (int e = 0; e < 4; ++e) { lo[e] = (float)m[e] + (float)g[e] * lo[e]; hi[e] = (float)m[4 + e] + (float)g[4 + e] * hi[e]; }
        *(f16x8*)(Mg + (size_t)row * 1024 + col) = pack8(lo, hi);
    } };
struct EpiWout { const Ctx* C; int l;
    __device__ __forceinline__ void operator()(int row, int col, f32x4 lo, f32x4 hi) const {
        const RowInfo ri = row_info(row); const float* x = C->xsrc(l, row) + col; const float* g = C->mod(l, ri.mrow, 2) + col; float* t = C->ta(row) + col;
        const f32x4 x0 = *(const f32x4*)x, x1 = *(const f32x4*)(x + 4), g0 = *(const f32x4*)g, g1 = *(const f32x4*)(g + 4);
        *(f32x4*)t = x0 * ALPHA + g0 * lo; *(f32x4*)(t + 4) = x1 * ALPHA + g1 * hi;
    } };
struct EpiUp { f16* Hd;
    __device__ __forceinline__ void operator()(int row, int col, f32x4 lo, f32x4 hi) const {
#pragma unroll
        for (int e = 0; e < 4; ++e) { const float a = fmaxf(lo[e], 0.f), b = fmaxf(hi[e], 0.f); lo[e] = a * a; hi[e] = b * b; }
        *(f16x8*)(Hd + (size_t)row * DFF + col) = pack8(lo, hi);
    } };
struct EpiDown { const Ctx* C; int l;
    __device__ __forceinline__ void operator()(int row, int col, f32x4 lo, f32x4 hi) const {
        const RowInfo ri = row_info(row); const float* g = C->mod(l, ri.mrow, 5) + col; float* t = C->ta(row) + col;
        const f32x4 x0 = *(const f32x4*)t, x1 = *(const f32x4*)(t + 4), g0 = *(const f32x4*)g, g1 = *(const f32x4*)(g + 4);
        *(f32x4*)t = x0 * ALPHA + g0 * lo; *(f32x4*)(t + 4) = x1 * ALPHA + g1 * hi;
    } };

typedef _Float16 f16x2 __attribute__((ext_vector_type(2)));
template <int DQK>
__device__ __forceinline__ void attn_naive_query(const f16* q, const f16* Kh, const f16* Vh, int nkeys, f16* out, LAS float* scr, int lane) {
    f16x8 qv[DQK / 8];
#pragma unroll
    for (int c = 0; c < DQK / 8; ++c) qv[c] = *(const f16x8*)(q + 8 * c);
    float m = -1e30f, ls = 0.f; float acc[64];
#pragma unroll
    for (int d = 0; d < 64; ++d) acc[d] = 0.f;
    for (int j = lane; j < nkeys; j += 64) {
        const f16* kr = Kh + (size_t)j * DQK; const f16* vr = Vh + (size_t)j * 64;
        float s = 0.f;
#pragma unroll
        for (int c = 0; c < DQK / 8; ++c) { const f16x8 v = *(const f16x8*)(kr + 8 * c);
#pragma unroll
            for (int e = 0; e < 4; ++e) s = __builtin_amdgcn_fdot2((f16x2){qv[c][2 * e], qv[c][2 * e + 1]}, (f16x2){v[2 * e], v[2 * e + 1]}, s, false); }
        const float mn = fmaxf(m, s), a = exp2f(m - mn), p = exp2f(s - mn);
        ls = ls * a + p; m = mn;
#pragma unroll
        for (int c = 0; c < 8; ++c) { const f16x8 v = *(const f16x8*)(vr + 8 * c);
#pragma unroll
            for (int e = 0; e < 8; ++e) acc[8 * c + e] = acc[8 * c + e] * a + p * (float)v[e]; }
    }
    const float mg = wave_max(m), w = exp2f(m - mg);
    const float L = wave_sum(ls * w);
#pragma unroll
    for (int d = 0; d < 64; ++d) scr[lane * 65 + d] = acc[d] * w;
    asm volatile("s_waitcnt lgkmcnt(0)" ::: "memory");
    float o = 0.f;
#pragma unroll 8
    for (int i = 0; i < 64; ++i) o += scr[i * 65 + lane];
    asm volatile("s_waitcnt lgkmcnt(0)" ::: "memory");
    out[lane] = (f16)(o / L);
}
__device__ __forceinline__ void phase_attn_naive(const Ctx& C, int l) {
    LAS float* scr = (LAS float*)C.lds + C.wid * (64 * 65);
    const f16* QA = (const f16*)(C.A.ws + A_QA); const f16* QC = (const f16*)(C.A.ws + A_QC);
    const f16* KA = (const f16*)(C.A.ws + A_KA); const f16* VA = (const f16*)(C.A.ws + A_VA);
    const f16* KC = (const f16*)(C.A.ws + A_KC); const f16* VC = (const f16*)(C.A.ws + A_VC);
    f16* YA = (f16*)(C.A.ws + A_YA); f16* YC = (f16*)(C.A.ws + A_YC);
    const int NQL = NB * 8 * SEQ, NQC = NB * 8 * CTX;
    const int total = 2 * NQL + (l == 0 ? 2 * NQC : 0);
    for (int u = C.bid * NWAVES + C.wid; u < total; u += C.nblk * NWAVES) {
        int v = u; int type, lat;
        if (v < 2 * NQL) { type = v / NQL; v -= type * NQL; lat = 1; } else { v -= 2 * NQL; type = v / NQC; v -= type * NQC; lat = 0; }
        const int nq = lat ? SEQ : CTX;
        const int t = v % nq, h = (v / nq) & 7, b = v / (nq * 8);
        const int row = lat ? b * SEQ + t : NLAT + b * CTX + t;
        const int nkeys = lat ? NKEY : CTX;
        if (type == 0) {
            const f16* q = lat ? QA + ((size_t)(b * 8 + h) * SEQ + t) * 64 : QA + (size_t)NB * 8 * SEQ * 64 + ((size_t)(b * 8 + h) * CTX + t) * 64;
            attn_naive_query<64>(q, KA + (size_t)(b * 2 + (h >> 2)) * NKEY * 64, VA + (size_t)(b * 2 + (h >> 2)) * NKEY * 64, nkeys, YA + (size_t)row * 512 + h * 64, scr, C.lane);
        } else {
            const f16* q = lat ? QC + ((size_t)(b * 8 + h) * SEQ + t) * 96 : QC + (size_t)NB * 8 * SEQ * 96 + ((size_t)(b * 8 + h) * CTX + t) * 96;
            attn_naive_query<96>(q, KC + (size_t)(b * 8 + h) * NKEY * 96, VC + (size_t)(b * 8 + h) * NKEY * 64, nkeys, YC + (size_t)row * 512 + h * 64, scr, C.lane);
        }
    }
}

__device__ __forceinline__ void phase_s5_naive(const Ctx& C, int l) {
    const f16* U = (const f16*)(C.A.ws + A_U); float* YSF = (float*)(C.A.ws + A_YSF);
    LAS float* cst = (LAS float*)C.lds + C.wid * (16 * 128 + 4 * 128);
    LAS float* sst = cst + 16 * 128;
    const int lane = C.lane;
    for (int u = C.bid * NWAVES + C.wid; u < NB * 32; u += C.nblk * NWAVES) {
        const int b = u >> 5, g = u & 31;
        for (int dir = 0; dir < 2; ++dir) {
            const size_t gi = ((size_t)(l * 2 + dir) * 32 + g);
            const float are = C.A.in[I_SARE][gi * 64 + lane], aim = C.A.in[I_SAIM][gi * 64 + lane];
            const float dt = expf(C.A.in[I_SLDT][gi]);
            const float mag = expf(are * dt), th = aim * dt;
            const float abr = mag * cosf(th), abi = mag * sinf(th);
            const float den = are * are + aim * aim, nr = abr - 1.0f;
            const float cr = (nr * are + abi * aim) / den, ci = (abi * are - nr * aim) / den;
            float bbr[16], bbi[16];
#pragma unroll
            for (int c = 0; c < 16; ++c) {
                const float br = C.A.in[I_SBRE][(gi * 64 + lane) * 16 + c], bi = C.A.in[I_SBIM][(gi * 64 + lane) * 16 + c];
                bbr[c] = cr * br - ci * bi; bbi[c] = cr * bi + ci * br; }
#pragma unroll
            for (int c = 0; c < 16; ++c) { cst[c * 128 + lane] = C.A.in[I_SCRE][(gi * 16 + c) * 64 + lane]; cst[c * 128 + 64 + lane] = C.A.in[I_SCIM][(gi * 16 + c) * 64 + lane]; }
            asm volatile("s_waitcnt lgkmcnt(0)" ::: "memory");
            float xr = 0.f, xi = 0.f;
            const int tk = lane >> 4, cc = lane & 15;
            const float dcoef = C.A.in[I_SD][l * 512 + g * 16 + cc];
            for (int i0 = 0; i0 < NKEY; i0 += 4) {
                int rows[4];
#pragma unroll
                for (int k = 0; k < 4; ++k) {
                    const int i = i0 + k; int row;
                    if (dir == 0) row = i < CTX ? NLAT + b * CTX + i : b * SEQ + (i - CTX);
                    else row = i < CTX ? NLAT + b * CTX + (CTX - 1 - i) : b * SEQ + (SEQ - 1 - (i - CTX));
                    rows[k] = row;
                    const f16x8 u0 = *(const f16x8*)(U + (size_t)row * 512 + g * 16), u1 = *(const f16x8*)(U + (size_t)row * 512 + g * 16 + 8);
                    float bur = 0.f, bui = 0.f;
#pragma unroll
                    for (int c = 0; c < 8; ++c) { bur += bbr[c] * (float)u0[c] + bbr[8 + c] * (float)u1[c]; bui += bbi[c] * (float)u0[c] + bbi[8 + c] * (float)u1[c]; }
                    const float nxr = abr * xr - abi * xi + bur, nxi = abr * xi + abi * xr + bui;
                    xr = nxr; xi = nxi;
                    sst[k * 128 + lane] = xr; sst[k * 128 + 64 + lane] = xi;
                }
                asm volatile("s_waitcnt lgkmcnt(0)" ::: "memory");
                float y = 0.f;
#pragma unroll 16
                for (int p = 0; p < 64; ++p) y += cst[cc * 128 + p] * sst[tk * 128 + p] - cst[cc * 128 + 64 + p] * sst[tk * 128 + 64 + p];
                asm volatile("s_waitcnt lgkmcnt(0)" ::: "memory");
                int myrow = rows[0];
#pragma unroll
                for (int k = 1; k < 4; ++k) myrow = (tk == k) ? rows[k] : myrow;
                if (myrow < NLAT || l == 0) {
                    float* dst = YSF + (size_t)myrow * 512 + g * 16 + cc;
                    if (dir == 0) *dst = y + dcoef * (float)U[(size_t)myrow * 512 + g * 16 + cc];
                    else *dst = *dst + y;
                }
            }
            asm volatile("s_waitcnt vmcnt(0)" ::: "memory");
            __builtin_amdgcn_fence(__ATOMIC_RELEASE, "workgroup");
        }
    }
}
__device__ __forceinline__ void phase_s5_gelu(const Ctx& C, int nrows) {
    const float* YSF = (const float*)(C.A.ws + A_YSF); f16* G = (f16*)(C.A.ws + A_G);
    const size_t n4 = (size_t)nrows * 512 / 4;
    for (size_t i = (size_t)C.bid * NTHREADS + C.tid; i < n4; i += (size_t)C.nblk * NTHREADS) {
        f32x4 v = ((const f32x4*)YSF)[i];
#pragma unroll
        for (int e = 0; e < 4; ++e) v[e] = gelu_tanh(v[e]);
        ((f16x4*)G)[i] = pack4(v);
    }
}

constexpr int NPL = 14;
template <int K>
__global__ void __launch_bounds__(NTHREADS, 2) fwd(Args args, int l) {
    extern __shared__ __attribute__((aligned(16))) unsigned char lds_raw[];
    Ctx C(args);
    C.lds = (LAS unsigned char*)lds_raw;
    C.tid = threadIdx.x; C.lane = C.tid & 63; C.wid = __builtin_amdgcn_readfirstlane(C.tid >> 6); C.nblk = gridDim.x; C.bid = blockIdx.x;
    unsigned char* ws = args.ws;
    const int mrows = l == 0 ? MALL : NLAT;
    if constexpr (K == 100) phase_setup(C);
    if constexpr (K == 0) { phase_cvt(C, l); phase_p1(C, l); }
    if constexpr (K == 1) { EpiStore E{(f16*)(ws + A_PROJ), PLD};
        gemm_simple(C, (const f16*)(ws + A_H), D, (const f16*)(ws + W_INA), D, MALL, 2560, D, E, l == 0 ? (1 << 30) : NLAT, l == 0 ? (1 << 30) : 1280); }
    if constexpr (K == 2) phase_p3(C, l);
    if constexpr (K == 3) { EpiKvUp E1{(f16*)(ws + A_KC), (f16*)(ws + A_VC)};
        gemm_simple(C, (const f16*)(ws + A_PROJ) + OFF_CKV, PLD, (const f16*)(ws + W_KVB), 256, MALL, 1024, 256, E1);
        EpiQUp E2{(f16*)(ws + A_QC), (const float*)(ws + WS_ROPE) + 2048};
        gemm_simple(C, (const f16*)(ws + A_PROJ) + OFF_CQ, PLD, (const f16*)(ws + W_QB), 768, mrows, 768, 768, E2); }
    if constexpr (K == 4) phase_attn_naive(C, l);
    if constexpr (K == 5) phase_s5_naive(C, l);
    if constexpr (K == 6) phase_s5_gelu(C, mrows);
    if constexpr (K == 7) { EpiGlu E{(f16*)(ws + A_YS)};
        gemm_simple(C, (const f16*)(ws + A_G), 512, (const f16*)(ws + W_GLU), 512, mrows, 1024, 512, E);
        phase_hre(C, l, mrows); }
    if constexpr (K == 8) {
#pragma unroll 1
        for (int br = 0; br < 3; ++br) {
            const f16* Y = (const f16*)(ws + (br == 0 ? A_YA : br == 1 ? A_YS : A_YC));
            EpiGate Eg{(f16*)(ws + A_GATE)};
            gemm_simple(C, (const f16*)(ws + A_H), D, (const f16*)(ws + W_GATE) + (size_t)br * 1024 * 1024, D, mrows, 1024, D, Eg);
            EpiBranch Eb{(const f16*)(ws + A_GATE), (f16*)(ws + A_MERGED), br == 0};
            gemm_simple(C, Y, 512, (const f16*)(ws + W_BR) + (size_t)br * 1024 * 512, 512, mrows, 1024, 512, Eb);
        } }
    if constexpr (K == 9) { EpiWout E{&C, l}; gemm_simple(C, (const f16*)(ws + A_MERGED), D, (const f16*)(ws + W_OUT), D, mrows, 1024, D, E); }
    if constexpr (K == 10) phase_p10(C, l, mrows);
    if constexpr (K == 11) { EpiUp E{(f16*)(ws + A_HID)}; gemm_simple(C, (const f16*)(ws + A_H), D, (const f16*)(ws + W_UP), D, mrows, DFF, D, E); }
    if constexpr (K == 12) { EpiDown E{&C, l}; gemm_simple(C, (const f16*)(ws + A_HID), DFF, (const f16*)(ws + W_DOWN), DFF, mrows, 1024, DFF, E); }
    if constexpr (K == 13) phase_p13(C, l, mrows);
}

template <int K> static void launch_phase(const Args& a, int l, hipStream_t stream) {
    static bool attr = false;
    if (!attr) { (void)hipFuncSetAttribute((const void*)fwd<K>, hipFuncAttributeMaxDynamicSharedMemorySize, LDS_BYTES); attr = true; }
    hipLaunchKernelGGL(fwd<K>, dim3(256), dim3(NTHREADS), LDS_BYTES, stream, a, l);
}
extern "C" void kernel_launch(void* const* d_in, const int* in_sizes, int n_in, void* d_out, int out_size, void* d_ws, size_t ws_size, hipStream_t stream) {
    if (n_in != 32 || out_size != NLAT * D || ws_size < WS_NEED) { fprintf(stderr, "kernel_launch: unexpected shapes n_in %d out %d ws %zu (need %zu)\n", n_in, out_size, ws_size, (size_t)WS_NEED); return; }
    Args a{};
    for (int i = 0; i < 32; ++i) a.in[i] = (const float*)d_in[i];
    a.out = (float*)d_out; a.ws = (unsigned char*)d_ws;
    launch_phase<100>(a, 0, stream);
    for (int l = 0; l < 2; ++l) {
        launch_phase<0>(a, l, stream); launch_phase<1>(a, l, stream); launch_phase<2>(a, l, stream); launch_phase<3>(a, l, stream);
        launch_phase<4>(a, l, stream); launch_phase<5>(a, l, stream); launch_phase<6>(a, l, stream); launch_phase<7>(a, l, stream);
        launch_phase<8>(a, l, stream); launch_phase<9>(a, l, stream); launch_phase<10>(a, l, stream); launch_phase<11>(a, l, stream);
        launch_phase<12>(a, l, stream); launch_phase<13>(a, l, stream);
    }
    const hipError_t le = hipPeekAtLastError();
    if (le != hipSuccess) fprintf(stderr, "kernel_launch: launch failed: %s\n", hipGetErrorName(le));
}
```

```cpp
#include <hip/hip_runtime.h>
#include <hip/hip_cooperative_groups.h>
#include <cstdio>
#include <cstdint>
#include <cmath>

namespace cg = cooperative_groups;

#define LAS __attribute__((address_space(3)))
typedef _Float16 f16;
typedef _Float16 f16x8 __attribute__((ext_vector_type(8)));
typedef _Float16 f16x4 __attribute__((ext_vector_type(4)));
typedef float f32x4 __attribute__((ext_vector_type(4)));
typedef float f32x16 __attribute__((ext_vector_type(16)));

constexpr int D = 1024, NB = 4, SEQ = 4096, CTX = 256, NLAT = NB * SEQ, NCTX = NB * CTX, MALL = NLAT + NCTX;
constexpr int NKEY = CTX + SEQ;
constexpr int OFF_AK = 0, OFF_AV = 128, OFF_CKV = 256, OFF_CKR = 512, OFF_U = 544, OFF_AQ = 1056, OFF_CQ = 1568, OFF_GATE = 2336, N_IN = 5408;
constexpr int PLD = 2560;
constexpr int DFF = 4096;
constexpr float EPS = 1e-6f;
constexpr float ALPHA = 1.4142135623730951f;
constexpr float LOG2E = 1.4426950408889634f;
constexpr float QSCALE_A = 0.125f * LOG2E;
constexpr float QSCALE_C = 0.10206207261596575f * LOG2E;

constexpr size_t MiB = 1u << 20;
constexpr size_t WS_CTL = 0;
constexpr size_t WS_MOD = 1 * MiB;
constexpr size_t WS_ROPE = 1 * MiB + 512 * 1024;
constexpr size_t WS_W16 = 2 * MiB;
constexpr size_t W_INA = WS_W16;
constexpr size_t W_GATE = W_INA + (size_t)2560 * 1024 * 2;
constexpr size_t W_QB = W_GATE + (size_t)3072 * 1024 * 2;
constexpr size_t W_KVB = W_QB + (size_t)768 * 768 * 2;
constexpr size_t W_GLU = W_KVB + (size_t)1024 * 256 * 2;
constexpr size_t W_BR = W_GLU + (size_t)1024 * 512 * 2;
constexpr size_t W_OUT = W_BR + (size_t)3 * 1024 * 512 * 2;
constexpr size_t W_UP = W_OUT + (size_t)1024 * 1024 * 2;
constexpr size_t W_DOWN = W_UP + (size_t)4096 * 1024 * 2;
constexpr size_t W_END = W_DOWN + (size_t)1024 * 4096 * 2;
constexpr size_t WS_TACTX = 37 * MiB;
constexpr size_t WS_ACT = 41 * MiB;
static_assert(W_END <= WS_TACTX, "weights fit");
constexpr size_t A_H = WS_ACT + 0 * MiB;
constexpr size_t A_QC = WS_ACT + 0 * MiB;
constexpr size_t A_PROJ = WS_ACT + 34 * MiB;
constexpr size_t A_YA = WS_ACT + 34 * MiB;
constexpr size_t A_YC = WS_ACT + 51 * MiB;
constexpr size_t A_YSF = WS_ACT + 68 * MiB;
constexpr size_t A_G = WS_ACT + 102 * MiB;
constexpr size_t A_QA = WS_ACT + 119 * MiB;
constexpr size_t A_YS = WS_ACT + 119 * MiB;
constexpr size_t A_KA = WS_ACT + 136 * MiB;
constexpr size_t A_VA = A_KA + (size_t)NB * 2 * NKEY * 64 * 2;
constexpr size_t A_U = WS_ACT + 145 * MiB;
constexpr size_t A_KC = WS_ACT + 162 * MiB;
constexpr size_t A_VC = WS_ACT + 188 * MiB;
constexpr size_t A_GATE = WS_ACT + 136 * MiB;
constexpr size_t A_MERGED = WS_ACT + 170 * MiB;
constexpr size_t A_HID = WS_ACT + 34 * MiB;
constexpr size_t WS_NEED = WS_ACT + 205 * MiB;
static_assert(A_VA + (size_t)NB * 2 * NKEY * 64 * 2 <= A_U && A_VC + 17 * MiB <= WS_NEED && A_MERGED + 34 * MiB <= WS_NEED && A_HID + 136 * MiB <= WS_NEED, "ws map");
static_assert(WS_NEED <= 256 * MiB, "ws budget");

constexpr int LDS_BYTES = 147456;
constexpr int NTHREADS = 512, NWAVES = 8;

struct Args {
    const float* in[32];
    float* out;
    unsigned char* ws;
    int ph_lo, ph_hi;
};
enum { I_X = 0, I_C, I_CTX, I_CCTX, I_WMOD, I_BMOD, I_WIN, I_AQG, I_AKG, I_CQG, I_CKVG, I_WQB, I_WKVB, I_SARE, I_SAIM, I_SLDT, I_SBRE, I_SBIM, I_SCRE, I_SCIM,
       I_SD, I_WGLU, I_WBA, I_WBS, I_WBC, I_WOUT, I_LN1G, I_LN1B, I_WUP, I_WDOWN, I_LN2G, I_LN2B };

__device__ __forceinline__ float wave_sum(float v) {
#pragma unroll
    for (int o = 1; o < 64; o <<= 1) v += __shfl_xor(v, o);
    return v;
}
__device__ __forceinline__ float wave_max(float v) {
#pragma unroll
    for (int o = 1; o < 64; o <<= 1) v = fmaxf(v, __shfl_xor(v, o));
    return v;
}
__device__ __forceinline__ float sigmoidf_(float x) { return 1.0f / (1.0f + __expf(-x)); }
__device__ __forceinline__ float gelu_tanh(float x) {
    const float u = 0.7978845608028654f * (x + 0.044715f * x * x * x);
    const float e = __expf(2.0f * u);
    const float t = 1.0f - 2.0f / (e + 1.0f);
    return 0.5f * x * (1.0f + t);
}
__device__ __forceinline__ f16x8 pack8(f32x4 lo, f32x4 hi) {
    f16x8 r; r[0] = (f16)lo[0]; r[1] = (f16)lo[1]; r[2] = (f16)lo[2]; r[3] = (f16)lo[3]; r[4] = (f16)hi[0]; r[5] = (f16)hi[1]; r[6] = (f16)hi[2]; r[7] = (f16)hi[3]; return r;
}
__device__ __forceinline__ f16x4 pack4(f32x4 v) { f16x4 r; r[0] = (f16)v[0]; r[1] = (f16)v[1]; r[2] = (f16)v[2]; r[3] = (f16)v[3]; return r; }

struct RowInfo { int b, t, pos, lat, mrow; };
__device__ __forceinline__ RowInfo row_info(int r) {
    RowInfo o;
    if (r < NLAT) { o.lat = 1; o.b = r >> 12; o.t = r & 4095; o.pos = CTX + o.t; o.mrow = o.b; }
    else { const int rr = r - NLAT; o.lat = 0; o.b = rr >> 8; o.t = rr & 255; o.pos = o.t; o.mrow = 4; }
    return o;
}

#define CAS __attribute__((address_space(4)))
struct Ctx {
    const CAS unsigned char* kp; LAS unsigned char* lds;
    int tid, lane, wid, nblk, bid;
    __device__ __forceinline__ const float* in(int i) const { return *(const float* const CAS*)(kp + 8 * i); }
    __device__ __forceinline__ float* out() const { return *(float* const CAS*)(kp + 256); }
    __device__ __forceinline__ unsigned char* ws() const { return *(unsigned char* const CAS*)(kp + 264); }
    __device__ __forceinline__ const float* mod(int l, int mrow, int which) const { return (const float*)(ws() + WS_MOD) + ((size_t)(l * 5 + mrow) * 6 + which) * D; }
    __device__ __forceinline__ const float* xsrc(int l, int r) const {
        if (l == 0) return r < NLAT ? in(I_X) + (size_t)r * D : in(I_CTX) + (size_t)(r - NLAT) * D;
        return r < NLAT ? out() + (size_t)r * D : (const float*)(ws() + WS_TACTX) + (size_t)(r - NLAT) * D;
    }
    __device__ __forceinline__ float* ta(int r) const { return r < NLAT ? out() + (size_t)r * D : (float*)(ws() + WS_TACTX) + (size_t)(r - NLAT) * D; }
};
__device__ __forceinline__ Ctx make_ctx() {
    extern __shared__ __attribute__((aligned(16))) unsigned char lds_raw[];
    Ctx C;
    const CAS unsigned char* kp = (const CAS unsigned char*)__builtin_amdgcn_kernarg_segment_ptr();
    asm volatile("" : "+s"(kp));
    C.kp = kp; C.lds = (LAS unsigned char*)lds_raw;
    int tid = threadIdx.x; asm volatile("" : "+v"(tid));
    C.tid = tid; C.lane = tid & 63; C.wid = __builtin_amdgcn_readfirstlane(tid >> 6);
    int bid = blockIdx.x; asm volatile("" : "+s"(bid));
    C.bid = bid; C.nblk = gridDim.x;
    return C;
}

__device__ __forceinline__ void phase_setup(const Ctx& C) {
    LAS float* sv = (LAS float*)C.lds;
    LAS float* red = sv + 5 * 1024;
    for (int i = C.tid; i < 5 * 1024; i += NTHREADS) {
        const int mr = i >> 10, k = i & 1023;
        const float v = mr < 4 ? C.in(I_C)[mr * D + k] : C.in(I_CCTX)[k];
        sv[i] = v / (1.0f + __expf(-v));
    }
    __syncthreads();
    for (int u = C.bid; u < 192; u += C.nblk) {
        const int l = u / 96, n0 = (u % 96) * 64;
        const float* W = C.in(I_WMOD) + (size_t)l * D * 6144 + n0 + C.lane;
        float acc[5] = {0.f, 0.f, 0.f, 0.f, 0.f};
        const int kb = C.wid * 128;
#pragma unroll 8
        for (int k = 0; k < 128; ++k) {
            const float w = W[(size_t)(kb + k) * 6144];
#pragma unroll
            for (int m = 0; m < 5; ++m) acc[m] += sv[m * 1024 + kb + k] * w;
        }
#pragma unroll
        for (int m = 0; m < 5; ++m) red[(C.wid * 5 + m) * 64 + C.lane] = acc[m];
        __syncthreads();
        if (C.tid < 320) {
            const int m = C.tid >> 6, c = C.tid & 63; float s = 0.f;
#pragma unroll
            for (int w = 0; w < 8; ++w) s += red[(w * 5 + m) * 64 + c];
            ((float*)(C.ws() + WS_MOD))[(size_t)(l * 5 + m) * 6144 + n0 + c] = s + C.in(I_BMOD)[l * 6144 + n0 + c];
        }
        __syncthreads();
    }
    if (C.bid == C.nblk - 1) {
        float* ra = (float*)(C.ws() + WS_ROPE);
        for (int i = C.tid; i < 1024; i += NTHREADS) {
            const int pos = i >> 4, f = i & 15;
            const float inv = powf(10000.0f, -(float)(2 * f) / 32.0f);
            const float ang = (float)pos * inv;
            ra[i] = cosf(ang); ra[1024 + i] = sinf(ang);
        }
        for (int i = C.tid; i < 512; i += NTHREADS) {
            const int pos = i >> 3, f = i & 7;
            const float inv = powf(10000.0f, -(float)(2 * f) / 16.0f);
            const float ang = (float)pos * inv;
            ra[2048 + i] = cosf(ang); ra[2048 + 512 + i] = sinf(ang);
        }
    }
}

__device__ __forceinline__ int glu_row(int n) { const int isg = n >= 512, j = n & 511; return 8 * (j >> 2) + 4 * isg + (j & 3); }
__device__ __forceinline__ void cvt_item(const float* W, int ldw, int coff, int K, int nblk, f16* WT, int mode, LAS float* scr, int item, int lane) {
    const int kb = item / nblk, nb = item % nblk, k0 = 64 * kb, n0 = 32 * nb;
#pragma unroll 8
    for (int i = 0; i < 32; ++i) { const int kk = 2 * i + (lane >> 5); scr[kk * 33 + (lane & 31)] = W[(size_t)(k0 + kk) * ldw + coff + n0 + (lane & 31)]; }
    asm volatile("s_waitcnt lgkmcnt(0)" ::: "memory");
    const int c = lane & 7;
#pragma unroll
    for (int j = 0; j < 4; ++j) {
        const int n = (lane >> 3) + 8 * j; const LAS float* s = scr + (8 * c) * 33 + n;
        f16x8 o;
#pragma unroll
        for (int e = 0; e < 8; ++e) o[e] = (f16)s[e * 33];
        const int nn = n0 + n; const int row = mode ? glu_row(nn) : nn;
        *(f16x8*)(WT + (size_t)row * K + k0 + 8 * c) = o;
    }
    asm volatile("s_waitcnt lgkmcnt(0)" ::: "memory");
}
__device__ __forceinline__ void cvt_mat(const Ctx& C, const float* src, int ldw, int coff, int K, int N, size_t dst, int mode, int& base) {
    LAS float* scr = (LAS float*)C.lds + C.wid * (64 * 33);
    const int gw = C.bid * NWAVES + C.wid, ngw = C.nblk * NWAVES;
    const int nblk = N / 32, items = (K / 64) * nblk;
    int first = gw - (base % ngw); if (first < 0) first += ngw;
    for (int it = first; it < items; it += ngw) cvt_item(src, ldw, coff, K, nblk, (f16*)(C.ws() + dst), mode, scr, it, C.lane);
    base += items;
}
__device__ __forceinline__ void phase_cvt(const Ctx& C, int l) {
    int base = 0;
    cvt_mat(C, C.in(I_WIN) + (size_t)l * D * N_IN, N_IN, 0, D, OFF_GATE, W_INA, 0, base);
    cvt_mat(C, C.in(I_WIN) + (size_t)l * D * N_IN, N_IN, OFF_GATE, D, 3072, W_GATE, 0, base);
    cvt_mat(C, C.in(I_WQB) + (size_t)l * 768 * 768, 768, 0, 768, 768, W_QB, 0, base);
    cvt_mat(C, C.in(I_WKVB) + (size_t)l * 256 * 1024, 1024, 0, 256, 1024, W_KVB, 0, base);
    cvt_mat(C, C.in(I_WGLU) + (size_t)l * 512 * 1024, 1024, 0, 512, 1024, W_GLU, 1, base);
    cvt_mat(C, C.in(I_WBA) + (size_t)l * 512 * 1024, 1024, 0, 512, 1024, W_BR, 0, base);
    cvt_mat(C, C.in(I_WBS) + (size_t)l * 512 * 1024, 1024, 0, 512, 1024, W_BR + (size_t)1024 * 512 * 2, 0, base);
    cvt_mat(C, C.in(I_WBC) + (size_t)l * 512 * 1024, 1024, 0, 512, 1024, W_BR + (size_t)2 * 1024 * 512 * 2, 0, base);
    cvt_mat(C, C.in(I_WOUT) + (size_t)l * 1024 * 1024, 1024, 0, 1024, 1024, W_OUT, 0, base);
    cvt_mat(C, C.in(I_WUP) + (size_t)l * 1024 * 4096, 4096, 0, 1024, 4096, W_UP, 0, base);
    cvt_mat(C, C.in(I_WDOWN) + (size_t)l * 4096 * 1024, 1024, 0, 4096, 1024, W_DOWN, 0, base);
    f16* pad = (f16*)(C.ws() + W_INA) + (size_t)OFF_GATE * 1024;
    const f16x8 z = {0, 0, 0, 0, 0, 0, 0, 0};
    for (int i = C.bid * NTHREADS + C.tid; i < (2560 - OFF_GATE) * 1024 / 8; i += C.nblk * NTHREADS) ((f16x8*)pad)[i] = z;
}

__device__ __forceinline__ void row_load(const float* p, int lane, f32x4 (&v)[4]) {
#pragma unroll
    for (int j = 0; j < 4; ++j) v[j] = ((const f32x4*)p)[lane + 64 * j];
}
__device__ __forceinline__ void row_ln(f32x4 (&v)[4]) {
    float s = 0.f;
#pragma unroll
    for (int j = 0; j < 4; ++j) s += (v[j][0] + v[j][1]) + (v[j][2] + v[j][3]);
    const float mean = wave_sum(s) * (1.0f / D);
    float q = 0.f;
#pragma unroll
    for (int j = 0; j < 4; ++j) { v[j] = v[j] - mean; q += (v[j][0] * v[j][0] + v[j][1] * v[j][1]) + (v[j][2] * v[j][2] + v[j][3] * v[j][3]); }
    const float rstd = 1.0f / sqrtf(wave_sum(q) * (1.0f / D) + EPS);
#pragma unroll
    for (int j = 0; j < 4; ++j) v[j] = v[j] * rstd;
}
__device__ __forceinline__ void row_modulate_store(const f32x4 (&v)[4], const float* sh, const float* sc, f16* o, int lane) {
#pragma unroll
    for (int j = 0; j < 4; ++j) {
        const f32x4 s = ((const f32x4*)sc)[lane + 64 * j], t = ((const f32x4*)sh)[lane + 64 * j];
        const f32x4 y = v[j] * (s + 1.0f) + t;
        ((f16x4*)o)[lane + 64 * j] = pack4(y);
    }
}
__device__ __forceinline__ void phase_p1(const Ctx& C, int l) {
    f16* H = (f16*)(C.ws() + A_H);
    for (int r = C.bid * NWAVES + C.wid; r < MALL; r += C.nblk * NWAVES) {
        const RowInfo ri = row_info(r);
        f32x4 v[4]; row_load(C.xsrc(l, r), C.lane, v); row_ln(v);
        row_modulate_store(v, C.mod(l, ri.mrow, 0), C.mod(l, ri.mrow, 1), H + (size_t)r * D, C.lane);
    }
}
__device__ __forceinline__ void phase_p10(const Ctx& C, int l, int nrows) {
    f16* H = (f16*)(C.ws() + A_H);
    const float* g = C.in(I_LN1G) + l * D; const float* bb = C.in(I_LN1B) + l * D;
    for (int r = C.bid * NWAVES + C.wid; r < nrows; r += C.nblk * NWAVES) {
        const RowInfo ri = row_info(r);
        float* t = C.ta(r);
        f32x4 v[4]; row_load(t, C.lane, v); row_ln(v);
#pragma unroll
        for (int j = 0; j < 4; ++j) { v[j] = v[j] * ((const f32x4*)g)[C.lane + 64 * j] + ((const f32x4*)bb)[C.lane + 64 * j]; ((f32x4*)t)[C.lane + 64 * j] = v[j]; }
        row_ln(v);
        row_modulate_store(v, C.mod(l, ri.mrow, 3), C.mod(l, ri.mrow, 4), H + (size_t)r * D, C.lane);
    }
}
__device__ __forceinline__ void phase_p13(const Ctx& C, int l, int nrows) {
    const float* g = C.in(I_LN2G) + l * D; const float* bb = C.in(I_LN2B) + l * D;
    for (int r = C.bid * NWAVES + C.wid; r < nrows; r += C.nblk * NWAVES) {
        float* t = C.ta(r);
        f32x4 v[4]; row_load(t, C.lane, v); row_ln(v);
#pragma unroll
        for (int j = 0; j < 4; ++j) { v[j] = v[j] * ((const f32x4*)g)[C.lane + 64 * j] + ((const f32x4*)bb)[C.lane + 64 * j]; ((f32x4*)t)[C.lane + 64 * j] = v[j]; }
    }
}
__device__ __forceinline__ void phase_hre(const Ctx& C, int l, int nrows) {
    f16* H = (f16*)(C.ws() + A_H);
    for (int r = C.bid * NWAVES + C.wid; r < nrows; r += C.nblk * NWAVES) {
        const RowInfo ri = row_info(r);
        f32x4 v[4]; row_load(C.xsrc(l, r), C.lane, v); row_ln(v);
        row_modulate_store(v, C.mod(l, ri.mrow, 0), C.mod(l, ri.mrow, 1), H + (size_t)r * D, C.lane);
    }
}

__device__ __forceinline__ void phase_p3(const Ctx& C, int l) {
    f16* PROJ = (f16*)(C.ws() + A_PROJ);
    f16* KA = (f16*)(C.ws() + A_KA); f16* VA = (f16*)(C.ws() + A_VA); f16* KC = (f16*)(C.ws() + A_KC); f16* U = (f16*)(C.ws() + A_U);
    f16* QA = (f16*)(C.ws() + A_QA);
    const float* ropeA = (const float*)(C.ws() + WS_ROPE); const float* ropeC = ropeA + 2048;
    const float* akg = C.in(I_AKG) + l * 64; const float* aqg = C.in(I_AQG) + l * 64;
    const float* ckvg = C.in(I_CKVG) + l * 256; const float* cqg = C.in(I_CQG) + l * 768;
    const int lane = C.lane;
    for (int r = C.bid * NWAVES + C.wid; r < MALL; r += C.nblk * NWAVES) {
        const RowInfo ri = row_info(r);
        f16* prow = PROJ + (size_t)r * PLD;
        const int prow_i = ri.t >> 6, pcol_i = ri.t & 63;
        float cA = 1.f, sA = 0.f;
        if (ri.lat) { const int part = lane >> 5, j = lane & 15, pi = part ? pcol_i : prow_i; cA = ropeA[pi * 16 + j]; sA = ropeA[1024 + pi * 16 + j]; if (!((lane >> 4) & 1)) sA = -sA; }
#pragma unroll
        for (int hd = 0; hd < 2; ++hd) {
            const float x = (float)prow[OFF_AK + hd * 64 + lane];
            const float ss = wave_sum(x * x);
            float y = x * (1.0f / sqrtf(ss * (1.0f / 64.0f) + EPS)) * akg[lane];
            const float p = __shfl_xor(y, 16);
            y = y * cA + p * sA;
            KA[((size_t)(ri.b * 2 + hd) * NKEY + ri.pos) * 64 + lane] = (f16)y;
            VA[((size_t)(ri.b * 2 + hd) * NKEY + ri.pos) * 64 + lane] = prow[OFF_AV + hd * 64 + lane];
        }
        {
            f16x4 x4 = *(f16x4*)(prow + OFF_CKV + 4 * lane);
            float xf[4]; float ss = 0.f;
#pragma unroll
            for (int e = 0; e < 4; ++e) { xf[e] = (float)x4[e]; ss += xf[e] * xf[e]; }
            ss = wave_sum(ss);
            const float rs = 1.0f / sqrtf(ss * (1.0f / 256.0f) + EPS);
#pragma unroll
            for (int e = 0; e < 4; ++e) x4[e] = (f16)(xf[e] * rs * ckvg[4 * lane + e]);
            *(f16x4*)(prow + OFF_CKV + 4 * lane) = x4;
        }
        {
            const int d = lane & 31;
            float x = (float)prow[OFF_CKR + d];
            float cc = 1.f, sc = 0.f;
            if (ri.lat) { const int part = d >> 4, j = d & 7, pi = part ? pcol_i : prow_i; cc = ropeC[pi * 8 + j]; sc = ropeC[512 + pi * 8 + j]; if (!((d >> 3) & 1)) sc = -sc; }
            const float p = __shfl_xor(x, 8);
            x = x * cc + p * sc;
            if (lane < 32) {
#pragma unroll
                for (int h = 0; h < 8; ++h) KC[((size_t)(ri.b * 8 + h) * NKEY + ri.pos) * 96 + 64 + d] = (f16)x;
            }
        }
        *(f16x8*)(U + (size_t)r * 512 + 8 * lane) = *(const f16x8*)(prow + OFF_U + 8 * lane);
        if (ri.lat || l == 0) {
            f16* qdst = ri.lat ? QA + ((size_t)(ri.b * 8) * SEQ + ri.t) * 64 : QA + (size_t)NB * 8 * SEQ * 64 + ((size_t)(ri.b * 8) * CTX + ri.t) * 64;
            const size_t hstride = ri.lat ? (size_t)SEQ * 64 : (size_t)CTX * 64;
#pragma unroll
            for (int h = 0; h < 8; ++h) {
                const float x = (float)prow[OFF_AQ + h * 64 + lane];
                const float ss = wave_sum(x * x);
                float y = x * (1.0f / sqrtf(ss * (1.0f / 64.0f) + EPS)) * aqg[lane];
                const float p = __shfl_xor(y, 16);
                y = (y * cA + p * sA) * QSCALE_A;
                qdst[h * hstride + lane] = (f16)y;
            }
            f16x4 x4[3]; float ss = 0.f;
#pragma unroll
            for (int i = 0; i < 3; ++i) { x4[i] = *(f16x4*)(prow + OFF_CQ + 256 * i + 4 * lane);
#pragma unroll
                for (int e = 0; e < 4; ++e) { const float f = (float)x4[i][e]; ss += f * f; } }
            ss = wave_sum(ss);
            const float rs = 1.0f / sqrtf(ss * (1.0f / 768.0f) + EPS);
#pragma unroll
            for (int i = 0; i < 3; ++i) {
#pragma unroll
                for (int e = 0; e < 4; ++e) x4[i][e] = (f16)((float)x4[i][e] * rs * cqg[256 * i + 4 * lane + e]);
                *(f16x4*)(prow + OFF_CQ + 256 * i + 4 * lane) = x4[i]; }
        }
    }
}

template <class Epi>
__device__ __forceinline__ void gemm_simple(const Ctx& C, const f16* A, int lda, const f16* Bt, int ldb, int M, int N, int K, const Epi& E, int mskip_from = 1 << 30, int nskip_from = 1 << 30) {
    const int wr = C.wid >> 2, wc = C.wid & 3, fr = C.lane & 15, fq = C.lane >> 4;
    const int tilesN = N / 256, tilesM = M / 64;
    for (int tile = C.bid; tile < tilesM * tilesN; tile += C.nblk) {
        const int tm = tile / tilesN, tn = tile % tilesN;
        if (tm * 64 >= mskip_from && tn * 256 >= nskip_from) continue;
        const int m0 = tm * 64 + wr * 32, n0 = tn * 256 + wc * 64;
        f32x4 acc[2][2][2];
#pragma unroll
        for (int a = 0; a < 2; ++a)
#pragma unroll
            for (int g = 0; g < 2; ++g)
#pragma unroll
                for (int n = 0; n < 2; ++n) acc[a][g][n] = (f32x4){0.f, 0.f, 0.f, 0.f};
        const f16* ap[2]; const f16* bp[2][2];
#pragma unroll
        for (int a = 0; a < 2; ++a) ap[a] = A + (size_t)(m0 + a * 16 + fr) * lda + fq * 8;
#pragma unroll
        for (int g = 0; g < 2; ++g)
#pragma unroll
            for (int n = 0; n < 2; ++n) bp[g][n] = Bt + (size_t)(n0 + g * 32 + 8 * (fr >> 2) + 4 * n + (fr & 3)) * ldb + fq * 8;
        for (int k0 = 0; k0 < K; k0 += 32) {
            f16x8 av[2], bv[2][2];
#pragma unroll
            for (int a = 0; a < 2; ++a) av[a] = *(const f16x8*)(ap[a] + k0);
#pragma unroll
            for (int g = 0; g < 2; ++g)
#pragma unroll
                for (int n = 0; n < 2; ++n) bv[g][n] = *(const f16x8*)(bp[g][n] + k0);
#pragma unroll
            for (int a = 0; a < 2; ++a)
#pragma unroll
                for (int g = 0; g < 2; ++g)
#pragma unroll
                    for (int n = 0; n < 2; ++n) acc[a][g][n] = __builtin_amdgcn_mfma_f32_16x16x32_f16(bv[g][n], av[a], acc[a][g][n], 0, 0, 0);
        }
#pragma unroll
        for (int a = 0; a < 2; ++a)
#pragma unroll
            for (int g = 0; g < 2; ++g) E(m0 + a * 16 + fr, n0 + g * 32 + 8 * fq, acc[a][g][0], acc[a][g][1]);
    }
}

struct EpiStore { f16* O; int ldo;
    __device__ __forceinline__ void operator()(int row, int col, f32x4 lo, f32x4 hi) const { *(f16x8*)(O + (size_t)row * ldo + col) = pack8(lo, hi); } };
struct EpiKvUp { f16* KC; f16* VC;
    __device__ __forceinline__ void operator()(int row, int col, f32x4 lo, f32x4 hi) const {
        const RowInfo ri = row_info(row); const int h = col >> 7, w = col & 127;
        if (w < 64) *(f16x8*)(KC + ((size_t)(ri.b * 8 + h) * NKEY + ri.pos) * 96 + w) = pack8(lo, hi);
        else *(f16x8*)(VC + ((size_t)(ri.b * 8 + h) * NKEY + ri.pos) * 64 + (w - 64)) = pack8(lo, hi);
    } };
struct EpiQUp { f16* QC; const float* ropeC;
    __device__ __forceinline__ void operator()(int row, int col, f32x4 lo, f32x4 hi) const {
        const RowInfo ri = row_info(row); const int h = col / 96, w = col - h * 96;
        if (w >= 64) {
            f32x4 plo, phi;
#pragma unroll
            for (int e = 0; e < 4; ++e) { plo[e] = __shfl_xor(lo[e], 16); phi[e] = __shfl_xor(hi[e], 16); }
            if (ri.lat) {
                const int j0 = w - 64, part = j0 >> 4, second = (j0 >> 3) & 1, pi = part ? (ri.t & 63) : (ri.t >> 6);
                const float* cc = ropeC + pi * 8; const float* ss = ropeC + 512 + pi * 8;
#pragma unroll
                for (int e = 0; e < 4; ++e) {
                    const float s0 = second ? ss[e] : -ss[e], s1 = second ? ss[4 + e] : -ss[4 + e];
                    lo[e] = lo[e] * cc[e] + plo[e] * s0; hi[e] = hi[e] * cc[4 + e] + phi[e] * s1; }
            }
        }
        lo = lo * QSCALE_C; hi = hi * QSCALE_C;
        f16* dst = ri.lat ? QC + ((size_t)(ri.b * 8 + h) * SEQ + ri.t) * 96 + w : QC + (size_t)NB * 8 * SEQ * 96 + ((size_t)(ri.b * 8 + h) * CTX + ri.t) * 96 + w;
        *(f16x8*)dst = pack8(lo, hi);
    } };
struct EpiGlu { f16* YS;
    __device__ __forceinline__ void operator()(int row, int col, f32x4 lo, f32x4 hi) const {
        f32x4 o;
#pragma unroll
        for (int e = 0; e < 4; ++e) o[e] = lo[e] * sigmoidf_(hi[e]);
        *(f16x4*)(YS + (size_t)row * 512 + (col >> 1)) = pack4(o);
    } };
struct EpiGate { f16* G;
    __device__ __forceinline__ void operator()(int row, int col, f32x4 lo, f32x4 hi) const {
#pragma unroll
        for (int e = 0; e < 4; ++e) { lo[e] = sigmoidf_(lo[e]); hi[e] = sigmoidf_(hi[e]); }
        *(f16x8*)(G + (size_t)row * 1024 + col) = pack8(lo, hi);
    } };
struct EpiBranch { const f16* G; f16* Mg; int first;
    __device__ __forceinline__ void operator()(int row, int col, f32x4 lo, f32x4 hi) const {
        const f16x8 g = *(const f16x8*)(G + (size_t)row * 1024 + col);
        f16x8 m = {0, 0, 0, 0, 0, 0, 0, 0};
        if (!first) m = *(const f16x8*)(Mg + (size_t)row * 1024 + col);
#pragma unroll
        for (int e = 0; e < 4; ++e) { lo[e] = (float)m[e] + (float)g[e] * lo[e]; hi[e] = (float)m[4 + e] + (float)g[4 + e] * hi[e]; }
        *(f16x8*)(Mg + (size_t)row * 1024 + col) = pack8(lo, hi);
    } };
struct EpiWout { const Ctx* C; int l;
    __device__ __forceinline__ void operator()(int row, int col, f32x4 lo, f32x4 hi) const {
        const RowInfo ri = row_info(row); const float* x = C->xsrc(l, row) + col; const float* g = C->mod(l, ri.mrow, 2) + col; float* t = C->ta(row) + col;
        const f32x4 x0 = *(const f32x4*)x, x1 = *(const f32x4*)(x + 4), g0 = *(const f32x4*)g, g1 = *(const f32x4*)(g + 4);
        *(f32x4*)t = x0 * ALPHA + g0 * lo; *(f32x4*)(t + 4) = x1 * ALPHA + g1 * hi;
    } };
struct EpiUp { f16* Hd;
    __device__ __forceinline__ void operator()(int row, int col, f32x4 lo, f32x4 hi) const {
#pragma unroll
        for (int e = 0; e < 4; ++e) { const float a = fmaxf(lo[e], 0.f), b = fmaxf(hi[e], 0.f); lo[e] = a * a; hi[e] = b * b; }
        *(f16x8*)(Hd + (size_t)row * DFF + col) = pack8(lo, hi);
    } };
struct EpiDown { const Ctx* C; int l;
    __device__ __forceinline__ void operator()(int row, int col, f32x4 lo, f32x4 hi) const {
        const RowInfo ri = row_info(row); const float* g = C->mod(l, ri.mrow, 5) + col; float* t = C->ta(row) + col;
        const f32x4 x0 = *(const f32x4*)t, x1 = *(const f32x4*)(t + 4), g0 = *(const f32x4*)g, g1 = *(const f32x4*)(g + 4);
        *(f32x4*)t = x0 * ALPHA + g0 * lo; *(f32x4*)(t + 4) = x1 * ALPHA + g1 * hi;
    } };

typedef _Float16 f16x2 __attribute__((ext_vector_type(2)));
template <int DQK>
__device__ __forceinline__ void attn_naive_query(const f16* q, const f16* Kh, const f16* Vh, int nkeys, f16* out, LAS float* scr, int lane) {
    f16x8 qv[DQK / 8];
#pragma unroll
    for (int c = 0; c < DQK / 8; ++c) qv[c] = *(const f16x8*)(q + 8 * c);
    float m = -1e30f, ls = 0.f; float acc[64];
#pragma unroll
    for (int d = 0; d < 64; ++d) acc[d] = 0.f;
    for (int j = lane; j < nkeys; j += 64) {
        const f16* kr = Kh + (size_t)j * DQK; const f16* vr = Vh + (size_t)j * 64;
        float s = 0.f;
#pragma unroll
        for (int c = 0; c < DQK / 8; ++c) { const f16x8 v = *(const f16x8*)(kr + 8 * c);
#pragma unroll
            for (int e = 0; e < 4; ++e) s = __builtin_amdgcn_fdot2((f16x2){qv[c][2 * e], qv[c][2 * e + 1]}, (f16x2){v[2 * e], v[2 * e + 1]}, s, false); }
        const float mn = fmaxf(m, s), a = exp2f(m - mn), p = exp2f(s - mn);
        ls = ls * a + p; m = mn;
#pragma unroll
        for (int c = 0; c < 8; ++c) { const f16x8 v = *(const f16x8*)(vr + 8 * c);
#pragma unroll
            for (int e = 0; e < 8; ++e) acc[8 * c + e] = acc[8 * c + e] * a + p * (float)v[e]; }
    }
    const float mg = wave_max(m), w = exp2f(m - mg);
    const float L = wave_sum(ls * w);
#pragma unroll
    for (int d = 0; d < 64; ++d) scr[lane * 65 + d] = acc[d] * w;
    asm volatile("s_waitcnt lgkmcnt(0)" ::: "memory");
    float o = 0.f;
#pragma unroll 8
    for (int i = 0; i < 64; ++i) o += scr[i * 65 + lane];
    asm volatile("s_waitcnt lgkmcnt(0)" ::: "memory");
    out[lane] = (f16)(o / L);
}
__device__ __forceinline__ void phase_attn_naive(const Ctx& C, int l) {
    LAS float* scr = (LAS float*)C.lds + C.wid * (64 * 65);
    const f16* QA = (const f16*)(C.ws() + A_QA); const f16* QC = (const f16*)(C.ws() + A_QC);
    const f16* KA = (const f16*)(C.ws() + A_KA); const f16* VA = (const f16*)(C.ws() + A_VA);
    const f16* KC = (const f16*)(C.ws() + A_KC); const f16* VC = (const f16*)(C.ws() + A_VC);
    f16* YA = (f16*)(C.ws() + A_YA); f16* YC = (f16*)(C.ws() + A_YC);
    const int NQL = NB * 8 * SEQ, NQC = NB * 8 * CTX;
    const int total = 2 * NQL + (l == 0 ? 2 * NQC : 0);
    for (int u = C.bid * NWAVES + C.wid; u < total; u += C.nblk * NWAVES) {
        int v = u; int type, lat;
        if (v < 2 * NQL) { type = v / NQL; v -= type * NQL; lat = 1; } else { v -= 2 * NQL; type = v / NQC; v -= type * NQC; lat = 0; }
        const int nq = lat ? SEQ : CTX;
        const int t = v % nq, h = (v / nq) & 7, b = v / (nq * 8);
        const int row = lat ? b * SEQ + t : NLAT + b * CTX + t;
        const int nkeys = lat ? NKEY : CTX;
        if (type == 0) {
            const f16* q = lat ? QA + ((size_t)(b * 8 + h) * SEQ + t) * 64 : QA + (size_t)NB * 8 * SEQ * 64 + ((size_t)(b * 8 + h) * CTX + t) * 64;
            attn_naive_query<64>(q, KA + (size_t)(b * 2 + (h >> 2)) * NKEY * 64, VA + (size_t)(b * 2 + (h >> 2)) * NKEY * 64, nkeys, YA + (size_t)row * 512 + h * 64, scr, C.lane);
        } else {
            const f16* q = lat ? QC + ((size_t)(b * 8 + h) * SEQ + t) * 96 : QC + (size_t)NB * 8 * SEQ * 96 + ((size_t)(b * 8 + h) * CTX + t) * 96;
            attn_naive_query<96>(q, KC + (size_t)(b * 8 + h) * NKEY * 96, VC + (size_t)(b * 8 + h) * NKEY * 64, nkeys, YC + (size_t)row * 512 + h * 64, scr, C.lane);
        }
    }
}

__device__ __forceinline__ void phase_s5_naive(const Ctx& C, int l) {
    const f16* U = (const f16*)(C.ws() + A_U); float* YSF = (float*)(C.ws() + A_YSF);
    LAS float* cst = (LAS float*)C.lds + C.wid * (16 * 128 + 4 * 128);
    LAS float* sst = cst + 16 * 128;
    const int lane = C.lane;
    for (int u = C.bid * NWAVES + C.wid; u < NB * 32; u += C.nblk * NWAVES) {
        const int b = u >> 5, g = u & 31;
        for (int dir = 0; dir < 2; ++dir) {
            const size_t gi = ((size_t)(l * 2 + dir) * 32 + g);
            const float are = C.in(I_SARE)[gi * 64 + lane], aim = C.in(I_SAIM)[gi * 64 + lane];
            const float dt = expf(C.in(I_SLDT)[gi]);
            const float mag = expf(are * dt), th = aim * dt;
            const float abr = mag * cosf(th), abi = mag * sinf(th);
            const float den = are * are + aim * aim, nr = abr - 1.0f;
            const float cr = (nr * are + abi * aim) / den, ci = (abi * are - nr * aim) / den;
            float bbr[16], bbi[16];
#pragma unroll
            for (int c = 0; c < 16; ++c) {
                const float br = C.in(I_SBRE)[(gi * 64 + lane) * 16 + c], bi = C.in(I_SBIM)[(gi * 64 + lane) * 16 + c];
                bbr[c] = cr * br - ci * bi; bbi[c] = cr * bi + ci * br; }
#pragma unroll
            for (int c = 0; c < 16; ++c) { cst[c * 128 + lane] = C.in(I_SCRE)[(gi * 16 + c) * 64 + lane]; cst[c * 128 + 64 + lane] = C.in(I_SCIM)[(gi * 16 + c) * 64 + lane]; }
            asm volatile("s_waitcnt lgkmcnt(0)" ::: "memory");
            float xr = 0.f, xi = 0.f;
            const int tk = lane >> 4, cc = lane & 15;
            const float dcoef = C.in(I_SD)[l * 512 + g * 16 + cc];
            for (int i0 = 0; i0 < NKEY; i0 += 4) {
                int rows[4];
#pragma unroll
                for (int k = 0; k < 4; ++k) {
                    const int i = i0 + k; int row;
                    if (dir == 0) row = i < CTX ? NLAT + b * CTX + i : b * SEQ + (i - CTX);
                    else row = i < CTX ? NLAT + b * CTX + (CTX - 1 - i) : b * SEQ + (SEQ - 1 - (i - CTX));
                    rows[k] = row;
                    const f16x8 u0 = *(const f16x8*)(U + (size_t)row * 512 + g * 16), u1 = *(const f16x8*)(U + (size_t)row * 512 + g * 16 + 8);
                    float bur = 0.f, bui = 0.f;
#pragma unroll
                    for (int c = 0; c < 8; ++c) { bur += bbr[c] * (float)u0[c] + bbr[8 + c] * (float)u1[c]; bui += bbi[c] * (float)u0[c] + bbi[8 + c] * (float)u1[c]; }
                    const float nxr = abr * xr - abi * xi + bur, nxi = abr * xi + abi * xr + bui;
                    xr = nxr; xi = nxi;
                    sst[k * 128 + lane] = xr; sst[k * 128 + 64 + lane] = xi;
                }
                asm volatile("s_waitcnt lgkmcnt(0)" ::: "memory");
                float y = 0.f;
#pragma unroll 16
                for (int p = 0; p < 64; ++p) y += cst[cc * 128 + p] * sst[tk * 128 + p] - cst[cc * 128 + 64 + p] * sst[tk * 128 + 64 + p];
                asm volatile("s_waitcnt lgkmcnt(0)" ::: "memory");
                int myrow = rows[0];
#pragma unroll
                for (int k = 1; k < 4; ++k) myrow = (tk == k) ? rows[k] : myrow;
                if (myrow < NLAT || l == 0) {
                    float* dst = YSF + (size_t)myrow * 512 + g * 16 + cc;
                    if (dir == 0) *dst = y + dcoef * (float)U[(size_t)myrow * 512 + g * 16 + cc];
                    else *dst = *dst + y;
                }
            }
            asm volatile("s_waitcnt vmcnt(0)" ::: "memory");
            __builtin_amdgcn_fence(__ATOMIC_RELEASE, "workgroup");
        }
    }
}
__device__ __forceinline__ void phase_s5_gelu(const Ctx& C, int nrows) {
    const float* YSF = (const float*)(C.ws() + A_YSF); f16* G = (f16*)(C.ws() + A_G);
    const size_t n4 = (size_t)nrows * 512 / 4;
    for (size_t i = (size_t)C.bid * NTHREADS + C.tid; i < n4; i += (size_t)C.nblk * NTHREADS) {
        f32x4 v = ((const f32x4*)YSF)[i];
#pragma unroll
        for (int e = 0; e < 4; ++e) v[e] = gelu_tanh(v[e]);
        ((f16x4*)G)[i] = pack4(v);
    }
}

typedef __attribute__((address_space(1))) unsigned gu32;
#define XB_TMO      128
#define XB_XCNT(j)  (256  + 64 * (j))
#define XB_XSUB(j)  (1280 + 64 * (j))
#define XB_XGEN(j)  (2304 + 64 * (j))
#define XB_TOP      3328
#define XB_TOPGEN   3392
#define XCD_BAR_WORDS 3456
#define XB_SPIN_CAP (1u << 26)

__device__ __forceinline__ unsigned xb_ld(unsigned* p)              { return __hip_atomic_load(p, __ATOMIC_RELAXED, __HIP_MEMORY_SCOPE_AGENT); }
__device__ __forceinline__ unsigned xb_add(unsigned* p, unsigned v) { return __hip_atomic_fetch_add(p, v, __ATOMIC_RELAXED, __HIP_MEMORY_SCOPE_AGENT); }
__device__ __forceinline__ unsigned xb_xcc_id() { return (unsigned)__builtin_amdgcn_s_getreg((3 << 11) | 20) & 0xFu; }
#define XB_SPIN(cond, bar) do { unsigned _sp = 0; while (cond) { __builtin_amdgcn_s_sleep(1); \
    if ((++_sp & 255u) == 0u) { if (xb_ld(&(bar)[XB_TMO])) break; if (_sp > XB_SPIN_CAP) { atomicAdd(&(bar)[XB_TMO], 1u); break; } } } } while (0)

struct XcdBarrier {
    unsigned* bar; unsigned x;
    volatile LAS unsigned* st;
};

__device__ __forceinline__ XcdBarrier xcd_barrier_post(unsigned* bar, volatile LAS unsigned* st) {
    XcdBarrier b; b.bar = bar; b.x = xb_xcc_id(); b.st = st;
    if (threadIdx.x == 0) (void)xb_add(&bar[XB_XCNT(b.x)], 1u);
    return b;
}
__device__ __forceinline__ void xcd_barrier_complete(unsigned* bar, unsigned x, unsigned& nloc, unsigned& nx) {
    const unsigned G = gridDim.x * gridDim.y * gridDim.z;
    unsigned sum, cnt, mine, sp = 0u;
    for (;;) {
        sum = 0u; cnt = 0u; mine = 0u;
#pragma unroll
        for (unsigned j = 0; j < 16; ++j) { const unsigned c = xb_ld(&bar[XB_XCNT(j)]); sum += c; cnt += (c > 0u) ? 1u : 0u; mine = (j == x) ? c : mine; }
        if (sum == G) break;
        __builtin_amdgcn_s_sleep(1);
        if ((++sp & 255u) == 0u) { if (xb_ld(&bar[XB_TMO])) break; if (sp > XB_SPIN_CAP) { atomicAdd(&bar[XB_TMO], 1u); break; } }
    }
    nloc = mine > 0u ? mine : 1u; nx = cnt > 0u ? cnt : 1u;
}

__device__ __forceinline__ void xcd_barrier(const XcdBarrier& b) {
    asm volatile("s_waitcnt vmcnt(0)" ::: "memory");
    __syncthreads();
    if (threadIdx.x == 0) {
        unsigned* bar = b.bar;
        __builtin_amdgcn_s_waitcnt(0);
        unsigned nloc = b.st[0], nx = b.st[1];
        if (nloc == 0u) { xcd_barrier_complete(bar, b.x, nloc, nx); b.st[0] = nloc; b.st[1] = nx; }
        const unsigned old = xb_add(&bar[XB_XSUB(b.x)], 1u);
        const unsigned gen = old / nloc;
        if (old + 1u == (gen + 1u) * nloc) {
            __builtin_amdgcn_fence(__ATOMIC_RELEASE, "agent");
            asm volatile("s_waitcnt vmcnt(0)" ::: "memory");
            const unsigned og = xb_add(&bar[XB_TOP], 1u);
            const unsigned tg = og / nx;
            if (og + 1u == (tg + 1u) * nx) xb_add(&bar[XB_TOPGEN], 1u);
            else XB_SPIN(xb_ld(&bar[XB_TOPGEN]) == tg, bar);
            __builtin_amdgcn_fence(__ATOMIC_ACQUIRE, "agent");
            xb_add(&bar[XB_XGEN(b.x)], 1u);
            asm volatile("s_waitcnt vmcnt(0)" ::: "memory");
        } else {
            XB_SPIN(xb_ld(&bar[XB_XGEN(b.x)]) == gen, bar);
            __builtin_amdgcn_fence(__ATOMIC_ACQUIRE, "agent");
            asm volatile("s_waitcnt vmcnt(0)" ::: "memory");
        }
    }
    __syncthreads();
}

#define GSYNC() xcd_barrier(bar)
constexpr int MISC_OFF = LDS_BYTES - 256;
constexpr int CW_BAR = 4096;
#define CTX() const Ctx C = make_ctx(); unsigned char* ws = C.ws()
__global__ void __launch_bounds__(NTHREADS, 2) fwd_all(Args args) {
    cg::grid_group grid = cg::this_grid();
    extern __shared__ __attribute__((aligned(16))) unsigned char lds_raw[];
    volatile LAS unsigned* MISC = (volatile LAS unsigned*)((LAS unsigned char*)lds_raw + MISC_OFF);
    if (threadIdx.x < 64) MISC[threadIdx.x] = 0u;
    __syncthreads();
    const XcdBarrier bar = xcd_barrier_post((unsigned*)(args.ws + WS_CTL) + CW_BAR, MISC + 8);
    { CTX(); (void)ws; phase_setup(C); }
    asm volatile("s_waitcnt vmcnt(0)" ::: "memory");
    grid.sync();
    __builtin_amdgcn_fence(__ATOMIC_ACQUIRE, "agent");
    asm volatile("s_waitcnt vmcnt(0)" ::: "memory");
#pragma unroll 1
    for (int l = 0; l < 2; ++l) {
        const int mrows = l == 0 ? MALL : NLAT;
        { CTX(); (void)ws; phase_cvt(C, l); phase_p1(C, l); }
        GSYNC();
        { CTX(); EpiStore E{(f16*)(ws + A_PROJ), PLD};
          gemm_simple(C, (const f16*)(ws + A_H), D, (const f16*)(ws + W_INA), D, MALL, 2560, D, E, l == 0 ? (1 << 30) : NLAT, l == 0 ? (1 << 30) : 1280); }
        GSYNC();
        { CTX(); (void)ws; phase_p3(C, l); }
        GSYNC();
        { CTX(); EpiKvUp E1{(f16*)(ws + A_KC), (f16*)(ws + A_VC)};
          gemm_simple(C, (const f16*)(ws + A_PROJ) + OFF_CKV, PLD, (const f16*)(ws + W_KVB), 256, MALL, 1024, 256, E1); }
        { CTX(); EpiQUp E2{(f16*)(ws + A_QC), (const float*)(ws + WS_ROPE) + 2048};
          gemm_simple(C, (const f16*)(ws + A_PROJ) + OFF_CQ, PLD, (const f16*)(ws + W_QB), 768, mrows, 768, 768, E2); }
        GSYNC();
        { CTX(); (void)ws; phase_attn_naive(C, l); }
        __syncthreads();
        { CTX(); (void)ws; phase_s5_naive(C, l); }
        GSYNC();
        { CTX(); (void)ws; phase_s5_gelu(C, mrows); }
        GSYNC();
        { CTX(); EpiGlu E{(f16*)(ws + A_YS)};
          gemm_simple(C, (const f16*)(ws + A_G), 512, (const f16*)(ws + W_GLU), 512, mrows, 1024, 512, E); }
        { CTX(); (void)ws; phase_hre(C, l, mrows); }
        GSYNC();
#pragma unroll 1
        for (int br = 0; br < 3; ++br) {
            { CTX(); EpiGate Eg{(f16*)(ws + A_GATE)};
              gemm_simple(C, (const f16*)(ws + A_H), D, (const f16*)(ws + W_GATE) + (size_t)br * 1024 * 1024, D, mrows, 1024, D, Eg); }
            { CTX(); const f16* Y = (const f16*)(ws + (br == 0 ? A_YA : br == 1 ? A_YS : A_YC));
              EpiBranch Eb{(const f16*)(ws + A_GATE), (f16*)(ws + A_MERGED), br == 0};
              gemm_simple(C, Y, 512, (const f16*)(ws + W_BR) + (size_t)br * 1024 * 512, 512, mrows, 1024, 512, Eb); }
        }
        GSYNC();
        { CTX(); EpiWout E{&C, l}; gemm_simple(C, (const f16*)(ws + A_MERGED), D, (const f16*)(ws + W_OUT), D, mrows, 1024, D, E); }
        GSYNC();
        { CTX(); (void)ws; phase_p10(C, l, mrows); }
        GSYNC();
        { CTX(); EpiUp E{(f16*)(ws + A_HID)}; gemm_simple(C, (const f16*)(ws + A_H), D, (const f16*)(ws + W_UP), D, mrows, DFF, D, E); }
        GSYNC();
        { CTX(); EpiDown E{&C, l}; gemm_simple(C, (const f16*)(ws + A_HID), DFF, (const f16*)(ws + W_DOWN), DFF, mrows, 1024, DFF, E); }
        GSYNC();
        { CTX(); (void)ws; phase_p13(C, l, mrows); }
        if (l == 0) GSYNC();
    }
}

extern "C" void kernel_launch(void* const* d_in, const int* in_sizes, int n_in, void* d_out, int out_size, void* d_ws, size_t ws_size, hipStream_t stream) {
    static int grid_blocks = 0;
    if (grid_blocks == 0) {
        if (n_in != 32 || out_size != NLAT * D || ws_size < WS_NEED) { fprintf(stderr, "kernel_launch: unexpected shapes n_in %d out %d ws %zu (need %zu)\n", n_in, out_size, ws_size, (size_t)WS_NEED); grid_blocks = -1; return; }
        int dev = 0, cus = 0, per_cu = 0;
        hipGetDevice(&dev);
        hipDeviceGetAttribute(&cus, hipDeviceAttributeMultiprocessorCount, dev);
        if (hipFuncSetAttribute((const void*)fwd_all, hipFuncAttributeMaxDynamicSharedMemorySize, LDS_BYTES) != hipSuccess) { fprintf(stderr, "kernel_launch: hipFuncSetAttribute failed\n"); grid_blocks = -1; return; }
        hipOccupancyMaxActiveBlocksPerMultiprocessor(&per_cu, (const void*)fwd_all, NTHREADS, LDS_BYTES);
        if (per_cu < 1) { fprintf(stderr, "kernel_launch: occupancy query says %d blocks per CU\n", per_cu); grid_blocks = -1; return; }
        grid_blocks = cus;
    }
    if (grid_blocks < 0) return;
    Args a{};
    for (int i = 0; i < 32; ++i) a.in[i] = (const float*)d_in[i];
    a.out = (float*)d_out; a.ws = (unsigned char*)d_ws;
    if (hipMemsetAsync((char*)d_ws + WS_CTL, 0, 1 * MiB, stream) != hipSuccess) { fprintf(stderr, "kernel_launch: hipMemsetAsync failed\n"); return; }
    void* kargs[] = {&a};
    const hipError_t e = hipLaunchCooperativeKernel((const void*)fwd_all, dim3(grid_blocks), dim3(NTHREADS), kargs, LDS_BYTES, stream);
    if (e != hipSuccess) fprintf(stderr, "kernel_launch: cooperative launch failed: %s (grid %d)\n", hipGetErrorString(e), grid_blocks);
}
```

```cpp
#include <hip/hip_runtime.h>
#include <hip/hip_cooperative_groups.h>
#include <cstdio>
#include <cstdint>
#include <cmath>

namespace cg = cooperative_groups;

#define LAS __attribute__((address_space(3)))
typedef _Float16 f16;
typedef _Float16 f16x8 __attribute__((ext_vector_type(8)));
typedef _Float16 f16x4 __attribute__((ext_vector_type(4)));
typedef float f32x4 __attribute__((ext_vector_type(4)));
typedef float f32x16 __attribute__((ext_vector_type(16)));

constexpr int D = 1024, NB = 4, SEQ = 4096, CTX = 256, NLAT = NB * SEQ, NCTX = NB * CTX, MALL = NLAT + NCTX;
constexpr int NKEY = CTX + SEQ;
constexpr int OFF_AK = 0, OFF_AV = 128, OFF_CKV = 256, OFF_CKR = 512, OFF_U = 544, OFF_AQ = 1056, OFF_CQ = 1568, OFF_GATE = 2336, N_IN = 5408;
constexpr int PLD = 2560;
constexpr int DFF = 4096;
constexpr float EPS = 1e-6f;
constexpr float ALPHA = 1.4142135623730951f;
constexpr float LOG2E = 1.4426950408889634f;
constexpr float QSCALE_A = 0.125f * LOG2E;
constexpr float QSCALE_C = 0.10206207261596575f * LOG2E;

constexpr size_t MiB = 1u << 20;
constexpr size_t WS_CTL = 0;
constexpr size_t WS_MOD = 1 * MiB;
constexpr size_t WS_ROPE = 1 * MiB + 512 * 1024;
constexpr size_t WS_W16 = 2 * MiB;
constexpr size_t W_INA = WS_W16;
constexpr size_t W_GATE = W_INA + (size_t)2560 * 1024 * 2;
constexpr size_t W_QB = W_GATE + (size_t)3072 * 1024 * 2;
constexpr size_t W_KVB = W_QB + (size_t)768 * 768 * 2;
constexpr size_t W_GLU = W_KVB + (size_t)1024 * 256 * 2;
constexpr size_t W_BR = W_GLU + (size_t)1024 * 512 * 2;
constexpr size_t W_OUT = W_BR + (size_t)3 * 1024 * 512 * 2;
constexpr size_t W_UP = W_OUT + (size_t)1024 * 1024 * 2;
constexpr size_t W_DOWN = W_UP + (size_t)4096 * 1024 * 2;
constexpr size_t W_END = W_DOWN + (size_t)1024 * 4096 * 2;
constexpr size_t WS_TACTX = 37 * MiB;
constexpr size_t WS_ACT = 41 * MiB;
static_assert(W_END <= WS_TACTX, "weights fit");
constexpr size_t A_H = WS_ACT + 0 * MiB;
constexpr size_t A_QC = WS_ACT + 0 * MiB;
constexpr size_t A_PROJ = WS_ACT + 34 * MiB;
constexpr size_t A_YA = WS_ACT + 34 * MiB;
constexpr size_t A_YC = WS_ACT + 51 * MiB;
constexpr size_t A_YSF = WS_ACT + 68 * MiB;
constexpr size_t A_G = WS_ACT + 68 * MiB;
constexpr size_t A_QA = WS_ACT + 119 * MiB;
constexpr size_t A_YS = WS_ACT + 119 * MiB;
constexpr size_t A_KA = WS_ACT + 136 * MiB;
constexpr size_t A_VA = A_KA + (size_t)NB * 2 * NKEY * 64 * 2;
constexpr size_t A_U = WS_ACT + 145 * MiB;
constexpr size_t A_KC = WS_ACT + 162 * MiB;
constexpr size_t A_VC = WS_ACT + 188 * MiB;
constexpr size_t A_GATE = WS_ACT + 136 * MiB;
constexpr size_t A_MERGED = WS_ACT + 170 * MiB;
constexpr size_t A_HID = WS_ACT + 34 * MiB;
constexpr size_t A_S5S = WS_ACT + 68 * MiB;
constexpr size_t A_S5X = WS_ACT + 102 * MiB;
constexpr size_t T_K = WS_ACT + 205 * MiB;
constexpr size_t T_E = T_K + (size_t)64 * 17 * 256 * 2;
constexpr size_t T_M = T_E + (size_t)64 * 16 * 16 * 128 * 2;
constexpr size_t WS_NEED = WS_ACT + 215 * MiB;
static_assert(T_M + (size_t)64 * 128 * 256 * 2 <= WS_NEED, "s5 tables");
static_assert(A_VA + (size_t)NB * 2 * NKEY * 64 * 2 <= A_U && A_VC + 17 * MiB <= WS_NEED && A_MERGED + 34 * MiB <= WS_NEED && A_HID + 136 * MiB <= WS_NEED, "ws map");
static_assert(WS_NEED <= 256 * MiB, "ws budget");

constexpr int LDS_BYTES = 147456;
constexpr int NTHREADS = 512, NWAVES = 8;

struct Args {
    const float* in[32];
    float* out;
    unsigned char* ws;
    int ph_lo, ph_hi;
};
enum { I_X = 0, I_C, I_CTX, I_CCTX, I_WMOD, I_BMOD, I_WIN, I_AQG, I_AKG, I_CQG, I_CKVG, I_WQB, I_WKVB, I_SARE, I_SAIM, I_SLDT, I_SBRE, I_SBIM, I_SCRE, I_SCIM,
       I_SD, I_WGLU, I_WBA, I_WBS, I_WBC, I_WOUT, I_LN1G, I_LN1B, I_WUP, I_WDOWN, I_LN2G, I_LN2B };

__device__ __forceinline__ float wave_sum(float v) {
#pragma unroll
    for (int o = 1; o < 64; o <<= 1) v += __shfl_xor(v, o);
    return v;
}
__device__ __forceinline__ float wave_max(float v) {
#pragma unroll
    for (int o = 1; o < 64; o <<= 1) v = fmaxf(v, __shfl_xor(v, o));
    return v;
}
__device__ __forceinline__ float sigmoidf_(float x) { return 1.0f / (1.0f + __expf(-x)); }
__device__ __forceinline__ float gelu_tanh(float x) {
    const float u = 0.7978845608028654f * (x + 0.044715f * x * x * x);
    const float e = __expf(2.0f * u);
    const float t = 1.0f - 2.0f / (e + 1.0f);
    return 0.5f * x * (1.0f + t);
}
__device__ __forceinline__ f16x8 pack8(f32x4 lo, f32x4 hi) {
    f16x8 r; r[0] = (f16)lo[0]; r[1] = (f16)lo[1]; r[2] = (f16)lo[2]; r[3] = (f16)lo[3]; r[4] = (f16)hi[0]; r[5] = (f16)hi[1]; r[6] = (f16)hi[2]; r[7] = (f16)hi[3]; return r;
}
__device__ __forceinline__ f16x4 pack4(f32x4 v) { f16x4 r; r[0] = (f16)v[0]; r[1] = (f16)v[1]; r[2] = (f16)v[2]; r[3] = (f16)v[3]; return r; }

struct RowInfo { int b, t, pos, lat, mrow; };
__device__ __forceinline__ RowInfo row_info(int r) {
    RowInfo o;
    if (r < NLAT) { o.lat = 1; o.b = r >> 12; o.t = r & 4095; o.pos = CTX + o.t; o.mrow = o.b; }
    else { const int rr = r - NLAT; o.lat = 0; o.b = rr >> 8; o.t = rr & 255; o.pos = o.t; o.mrow = 4; }
    return o;
}

#define CAS __attribute__((address_space(4)))
struct Ctx {
    const CAS unsigned char* kp; LAS unsigned char* lds;
    int tid, lane, wid, nblk, bid;
    __device__ __forceinline__ const float* in(int i) const { return *(const float* const CAS*)(kp + 8 * i); }
    __device__ __forceinline__ float* out() const { return *(float* const CAS*)(kp + 256); }
    __device__ __forceinline__ unsigned char* ws() const { return *(unsigned char* const CAS*)(kp + 264); }
    __device__ __forceinline__ const float* mod(int l, int mrow, int which) const { return (const float*)(ws() + WS_MOD) + ((size_t)(l * 5 + mrow) * 6 + which) * D; }
    __device__ __forceinline__ const float* xsrc(int l, int r) const {
        if (l == 0) return r < NLAT ? in(I_X) + (size_t)r * D : in(I_CTX) + (size_t)(r - NLAT) * D;
        return r < NLAT ? out() + (size_t)r * D : (const float*)(ws() + WS_TACTX) + (size_t)(r - NLAT) * D;
    }
    __device__ __forceinline__ float* ta(int r) const { return r < NLAT ? out() + (size_t)r * D : (float*)(ws() + WS_TACTX) + (size_t)(r - NLAT) * D; }
};
__device__ __forceinline__ Ctx make_ctx(int wid) {
    extern __shared__ __attribute__((aligned(16))) unsigned char lds_raw[];
    Ctx C;
    const CAS unsigned char* kp = (const CAS unsigned char*)__builtin_amdgcn_kernarg_segment_ptr();
    asm volatile("" : "+s"(kp));
    C.kp = kp; C.lds = (LAS unsigned char*)lds_raw;
    int lane = __builtin_amdgcn_mbcnt_hi(~0u, __builtin_amdgcn_mbcnt_lo(~0u, 0u)); asm volatile("" : "+v"(lane));
    asm volatile("" : "+s"(wid));
    C.tid = wid * 64 + lane; C.lane = lane; C.wid = wid;
    int bid = blockIdx.x; asm volatile("" : "+s"(bid));
    C.bid = bid; C.nblk = gridDim.x;
    return C;
}

__device__ __forceinline__ void phase_setup(const Ctx& C) {
    LAS float* sv = (LAS float*)C.lds;
    LAS float* red = sv + 5 * 1024;
    for (int i = C.tid; i < 5 * 1024; i += NTHREADS) {
        const int mr = i >> 10, k = i & 1023;
        const float v = mr < 4 ? C.in(I_C)[mr * D + k] : C.in(I_CCTX)[k];
        sv[i] = v / (1.0f + __expf(-v));
    }
    __syncthreads();
    for (int u = C.bid; u < 192; u += C.nblk) {
        const int l = u / 96, n0 = (u % 96) * 64;
        const float* W = C.in(I_WMOD) + (size_t)l * D * 6144 + n0 + C.lane;
        float acc[5] = {0.f, 0.f, 0.f, 0.f, 0.f};
        const int kb = C.wid * 128;
#pragma unroll 8
        for (int k = 0; k < 128; ++k) {
            const float w = W[(size_t)(kb + k) * 6144];
#pragma unroll
            for (int m = 0; m < 5; ++m) acc[m] += sv[m * 1024 + kb + k] * w;
        }
#pragma unroll
        for (int m = 0; m < 5; ++m) red[(C.wid * 5 + m) * 64 + C.lane] = acc[m];
        __syncthreads();
        if (C.tid < 320) {
            const int m = C.tid >> 6, c = C.tid & 63; float s = 0.f;
#pragma unroll
            for (int w = 0; w < 8; ++w) s += red[(w * 5 + m) * 64 + c];
            ((float*)(C.ws() + WS_MOD))[(size_t)(l * 5 + m) * 6144 + n0 + c] = s + C.in(I_BMOD)[l * 6144 + n0 + c];
        }
        __syncthreads();
    }
    if (C.bid == C.nblk - 1) {
        float* ra = (float*)(C.ws() + WS_ROPE);
        for (int i = C.tid; i < 1024; i += NTHREADS) {
            const int pos = i >> 4, f = i & 15;
            const float inv = powf(10000.0f, -(float)(2 * f) / 32.0f);
            const float ang = (float)pos * inv;
            ra[i] = cosf(ang); ra[1024 + i] = sinf(ang);
        }
        for (int i = C.tid; i < 512; i += NTHREADS) {
            const int pos = i >> 3, f = i & 7;
            const float inv = powf(10000.0f, -(float)(2 * f) / 16.0f);
            const float ang = (float)pos * inv;
            ra[2048 + i] = cosf(ang); ra[2048 + 512 + i] = sinf(ang);
        }
    }
}

__device__ __forceinline__ int glu_row(int n) { const int isg = n >= 512, j = n & 511; return 8 * (j >> 2) + 4 * isg + (j & 3); }
__device__ __forceinline__ void cvt_item(const float* W, int ldw, int coff, int K, int nblk, f16* WT, int mode, LAS float* scr, int item, int lane) {
    const int kb = item / nblk, nb = item % nblk, k0 = 64 * kb, n0 = 32 * nb;
#pragma unroll 8
    for (int i = 0; i < 32; ++i) { const int kk = 2 * i + (lane >> 5); scr[kk * 33 + (lane & 31)] = W[(size_t)(k0 + kk) * ldw + coff + n0 + (lane & 31)]; }
    asm volatile("s_waitcnt lgkmcnt(0)" ::: "memory");
    const int c = lane & 7;
#pragma unroll
    for (int j = 0; j < 4; ++j) {
        const int n = (lane >> 3) + 8 * j; const LAS float* s = scr + (8 * c) * 33 + n;
        f16x8 o;
#pragma unroll
        for (int e = 0; e < 8; ++e) o[e] = (f16)s[e * 33];
        const int nn = n0 + n; const int row = mode ? glu_row(nn) : nn;
        *(f16x8*)(WT + (size_t)row * K + k0 + 8 * c) = o;
    }
    asm volatile("s_waitcnt lgkmcnt(0)" ::: "memory");
}
__device__ __forceinline__ void cvt_mat(const Ctx& C, const float* src, int ldw, int coff, int K, int N, size_t dst, int mode, int& base) {
    LAS float* scr = (LAS float*)C.lds + C.wid * (64 * 33);
    const int gw = C.bid * NWAVES + C.wid, ngw = C.nblk * NWAVES;
    const int nblk = N / 32, items = (K / 64) * nblk;
    int first = gw - (base % ngw); if (first < 0) first += ngw;
    for (int it = first; it < items; it += ngw) cvt_item(src, ldw, coff, K, nblk, (f16*)(C.ws() + dst), mode, scr, it, C.lane);
    base += items;
}
__device__ __forceinline__ void phase_cvt(const Ctx& C, int l) {
    int base = 0;
    cvt_mat(C, C.in(I_WIN) + (size_t)l * D * N_IN, N_IN, 0, D, OFF_GATE, W_INA, 0, base);
    cvt_mat(C, C.in(I_WIN) + (size_t)l * D * N_IN, N_IN, OFF_GATE, D, 3072, W_GATE, 0, base);
    cvt_mat(C, C.in(I_WQB) + (size_t)l * 768 * 768, 768, 0, 768, 768, W_QB, 0, base);
    cvt_mat(C, C.in(I_WKVB) + (size_t)l * 256 * 1024, 1024, 0, 256, 1024, W_KVB, 0, base);
    cvt_mat(C, C.in(I_WGLU) + (size_t)l * 512 * 1024, 1024, 0, 512, 1024, W_GLU, 1, base);
    cvt_mat(C, C.in(I_WBA) + (size_t)l * 512 * 1024, 1024, 0, 512, 1024, W_BR, 0, base);
    cvt_mat(C, C.in(I_WBS) + (size_t)l * 512 * 1024, 1024, 0, 512, 1024, W_BR + (size_t)1024 * 512 * 2, 0, base);
    cvt_mat(C, C.in(I_WBC) + (size_t)l * 512 * 1024, 1024, 0, 512, 1024, W_BR + (size_t)2 * 1024 * 512 * 2, 0, base);
    cvt_mat(C, C.in(I_WOUT) + (size_t)l * 1024 * 1024, 1024, 0, 1024, 1024, W_OUT, 0, base);
    cvt_mat(C, C.in(I_WUP) + (size_t)l * 1024 * 4096, 4096, 0, 1024, 4096, W_UP, 0, base);
    cvt_mat(C, C.in(I_WDOWN) + (size_t)l * 4096 * 1024, 1024, 0, 4096, 1024, W_DOWN, 0, base);
    f16* pad = (f16*)(C.ws() + W_INA) + (size_t)OFF_GATE * 1024;
    const f16x8 z = {0, 0, 0, 0, 0, 0, 0, 0};
    for (int i = C.bid * NTHREADS + C.tid; i < (2560 - OFF_GATE) * 1024 / 8; i += C.nblk * NTHREADS) ((f16x8*)pad)[i] = z;
}

__device__ __forceinline__ void row_load(const float* p, int lane, f32x4 (&v)[4]) {
#pragma unroll
    for (int j = 0; j < 4; ++j) v[j] = ((const f32x4*)p)[lane + 64 * j];
}
__device__ __forceinline__ void row_ln(f32x4 (&v)[4]) {
    float s = 0.f;
#pragma unroll
    for (int j = 0; j < 4; ++j) s += (v[j][0] + v[j][1]) + (v[j][2] + v[j][3]);
    const float mean = wave_sum(s) * (1.0f / D);
    float q = 0.f;
#pragma unroll
    for (int j = 0; j < 4; ++j) { v[j] = v[j] - mean; q += (v[j][0] * v[j][0] + v[j][1] * v[j][1]) + (v[j][2] * v[j][2] + v[j][3] * v[j][3]); }
    const float rstd = 1.0f / sqrtf(wave_sum(q) * (1.0f / D) + EPS);
#pragma unroll
    for (int j = 0; j < 4; ++j) v[j] = v[j] * rstd;
}
__device__ __forceinline__ void row_modulate_store(const f32x4 (&v)[4], const float* sh, const float* sc, f16* o, int lane) {
#pragma unroll
    for (int j = 0; j < 4; ++j) {
        const f32x4 s = ((const f32x4*)sc)[lane + 64 * j], t = ((const f32x4*)sh)[lane + 64 * j];
        const f32x4 y = v[j] * (s + 1.0f) + t;
        ((f16x4*)o)[lane + 64 * j] = pack4(y);
    }
}
__device__ __forceinline__ void phase_p1(const Ctx& C, int l) {
    f16* H = (f16*)(C.ws() + A_H);
    for (int r = C.bid * NWAVES + C.wid; r < MALL; r += C.nblk * NWAVES) {
        const RowInfo ri = row_info(r);
        f32x4 v[4]; row_load(C.xsrc(l, r), C.lane, v); row_ln(v);
        row_modulate_store(v, C.mod(l, ri.mrow, 0), C.mod(l, ri.mrow, 1), H + (size_t)r * D, C.lane);
    }
}
__device__ __forceinline__ void phase_p10(const Ctx& C, int l, int nrows) {
    f16* H = (f16*)(C.ws() + A_H);
    const float* g = C.in(I_LN1G) + l * D; const float* bb = C.in(I_LN1B) + l * D;
    for (int r = C.bid * NWAVES + C.wid; r < nrows; r += C.nblk * NWAVES) {
        const RowInfo ri = row_info(r);
        float* t = C.ta(r);
        f32x4 v[4]; row_load(t, C.lane, v); row_ln(v);
#pragma unroll
        for (int j = 0; j < 4; ++j) { v[j] = v[j] * ((const f32x4*)g)[C.lane + 64 * j] + ((const f32x4*)bb)[C.lane + 64 * j]; ((f32x4*)t)[C.lane + 64 * j] = v[j]; }
        row_ln(v);
        row_modulate_store(v, C.mod(l, ri.mrow, 3), C.mod(l, ri.mrow, 4), H + (size_t)r * D, C.lane);
    }
}
__device__ __forceinline__ void phase_p13(const Ctx& C, int l, int nrows) {
    const float* g = C.in(I_LN2G) + l * D; const float* bb = C.in(I_LN2B) + l * D;
    for (int r = C.bid * NWAVES + C.wid; r < nrows; r += C.nblk * NWAVES) {
        float* t = C.ta(r);
        f32x4 v[4]; row_load(t, C.lane, v); row_ln(v);
#pragma unroll
        for (int j = 0; j < 4; ++j) { v[j] = v[j] * ((const f32x4*)g)[C.lane + 64 * j] + ((const f32x4*)bb)[C.lane + 64 * j]; ((f32x4*)t)[C.lane + 64 * j] = v[j]; }
    }
}
__device__ __forceinline__ void phase_hre(const Ctx& C, int l, int nrows) {
    f16* H = (f16*)(C.ws() + A_H);
    for (int r = C.bid * NWAVES + C.wid; r < nrows; r += C.nblk * NWAVES) {
        const RowInfo ri = row_info(r);
        f32x4 v[4]; row_load(C.xsrc(l, r), C.lane, v); row_ln(v);
        row_modulate_store(v, C.mod(l, ri.mrow, 0), C.mod(l, ri.mrow, 1), H + (size_t)r * D, C.lane);
    }
}

__device__ __forceinline__ void phase_p3(const Ctx& C, int l) {
    f16* PROJ = (f16*)(C.ws() + A_PROJ);
    f16* KA = (f16*)(C.ws() + A_KA); f16* VA = (f16*)(C.ws() + A_VA); f16* KC = (f16*)(C.ws() + A_KC); f16* U = (f16*)(C.ws() + A_U);
    f16* QA = (f16*)(C.ws() + A_QA);
    const float* ropeA = (const float*)(C.ws() + WS_ROPE); const float* ropeC = ropeA + 2048;
    const float* akg = C.in(I_AKG) + l * 64; const float* aqg = C.in(I_AQG) + l * 64;
    const float* ckvg = C.in(I_CKVG) + l * 256; const float* cqg = C.in(I_CQG) + l * 768;
    const int lane = C.lane;
    for (int r = C.bid * NWAVES + C.wid; r < MALL; r += C.nblk * NWAVES) {
        const RowInfo ri = row_info(r);
        f16* prow = PROJ + (size_t)r * PLD;
        const int prow_i = ri.t >> 6, pcol_i = ri.t & 63;
        float cA = 1.f, sA = 0.f;
        if (ri.lat) { const int part = lane >> 5, j = lane & 15, pi = part ? pcol_i : prow_i; cA = ropeA[pi * 16 + j]; sA = ropeA[1024 + pi * 16 + j]; if (!((lane >> 4) & 1)) sA = -sA; }
#pragma unroll
        for (int hd = 0; hd < 2; ++hd) {
            const float x = (float)prow[OFF_AK + hd * 64 + lane];
            const float ss = wave_sum(x * x);
            float y = x * (1.0f / sqrtf(ss * (1.0f / 64.0f) + EPS)) * akg[lane];
            const float p = __shfl_xor(y, 16);
            y = y * cA + p * sA;
            KA[((size_t)(ri.b * 2 + hd) * NKEY + ri.pos) * 64 + lane] = (f16)y;
            VA[((size_t)(ri.b * 2 + hd) * NKEY + ri.pos) * 64 + lane] = prow[OFF_AV + hd * 64 + lane];
        }
        {
            f16x4 x4 = *(f16x4*)(prow + OFF_CKV + 4 * lane);
            float xf[4]; float ss = 0.f;
#pragma unroll
            for (int e = 0; e < 4; ++e) { xf[e] = (float)x4[e]; ss += xf[e] * xf[e]; }
            ss = wave_sum(ss);
            const float rs = 1.0f / sqrtf(ss * (1.0f / 256.0f) + EPS);
#pragma unroll
            for (int e = 0; e < 4; ++e) x4[e] = (f16)(xf[e] * rs * ckvg[4 * lane + e]);
            *(f16x4*)(prow + OFF_CKV + 4 * lane) = x4;
        }
        {
            const int d = lane & 31;
            float x = (float)prow[OFF_CKR + d];
            float cc = 1.f, sc = 0.f;
            if (ri.lat) { const int part = d >> 4, j = d & 7, pi = part ? pcol_i : prow_i; cc = ropeC[pi * 8 + j]; sc = ropeC[512 + pi * 8 + j]; if (!((d >> 3) & 1)) sc = -sc; }
            const float p = __shfl_xor(x, 8);
            x = x * cc + p * sc;
            if (lane < 32) {
#pragma unroll
                for (int h = 0; h < 8; ++h) KC[((size_t)(ri.b * 8 + h) * NKEY + ri.pos) * 96 + 64 + d] = (f16)x;
            }
        }
        *(f16x8*)(U + (size_t)r * 512 + 8 * lane) = *(const f16x8*)(prow + OFF_U + 8 * lane);
        if (ri.lat || l == 0) {
            f16* qdst = ri.lat ? QA + ((size_t)(ri.b * 8) * SEQ + ri.t) * 64 : QA + (size_t)NB * 8 * SEQ * 64 + ((size_t)(ri.b * 8) * CTX + ri.t) * 64;
            const size_t hstride = ri.lat ? (size_t)SEQ * 64 : (size_t)CTX * 64;
#pragma unroll
            for (int h = 0; h < 8; ++h) {
                const float x = (float)prow[OFF_AQ + h * 64 + lane];
                const float ss = wave_sum(x * x);
                float y = x * (1.0f / sqrtf(ss * (1.0f / 64.0f) + EPS)) * aqg[lane];
                const float p = __shfl_xor(y, 16);
                y = (y * cA + p * sA) * QSCALE_A;
                qdst[h * hstride + lane] = (f16)y;
            }
            f16x4 x4[3]; float ss = 0.f;
#pragma unroll
            for (int i = 0; i < 3; ++i) { x4[i] = *(f16x4*)(prow + OFF_CQ + 256 * i + 4 * lane);
#pragma unroll
                for (int e = 0; e < 4; ++e) { const float f = (float)x4[i][e]; ss += f * f; } }
            ss = wave_sum(ss);
            const float rs = 1.0f / sqrtf(ss * (1.0f / 768.0f) + EPS);
#pragma unroll
            for (int i = 0; i < 3; ++i) {
#pragma unroll
                for (int e = 0; e < 4; ++e) x4[i][e] = (f16)((float)x4[i][e] * rs * cqg[256 * i + 4 * lane + e]);
                *(f16x4*)(prow + OFF_CQ + 256 * i + 4 * lane) = x4[i]; }
        }
    }
}

namespace pg8 {
#define PG8_LAS __attribute__((address_space(3)))
typedef _Float16 bf16_t;
typedef _Float16 bf16x8 __attribute__((ext_vector_type(8)));
constexpr int BM = 256, BK = 64, HALF = 128, HTB = HALF * BK * 2  , STAGE_BYTES = 8 * HTB, NXCD = 8, WGM = 8;

__host__ __device__ __forceinline__ int lds_byte(int r, int c) { const int st = (r >> 4) * 2 + (c >> 5), rr = r & 15, cc = c & 31, ob = rr * 64 + cc * 2; return st * 1024 + (ob ^ (((ob >> 9) & 1) << 5)); }
__host__ __device__ __forceinline__ void stage_rc(int b, int& R, int& C) { const int st = b / 1024, sb = b % 1024, swz = sb ^ (((sb >> 9) & 1) << 5); R = (st >> 1) * 16 + swz / 64; C = (st & 1) * 32 + (swz % 64) / 2; }
__host__ __device__ __forceinline__ int perm32(int rho) { const int n = rho >> 4, i = rho & 15; return 8 * (i >> 2) + 4 * n + (i & 3); }
struct Unit { int pm, pn; };
struct Gemm { const bf16_t* A; const bf16_t* Bt; int M, N, K, lda, ldb; };

struct StaticOrder {
    int nM, nN, nwg, G, c;
    __host__ __device__ void init(int M, int N, int G_, int c_) { nM = M / BM; nN = N / BM; nwg = nM * nN; G = G_; c = c_; }
    __host__ __device__ bool next(int i, Unit& u) const {
        const long L = (long)i * G + c; if (L >= nwg) return false;
        int wgid = (int)L; { const int q = nwg / NXCD, r = nwg % NXCD, xcd = wgid % NXCD, off = wgid / NXCD; wgid = (xcd < r ? xcd * (q + 1) : r * (q + 1) + (xcd - r) * q) + off; }
        const int nig = WGM * nN, gid = wgid / nig, fm = gid * WGM, gsz = (nM - fm) < WGM ? (nM - fm) : WGM;
        u.pm = fm + ((wgid % nig) % gsz); u.pn = (wgid % nig) / gsz; return true;
    }
    __device__ __forceinline__ void a_ready(const Unit&) const {}
    __device__ __forceinline__ void done(const Unit&) const {}
};

template <class F> struct EpiFn { static constexpr bool PERM = true, AFTER_DRAIN = false; F f;
    __device__ __forceinline__ void operator()(const f32x4 (&acc)[2][2][4][2], const Unit& u, int wr, int wc, int fr, int fq) const {
#pragma unroll
        for (int ai = 0; ai < 2; ++ai)
#pragma unroll
            for (int m = 0; m < 4; ++m) { const int row = u.pm * BM + ai * HALF + wr * 64 + m * 16 + fr;
#pragma unroll
                for (int bj = 0; bj < 2; ++bj) f(row, u.pn * BM + bj * HALF + wc * 32 + 8 * fq, acc[ai][bj][m][0], acc[ai][bj][m][1]);
                asm volatile("" ::: "memory"); }
    } };

template <class Epi, class Sched, bool ALIGN_EPI = false, bool SP2 = false>
__device__ __forceinline__ void gemm_phase(PG8_LAS unsigned char* lds, const Gemm g, const Sched& S, const Epi& E, const int tid) {
    const int wid = __builtin_amdgcn_readfirstlane(tid >> 6), lane = tid & 63, wr = wid >> 2, wc = wid & 3, fr = lane & 15, fq = lane >> 4;
    const int K = g.K, nt = K / BK;
    unsigned voffA[2], voffB[2];
#pragma unroll
    for (int i = 0; i < 2; ++i) { int R, C; stage_rc(tid * 16 + i * 8192, R, C); const int Rb = Epi::PERM ? ((R & ~31) + perm32(R & 31)) : R;
        voffA[i] = (unsigned)(R * g.lda + C) * 2u; voffB[i] = (unsigned)(Rb * g.ldb + C) * 2u; }
    const size_t kstep = (size_t)(BK * 2);
    const size_t hstepA = (size_t)HALF * g.lda * 2, hstepB = (size_t)HALF * g.ldb * 2;
    const size_t tstepA = 2 * hstepA, tstepB = 2 * hstepB;
    const unsigned ldsw = (unsigned)wid * 1024u;
    const int aoff = lds_byte(wr * 64 + fr, fq * 8), boff = lds_byte(wc * 32 + fr, fq * 8);
#define PG8_SA(b, h) (((b) * 2 + (h)) * HTB)
#define PG8_SB(b, h) ((4 + (b) * 2 + (h)) * HTB)
#define PG8_STAGE(bufoff, gbase, voff) do { _Pragma("unroll") for (int _i = 0; _i < 2; ++_i) \
        __builtin_amdgcn_global_load_lds((const unsigned*)((const char*)(gbase) + (voff)[_i]), (PG8_LAS unsigned*)(lds + (bufoff) + ldsw + _i * 8192), 16, 0, 0); } while (0)
#define PG8_LDA(dst, b, h) do { _Pragma("unroll") for (int m = 0; m < 4; ++m) _Pragma("unroll") for (int k = 0; k < 2; ++k) dst[m][k] = *(const PG8_LAS bf16x8*)(lds + PG8_SA(b, h) + aoff + m * 2048 + k * 1024); } while (0)
#define PG8_LDB(dst, b, h) do { _Pragma("unroll") for (int n = 0; n < 2; ++n) _Pragma("unroll") for (int k = 0; k < 2; ++k) dst[n][k] = *(const PG8_LAS bf16x8*)(lds + PG8_SB(b, h) + boff + n * 2048 + k * 1024); } while (0)
#define PG8_MMA(ai, bj, At, Bt) do { __builtin_amdgcn_s_setprio(1); _Pragma("unroll") for (int m = 0; m < 4; ++m) _Pragma("unroll") for (int n = 0; n < 2; ++n) _Pragma("unroll") for (int k = 0; k < 2; ++k) \
        acc[ai][bj][m][n] = __builtin_amdgcn_mfma_f32_16x16x32_f16(Bt[n][k], At[m][k], acc[ai][bj][m][n], 0, 0, 0); __builtin_amdgcn_s_setprio(0); } while (0)
#define PG8_WAIT_V(n) asm volatile("s_waitcnt vmcnt(" #n ")" ::: "memory")
#define PG8_WAIT_L(n) asm volatile("s_waitcnt lgkmcnt(" #n ")" ::: "memory")
#define PG8_BAR __builtin_amdgcn_s_barrier()
#define PG8_SCHED __builtin_amdgcn_sched_barrier(0)
    Unit cur, nxt; int ui = 0;
    if (!S.next(0, cur)) return;
    f32x4 acc[2][2][4][2];
#pragma unroll
    for (int a = 0; a < 2; ++a)
#pragma unroll
        for (int b = 0; b < 2; ++b)
#pragma unroll
            for (int m = 0; m < 4; ++m)
#pragma unroll
                for (int n = 0; n < 2; ++n) acc[a][b][m][n] = (f32x4){0.f, 0.f, 0.f, 0.f};
    bf16x8 At[4][2], B0[2][2], B1[2][2];
    const char* cA = (const char*)g.A + (size_t)cur.pm * tstepA; const char* cB = (const char*)g.Bt + (size_t)cur.pn * tstepB;
    S.a_ready(cur);
    if constexpr (SP2) {
        PG8_STAGE(PG8_SB(0, 0), cB, voffB); PG8_STAGE(PG8_SB(0, 1), cB + hstepB, voffB); PG8_STAGE(PG8_SA(0, 0), cA, voffA); PG8_STAGE(PG8_SA(0, 1), cA + hstepA, voffA);
        if (wr == 1) PG8_BAR;
        PG8_WAIT_V(2); PG8_BAR;
        PG8_STAGE(PG8_SB(1, 0), cB + kstep, voffB); PG8_STAGE(PG8_SA(1, 0), cA + kstep, voffA); PG8_STAGE(PG8_SB(1, 1), cB + hstepB + kstep, voffB);
        PG8_WAIT_V(6); PG8_BAR;
    } else {
        PG8_STAGE(PG8_SB(0, 0), cB, voffB); PG8_STAGE(PG8_SA(0, 0), cA, voffA); PG8_STAGE(PG8_SB(0, 1), cB + hstepB, voffB); PG8_STAGE(PG8_SA(0, 1), cA + hstepA, voffA);
        if (wr == 1) PG8_BAR;
        PG8_WAIT_V(4); PG8_BAR;
        PG8_STAGE(PG8_SB(1, 0), cB + kstep, voffB); PG8_STAGE(PG8_SA(1, 0), cA + kstep, voffA); PG8_STAGE(PG8_SB(1, 1), cB + hstepB + kstep, voffB);
        PG8_WAIT_V(6); PG8_BAR;
    }
    for (;;) {
        const bool has_next = S.next(ui + 1, nxt);
        const char* nA = has_next ? (const char*)g.A + (size_t)nxt.pm * tstepA : cA; const char* nB = has_next ? (const char*)g.Bt + (size_t)nxt.pn * tstepB : cB;
#pragma unroll 1
        for (int t = 0; t < nt; t += 2) {
            const bool last = (t == nt - 2);
            const char* a1 = cA + (size_t)(t + 1) * kstep;
            const char* a2 = last ? nA : cA + (size_t)(t + 2) * kstep; const char* b2 = last ? nB : cB + (size_t)(t + 2) * kstep;
            const char* a3 = a2 + kstep; const char* b3 = b2 + kstep;
            if (last && has_next) S.a_ready(nxt);
            if constexpr (SP2) {
            PG8_LDB(B0, 0, 0); PG8_LDB(B1, 0, 1); PG8_SCHED; PG8_LDA(At, 0, 0); PG8_STAGE(PG8_SA(1, 1), a1 + hstepA, voffA);
            PG8_WAIT_V(8); PG8_WAIT_L(0); PG8_BAR; PG8_MMA(0, 0, At, B0); PG8_MMA(0, 1, At, B1); PG8_BAR; PG8_SCHED;
            PG8_LDA(At, 0, 1); PG8_STAGE(PG8_SB(0, 0), b2, voffB); PG8_STAGE(PG8_SB(0, 1), b2 + hstepB, voffB); PG8_STAGE(PG8_SA(0, 0), a2, voffA);
            PG8_WAIT_V(8); PG8_WAIT_L(0); PG8_BAR; PG8_MMA(1, 0, At, B0); PG8_MMA(1, 1, At, B1); PG8_BAR; PG8_SCHED;
            PG8_LDB(B0, 1, 0); PG8_LDB(B1, 1, 1); PG8_SCHED; PG8_LDA(At, 1, 0); PG8_STAGE(PG8_SA(0, 1), a2 + hstepA, voffA);
            PG8_WAIT_V(8); PG8_WAIT_L(0); PG8_BAR; PG8_MMA(0, 0, At, B0); PG8_MMA(0, 1, At, B1); PG8_BAR; PG8_SCHED;
            PG8_LDA(At, 1, 1); PG8_STAGE(PG8_SB(1, 0), b3, voffB); PG8_STAGE(PG8_SB(1, 1), b3 + hstepB, voffB); PG8_STAGE(PG8_SA(1, 0), a3, voffA);
            PG8_WAIT_V(8); PG8_WAIT_L(0); PG8_BAR; PG8_MMA(1, 0, At, B0); PG8_MMA(1, 1, At, B1); PG8_BAR; PG8_SCHED;
            } else {
            PG8_LDB(B0, 0, 0); PG8_SCHED; PG8_LDA(At, 0, 0); PG8_STAGE(PG8_SA(1, 1), a1 + hstepA, voffA);
            PG8_WAIT_L(8); PG8_BAR; PG8_WAIT_L(0); PG8_MMA(0, 0, At, B0); PG8_BAR; PG8_SCHED;
            PG8_LDB(B1, 0, 1); PG8_STAGE(PG8_SB(0, 0), b2, voffB);
            PG8_BAR; PG8_WAIT_L(0); PG8_MMA(0, 1, At, B1); PG8_BAR;
            PG8_LDA(At, 0, 1); PG8_STAGE(PG8_SA(0, 0), a2, voffA);
            PG8_BAR; PG8_WAIT_L(0); PG8_MMA(1, 0, At, B0); PG8_BAR; PG8_SCHED;
            PG8_STAGE(PG8_SB(0, 1), b2 + hstepB, voffB);
            PG8_WAIT_V(6); PG8_BAR; PG8_MMA(1, 1, At, B1); PG8_BAR;
            PG8_LDB(B0, 1, 0); PG8_SCHED; PG8_LDA(At, 1, 0); PG8_STAGE(PG8_SA(0, 1), a2 + hstepA, voffA);
            PG8_WAIT_L(8); PG8_BAR; PG8_WAIT_L(0); PG8_MMA(0, 0, At, B0); PG8_BAR; PG8_SCHED;
            PG8_LDB(B1, 1, 1); PG8_STAGE(PG8_SB(1, 0), b3, voffB);
            PG8_BAR; PG8_WAIT_L(0); PG8_MMA(0, 1, At, B1); PG8_BAR;
            PG8_LDA(At, 1, 1); PG8_STAGE(PG8_SA(1, 0), a3, voffA);
            PG8_BAR; PG8_WAIT_L(0); PG8_MMA(1, 0, At, B0); PG8_BAR; PG8_SCHED;
            PG8_STAGE(PG8_SB(1, 1), b3 + hstepB, voffB);
            PG8_WAIT_V(6); PG8_BAR; PG8_MMA(1, 1, At, B1); PG8_BAR;
            }
        }
        if constexpr (ALIGN_EPI) { if (wr == 0) PG8_BAR; }
        if constexpr (!Epi::AFTER_DRAIN) { E(acc, cur, wr, wc, fr, fq); S.done(cur); }
        if (!has_next) break;
#pragma unroll
        for (int a = 0; a < 2; ++a)
#pragma unroll
            for (int b = 0; b < 2; ++b)
#pragma unroll
                for (int m = 0; m < 4; ++m)
#pragma unroll
                    for (int n = 0; n < 2; ++n) acc[a][b][m][n] = (f32x4){0.f, 0.f, 0.f, 0.f};
        cur = nxt; cA = nA; cB = nB; ++ui;
        if constexpr (ALIGN_EPI) { if (wr == 1) PG8_BAR; }
    }
    PG8_WAIT_V(0);
    if constexpr (!ALIGN_EPI) { if (wr == 0) PG8_BAR; }
    PG8_BAR;
    if constexpr (Epi::AFTER_DRAIN) { E.fused(acc, cur, wr, wc, fr, fq, lds, wid, lane); S.done(cur); }
#undef PG8_SA
#undef PG8_SB
#undef PG8_STAGE
#undef PG8_LDA
#undef PG8_LDB
#undef PG8_MMA
#undef PG8_WAIT_V
#undef PG8_WAIT_L
#undef PG8_BAR
#undef PG8_SCHED
}
}

template <class Epi>
__device__ __forceinline__ void gemm_simple(const Ctx& C, const f16* A, int lda, const f16* Bt, int ldb, int M, int N, int K, const Epi& E, int mskip_from = 1 << 30, int nskip_from = 1 << 30) {
    const int wr = C.wid >> 2, wc = C.wid & 3, fr = C.lane & 15, fq = C.lane >> 4;
    const int tilesN = N / 256, tilesM = M / 64;
    for (int tile = C.bid; tile < tilesM * tilesN; tile += C.nblk) {
        const int tm = tile / tilesN, tn = tile % tilesN;
        if (tm * 64 >= mskip_from && tn * 256 >= nskip_from) continue;
        const int m0 = tm * 64 + wr * 32, n0 = tn * 256 + wc * 64;
        f32x4 acc[2][2][2];
#pragma unroll
        for (int a = 0; a < 2; ++a)
#pragma unroll
            for (int g = 0; g < 2; ++g)
#pragma unroll
                for (int n = 0; n < 2; ++n) acc[a][g][n] = (f32x4){0.f, 0.f, 0.f, 0.f};
        const f16* ap[2]; const f16* bp[2][2];
#pragma unroll
        for (int a = 0; a < 2; ++a) ap[a] = A + (size_t)(m0 + a * 16 + fr) * lda + fq * 8;
#pragma unroll
        for (int g = 0; g < 2; ++g)
#pragma unroll
            for (int n = 0; n < 2; ++n) bp[g][n] = Bt + (size_t)(n0 + g * 32 + 8 * (fr >> 2) + 4 * n + (fr & 3)) * ldb + fq * 8;
        for (int k0 = 0; k0 < K; k0 += 32) {
            f16x8 av[2], bv[2][2];
#pragma unroll
            for (int a = 0; a < 2; ++a) av[a] = *(const f16x8*)(ap[a] + k0);
#pragma unroll
            for (int g = 0; g < 2; ++g)
#pragma unroll
                for (int n = 0; n < 2; ++n) bv[g][n] = *(const f16x8*)(bp[g][n] + k0);
#pragma unroll
            for (int a = 0; a < 2; ++a)
#pragma unroll
                for (int g = 0; g < 2; ++g)
#pragma unroll
                    for (int n = 0; n < 2; ++n) acc[a][g][n] = __builtin_amdgcn_mfma_f32_16x16x32_f16(bv[g][n], av[a], acc[a][g][n], 0, 0, 0);
        }
#pragma unroll
        for (int a = 0; a < 2; ++a)
#pragma unroll
            for (int g = 0; g < 2; ++g) E(m0 + a * 16 + fr, n0 + g * 32 + 8 * fq, acc[a][g][0], acc[a][g][1]);
    }
}

template <class F>
__device__ __forceinline__ void gemm_pg8(const Ctx& C, const f16* A, int lda, const f16* Bt, int ldb, int M, int N, int K, const F& f) {
    pg8::Gemm g{A, Bt, M, N, K, lda, ldb}; pg8::StaticOrder S; S.init(M, N, C.nblk, C.bid);
    pg8::EpiFn<F> E{f};
    pg8::gemm_phase<pg8::EpiFn<F>, pg8::StaticOrder, true, true>(C.lds, g, S, E, C.tid);
}
struct EpiStore { f16* O; int ldo;
    __device__ __forceinline__ void operator()(int row, int col, f32x4 lo, f32x4 hi) const { *(f16x8*)(O + (size_t)row * ldo + col) = pack8(lo, hi); } };
struct EpiKvUp { f16* KC; f16* VC;
    __device__ __forceinline__ void operator()(int row, int col, f32x4 lo, f32x4 hi) const {
        const RowInfo ri = row_info(row); const int h = col >> 7, w = col & 127;
        if (w < 64) *(f16x8*)(KC + ((size_t)(ri.b * 8 + h) * NKEY + ri.pos) * 96 + w) = pack8(lo, hi);
        else *(f16x8*)(VC + ((size_t)(ri.b * 8 + h) * NKEY + ri.pos) * 64 + (w - 64)) = pack8(lo, hi);
    } };
struct EpiQUp { f16* QC; const float* ropeC;
    __device__ __forceinline__ void operator()(int row, int col, f32x4 lo, f32x4 hi) const {
        const RowInfo ri = row_info(row); const int h = col / 96, w = col - h * 96;
        if (w >= 64) {
            f32x4 plo, phi;
#pragma unroll
            for (int e = 0; e < 4; ++e) { plo[e] = __shfl_xor(lo[e], 16); phi[e] = __shfl_xor(hi[e], 16); }
            if (ri.lat) {
                const int j0 = w - 64, part = j0 >> 4, second = (j0 >> 3) & 1, pi = part ? (ri.t & 63) : (ri.t >> 6);
                const float* cc = ropeC + pi * 8; const float* ss = ropeC + 512 + pi * 8;
#pragma unroll
                for (int e = 0; e < 4; ++e) {
                    const float s0 = second ? ss[e] : -ss[e], s1 = second ? ss[4 + e] : -ss[4 + e];
                    lo[e] = lo[e] * cc[e] + plo[e] * s0; hi[e] = hi[e] * cc[4 + e] + phi[e] * s1; }
            }
        }
        lo = lo * QSCALE_C; hi = hi * QSCALE_C;
        f16* dst = ri.lat ? QC + ((size_t)(ri.b * 8 + h) * SEQ + ri.t) * 96 + w : QC + (size_t)NB * 8 * SEQ * 96 + ((size_t)(ri.b * 8 + h) * CTX + ri.t) * 96 + w;
        *(f16x8*)dst = pack8(lo, hi);
    } };
struct EpiGlu { f16* YS;
    __device__ __forceinline__ void operator()(int row, int col, f32x4 lo, f32x4 hi) const {
        f32x4 o;
#pragma unroll
        for (int e = 0; e < 4; ++e) o[e] = lo[e] * sigmoidf_(hi[e]);
        *(f16x4*)(YS + (size_t)row * 512 + (col >> 1)) = pack4(o);
    } };
struct EpiGate { f16* G;
    __device__ __forceinline__ void operator()(int row, int col, f32x4 lo, f32x4 hi) const {
#pragma unroll
        for (int e = 0; e < 4; ++e) { lo[e] = sigmoidf_(lo[e]); hi[e] = sigmoidf_(hi[e]); }
        *(f16x8*)(G + (size_t)row * 1024 + col) = pack8(lo, hi);
    } };
struct EpiBranch { const f16* G; f16* Mg; int first;
    __device__ __forceinline__ void operator()(int row, int col, f32x4 lo, f32x4 hi) const {
        const f16x8 g = *(const f16x8*)(G + (size_t)row * 1024 + col);
        f16x8 m = {0, 0, 0, 0, 0, 0, 0, 0};
        if (!first) m = *(const f16x8*)(Mg + (size_t)row * 1024 + col);
#pragma unroll
        for (int e = 0; e < 4; ++e) { lo[e] = (float)m[e] + (float)g[e] * lo[e]; hi[e] = (float)m[4 + e] + (float)g[4 + e] * hi[e]; }
        *(f16x8*)(Mg + (size_t)row * 1024 + col) = pack8(lo, hi);
    } };
struct EpiWout { const Ctx* C; int l;
    __device__ __forceinline__ void operator()(int row, int col, f32x4 lo, f32x4 hi) const {
        const RowInfo ri = row_info(row); const float* x = C->xsrc(l, row) + col; const float* g = C->mod(l, ri.mrow, 2) + col; float* t = C->ta(row) + col;
        const f32x4 x0 = *(const f32x4*)x, x1 = *(const f32x4*)(x + 4), g0 = *(const f32x4*)g, g1 = *(const f32x4*)(g + 4);
        *(f32x4*)t = x0 * ALPHA + g0 * lo; *(f32x4*)(t + 4) = x1 * ALPHA + g1 * hi;
    } };
struct EpiUp { f16* Hd;
    __device__ __forceinline__ void operator()(int row, int col, f32x4 lo, f32x4 hi) const {
#pragma unroll
        for (int e = 0; e < 4; ++e) { const float a = fmaxf(lo[e], 0.f), b = fmaxf(hi[e], 0.f); lo[e] = a * a; hi[e] = b * b; }
        *(f16x8*)(Hd + (size_t)row * DFF + col) = pack8(lo, hi);
    } };
struct EpiDown { const Ctx* C; int l;
    __device__ __forceinline__ void operator()(int row, int col, f32x4 lo, f32x4 hi) const {
        const RowInfo ri = row_info(row); const float* g = C->mod(l, ri.mrow, 5) + col; float* t = C->ta(row) + col;
        const f32x4 x0 = *(const f32x4*)t, x1 = *(const f32x4*)(t + 4), g0 = *(const f32x4*)g, g1 = *(const f32x4*)(g + 4);
        *(f32x4*)t = x0 * ALPHA + g0 * lo; *(f32x4*)(t + 4) = x1 * ALPHA + g1 * hi;
    } };

typedef _Float16 f16x2 __attribute__((ext_vector_type(2)));
template <int DQK>
__device__ __forceinline__ void attn_naive_query(const f16* q, const f16* Kh, const f16* Vh, int nkeys, f16* out, LAS float* scr, int lane) {
    f16x8 qv[DQK / 8];
#pragma unroll
    for (int c = 0; c < DQK / 8; ++c) qv[c] = *(const f16x8*)(q + 8 * c);
    float m = -1e30f, ls = 0.f; float acc[64];
#pragma unroll
    for (int d = 0; d < 64; ++d) acc[d] = 0.f;
    for (int j = lane; j < nkeys; j += 64) {
        const f16* kr = Kh + (size_t)j * DQK; const f16* vr = Vh + (size_t)j * 64;
        float s = 0.f;
#pragma unroll
        for (int c = 0; c < DQK / 8; ++c) { const f16x8 v = *(const f16x8*)(kr + 8 * c);
#pragma unroll
            for (int e = 0; e < 4; ++e) s = __builtin_amdgcn_fdot2((f16x2){qv[c][2 * e], qv[c][2 * e + 1]}, (f16x2){v[2 * e], v[2 * e + 1]}, s, false); }
        const float mn = fmaxf(m, s), a = exp2f(m - mn), p = exp2f(s - mn);
        ls = ls * a + p; m = mn;
#pragma unroll
        for (int c = 0; c < 8; ++c) { const f16x8 v = *(const f16x8*)(vr + 8 * c);
#pragma unroll
            for (int e = 0; e < 8; ++e) acc[8 * c + e] = acc[8 * c + e] * a + p * (float)v[e]; }
    }
    const float mg = wave_max(m), w = exp2f(m - mg);
    const float L = wave_sum(ls * w);
#pragma unroll
    for (int d = 0; d < 64; ++d) scr[lane * 65 + d] = acc[d] * w;
    asm volatile("s_waitcnt lgkmcnt(0)" ::: "memory");
    float o = 0.f;
#pragma unroll 8
    for (int i = 0; i < 64; ++i) o += scr[i * 65 + lane];
    asm volatile("s_waitcnt lgkmcnt(0)" ::: "memory");
    out[lane] = (f16)(o / L);
}
__device__ __forceinline__ void phase_attn_naive(const Ctx& C, int l) {
    LAS float* scr = (LAS float*)C.lds + C.wid * (64 * 65);
    const f16* QA = (const f16*)(C.ws() + A_QA); const f16* QC = (const f16*)(C.ws() + A_QC);
    const f16* KA = (const f16*)(C.ws() + A_KA); const f16* VA = (const f16*)(C.ws() + A_VA);
    const f16* KC = (const f16*)(C.ws() + A_KC); const f16* VC = (const f16*)(C.ws() + A_VC);
    f16* YA = (f16*)(C.ws() + A_YA); f16* YC = (f16*)(C.ws() + A_YC);
    const int NQL = NB * 8 * SEQ, NQC = NB * 8 * CTX;
    const int total = 2 * NQL + (l == 0 ? 2 * NQC : 0);
    for (int u = C.bid * NWAVES + C.wid; u < total; u += C.nblk * NWAVES) {
        int v = u; int type, lat;
        if (v < 2 * NQL) { type = v / NQL; v -= type * NQL; lat = 1; } else { v -= 2 * NQL; type = v / NQC; v -= type * NQC; lat = 0; }
        const int nq = lat ? SEQ : CTX;
        const int t = v % nq, h = (v / nq) & 7, b = v / (nq * 8);
        const int row = lat ? b * SEQ + t : NLAT + b * CTX + t;
        const int nkeys = lat ? NKEY : CTX;
        if (type == 0) {
            const f16* q = lat ? QA + ((size_t)(b * 8 + h) * SEQ + t) * 64 : QA + (size_t)NB * 8 * SEQ * 64 + ((size_t)(b * 8 + h) * CTX + t) * 64;
            attn_naive_query<64>(q, KA + (size_t)(b * 2 + (h >> 2)) * NKEY * 64, VA + (size_t)(b * 2 + (h >> 2)) * NKEY * 64, nkeys, YA + (size_t)row * 512 + h * 64, scr, C.lane);
        } else {
            const f16* q = lat ? QC + ((size_t)(b * 8 + h) * SEQ + t) * 96 : QC + (size_t)NB * 8 * SEQ * 96 + ((size_t)(b * 8 + h) * CTX + t) * 96;
            attn_naive_query<96>(q, KC + (size_t)(b * 8 + h) * NKEY * 96, VC + (size_t)(b * 8 + h) * NKEY * 64, nkeys, YC + (size_t)row * 512 + h * 64, scr, C.lane);
        }
    }
}

namespace fa {
typedef _Float16 h2 __attribute__((ext_vector_type(2)));
typedef float f2 __attribute__((ext_vector_type(2)));
typedef short s16x4 __attribute__((ext_vector_type(4)));
typedef unsigned u32x4 __attribute__((ext_vector_type(4)));
#define FA_SBAR() __builtin_amdgcn_sched_barrier(0)
constexpr float THR = 8.f;
constexpr int SHM_V = 64 * 64 * 2;
template <int DQK> struct Cfg { static constexpr int KROWB = DQK == 64 ? 128 : 256, SHM_K = 64 * KROWB, NCH = DQK / 8; };
template <int DQK> __device__ __forceinline__ int kswz(int row, int ch) {
    if constexpr (DQK == 64) return row * 128 + ((ch ^ ((row >> 1) & 7)) << 4);
    else return row * 256 + ((ch ^ (row & 15)) << 4);
}
__device__ __forceinline__ int crow(int r, int hi) { return (r & 3) + 8 * (r >> 2) + 4 * hi; }
__device__ __forceinline__ unsigned cvtpk(float lo, float hi) { f2 v = {lo, hi}; h2 h = __builtin_convertvector(v, h2); return __builtin_bit_cast(unsigned, h); }
__device__ __forceinline__ void partialSM(f32x16& p0, f32x16& p1, float& m_reg, float& mn, float& alpha) {
    float pmax = p0[0];
#pragma unroll
    for (int r = 1; r < 16; ++r) pmax = fmaxf(pmax, p0[r]);
#pragma unroll
    for (int r = 0; r < 16; ++r) pmax = fmaxf(pmax, p1[r]);
    { auto rr = __builtin_amdgcn_permlane32_swap(__float_as_uint(pmax), __float_as_uint(pmax), false, false);
      pmax = fmaxf(__uint_as_float(rr[0]), __uint_as_float(rr[1])); }
    if (__builtin_expect(__all(pmax - m_reg <= THR), 1)) { mn = m_reg; alpha = 1.f; }
    else { mn = fmaxf(m_reg, pmax); alpha = __builtin_amdgcn_exp2f(m_reg - mn); m_reg = mn; }
#pragma unroll
    for (int r = 0; r < 16; ++r) { p0[r] = p0[r] - mn; p1[r] = p1[r] - mn; }
#pragma unroll
    for (int r = 0; r < 16; ++r) p0[r] = __builtin_amdgcn_exp2f(p0[r]);
}
__device__ __forceinline__ void finishSM(f32x16& p0, f32x16& p1, float alpha, float& l_reg, f16x8& pa0, f16x8& pa1, f16x8& pa2, f16x8& pa3) {
#pragma unroll
    for (int r = 0; r < 16; ++r) p1[r] = __builtin_amdgcn_exp2f(p1[r]);
    float ps = 0;
#pragma unroll
    for (int r = 0; r < 16; ++r) ps += p0[r];
#pragma unroll
    for (int r = 0; r < 16; ++r) ps += p1[r];
    { auto rr = __builtin_amdgcn_permlane32_swap(__float_as_uint(ps), __float_as_uint(ps), false, false);
      ps = __uint_as_float(rr[0]) + __uint_as_float(rr[1]); }
    l_reg = l_reg * alpha + ps;
#define FA_PK4(P, BASE, OUT) do { unsigned a0 = cvtpk(P[BASE + 0], P[BASE + 1]), a1 = cvtpk(P[BASE + 2], P[BASE + 3]);   \
    unsigned b0 = cvtpk(P[BASE + 4], P[BASE + 5]), b1 = cvtpk(P[BASE + 6], P[BASE + 7]);                              \
    auto r0 = __builtin_amdgcn_permlane32_swap(a0, b0, false, false); auto r1 = __builtin_amdgcn_permlane32_swap(a1, b1, false, false); \
    u32x4 w = {r0[0], r1[0], r0[1], r1[1]}; OUT = __builtin_bit_cast(f16x8, w); } while (0)
    FA_PK4(p0, 0, pa0); FA_PK4(p0, 8, pa1); FA_PK4(p1, 0, pa2); FA_PK4(p1, 8, pa3);
#undef FA_PK4
}
template <int DQK>
__device__ __forceinline__ void qkt(f32x16& p0, f32x16& p1, const LAS unsigned char* Ks, const f16x8* qr, int r32, int hi) {
    p0 = f32x16{}; p1 = f32x16{};
#pragma unroll
    for (int d0 = 0; d0 < DQK / 16; ++d0) {
        const f16x8 b0 = *(const LAS f16x8*)(Ks + kswz<DQK>(r32, d0 * 2 + hi));
        const f16x8 b1 = *(const LAS f16x8*)(Ks + kswz<DQK>(32 + r32, d0 * 2 + hi));
        p0 = __builtin_amdgcn_mfma_f32_32x32x16_f16(b0, qr[d0], p0, 0, 0, 0);
        p1 = __builtin_amdgcn_mfma_f32_32x32x16_f16(b1, qr[d0], p1, 0, 0, 0);
    }
}
__device__ __forceinline__ int v_st(int k, int c) { const int kk = (k & ~0xC) | ((k & 4) << 1) | ((k & 8) >> 1); return ((kk >> 3) * 2 + (c >> 5)) * 512 + ((kk & 7) * 32 + (c & 31)) * 2; }
__device__ __forceinline__ int v_rd_base(int lane) { return ((lane & 3) << 3) | (((lane >> 2) & 3) << 6) | (((lane >> 4) & 1) << 5) | (((lane >> 5) & 1) << 8); }
constexpr int v_rd_off(int d0, int ks, int half) { return d0 * 512 + ks * 2048 + half * 1024; }
template <int OFF> __device__ __forceinline__ s16x4 tr_read(int vb) {
    s16x4 r; asm volatile("ds_read_b64_tr_b16 %0, %1 offset:%2" : "=&v"(r) : "v"(vb), "i"(OFF) : "memory"); return r;
}
template <int D0> __device__ __forceinline__ void pv_one(f32x16& od, int vb, f16x8 pa0, f16x8 pa1, f16x8 pa2, f16x8 pa3) {
    const s16x4 l0 = tr_read<v_rd_off(D0, 0, 0)>(vb), h0 = tr_read<v_rd_off(D0, 0, 1)>(vb), l1 = tr_read<v_rd_off(D0, 1, 0)>(vb), h1 = tr_read<v_rd_off(D0, 1, 1)>(vb);
    const s16x4 l2 = tr_read<v_rd_off(D0, 2, 0)>(vb), h2_ = tr_read<v_rd_off(D0, 2, 1)>(vb), l3 = tr_read<v_rd_off(D0, 3, 0)>(vb), h3 = tr_read<v_rd_off(D0, 3, 1)>(vb);
    asm volatile("s_waitcnt lgkmcnt(0)" ::: "memory"); FA_SBAR();
#define FA_PK(L, H) __builtin_bit_cast(f16x8, (short __attribute__((ext_vector_type(8)))){L[0], L[1], L[2], L[3], H[0], H[1], H[2], H[3]})
    od = __builtin_amdgcn_mfma_f32_32x32x16_f16(pa0, FA_PK(l0, h0), od, 0, 0, 0);
    od = __builtin_amdgcn_mfma_f32_32x32x16_f16(pa1, FA_PK(l1, h1), od, 0, 0, 0);
    od = __builtin_amdgcn_mfma_f32_32x32x16_f16(pa2, FA_PK(l2, h2_), od, 0, 0, 0);
    od = __builtin_amdgcn_mfma_f32_32x32x16_f16(pa3, FA_PK(l3, h3), od, 0, 0, 0);
#undef FA_PK
}
__device__ __forceinline__ void pv_d0(f32x16* o, int vb, f16x8 pa0, f16x8 pa1, f16x8 pa2, f16x8 pa3) {
    pv_one<0>(o[0], vb, pa0, pa1, pa2, pa3); pv_one<1>(o[1], vb, pa0, pa1, pa2, pa3);
}
template <int DQK>
__device__ __forceinline__ void attn_unit(const f16* __restrict__ Qb, const f16* __restrict__ Kh, const f16* __restrict__ Vh, f16* __restrict__ Ob, int nkeys, LAS unsigned char* lds, const int tid) {
    constexpr int SHM_K = Cfg<DQK>::SHM_K, NCH = Cfg<DQK>::NCH, ND0 = DQK / 16;
    const int wid = tid >> 6, lane = tid & 63, r32 = lane & 31, hi = lane >> 5;
    LAS unsigned char* V_lds = lds; LAS unsigned char* K_lds = lds + 2 * SHM_V;
    LAS float* wsx = (LAS float*)(lds + 2 * SHM_V + 2 * SHM_K) + wid * 64; LAS float* li_l = wsx; LAS float* al_l = wsx + 32;
    float m_reg = -1e30f, l_reg = 0; f32x16 o[2] = {}; f16x8 qr[ND0];
    const f16* Qw = Qb + (size_t)(wid * 32 + r32) * DQK + hi * 8;
#pragma unroll
    for (int d0 = 0; d0 < ND0; ++d0) qr[d0] = *(const f16x8*)(Qw + d0 * 16);
    const int vr = tid >> 3, vc = (tid & 7) * 8, vst = v_st(vr, vc);
    const int k0id = tid, k1id = (tid + 512 < 64 * NCH) ? tid + 512 : tid;
    const int k0r = k0id / NCH, k0c = k0id % NCH, k1r = k1id / NCH, k1c = k1id % NCH;
    const bool k1on = (NCH > 8) && (tid + 512 < 64 * NCH);
    const int vb0 = (int)(uintptr_t)V_lds + v_rd_base(lane);
    struct { f16x8 vs, ks0, ks1; } sr_[2];
#define FA_SLOAD(i, kk0) do { sr_[i].vs = *(const f16x8*)(Vh + (size_t)((kk0) + vr) * 64 + vc); sr_[i].ks0 = *(const f16x8*)(Kh + (size_t)((kk0) + k0r) * DQK + k0c * 8); \
    if (NCH > 8) sr_[i].ks1 = *(const f16x8*)(Kh + (size_t)((kk0) + k1r) * DQK + k1c * 8); } while (0)
#define FA_SWRITE(b, i) do { *(LAS f16x8*)(V_lds + (b) * SHM_V + vst) = sr_[i].vs; *(LAS f16x8*)(K_lds + (b) * SHM_K + kswz<DQK>(k0r, k0c)) = sr_[i].ks0; \
    if (k1on) *(LAS f16x8*)(K_lds + (b) * SHM_K + kswz<DQK>(k1r, k1c)) = sr_[i].ks1; } while (0)
#define FA_SWAIT() do { if (NCH > 8) asm volatile("s_waitcnt vmcnt(3)" ::: "memory"); else asm volatile("s_waitcnt vmcnt(2)" ::: "memory"); } while (0)
#define FA_RESC(a) do { if (__any((a) < 1.f)) { if (hi == 0) al_l[r32] = (a); asm volatile("s_waitcnt lgkmcnt(0)" ::: "memory"); \
    _Pragma("unroll") for (int d = 0; d < 2; ++d) _Pragma("unroll") for (int r = 0; r < 16; ++r) o[d][r] *= al_l[crow(r, hi)]; } } while (0)
    f32x16 pA0, pA1, pB0, pB1; float mnA, mnB, alA, alB; f16x8 pa0, pa1, pa2, pa3; const int NT = nkeys / 64;
    constexpr int SE = 0, SO = 1;
    FA_SLOAD(SE, 0); asm volatile("s_waitcnt vmcnt(0)" ::: "memory"); FA_SWRITE(0, SE); __syncthreads();
    qkt<DQK>(pA0, pA1, K_lds, qr, r32, hi); partialSM(pA0, pA1, m_reg, mnA, alA);
    FA_SLOAD(SO, 64); if (2 < NT) FA_SLOAD(SE, 128);
    FA_SWAIT(); FA_SWRITE(1, SO); __syncthreads();
    for (int j = 1; j + 1 < NT; j += 2) {
        FA_SBAR(); qkt<DQK>(pB0, pB1, K_lds + SHM_K, qr, r32, hi);
        finishSM(pA0, pA1, alA, l_reg, pa0, pa1, pa2, pa3); FA_SBAR();
        FA_SLOAD(SO, (j + 2) * 64); FA_SBAR();
        pv_d0(o, vb0, pa0, pa1, pa2, pa3); partialSM(pB0, pB1, m_reg, mnB, alB);
        __syncthreads(); FA_SWAIT(); FA_SWRITE(0, SE);
        FA_RESC(alB); __syncthreads();
        FA_SBAR(); qkt<DQK>(pA0, pA1, K_lds, qr, r32, hi);
        finishSM(pB0, pB1, alB, l_reg, pa0, pa1, pa2, pa3); FA_SBAR();
        if (j + 3 < NT) FA_SLOAD(SE, (j + 3) * 64);
        FA_SBAR();
        pv_d0(o, vb0 + SHM_V, pa0, pa1, pa2, pa3); partialSM(pA0, pA1, m_reg, mnA, alA);
        __syncthreads(); FA_SWAIT(); FA_SWRITE(1, SO);
        FA_RESC(alA); __syncthreads();
    }
    FA_SBAR(); qkt<DQK>(pB0, pB1, K_lds + SHM_K, qr, r32, hi);
    finishSM(pA0, pA1, alA, l_reg, pa0, pa1, pa2, pa3); FA_SBAR();
    pv_d0(o, vb0, pa0, pa1, pa2, pa3); partialSM(pB0, pB1, m_reg, mnB, alB);
    __syncthreads(); FA_RESC(alB);
    finishSM(pB0, pB1, alB, l_reg, pa0, pa1, pa2, pa3); FA_SBAR();
    pv_d0(o, vb0 + SHM_V, pa0, pa1, pa2, pa3);
    if (hi == 0) li_l[r32] = l_reg;
    asm volatile("s_waitcnt lgkmcnt(0)" ::: "memory");
    float rli[16];
#pragma unroll
    for (int r = 0; r < 16; ++r) rli[r] = __builtin_amdgcn_rcpf(li_l[crow(r, hi)]);
    f16* Ow = Ob + (size_t)(wid * 32) * 512;
#pragma unroll
    for (int r = 0; r < 16; ++r) { const int orow = crow(r, hi);
#pragma unroll
        for (int d0 = 0; d0 < 2; ++d0) Ow[(size_t)orow * 512 + d0 * 32 + r32] = (f16)(o[d0][r] * rli[r]); }
#undef FA_SLOAD
#undef FA_SWRITE
#undef FA_SWAIT
#undef FA_RESC
}
}
__device__ __forceinline__ void phase_attn_flash(const Ctx& C, int l) {
    const f16* QA = (const f16*)(C.ws() + A_QA); const f16* QC = (const f16*)(C.ws() + A_QC);
    const f16* KA = (const f16*)(C.ws() + A_KA); const f16* VA = (const f16*)(C.ws() + A_VA);
    const f16* KC = (const f16*)(C.ws() + A_KC); const f16* VC = (const f16*)(C.ws() + A_VC);
    f16* YA = (f16*)(C.ws() + A_YA); f16* YC = (f16*)(C.ws() + A_YC);
    const int vcu = (C.nblk % 8 == 0) ? (C.bid % 8) * (C.nblk / 8) + C.bid / 8 : C.bid;
    const int total = 1024 + (l == 0 ? 64 : 0);
    for (int u = vcu; u < total; u += C.nblk) {
        __syncthreads();
        int typeC, b, h, nkeys; size_t qrow, orow;
        if (u < 1024) { const int v = u & 511; typeC = u >> 9; b = v >> 7; h = (v >> 4) & 7; const int qb = v & 15; qrow = (size_t)(b * 8 + h) * SEQ + qb * 256; orow = (size_t)b * SEQ + qb * 256; nkeys = NKEY; }
        else { const int v = (u - 1024) & 31; typeC = (u - 1024) >> 5; b = v >> 3; h = v & 7; qrow = (size_t)NB * 8 * SEQ + (size_t)(b * 8 + h) * CTX; orow = (size_t)NLAT + b * CTX; nkeys = CTX; }
        if (!typeC) fa::attn_unit<64>(QA + qrow * 64, KA + (size_t)(b * 2 + (h >> 2)) * NKEY * 64, VA + (size_t)(b * 2 + (h >> 2)) * NKEY * 64, YA + orow * 512 + h * 64, nkeys, C.lds, C.tid);
        else fa::attn_unit<96>(QC + qrow * 96, KC + (size_t)(b * 8 + h) * NKEY * 96, VC + (size_t)(b * 8 + h) * NKEY * 64, YC + orow * 512 + h * 64, nkeys, C.lds, C.tid);
    }
}

constexpr float S5SC = 1024.0f, S5ISC = 1.0f / 1024.0f;
__device__ __forceinline__ int chunk_row0(int q) { const int b = q / 272, n = q - b * 272; return n < 16 ? NLAT + b * CTX + 16 * n : b * SEQ + 16 * (n - 16); }
__device__ __forceinline__ void phase_s5tab(const Ctx& C, int l) {
    LAS float* ApR = (LAS float*)C.lds; LAS float* ApI = ApR + 17 * 64; LAS float* BbR = ApI + 17 * 64; LAS float* BbI = BbR + 1024; LAS float* CR = BbI + 1024; LAS float* CI = CR + 1024;
    for (int u = C.bid; u < 64; u += C.nblk) {
        const int dir = u >> 5, g = u & 31; const size_t gi = (size_t)(l * 2 + dir) * 32 + g;
        const float dt = expf(C.in(I_SLDT)[gi]);
        __syncthreads();
        for (int i = C.tid; i < 17 * 64; i += NTHREADS) {
            const int p = i & 63, k = i >> 6; const float are = C.in(I_SARE)[gi * 64 + p], aim = C.in(I_SAIM)[gi * 64 + p];
            const float mag = expf(are * dt * (float)k), ang = (aim * dt) * (float)k;
            ApR[i] = mag * cosf(ang); ApI[i] = mag * sinf(ang);
        }
        for (int i = C.tid; i < 1024; i += NTHREADS) {
            const int p = i >> 4, c = i & 15; const float are = C.in(I_SARE)[gi * 64 + p], aim = C.in(I_SAIM)[gi * 64 + p];
            const float mag = expf(are * dt), th = aim * dt, abr = mag * cosf(th), abi = mag * sinf(th);
            const float den = are * are + aim * aim, nr = abr - 1.0f, cr = (nr * are + abi * aim) / den, ci = (abi * are - nr * aim) / den;
            const float br = C.in(I_SBRE)[(gi * 64 + p) * 16 + c], bi = C.in(I_SBIM)[(gi * 64 + p) * 16 + c];
            BbR[i] = cr * br - ci * bi; BbI[i] = cr * bi + ci * br;
            CR[i] = C.in(I_SCRE)[gi * 1024 + i]; CI[i] = C.in(I_SCIM)[gi * 1024 + i];
        }
        __syncthreads();
        f16* Et = (f16*)(C.ws() + T_E) + (size_t)u * 16 * 16 * 128; f16* Mt = (f16*)(C.ws() + T_M) + (size_t)u * 128 * 256; f16* Kt = (f16*)(C.ws() + T_K) + (size_t)u * 17 * 256;
        for (int i = C.tid; i < 16384; i += NTHREADS) {
            { const int t = i >> 10, c = (i >> 6) & 15, p = i & 63, k = dir == 0 ? t + 1 : 16 - t;
              const float cr = CR[c * 64 + p], ci = CI[c * 64 + p], ar = ApR[k * 64 + p], ai = ApI[k * 64 + p];
              Et[(size_t)(t * 16 + c) * 128 + p] = (f16)((cr * ar - ci * ai) * S5SC); Et[(size_t)(t * 16 + c) * 128 + 64 + p] = (f16)(-(cr * ai + ci * ar) * S5SC); }
            { const int p = i >> 8, sx = (i >> 4) & 15, c = i & 15, k = dir == 0 ? 15 - sx : sx;
              const float ar = ApR[k * 64 + p], ai = ApI[k * 64 + p], br = BbR[p * 16 + c], bi = BbI[p * 16 + c];
              Mt[(size_t)p * 256 + sx * 16 + c] = (f16)((ar * br - ai * bi) * S5SC); Mt[(size_t)(64 + p) * 256 + sx * 16 + c] = (f16)((ar * bi + ai * br) * S5SC); }
        }
        for (int i = C.tid; i < 17 * 256; i += NTHREADS) {
            const int tau = (i >> 8) - 1, c = (i >> 4) & 15, cp = i & 15; float acc = 0.f;
            if (tau >= 0) {
#pragma unroll 8
                for (int p = 0; p < 64; ++p) {
                    const float cr = CR[c * 64 + p], ci = CI[c * 64 + p], ar = ApR[tau * 64 + p], ai = ApI[tau * 64 + p];
                    acc += (cr * ar - ci * ai) * BbR[p * 16 + cp] - (cr * ai + ci * ar) * BbI[p * 16 + cp]; }
            }
            Kt[i] = (f16)(acc * S5SC);
        }
    }
}
__device__ __forceinline__ void phase_s5a(const Ctx& C) {
    const f16* U = (const f16*)(C.ws() + A_U); float* S = (float*)(C.ws() + A_S5S);
    const int r32 = C.lane & 31, hi = C.lane >> 5;
    for (int u = C.bid * NWAVES + C.wid; u < 64 * 34; u += C.nblk * NWAVES) {
        const int dirg = u / 34, nb = u - dirg * 34, g = dirg & 31;
        const int q = nb * 32 + r32, b = q / 272, n = q - b * 272;
        const f16* up = U + (size_t)chunk_row0(q) * 512 + g * 16 + 8 * hi;
        const f16* mp = (const f16*)(C.ws() + T_M) + (size_t)dirg * 128 * 256 + r32 * 256 + 8 * hi;
        f32x16 acc[4] = {};
#pragma unroll 4
        for (int sx = 0; sx < 16; ++sx) {
            const f16x8 bf = *(const f16x8*)(up + sx * 512);
#pragma unroll
            for (int mb = 0; mb < 4; ++mb) { const f16x8 af = *(const f16x8*)(mp + mb * 32 * 256 + sx * 16); acc[mb] = __builtin_amdgcn_mfma_f32_32x32x16_f16(af, bf, acc[mb], 0, 0, 0); }
        }
        float* sp = S + ((size_t)(dirg * 4 + b) * 128) * 272 + n;
#pragma unroll
        for (int mb = 0; mb < 4; ++mb)
#pragma unroll
            for (int r = 0; r < 16; ++r) sp[(size_t)(mb * 32 + fa::crow(r, hi)) * 272] = acc[mb][r] * S5ISC;
    }
}
__device__ __forceinline__ void phase_s5b(const Ctx& C, int l) {
    const float* S = (const float*)(C.ws() + A_S5S); f16* X = (f16*)(C.ws() + A_S5X);
    for (int idx = C.bid * NTHREADS + C.tid; idx < 64 * 4 * 64; idx += C.nblk * NTHREADS) {
        const int p = idx & 63, db = idx >> 6, dirg = db >> 2, b = db & 3, dir = dirg >> 5, g = dirg & 31; const size_t gi = (size_t)(l * 2 + dir) * 32 + g;
        const float are = C.in(I_SARE)[gi * 64 + p], aim = C.in(I_SAIM)[gi * 64 + p], dt = expf(C.in(I_SLDT)[gi]);
        const float mag = expf(are * dt * 16.0f), ang = (aim * dt) * 16.0f, ar = mag * cosf(ang), ai = mag * sinf(ang);
        const float* sr = S + ((size_t)db * 128 + p) * 272; const float* si = sr + 64 * 272;
        f16* xo = X + ((size_t)dirg * 1088 + b * 272) * 128 + p;
        float xr = 0.f, xi = 0.f;
#pragma unroll 1
        for (int seg = 0; seg < 2; ++seg) {
            const int start = seg ? 16 : 0, len = seg ? 256 : 16;
#pragma unroll 2
            for (int gq = 0; gq < len / 4; ++gq) {
                const int base = dir == 0 ? start + 4 * gq : start + len - 4 - 4 * gq;
                const f32x4 r4 = *(const f32x4*)(sr + base), i4 = *(const f32x4*)(si + base);
#pragma unroll
                for (int e = 0; e < 4; ++e) {
                    const int ee = dir == 0 ? e : 3 - e, n = base + ee;
                    xo[(size_t)n * 128] = (f16)xr; xo[(size_t)n * 128 + 64] = (f16)xi;
                    const float sre = dir == 0 ? r4[e] : r4[3 - e], sim = dir == 0 ? i4[e] : i4[3 - e];
                    const float nxr = ar * xr - ai * xi + sre, nxi = ar * xi + ai * xr + sim; xr = nxr; xi = nxi;
                }
            }
        }
    }
}
__device__ __forceinline__ void phase_s5c(const Ctx& C, int l) {
    const f16* U = (const f16*)(C.ws() + A_U); const f16* X = (const f16*)(C.ws() + A_S5X); f16* G = (f16*)(C.ws() + A_G);
    const int r32 = C.lane & 31, hi = C.lane >> 5, t0 = 2 * C.wid, trow = t0 + (r32 >> 4), crw = r32 & 15;
    const int nnb = l == 0 ? 34 : 32;
    for (int u = C.bid; u < 32 * nnb; u += C.nblk) {
        const int g = u & 31, nb = u >> 5, idx = nb * 32 + r32;
        const int q = l == 0 ? idx : (idx >> 8) * 272 + 16 + (idx & 255);
        const int row0 = chunk_row0(q);
        const f16* up = U + (size_t)row0 * 512 + g * 16 + 8 * hi;
        f32x16 acc = {};
#pragma unroll
        for (int dir = 0; dir < 2; ++dir) {
            const int dirg = dir * 32 + g;
            const f16* Kt = (const f16*)(C.ws() + T_K) + (size_t)dirg * 17 * 256 + crw * 16 + 8 * hi;
            const f16* Et = (const f16*)(C.ws() + T_E) + (size_t)dirg * 16 * 16 * 128 + (size_t)(trow * 16 + crw) * 128 + 8 * hi;
            const f16* xp = X + ((size_t)dirg * 1088 + q) * 128 + 8 * hi;
            const int s_lo = dir == 0 ? 0 : t0, s_hi = dir == 0 ? t0 + 1 : 15;
            for (int sx = s_lo; sx <= s_hi; ++sx) {
                const int tau = dir == 0 ? trow - sx : sx - trow;
                const f16x8 af = *(const f16x8*)(Kt + (tau + 1) * 256), bf = *(const f16x8*)(up + sx * 512);
                acc = __builtin_amdgcn_mfma_f32_32x32x16_f16(af, bf, acc, 0, 0, 0);
            }
#pragma unroll
            for (int kk = 0; kk < 8; ++kk) {
                const f16x8 af = *(const f16x8*)(Et + kk * 16), bf = *(const f16x8*)(xp + kk * 16);
                acc = __builtin_amdgcn_mfma_f32_32x32x16_f16(af, bf, acc, 0, 0, 0);
            }
        }
#pragma unroll
        for (int tl = 0; tl < 2; ++tl)
#pragma unroll
            for (int gp = 0; gp < 2; ++gp) {
                const size_t off = (size_t)(row0 + t0 + tl) * 512 + g * 16 + 4 * hi + 8 * gp;
                const f16x4 u4 = *(const f16x4*)(U + off); const f32x4 d4 = *(const f32x4*)(C.in(I_SD) + l * 512 + g * 16 + 4 * hi + 8 * gp);
                f32x4 y;
#pragma unroll
                for (int e = 0; e < 4; ++e) y[e] = gelu_tanh(acc[8 * tl + 4 * gp + e] * S5ISC + d4[e] * (float)u4[e]);
                *(f16x4*)(G + off) = pack4(y);
            }
    }
}

__device__ __forceinline__ void phase_s5_naive(const Ctx& C, int l) {
    const f16* U = (const f16*)(C.ws() + A_U); float* YSF = (float*)(C.ws() + A_YSF);
    LAS float* cst = (LAS float*)C.lds + C.wid * (16 * 128 + 4 * 128);
    LAS float* sst = cst + 16 * 128;
    const int lane = C.lane;
    for (int u = C.bid * NWAVES + C.wid; u < NB * 32; u += C.nblk * NWAVES) {
        const int b = u >> 5, g = u & 31;
        for (int dir = 0; dir < 2; ++dir) {
            const size_t gi = ((size_t)(l * 2 + dir) * 32 + g);
            const float are = C.in(I_SARE)[gi * 64 + lane], aim = C.in(I_SAIM)[gi * 64 + lane];
            const float dt = expf(C.in(I_SLDT)[gi]);
            const float mag = expf(are * dt), th = aim * dt;
            const float abr = mag * cosf(th), abi = mag * sinf(th);
            const float den = are * are + aim * aim, nr = abr - 1.0f;
            const float cr = (nr * are + abi * aim) / den, ci = (abi * are - nr * aim) / den;
            float bbr[16], bbi[16];
#pragma unroll
            for (int c = 0; c < 16; ++c) {
                const float br = C.in(I_SBRE)[(gi * 64 + lane) * 16 + c], bi = C.in(I_SBIM)[(gi * 64 + lane) * 16 + c];
                bbr[c] = cr * br - ci * bi; bbi[c] = cr * bi + ci * br; }
#pragma unroll
            for (int c = 0; c < 16; ++c) { cst[c * 128 + lane] = C.in(I_SCRE)[(gi * 16 + c) * 64 + lane]; cst[c * 128 + 64 + lane] = C.in(I_SCIM)[(gi * 16 + c) * 64 + lane]; }
            asm volatile("s_waitcnt lgkmcnt(0)" ::: "memory");
            float xr = 0.f, xi = 0.f;
            const int tk = lane >> 4, cc = lane & 15;
            const float dcoef = C.in(I_SD)[l * 512 + g * 16 + cc];
            for (int i0 = 0; i0 < NKEY; i0 += 4) {
                int rows[4];
#pragma unroll
                for (int k = 0; k < 4; ++k) {
                    const int i = i0 + k; int row;
                    if (dir == 0) row = i < CTX ? NLAT + b * CTX + i : b * SEQ + (i - CTX);
                    else row = i < CTX ? NLAT + b * CTX + (CTX - 1 - i) : b * SEQ + (SEQ - 1 - (i - CTX));
                    rows[k] = row;
                    const f16x8 u0 = *(const f16x8*)(U + (size_t)row * 512 + g * 16), u1 = *(const f16x8*)(U + (size_t)row * 512 + g * 16 + 8);
                    float bur = 0.f, bui = 0.f;
#pragma unroll
                    for (int c = 0; c < 8; ++c) { bur += bbr[c] * (float)u0[c] + bbr[8 + c] * (float)u1[c]; bui += bbi[c] * (float)u0[c] + bbi[8 + c] * (float)u1[c]; }
                    const float nxr = abr * xr - abi * xi + bur, nxi = abr * xi + abi * xr + bui;
                    xr = nxr; xi = nxi;
                    sst[k * 128 + lane] = xr; sst[k * 128 + 64 + lane] = xi;
                }
                asm volatile("s_waitcnt lgkmcnt(0)" ::: "memory");
                float y = 0.f;
#pragma unroll 16
                for (int p = 0; p < 64; ++p) y += cst[cc * 128 + p] * sst[tk * 128 + p] - cst[cc * 128 + 64 + p] * sst[tk * 128 + 64 + p];
                asm volatile("s_waitcnt lgkmcnt(0)" ::: "memory");
                int myrow = rows[0];
#pragma unroll
                for (int k = 1; k < 4; ++k) myrow = (tk == k) ? rows[k] : myrow;
                if (myrow < NLAT || l == 0) {
                    float* dst = YSF + (size_t)myrow * 512 + g * 16 + cc;
                    if (dir == 0) *dst = y + dcoef * (float)U[(size_t)myrow * 512 + g * 16 + cc];
                    else *dst = *dst + y;
                }
            }
            asm volatile("s_waitcnt vmcnt(0)" ::: "memory");
            __builtin_amdgcn_fence(__ATOMIC_RELEASE, "workgroup");
        }
    }
}
__device__ __forceinline__ void phase_s5_gelu(const Ctx& C, int nrows) {
    const float* YSF = (const float*)(C.ws() + A_YSF); f16* G = (f16*)(C.ws() + A_G);
    const size_t n4 = (size_t)nrows * 512 / 4;
    for (size_t i = (size_t)C.bid * NTHREADS + C.tid; i < n4; i += (size_t)C.nblk * NTHREADS) {
        f32x4 v = ((const f32x4*)YSF)[i];
#pragma unroll
        for (int e = 0; e < 4; ++e) v[e] = gelu_tanh(v[e]);
        ((f16x4*)G)[i] = pack4(v);
    }
}

typedef __attribute__((address_space(1))) unsigned gu32;
#define XB_TMO      128
#define XB_XCNT(j)  (256  + 64 * (j))
#define XB_XSUB(j)  (1280 + 64 * (j))
#define XB_XGEN(j)  (2304 + 64 * (j))
#define XB_TOP      3328
#define XB_TOPGEN   3392
#define XCD_BAR_WORDS 3456
#define XB_SPIN_CAP (1u << 26)

__device__ __forceinline__ unsigned xb_ld(unsigned* p)              { return __hip_atomic_load(p, __ATOMIC_RELAXED, __HIP_MEMORY_SCOPE_AGENT); }
__device__ __forceinline__ unsigned xb_add(unsigned* p, unsigned v) { return __hip_atomic_fetch_add(p, v, __ATOMIC_RELAXED, __HIP_MEMORY_SCOPE_AGENT); }
__device__ __forceinline__ unsigned xb_xcc_id() { return (unsigned)__builtin_amdgcn_s_getreg((3 << 11) | 20) & 0xFu; }
#define XB_SPIN(cond, bar) do { unsigned _sp = 0; while (cond) { __builtin_amdgcn_s_sleep(1); \
    if ((++_sp & 255u) == 0u) { if (xb_ld(&(bar)[XB_TMO])) break; if (_sp > XB_SPIN_CAP) { atomicAdd(&(bar)[XB_TMO], 1u); break; } } } } while (0)

struct XcdBarrier {
    unsigned* bar; unsigned x;
    volatile LAS unsigned* st;
};

__device__ __forceinline__ XcdBarrier xcd_barrier_post(unsigned* bar, volatile LAS unsigned* st) {
    XcdBarrier b; b.bar = bar; b.x = xb_xcc_id(); b.st = st;
    if (threadIdx.x == 0) (void)xb_add(&bar[XB_XCNT(b.x)], 1u);
    return b;
}
__device__ __forceinline__ void xcd_barrier_complete(unsigned* bar, unsigned x, unsigned& nloc, unsigned& nx) {
    const unsigned G = gridDim.x * gridDim.y * gridDim.z;
    unsigned sum, cnt, mine, sp = 0u;
    for (;;) {
        sum = 0u; cnt = 0u; mine = 0u;
#pragma unroll
        for (unsigned j = 0; j < 16; ++j) { const unsigned c = xb_ld(&bar[XB_XCNT(j)]); sum += c; cnt += (c > 0u) ? 1u : 0u; mine = (j == x) ? c : mine; }
        if (sum == G) break;
        __builtin_amdgcn_s_sleep(1);
        if ((++sp & 255u) == 0u) { if (xb_ld(&bar[XB_TMO])) break; if (sp > XB_SPIN_CAP) { atomicAdd(&bar[XB_TMO], 1u); break; } }
    }
    nloc = mine > 0u ? mine : 1u; nx = cnt > 0u ? cnt : 1u;
}

__device__ __forceinline__ void xcd_barrier(const XcdBarrier& b, const bool t0) {
    asm volatile("s_waitcnt vmcnt(0)" ::: "memory");
    __syncthreads();
    if (t0) {
        unsigned* bar = b.bar;
        __builtin_amdgcn_s_waitcnt(0);
        unsigned nloc = b.st[0], nx = b.st[1];
        if (nloc == 0u) { xcd_barrier_complete(bar, b.x, nloc, nx); b.st[0] = nloc; b.st[1] = nx; }
        const unsigned old = xb_add(&bar[XB_XSUB(b.x)], 1u);
        const unsigned gen = old / nloc;
        if (old + 1u == (gen + 1u) * nloc) {
            __builtin_amdgcn_fence(__ATOMIC_RELEASE, "agent");
            asm volatile("s_waitcnt vmcnt(0)" ::: "memory");
            const unsigned og = xb_add(&bar[XB_TOP], 1u);
            const unsigned tg = og / nx;
            if (og + 1u == (tg + 1u) * nx) xb_add(&bar[XB_TOPGEN], 1u);
            else XB_SPIN(xb_ld(&bar[XB_TOPGEN]) == tg, bar);
            __builtin_amdgcn_fence(__ATOMIC_ACQUIRE, "agent");
            xb_add(&bar[XB_XGEN(b.x)], 1u);
            asm volatile("s_waitcnt vmcnt(0)" ::: "memory");
        } else {
            XB_SPIN(xb_ld(&bar[XB_XGEN(b.x)]) == gen, bar);
            __builtin_amdgcn_fence(__ATOMIC_ACQUIRE, "agent");
            asm volatile("s_waitcnt vmcnt(0)" ::: "memory");
        }
    }
    __syncthreads();
}

struct Env { XcdBarrier bar; int wid; };
#define GSYNC() do { const Ctx Cb = make_ctx(env.wid); xcd_barrier(env.bar, Cb.tid == 0); } while (0)
constexpr int MISC_OFF = LDS_BYTES - 256;
constexpr int CW_BAR = 4096;
#define CTX() const Ctx C = make_ctx(env.wid); unsigned char* ws = C.ws()
template <int l>
__device__ __forceinline__ void layer_body(const Env& env) {
        const int mrows = l == 0 ? MALL : NLAT;
        { CTX(); (void)ws; phase_s5tab(C, l); __syncthreads(); phase_cvt(C, l); phase_p1(C, l); }
        GSYNC();
        if (l == 0) { CTX(); EpiStore E{(f16*)(ws + A_PROJ), PLD};
          gemm_pg8(C, (const f16*)(ws + A_H), D, (const f16*)(ws + W_INA), D, MALL, 2560, D, E); }
        else {
          { CTX(); EpiStore E{(f16*)(ws + A_PROJ), PLD}; gemm_pg8(C, (const f16*)(ws + A_H), D, (const f16*)(ws + W_INA), D, NLAT, 2560, D, E); }
          { CTX(); EpiStore E{(f16*)(ws + A_PROJ) + (size_t)NLAT * PLD, PLD};
            gemm_pg8(C, (const f16*)(ws + A_H) + (size_t)NLAT * D, D, (const f16*)(ws + W_INA), D, NCTX, 1280, D, E); }
        }
        GSYNC();
        { CTX(); (void)ws; phase_p3(C, l); }
        GSYNC();
        { CTX(); EpiKvUp E1{(f16*)(ws + A_KC), (f16*)(ws + A_VC)};
          gemm_pg8(C, (const f16*)(ws + A_PROJ) + OFF_CKV, PLD, (const f16*)(ws + W_KVB), 256, MALL, 1024, 256, E1); }
        { CTX(); EpiQUp E2{(f16*)(ws + A_QC), (const float*)(ws + WS_ROPE) + 2048};
          gemm_pg8(C, (const f16*)(ws + A_PROJ) + OFF_CQ, PLD, (const f16*)(ws + W_QB), 768, mrows, 768, 768, E2); }
        GSYNC();
        { CTX(); (void)ws; phase_s5a(C); }
        { CTX(); (void)ws; phase_attn_flash(C, l); }
        GSYNC();
        { CTX(); (void)ws; phase_s5b(C, l); }
        GSYNC();
        { CTX(); (void)ws; phase_s5c(C, l); }
        GSYNC();
        { CTX(); EpiGlu E{(f16*)(ws + A_YS)};
          gemm_pg8(C, (const f16*)(ws + A_G), 512, (const f16*)(ws + W_GLU), 512, mrows, 1024, 512, E); }
        { CTX(); (void)ws; phase_hre(C, l, mrows); }
        GSYNC();
#pragma unroll
        for (int br = 0; br < 3; ++br) {
            { CTX(); EpiGate Eg{(f16*)(ws + A_GATE)};
              gemm_pg8(C, (const f16*)(ws + A_H), D, (const f16*)(ws + W_GATE) + (size_t)br * 1024 * 1024, D, mrows, 1024, D, Eg); }
            { CTX(); const f16* Y = (const f16*)(ws + (br == 0 ? A_YA : br == 1 ? A_YS : A_YC));
              EpiBranch Eb{(const f16*)(ws + A_GATE), (f16*)(ws + A_MERGED), br == 0};
              gemm_pg8(C, Y, 512, (const f16*)(ws + W_BR) + (size_t)br * 1024 * 512, 512, mrows, 1024, 512, Eb); }
        }
        GSYNC();
        { CTX(); EpiWout E{&C, l}; gemm_pg8(C, (const f16*)(ws + A_MERGED), D, (const f16*)(ws + W_OUT), D, mrows, 1024, D, E); }
        GSYNC();
        { CTX(); (void)ws; phase_p10(C, l, mrows); }
        GSYNC();
        { CTX(); EpiUp E{(f16*)(ws + A_HID)}; gemm_pg8(C, (const f16*)(ws + A_H), D, (const f16*)(ws + W_UP), D, mrows, DFF, D, E); }
        GSYNC();
        { CTX(); EpiDown E{&C, l}; gemm_pg8(C, (const f16*)(ws + A_HID), DFF, (const f16*)(ws + W_DOWN), DFF, mrows, 1024, DFF, E); }
        GSYNC();
        { CTX(); (void)ws; phase_p13(C, l, mrows); }
        if (l == 0) GSYNC();
}
__global__ void __launch_bounds__(NTHREADS, 2) fwd_all(Args args) {
    cg::grid_group grid = cg::this_grid();
    extern __shared__ __attribute__((aligned(16))) unsigned char lds_raw[];
    volatile LAS unsigned* MISC = (volatile LAS unsigned*)((LAS unsigned char*)lds_raw + MISC_OFF);
    if (threadIdx.x < 64) MISC[threadIdx.x] = 0u;
    __syncthreads();
    Env env; env.wid = __builtin_amdgcn_readfirstlane(threadIdx.x >> 6);
    env.bar = xcd_barrier_post((unsigned*)(args.ws + WS_CTL) + CW_BAR, MISC + 8);
    { CTX(); (void)ws; phase_setup(C); }
    asm volatile("s_waitcnt vmcnt(0)" ::: "memory");
    grid.sync();
    __builtin_amdgcn_fence(__ATOMIC_ACQUIRE, "agent");
    asm volatile("s_waitcnt vmcnt(0)" ::: "memory");
    layer_body<0>(env);
    layer_body<1>(env);
}

extern "C" void kernel_launch(void* const* d_in, const int* in_sizes, int n_in, void* d_out, int out_size, void* d_ws, size_t ws_size, hipStream_t stream) {
    static int grid_blocks = 0;
    if (grid_blocks == 0) {
        if (n_in != 32 || out_size != NLAT * D || ws_size < WS_NEED) { fprintf(stderr, "kernel_launch: unexpected shapes n_in %d out %d ws %zu (need %zu)\n", n_in, out_size, ws_size, (size_t)WS_NEED); grid_blocks = -1; return; }
        int dev = 0, cus = 0, per_cu = 0;
        hipGetDevice(&dev);
        hipDeviceGetAttribute(&cus, hipDeviceAttributeMultiprocessorCount, dev);
        if (hipFuncSetAttribute((const void*)fwd_all, hipFuncAttributeMaxDynamicSharedMemorySize, LDS_BYTES) != hipSuccess) { fprintf(stderr, "kernel_launch: hipFuncSetAttribute failed\n"); grid_blocks = -1; return; }
        hipOccupancyMaxActiveBlocksPerMultiprocessor(&per_cu, (const void*)fwd_all, NTHREADS, LDS_BYTES);
        if (per_cu < 1) { fprintf(stderr, "kernel_launch: occupancy query says %d blocks per CU\n", per_cu); grid_blocks = -1; return; }
        grid_blocks = cus;
    }
    if (grid_blocks < 0) return;
    Args a{};
    for (int i = 0; i < 32; ++i) a.in[i] = (const float*)d_in[i];
    a.out = (float*)d_out; a.ws = (unsigned char*)d_ws;
    if (hipMemsetAsync((char*)d_ws + WS_CTL, 0, 1 * MiB, stream) != hipSuccess) { fprintf(stderr, "kernel_launch: hipMemsetAsync failed\n"); return; }
    void* kargs[] = {&a};
    const hipError_t e = hipLaunchCooperativeKernel((const void*)fwd_all, dim3(grid_blocks), dim3(NTHREADS), kargs, LDS_BYTES, stream);
    if (e != hipSuccess) fprintf(stderr, "kernel_launch: cooperative launch failed: %s (grid %d)\n", hipGetErrorString(e), grid_blocks);
}
```

```cpp
#include <hip/hip_runtime.h>
#include <hip/hip_cooperative_groups.h>
#include <cstdio>
#include <cstdint>
#include <cmath>

namespace cg = cooperative_groups;

#define LAS __attribute__((address_space(3)))
typedef _Float16 f16;
typedef _Float16 f16x8 __attribute__((ext_vector_type(8)));
typedef _Float16 f16x4 __attribute__((ext_vector_type(4)));
typedef float f32x4 __attribute__((ext_vector_type(4)));
typedef float f32x16 __attribute__((ext_vector_type(16)));

constexpr int D = 1024, NB = 4, SEQ = 4096, CTX = 256, NLAT = NB * SEQ, NCTX = NB * CTX, MALL = NLAT + NCTX;
constexpr int NKEY = CTX + SEQ;
constexpr int OFF_AK = 0, OFF_AV = 128, OFF_CKV = 256, OFF_CKR = 512, OFF_U = 544, OFF_AQ = 1056, OFF_CQ = 1568, OFF_GATE = 2336, N_IN = 5408;
constexpr int PLD = 2560;
constexpr int DFF = 4096;
constexpr float EPS = 1e-6f;
constexpr float ALPHA = 1.4142135623730951f;
constexpr float LOG2E = 1.4426950408889634f;
constexpr float QSCALE_A = 0.125f * LOG2E;
constexpr float QSCALE_C = 0.10206207261596575f * LOG2E;

constexpr size_t MiB = 1u << 20;
constexpr size_t WS_CTL = 0;
constexpr size_t WS_MOD = 1 * MiB;
constexpr size_t WS_ROPE = 1 * MiB + 512 * 1024;
constexpr size_t WS_W16 = 2 * MiB;
constexpr size_t W_INA = WS_W16;
constexpr size_t W_GATE = W_INA + (size_t)2560 * 1024 * 2;
constexpr size_t W_QB = W_GATE + (size_t)3072 * 1024 * 2;
constexpr size_t W_KVB = W_QB + (size_t)768 * 768 * 2;
constexpr size_t W_GLU = W_KVB + (size_t)1024 * 256 * 2;
constexpr size_t W_BR = W_GLU + (size_t)1024 * 512 * 2;
constexpr size_t W_OUT = W_BR + (size_t)3 * 1024 * 512 * 2;
constexpr size_t W_UP = W_OUT + (size_t)1024 * 1024 * 2;
constexpr size_t W_DOWN = W_UP + (size_t)4096 * 1024 * 2;
constexpr size_t W_END = W_DOWN + (size_t)1024 * 4096 * 2;
constexpr size_t WS_TACTX = 37 * MiB;
constexpr size_t WS_ACT = 41 * MiB;
static_assert(W_END <= WS_TACTX, "weights fit");
constexpr size_t A_H = WS_ACT + 0 * MiB;
constexpr size_t A_QC = WS_ACT + 0 * MiB;
constexpr size_t A_PROJ = WS_ACT + 34 * MiB;
constexpr size_t A_YA = WS_ACT + 34 * MiB;
constexpr size_t A_YC = WS_ACT + 51 * MiB;
constexpr size_t A_YSF = WS_ACT + 68 * MiB;
constexpr size_t A_G = WS_ACT + 68 * MiB;
constexpr size_t A_QA = WS_ACT + 119 * MiB;
constexpr size_t A_YS = WS_ACT + 119 * MiB;
constexpr size_t A_KA = WS_ACT + 136 * MiB;
constexpr size_t A_VA = A_KA + (size_t)NB * 2 * NKEY * 64 * 2;
constexpr size_t A_U = WS_ACT + 145 * MiB;
constexpr size_t A_KC = WS_ACT + 162 * MiB;
constexpr size_t A_VC = WS_ACT + 188 * MiB;
constexpr size_t A_GATE = WS_ACT + 136 * MiB;
constexpr size_t A_MERGED = WS_ACT + 170 * MiB;
constexpr size_t A_HID = WS_ACT + 34 * MiB;
constexpr size_t A_S5S = WS_ACT + 68 * MiB;
constexpr size_t A_S5X = WS_ACT + 102 * MiB;
constexpr size_t T_K = WS_ACT + 205 * MiB;
constexpr size_t T_E = T_K + (size_t)64 * 17 * 256 * 2;
constexpr size_t T_M = T_E + (size_t)64 * 16 * 16 * 128 * 2;
constexpr size_t WS_NEED = WS_ACT + 215 * MiB;
static_assert(T_M + (size_t)64 * 128 * 256 * 2 <= WS_NEED, "s5 tables");
static_assert(A_VA + (size_t)NB * 2 * NKEY * 64 * 2 <= A_U && A_VC + 17 * MiB <= WS_NEED && A_MERGED + 34 * MiB <= WS_NEED && A_HID + 136 * MiB <= WS_NEED, "ws map");
static_assert(WS_NEED <= 256 * MiB, "ws budget");

constexpr int LDS_BYTES = 147456;
constexpr int NTHREADS = 512, NWAVES = 8;

struct Args {
    const float* in[32];
    float* out;
    unsigned char* ws;
    int ph_lo, ph_hi;
};
enum { I_X = 0, I_C, I_CTX, I_CCTX, I_WMOD, I_BMOD, I_WIN, I_AQG, I_AKG, I_CQG, I_CKVG, I_WQB, I_WKVB, I_SARE, I_SAIM, I_SLDT, I_SBRE, I_SBIM, I_SCRE, I_SCIM,
       I_SD, I_WGLU, I_WBA, I_WBS, I_WBC, I_WOUT, I_LN1G, I_LN1B, I_WUP, I_WDOWN, I_LN2G, I_LN2B };

__device__ __forceinline__ float wave_sum(float v) {
#pragma unroll
    for (int o = 1; o < 64; o <<= 1) v += __shfl_xor(v, o);
    return v;
}
__device__ __forceinline__ float wave_max(float v) {
#pragma unroll
    for (int o = 1; o < 64; o <<= 1) v = fmaxf(v, __shfl_xor(v, o));
    return v;
}
__device__ __forceinline__ float sigmoidf_(float x) { return 1.0f / (1.0f + __expf(-x)); }
__device__ __forceinline__ float gelu_tanh(float x) {
    const float u = 0.7978845608028654f * (x + 0.044715f * x * x * x);
    const float e = __expf(2.0f * u);
    const float t = 1.0f - 2.0f / (e + 1.0f);
    return 0.5f * x * (1.0f + t);
}
__device__ __forceinline__ f16x8 pack8(f32x4 lo, f32x4 hi) {
    f16x8 r; r[0] = (f16)lo[0]; r[1] = (f16)lo[1]; r[2] = (f16)lo[2]; r[3] = (f16)lo[3]; r[4] = (f16)hi[0]; r[5] = (f16)hi[1]; r[6] = (f16)hi[2]; r[7] = (f16)hi[3]; return r;
}
__device__ __forceinline__ f16x4 pack4(f32x4 v) { f16x4 r; r[0] = (f16)v[0]; r[1] = (f16)v[1]; r[2] = (f16)v[2]; r[3] = (f16)v[3]; return r; }

struct RowInfo { int b, t, pos, lat, mrow; };
__device__ __forceinline__ RowInfo row_info(int r) {
    RowInfo o;
    if (r < NLAT) { o.lat = 1; o.b = r >> 12; o.t = r & 4095; o.pos = CTX + o.t; o.mrow = o.b; }
    else { const int rr = r - NLAT; o.lat = 0; o.b = rr >> 8; o.t = rr & 255; o.pos = o.t; o.mrow = 4; }
    return o;
}

#define CAS __attribute__((address_space(4)))
struct Ctx {
    const CAS unsigned char* kp; LAS unsigned char* lds;
    int tid, lane, wid, nblk, bid;
    __device__ __forceinline__ const float* in(int i) const { return *(const float* const CAS*)(kp + 8 * i); }
    __device__ __forceinline__ float* out() const { return *(float* const CAS*)(kp + 256); }
    __device__ __forceinline__ unsigned char* ws() const { return *(unsigned char* const CAS*)(kp + 264); }
    __device__ __forceinline__ const float* mod(int l, int mrow, int which) const { return (const float*)(ws() + WS_MOD) + ((size_t)(l * 5 + mrow) * 6 + which) * D; }
    __device__ __forceinline__ const float* xsrc(int l, int r) const {
        if (l == 0) return r < NLAT ? in(I_X) + (size_t)r * D : in(I_CTX) + (size_t)(r - NLAT) * D;
        return r < NLAT ? out() + (size_t)r * D : (const float*)(ws() + WS_TACTX) + (size_t)(r - NLAT) * D;
    }
    __device__ __forceinline__ float* ta(int r) const { return r < NLAT ? out() + (size_t)r * D : (float*)(ws() + WS_TACTX) + (size_t)(r - NLAT) * D; }
};
__device__ __forceinline__ Ctx make_ctx(int wid) {
    extern __shared__ __attribute__((aligned(16))) unsigned char lds_raw[];
    Ctx C;
    const CAS unsigned char* kp = (const CAS unsigned char*)__builtin_amdgcn_kernarg_segment_ptr();
    asm volatile("" : "+s"(kp));
    C.kp = kp; C.lds = (LAS unsigned char*)lds_raw;
    int lane = __builtin_amdgcn_mbcnt_hi(~0u, __builtin_amdgcn_mbcnt_lo(~0u, 0u)); asm volatile("" : "+v"(lane));
    asm volatile("" : "+s"(wid));
    C.tid = wid * 64 + lane; C.lane = lane; C.wid = wid;
    int bid = blockIdx.x; asm volatile("" : "+s"(bid));
    C.bid = bid; C.nblk = gridDim.x;
    return C;
}

__device__ __forceinline__ void phase_setup(const Ctx& C) {
    LAS float* sv = (LAS float*)C.lds;
    LAS float* red = sv + 5 * 1024;
    for (int i = C.tid; i < 5 * 1024; i += NTHREADS) {
        const int mr = i >> 10, k = i & 1023;
        const float v = mr < 4 ? C.in(I_C)[mr * D + k] : C.in(I_CCTX)[k];
        sv[i] = v / (1.0f + __expf(-v));
    }
    __syncthreads();
    for (int u = C.bid; u < 192; u += C.nblk) {
        const int l = u / 96, n0 = (u % 96) * 64;
        const float* W = C.in(I_WMOD) + (size_t)l * D * 6144 + n0 + C.lane;
        float acc[5] = {0.f, 0.f, 0.f, 0.f, 0.f};
        const int kb = C.wid * 128;
#pragma unroll 8
        for (int k = 0; k < 128; ++k) {
            const float w = W[(size_t)(kb + k) * 6144];
#pragma unroll
            for (int m = 0; m < 5; ++m) acc[m] += sv[m * 1024 + kb + k] * w;
        }
#pragma unroll
        for (int m = 0; m < 5; ++m) red[(C.wid * 5 + m) * 64 + C.lane] = acc[m];
        __syncthreads();
        if (C.tid < 320) {
            const int m = C.tid >> 6, c = C.tid & 63; float s = 0.f;
#pragma unroll
            for (int w = 0; w < 8; ++w) s += red[(w * 5 + m) * 64 + c];
            ((float*)(C.ws() + WS_MOD))[(size_t)(l * 5 + m) * 6144 + n0 + c] = s + C.in(I_BMOD)[l * 6144 + n0 + c];
        }
        __syncthreads();
    }
    if (C.bid == C.nblk - 1) {
        float* ra = (float*)(C.ws() + WS_ROPE);
        for (int i = C.tid; i < 1024; i += NTHREADS) {
            const int pos = i >> 4, f = i & 15;
            const float inv = powf(10000.0f, -(float)(2 * f) / 32.0f);
            const float ang = (float)pos * inv;
            ra[i] = cosf(ang); ra[1024 + i] = sinf(ang);
        }
        for (int i = C.tid; i < 512; i += NTHREADS) {
            const int pos = i >> 3, f = i & 7;
            const float inv = powf(10000.0f, -(float)(2 * f) / 16.0f);
            const float ang = (float)pos * inv;
            ra[2048 + i] = cosf(ang); ra[2048 + 512 + i] = sinf(ang);
        }
    }
}

__device__ __forceinline__ int glu_row(int n) { const int isg = n >= 512, j = n & 511; return 8 * (j >> 2) + 4 * isg + (j & 3); }
__device__ __forceinline__ void cvt_item(const float* W, int ldw, int coff, int K, int nblk, f16* WT, int mode, LAS float* scr, int item, int lane) {
    const int kb = item / nblk, nb = item % nblk, k0 = 64 * kb, n0 = 32 * nb;
#pragma unroll 8
    for (int i = 0; i < 32; ++i) { const int kk = 2 * i + (lane >> 5); scr[kk * 33 + (lane & 31)] = W[(size_t)(k0 + kk) * ldw + coff + n0 + (lane & 31)]; }
    asm volatile("s_waitcnt lgkmcnt(0)" ::: "memory");
    const int c = lane & 7;
#pragma unroll
    for (int j = 0; j < 4; ++j) {
        const int n = (lane >> 3) + 8 * j; const LAS float* s = scr + (8 * c) * 33 + n;
        f16x8 o;
#pragma unroll
        for (int e = 0; e < 8; ++e) o[e] = (f16)s[e * 33];
        const int nn = n0 + n; const int row = mode ? glu_row(nn) : nn;
        *(f16x8*)(WT + (size_t)row * K + k0 + 8 * c) = o;
    }
    asm volatile("s_waitcnt lgkmcnt(0)" ::: "memory");
}
__device__ __forceinline__ void cvt_mat(const Ctx& C, const float* src, int ldw, int coff, int K, int N, size_t dst, int mode, int& base, int b0) {
    LAS float* scr = (LAS float*)C.lds + C.wid * (64 * 33);
    const int gw = (C.bid - b0) * NWAVES + C.wid, ngw = (C.nblk - b0) * NWAVES;
    const int nblk = N / 32, items = (K / 64) * nblk;
    int first = gw - (base % ngw); if (first < 0) first += ngw;
    for (int it = first; it < items; it += ngw) cvt_item(src, ldw, coff, K, nblk, (f16*)(C.ws() + dst), mode, scr, it, C.lane);
    base += items;
}
__device__ __forceinline__ void phase_cvt(const Ctx& C, int l, int b0) {
    int base = 0;
    cvt_mat(C, C.in(I_WIN) + (size_t)l * D * N_IN, N_IN, 0, D, OFF_GATE, W_INA, 0, base, b0);
    cvt_mat(C, C.in(I_WIN) + (size_t)l * D * N_IN, N_IN, OFF_GATE, D, 3072, W_GATE, 0, base, b0);
    cvt_mat(C, C.in(I_WQB) + (size_t)l * 768 * 768, 768, 0, 768, 768, W_QB, 0, base, b0);
    cvt_mat(C, C.in(I_WKVB) + (size_t)l * 256 * 1024, 1024, 0, 256, 1024, W_KVB, 0, base, b0);
    cvt_mat(C, C.in(I_WGLU) + (size_t)l * 512 * 1024, 1024, 0, 512, 1024, W_GLU, 1, base, b0);
    cvt_mat(C, C.in(I_WBA) + (size_t)l * 512 * 1024, 1024, 0, 512, 1024, W_BR, 0, base, b0);
    cvt_mat(C, C.in(I_WBS) + (size_t)l * 512 * 1024, 1024, 0, 512, 1024, W_BR + (size_t)1024 * 512 * 2, 0, base, b0);
    cvt_mat(C, C.in(I_WBC) + (size_t)l * 512 * 1024, 1024, 0, 512, 1024, W_BR + (size_t)2 * 1024 * 512 * 2, 0, base, b0);
    cvt_mat(C, C.in(I_WOUT) + (size_t)l * 1024 * 1024, 1024, 0, 1024, 1024, W_OUT, 0, base, b0);
    cvt_mat(C, C.in(I_WUP) + (size_t)l * 1024 * 4096, 4096, 0, 1024, 4096, W_UP, 0, base, b0);
    cvt_mat(C, C.in(I_WDOWN) + (size_t)l * 4096 * 1024, 1024, 0, 4096, 1024, W_DOWN, 0, base, b0);
    f16* pad = (f16*)(C.ws() + W_INA) + (size_t)OFF_GATE * 1024;
    const f16x8 z = {0, 0, 0, 0, 0, 0, 0, 0};
    for (int i = (C.bid - b0) * NTHREADS + C.tid; i < (2560 - OFF_GATE) * 1024 / 8; i += (C.nblk - b0) * NTHREADS) ((f16x8*)pad)[i] = z;
}

__device__ __forceinline__ void row_load(const float* p, int lane, f32x4 (&v)[4]) {
#pragma unroll
    for (int j = 0; j < 4; ++j) v[j] = ((const f32x4*)p)[lane + 64 * j];
}
__device__ __forceinline__ void row_ln(f32x4 (&v)[4]) {
    float s = 0.f;
#pragma unroll
    for (int j = 0; j < 4; ++j) s += (v[j][0] + v[j][1]) + (v[j][2] + v[j][3]);
    const float mean = wave_sum(s) * (1.0f / D);
    float q = 0.f;
#pragma unroll
    for (int j = 0; j < 4; ++j) { v[j] = v[j] - mean; q += (v[j][0] * v[j][0] + v[j][1] * v[j][1]) + (v[j][2] * v[j][2] + v[j][3] * v[j][3]); }
    const float rstd = 1.0f / sqrtf(wave_sum(q) * (1.0f / D) + EPS);
#pragma unroll
    for (int j = 0; j < 4; ++j) v[j] = v[j] * rstd;
}
__device__ __forceinline__ void row_modulate_store(const f32x4 (&v)[4], const float* sh, const float* sc, f16* o, int lane) {
#pragma unroll
    for (int j = 0; j < 4; ++j) {
        const f32x4 s = ((const f32x4*)sc)[lane + 64 * j], t = ((const f32x4*)sh)[lane + 64 * j];
        const f32x4 y = v[j] * (s + 1.0f) + t;
        ((f16x4*)o)[lane + 64 * j] = pack4(y);
    }
}
__device__ __forceinline__ void phase_p1(const Ctx& C, int l) {
    f16* H = (f16*)(C.ws() + A_H);
    for (int r = C.bid * NWAVES + C.wid; r < MALL; r += C.nblk * NWAVES) {
        const RowInfo ri = row_info(r);
        f32x4 v[4]; row_load(C.xsrc(l, r), C.lane, v); row_ln(v);
        row_modulate_store(v, C.mod(l, ri.mrow, 0), C.mod(l, ri.mrow, 1), H + (size_t)r * D, C.lane);
    }
}
__device__ __forceinline__ void phase_p10(const Ctx& C, int l, int nrows) {
    f16* H = (f16*)(C.ws() + A_H);
    const float* g = C.in(I_LN1G) + l * D; const float* bb = C.in(I_LN1B) + l * D;
    for (int r = C.bid * NWAVES + C.wid; r < nrows; r += C.nblk * NWAVES) {
        const RowInfo ri = row_info(r);
        float* t = C.ta(r);
        f32x4 v[4]; row_load(t, C.lane, v); row_ln(v);
#pragma unroll
        for (int j = 0; j < 4; ++j) { v[j] = v[j] * ((const f32x4*)g)[C.lane + 64 * j] + ((const f32x4*)bb)[C.lane + 64 * j]; ((f32x4*)t)[C.lane + 64 * j] = v[j]; }
        row_ln(v);
        row_modulate_store(v, C.mod(l, ri.mrow, 3), C.mod(l, ri.mrow, 4), H + (size_t)r * D, C.lane);
    }
}
__device__ __forceinline__ void phase_p13(const Ctx& C, int l, int nrows) {
    const float* g = C.in(I_LN2G) + l * D; const float* bb = C.in(I_LN2B) + l * D;
    for (int r = C.bid * NWAVES + C.wid; r < nrows; r += C.nblk * NWAVES) {
        float* t = C.ta(r);
        f32x4 v[4]; row_load(t, C.lane, v); row_ln(v);
#pragma unroll
        for (int j = 0; j < 4; ++j) { v[j] = v[j] * ((const f32x4*)g)[C.lane + 64 * j] + ((const f32x4*)bb)[C.lane + 64 * j]; ((f32x4*)t)[C.lane + 64 * j] = v[j]; }
    }
}
__device__ __forceinline__ void phase_hre(const Ctx& C, int l, int nrows) {
    f16* H = (f16*)(C.ws() + A_H);
    for (int r = C.bid * NWAVES + C.wid; r < nrows; r += C.nblk * NWAVES) {
        const RowInfo ri = row_info(r);
        f32x4 v[4]; row_load(C.xsrc(l, r), C.lane, v); row_ln(v);
        row_modulate_store(v, C.mod(l, ri.mrow, 0), C.mod(l, ri.mrow, 1), H + (size_t)r * D, C.lane);
    }
}

__device__ __forceinline__ void phase_p3(const Ctx& C, int l) {
    f16* PROJ = (f16*)(C.ws() + A_PROJ);
    f16* KA = (f16*)(C.ws() + A_KA); f16* VA = (f16*)(C.ws() + A_VA); f16* KC = (f16*)(C.ws() + A_KC); f16* U = (f16*)(C.ws() + A_U);
    f16* QA = (f16*)(C.ws() + A_QA);
    const float* ropeA = (const float*)(C.ws() + WS_ROPE); const float* ropeC = ropeA + 2048;
    const float* akg = C.in(I_AKG) + l * 64; const float* aqg = C.in(I_AQG) + l * 64;
    const float* ckvg = C.in(I_CKVG) + l * 256; const float* cqg = C.in(I_CQG) + l * 768;
    const int lane = C.lane;
    for (int r = C.bid * NWAVES + C.wid; r < MALL; r += C.nblk * NWAVES) {
        const RowInfo ri = row_info(r);
        f16* prow = PROJ + (size_t)r * PLD;
        const int prow_i = ri.t >> 6, pcol_i = ri.t & 63;
        float cA = 1.f, sA = 0.f;
        if (ri.lat) { const int part = lane >> 5, j = lane & 15, pi = part ? pcol_i : prow_i; cA = ropeA[pi * 16 + j]; sA = ropeA[1024 + pi * 16 + j]; if (!((lane >> 4) & 1)) sA = -sA; }
#pragma unroll
        for (int hd = 0; hd < 2; ++hd) {
            const float x = (float)prow[OFF_AK + hd * 64 + lane];
            const float ss = wave_sum(x * x);
            float y = x * (1.0f / sqrtf(ss * (1.0f / 64.0f) + EPS)) * akg[lane];
            const float p = __shfl_xor(y, 16);
            y = y * cA + p * sA;
            KA[((size_t)(ri.b * 2 + hd) * NKEY + ri.pos) * 64 + lane] = (f16)y;
            VA[((size_t)(ri.b * 2 + hd) * NKEY + ri.pos) * 64 + lane] = prow[OFF_AV + hd * 64 + lane];
        }
        {
            f16x4 x4 = *(f16x4*)(prow + OFF_CKV + 4 * lane);
            float xf[4]; float ss = 0.f;
#pragma unroll
            for (int e = 0; e < 4; ++e) { xf[e] = (float)x4[e]; ss += xf[e] * xf[e]; }
            ss = wave_sum(ss);
            const float rs = 1.0f / sqrtf(ss * (1.0f / 256.0f) + EPS);
#pragma unroll
            for (int e = 0; e < 4; ++e) x4[e] = (f16)(xf[e] * rs * ckvg[4 * lane + e]);
            *(f16x4*)(prow + OFF_CKV + 4 * lane) = x4;
        }
        {
            const int d = lane & 31;
            float x = (float)prow[OFF_CKR + d];
            float cc = 1.f, sc = 0.f;
            if (ri.lat) { const int part = d >> 4, j = d & 7, pi = part ? pcol_i : prow_i; cc = ropeC[pi * 8 + j]; sc = ropeC[512 + pi * 8 + j]; if (!((d >> 3) & 1)) sc = -sc; }
            const float p = __shfl_xor(x, 8);
            x = x * cc + p * sc;
            if (lane < 32) {
#pragma unroll
                for (int h = 0; h < 8; ++h) KC[((size_t)(ri.b * 8 + h) * NKEY + ri.pos) * 96 + 64 + d] = (f16)x;
            }
        }
        *(f16x8*)(U + (size_t)r * 512 + 8 * lane) = *(const f16x8*)(prow + OFF_U + 8 * lane);
        if (ri.lat || l == 0) {
            f16* qdst = ri.lat ? QA + ((size_t)(ri.b * 8) * SEQ + ri.t) * 64 : QA + (size_t)NB * 8 * SEQ * 64 + ((size_t)(ri.b * 8) * CTX + ri.t) * 64;
            const size_t hstride = ri.lat ? (size_t)SEQ * 64 : (size_t)CTX * 64;
#pragma unroll
            for (int h = 0; h < 8; ++h) {
                const float x = (float)prow[OFF_AQ + h * 64 + lane];
                const float ss = wave_sum(x * x);
                float y = x * (1.0f / sqrtf(ss * (1.0f / 64.0f) + EPS)) * aqg[lane];
                const float p = __shfl_xor(y, 16);
                y = (y * cA + p * sA) * QSCALE_A;
                qdst[h * hstride + lane] = (f16)y;
            }
            f16x4 x4[3]; float ss = 0.f;
#pragma unroll
            for (int i = 0; i < 3; ++i) { x4[i] = *(f16x4*)(prow + OFF_CQ + 256 * i + 4 * lane);
#pragma unroll
                for (int e = 0; e < 4; ++e) { const float f = (float)x4[i][e]; ss += f * f; } }
            ss = wave_sum(ss);
            const float rs = 1.0f / sqrtf(ss * (1.0f / 768.0f) + EPS);
#pragma unroll
            for (int i = 0; i < 3; ++i) {
#pragma unroll
                for (int e = 0; e < 4; ++e) x4[i][e] = (f16)((float)x4[i][e] * rs * cqg[256 * i + 4 * lane + e]);
                *(f16x4*)(prow + OFF_CQ + 256 * i + 4 * lane) = x4[i]; }
        }
    }
}

namespace pg8 {
#define PG8_LAS __attribute__((address_space(3)))
typedef _Float16 bf16_t;
typedef _Float16 bf16x8 __attribute__((ext_vector_type(8)));
constexpr int BM = 256, BK = 64, HALF = 128, HTB = HALF * BK * 2  , STAGE_BYTES = 8 * HTB, NXCD = 8, WGM = 8;

__host__ __device__ __forceinline__ int lds_byte(int r, int c) { const int st = (r >> 4) * 2 + (c >> 5), rr = r & 15, cc = c & 31, ob = rr * 64 + cc * 2; return st * 1024 + (ob ^ (((ob >> 9) & 1) << 5)); }
__host__ __device__ __forceinline__ void stage_rc(int b, int& R, int& C) { const int st = b / 1024, sb = b % 1024, swz = sb ^ (((sb >> 9) & 1) << 5); R = (st >> 1) * 16 + swz / 64; C = (st & 1) * 32 + (swz % 64) / 2; }
__host__ __device__ __forceinline__ int perm32(int rho) { const int n = rho >> 4, i = rho & 15; return 8 * (i >> 2) + 4 * n + (i & 3); }
struct Unit { int pm, pn; };
struct Gemm { const bf16_t* A; const bf16_t* Bt; int M, N, K, lda, ldb; };

struct StaticOrder {
    int nM, nN, nwg, G, c;
    __host__ __device__ void init(int M, int N, int G_, int c_) { nM = M / BM; nN = N / BM; nwg = nM * nN; G = G_; c = c_; }
    __host__ __device__ bool next(int i, Unit& u) const {
        const long L = (long)i * G + c; if (L >= nwg) return false;
        int wgid = (int)L; { const int q = nwg / NXCD, r = nwg % NXCD, xcd = wgid % NXCD, off = wgid / NXCD; wgid = (xcd < r ? xcd * (q + 1) : r * (q + 1) + (xcd - r) * q) + off; }
        const int nig = WGM * nN, gid = wgid / nig, fm = gid * WGM, gsz = (nM - fm) < WGM ? (nM - fm) : WGM;
        u.pm = fm + ((wgid % nig) % gsz); u.pn = (wgid % nig) / gsz; return true;
    }
    __device__ __forceinline__ void a_ready(const Unit&) const {}
    __device__ __forceinline__ void done(const Unit&) const {}
};

template <class F> struct EpiFn { static constexpr bool PERM = true, AFTER_DRAIN = false; F f;
    __device__ __forceinline__ void operator()(const f32x4 (&acc)[2][2][4][2], const Unit& u, int wr, int wc, int fr, int fq) const {
#pragma unroll
        for (int ai = 0; ai < 2; ++ai)
#pragma unroll
            for (int m = 0; m < 4; ++m) { const int row = u.pm * BM + ai * HALF + wr * 64 + m * 16 + fr;
#pragma unroll
                for (int bj = 0; bj < 2; ++bj) f(row, u.pn * BM + bj * HALF + wc * 32 + 8 * fq, acc[ai][bj][m][0], acc[ai][bj][m][1]);
                asm volatile("" ::: "memory"); }
    } };

template <class Epi, class Sched, bool ALIGN_EPI = false, bool SP2 = false>
__device__ __forceinline__ void gemm_phase(PG8_LAS unsigned char* lds, const Gemm g, const Sched& S, const Epi& E, const int tid) {
    const int wid = __builtin_amdgcn_readfirstlane(tid >> 6), lane = tid & 63, wr = wid >> 2, wc = wid & 3, fr = lane & 15, fq = lane >> 4;
    const int K = g.K, nt = K / BK;
    unsigned voffA[2], voffB[2];
#pragma unroll
    for (int i = 0; i < 2; ++i) { int R, C; stage_rc(tid * 16 + i * 8192, R, C); const int Rb = Epi::PERM ? ((R & ~31) + perm32(R & 31)) : R;
        voffA[i] = (unsigned)(R * g.lda + C) * 2u; voffB[i] = (unsigned)(Rb * g.ldb + C) * 2u; }
    const size_t kstep = (size_t)(BK * 2);
    const size_t hstepA = (size_t)HALF * g.lda * 2, hstepB = (size_t)HALF * g.ldb * 2;
    const size_t tstepA = 2 * hstepA, tstepB = 2 * hstepB;
    const unsigned ldsw = (unsigned)wid * 1024u;
    const int aoff = lds_byte(wr * 64 + fr, fq * 8), boff = lds_byte(wc * 32 + fr, fq * 8);
#define PG8_SA(b, h) (((b) * 2 + (h)) * HTB)
#define PG8_SB(b, h) ((4 + (b) * 2 + (h)) * HTB)
#define PG8_STAGE(bufoff, gbase, voff) do { _Pragma("unroll") for (int _i = 0; _i < 2; ++_i) \
        __builtin_amdgcn_global_load_lds((const unsigned*)((const char*)(gbase) + (voff)[_i]), (PG8_LAS unsigned*)(lds + (bufoff) + ldsw + _i * 8192), 16, 0, 0); } while (0)
#define PG8_LDA(dst, b, h) do { _Pragma("unroll") for (int m = 0; m < 4; ++m) _Pragma("unroll") for (int k = 0; k < 2; ++k) dst[m][k] = *(const PG8_LAS bf16x8*)(lds + PG8_SA(b, h) + aoff + m * 2048 + k * 1024); } while (0)
#define PG8_LDB(dst, b, h) do { _Pragma("unroll") for (int n = 0; n < 2; ++n) _Pragma("unroll") for (int k = 0; k < 2; ++k) dst[n][k] = *(const PG8_LAS bf16x8*)(lds + PG8_SB(b, h) + boff + n * 2048 + k * 1024); } while (0)
#define PG8_MMA(ai, bj, At, Bt) do { __builtin_amdgcn_s_setprio(1); _Pragma("unroll") for (int m = 0; m < 4; ++m) _Pragma("unroll") for (int n = 0; n < 2; ++n) _Pragma("unroll") for (int k = 0; k < 2; ++k) \
        acc[ai][bj][m][n] = __builtin_amdgcn_mfma_f32_16x16x32_f16(Bt[n][k], At[m][k], acc[ai][bj][m][n], 0, 0, 0); __builtin_amdgcn_s_setprio(0); } while (0)
#define PG8_WAIT_V(n) asm volatile("s_waitcnt vmcnt(" #n ")" ::: "memory")
#define PG8_WAIT_L(n) asm volatile("s_waitcnt lgkmcnt(" #n ")" ::: "memory")
#define PG8_BAR __builtin_amdgcn_s_barrier()
#define PG8_SCHED __builtin_amdgcn_sched_barrier(0)
    Unit cur, nxt; int ui = 0;
    if (!S.next(0, cur)) return;
    f32x4 acc[2][2][4][2];
#pragma unroll
    for (int a = 0; a < 2; ++a)
#pragma unroll
        for (int b = 0; b < 2; ++b)
#pragma unroll
            for (int m = 0; m < 4; ++m)
#pragma unroll
                for (int n = 0; n < 2; ++n) acc[a][b][m][n] = (f32x4){0.f, 0.f, 0.f, 0.f};
    bf16x8 At[4][2], B0[2][2], B1[2][2];
    const char* cA = (const char*)g.A + (size_t)cur.pm * tstepA; const char* cB = (const char*)g.Bt + (size_t)cur.pn * tstepB;
    S.a_ready(cur);
    if constexpr (SP2) {
        PG8_STAGE(PG8_SB(0, 0), cB, voffB); PG8_STAGE(PG8_SB(0, 1), cB + hstepB, voffB); PG8_STAGE(PG8_SA(0, 0), cA, voffA); PG8_STAGE(PG8_SA(0, 1), cA + hstepA, voffA);
        if (wr == 1) PG8_BAR;
        PG8_WAIT_V(2); PG8_BAR;
        PG8_STAGE(PG8_SB(1, 0), cB + kstep, voffB); PG8_STAGE(PG8_SA(1, 0), cA + kstep, voffA); PG8_STAGE(PG8_SB(1, 1), cB + hstepB + kstep, voffB);
        PG8_WAIT_V(6); PG8_BAR;
    } else {
        PG8_STAGE(PG8_SB(0, 0), cB, voffB); PG8_STAGE(PG8_SA(0, 0), cA, voffA); PG8_STAGE(PG8_SB(0, 1), cB + hstepB, voffB); PG8_STAGE(PG8_SA(0, 1), cA + hstepA, voffA);
        if (wr == 1) PG8_BAR;
        PG8_WAIT_V(4); PG8_BAR;
        PG8_STAGE(PG8_SB(1, 0), cB + kstep, voffB); PG8_STAGE(PG8_SA(1, 0), cA + kstep, voffA); PG8_STAGE(PG8_SB(1, 1), cB + hstepB + kstep, voffB);
        PG8_WAIT_V(6); PG8_BAR;
    }
    for (;;) {
        const bool has_next = S.next(ui + 1, nxt);
        const char* nA = has_next ? (const char*)g.A + (size_t)nxt.pm * tstepA : cA; const char* nB = has_next ? (const char*)g.Bt + (size_t)nxt.pn * tstepB : cB;
#pragma unroll 1
        for (int t = 0; t < nt; t += 2) {
            const bool last = (t == nt - 2);
            const char* a1 = cA + (size_t)(t + 1) * kstep;
            const char* a2 = last ? nA : cA + (size_t)(t + 2) * kstep; const char* b2 = last ? nB : cB + (size_t)(t + 2) * kstep;
            const char* a3 = a2 + kstep; const char* b3 = b2 + kstep;
            if (last && has_next) S.a_ready(nxt);
            if constexpr (SP2) {
            PG8_LDB(B0, 0, 0); PG8_LDB(B1, 0, 1); PG8_SCHED; PG8_LDA(At, 0, 0); PG8_STAGE(PG8_SA(1, 1), a1 + hstepA, voffA);
            PG8_WAIT_V(8); PG8_WAIT_L(0); PG8_BAR; PG8_MMA(0, 0, At, B0); PG8_MMA(0, 1, At, B1); PG8_BAR; PG8_SCHED;
            PG8_LDA(At, 0, 1); PG8_STAGE(PG8_SB(0, 0), b2, voffB); PG8_STAGE(PG8_SB(0, 1), b2 + hstepB, voffB); PG8_STAGE(PG8_SA(0, 0), a2, voffA);
            PG8_WAIT_V(8); PG8_WAIT_L(0); PG8_BAR; PG8_MMA(1, 0, At, B0); PG8_MMA(1, 1, At, B1); PG8_BAR; PG8_SCHED;
            PG8_LDB(B0, 1, 0); PG8_LDB(B1, 1, 1); PG8_SCHED; PG8_LDA(At, 1, 0); PG8_STAGE(PG8_SA(0, 1), a2 + hstepA, voffA);
            PG8_WAIT_V(8); PG8_WAIT_L(0); PG8_BAR; PG8_MMA(0, 0, At, B0); PG8_MMA(0, 1, At, B1); PG8_BAR; PG8_SCHED;
            PG8_LDA(At, 1, 1); PG8_STAGE(PG8_SB(1, 0), b3, voffB); PG8_STAGE(PG8_SB(1, 1), b3 + hstepB, voffB); PG8_STAGE(PG8_SA(1, 0), a3, voffA);
            PG8_WAIT_V(8); PG8_WAIT_L(0); PG8_BAR; PG8_MMA(1, 0, At, B0); PG8_MMA(1, 1, At, B1); PG8_BAR; PG8_SCHED;
            } else {
            PG8_LDB(B0, 0, 0); PG8_SCHED; PG8_LDA(At, 0, 0); PG8_STAGE(PG8_SA(1, 1), a1 + hstepA, voffA);
            PG8_WAIT_L(8); PG8_BAR; PG8_WAIT_L(0); PG8_MMA(0, 0, At, B0); PG8_BAR; PG8_SCHED;
            PG8_LDB(B1, 0, 1); PG8_STAGE(PG8_SB(0, 0), b2, voffB);
            PG8_BAR; PG8_WAIT_L(0); PG8_MMA(0, 1, At, B1); PG8_BAR;
            PG8_LDA(At, 0, 1); PG8_STAGE(PG8_SA(0, 0), a2, voffA);
            PG8_BAR; PG8_WAIT_L(0); PG8_MMA(1, 0, At, B0); PG8_BAR; PG8_SCHED;
            PG8_STAGE(PG8_SB(0, 1), b2 + hstepB, voffB);
            PG8_WAIT_V(6); PG8_BAR; PG8_MMA(1, 1, At, B1); PG8_BAR;
            PG8_LDB(B0, 1, 0); PG8_SCHED; PG8_LDA(At, 1, 0); PG8_STAGE(PG8_SA(0, 1), a2 + hstepA, voffA);
            PG8_WAIT_L(8); PG8_BAR; PG8_WAIT_L(0); PG8_MMA(0, 0, At, B0); PG8_BAR; PG8_SCHED;
            PG8_LDB(B1, 1, 1); PG8_STAGE(PG8_SB(1, 0), b3, voffB);
            PG8_BAR; PG8_WAIT_L(0); PG8_MMA(0, 1, At, B1); PG8_BAR;
            PG8_LDA(At, 1, 1); PG8_STAGE(PG8_SA(1, 0), a3, voffA);
            PG8_BAR; PG8_WAIT_L(0); PG8_MMA(1, 0, At, B0); PG8_BAR; PG8_SCHED;
            PG8_STAGE(PG8_SB(1, 1), b3 + hstepB, voffB);
            PG8_WAIT_V(6); PG8_BAR; PG8_MMA(1, 1, At, B1); PG8_BAR;
            }
        }
        if constexpr (ALIGN_EPI) { if (wr == 0) PG8_BAR; }
        if constexpr (!Epi::AFTER_DRAIN) { E(acc, cur, wr, wc, fr, fq); S.done(cur); }
        if (!has_next) break;
#pragma unroll
        for (int a = 0; a < 2; ++a)
#pragma unroll
            for (int b = 0; b < 2; ++b)
#pragma unroll
                for (int m = 0; m < 4; ++m)
#pragma unroll
                    for (int n = 0; n < 2; ++n) acc[a][b][m][n] = (f32x4){0.f, 0.f, 0.f, 0.f};
        cur = nxt; cA = nA; cB = nB; ++ui;
        if constexpr (ALIGN_EPI) { if (wr == 1) PG8_BAR; }
    }
    PG8_WAIT_V(0);
    if constexpr (!ALIGN_EPI) { if (wr == 0) PG8_BAR; }
    PG8_BAR;
    if constexpr (Epi::AFTER_DRAIN) { E.fused(acc, cur, wr, wc, fr, fq, lds, wid, lane); S.done(cur); }
#undef PG8_SA
#undef PG8_SB
#undef PG8_STAGE
#undef PG8_LDA
#undef PG8_LDB
#undef PG8_MMA
#undef PG8_WAIT_V
#undef PG8_WAIT_L
#undef PG8_BAR
#undef PG8_SCHED
}
}

template <class Epi>
__device__ __forceinline__ void gemm_simple(const Ctx& C, const f16* A, int lda, const f16* Bt, int ldb, int M, int N, int K, const Epi& E, int mskip_from = 1 << 30, int nskip_from = 1 << 30) {
    const int wr = C.wid >> 2, wc = C.wid & 3, fr = C.lane & 15, fq = C.lane >> 4;
    const int tilesN = N / 256, tilesM = M / 64;
    for (int tile = C.bid; tile < tilesM * tilesN; tile += C.nblk) {
        const int tm = tile / tilesN, tn = tile % tilesN;
        if (tm * 64 >= mskip_from && tn * 256 >= nskip_from) continue;
        const int m0 = tm * 64 + wr * 32, n0 = tn * 256 + wc * 64;
        f32x4 acc[2][2][2];
#pragma unroll
        for (int a = 0; a < 2; ++a)
#pragma unroll
            for (int g = 0; g < 2; ++g)
#pragma unroll
                for (int n = 0; n < 2; ++n) acc[a][g][n] = (f32x4){0.f, 0.f, 0.f, 0.f};
        const f16* ap[2]; const f16* bp[2][2];
#pragma unroll
        for (int a = 0; a < 2; ++a) ap[a] = A + (size_t)(m0 + a * 16 + fr) * lda + fq * 8;
#pragma unroll
        for (int g = 0; g < 2; ++g)
#pragma unroll
            for (int n = 0; n < 2; ++n) bp[g][n] = Bt + (size_t)(n0 + g * 32 + 8 * (fr >> 2) + 4 * n + (fr & 3)) * ldb + fq * 8;
        for (int k0 = 0; k0 < K; k0 += 32) {
            f16x8 av[2], bv[2][2];
#pragma unroll
            for (int a = 0; a < 2; ++a) av[a] = *(const f16x8*)(ap[a] + k0);
#pragma unroll
            for (int g = 0; g < 2; ++g)
#pragma unroll
                for (int n = 0; n < 2; ++n) bv[g][n] = *(const f16x8*)(bp[g][n] + k0);
#pragma unroll
            for (int a = 0; a < 2; ++a)
#pragma unroll
                for (int g = 0; g < 2; ++g)
#pragma unroll
                    for (int n = 0; n < 2; ++n) acc[a][g][n] = __builtin_amdgcn_mfma_f32_16x16x32_f16(bv[g][n], av[a], acc[a][g][n], 0, 0, 0);
        }
#pragma unroll
        for (int a = 0; a < 2; ++a)
#pragma unroll
            for (int g = 0; g < 2; ++g) E(m0 + a * 16 + fr, n0 + g * 32 + 8 * fq, acc[a][g][0], acc[a][g][1]);
    }
}

template <class F>
__device__ __forceinline__ void gemm_pg8(const Ctx& C, const f16* A, int lda, const f16* Bt, int ldb, int M, int N, int K, const F& f) {
    pg8::Gemm g{A, Bt, M, N, K, lda, ldb}; pg8::StaticOrder S; S.init(M, N, C.nblk, C.bid);
    pg8::EpiFn<F> E{f};
    pg8::gemm_phase<pg8::EpiFn<F>, pg8::StaticOrder, true, true>(C.lds, g, S, E, C.tid);
}
template <class F>
__device__ __forceinline__ void gemm_small(const Ctx& C, const f16* A, int lda, const f16* Bt, int ldb, int row0, int N, int K, const F& f) {
    constexpr int PST = 68;
    LAS float* part = (LAS float*)C.lds;
    const int fr = C.lane & 15, fq = C.lane >> 4;
    const int tilesN = N / 64, ntiles = 16 * tilesN, kw = K / 8;
    for (int tile = C.bid; tile < ntiles; tile += C.nblk) {
        const int tm = tile / tilesN, tn = tile - tm * tilesN, m0 = tm * 64, n0 = tn * 64;
        f32x4 acc[4][4];
#pragma unroll
        for (int a = 0; a < 4; ++a)
#pragma unroll
            for (int b = 0; b < 4; ++b) acc[a][b] = (f32x4){0.f, 0.f, 0.f, 0.f};
        const f16* ap = A + (size_t)(m0 + fr) * lda + C.wid * kw + fq * 8;
        const f16* bp = Bt + (size_t)(n0 + fr) * ldb + C.wid * kw + fq * 8;
#pragma unroll 2
        for (int k0 = 0; k0 < kw; k0 += 32) {
            f16x8 av[4], bv[4];
#pragma unroll
            for (int a = 0; a < 4; ++a) av[a] = *(const f16x8*)(ap + (size_t)(a * 16) * lda + k0);
#pragma unroll
            for (int b = 0; b < 4; ++b) bv[b] = *(const f16x8*)(bp + (size_t)(b * 16) * ldb + k0);
#pragma unroll
            for (int a = 0; a < 4; ++a)
#pragma unroll
                for (int b = 0; b < 4; ++b) acc[a][b] = __builtin_amdgcn_mfma_f32_16x16x32_f16(bv[b], av[a], acc[a][b], 0, 0, 0);
        }
        __syncthreads();
        LAS float* pw = part + (size_t)C.wid * 64 * PST;
#pragma unroll
        for (int a = 0; a < 4; ++a)
#pragma unroll
            for (int b = 0; b < 4; ++b) *(LAS f32x4*)(pw + (a * 16 + fr) * PST + b * 16 + 4 * fq) = acc[a][b];
        __syncthreads();
        const int rl = 8 * C.wid + (C.lane & 7), c8 = ((C.lane >> 4) & 1) | (((C.lane >> 5) & 1) << 1) | (((C.lane >> 3) & 1) << 2);
        f32x4 lo = (f32x4){0.f, 0.f, 0.f, 0.f}, hi = lo;
#pragma unroll
        for (int w = 0; w < 8; ++w) { const LAS float* pr = part + ((size_t)w * 64 + rl) * PST + 8 * c8; lo = lo + *(const LAS f32x4*)pr; hi = hi + *(const LAS f32x4*)(pr + 4); }
        f(row0 + m0 + rl, n0 + 8 * c8, lo, hi);
    }
    __syncthreads();
}
template <class F>
__device__ __forceinline__ void gemm_rows(const Ctx& C, const f16* A, int lda, const f16* Bt, int ldb, int mrows, int N, int K, const F& f) {
    gemm_pg8(C, A, lda, Bt, ldb, NLAT, N, K, f);
    if (mrows > NLAT) gemm_small(C, A + (size_t)NLAT * lda, lda, Bt, ldb, NLAT, N, K, f);
}
struct EpiStore { f16* O; int ldo;
    __device__ __forceinline__ void operator()(int row, int col, f32x4 lo, f32x4 hi) const { *(f16x8*)(O + (size_t)row * ldo + col) = pack8(lo, hi); } };
struct EpiKvUp { f16* KC; f16* VC;
    __device__ __forceinline__ void operator()(int row, int col, f32x4 lo, f32x4 hi) const {
        const RowInfo ri = row_info(row); const int h = col >> 7, w = col & 127;
        if (w < 64) *(f16x8*)(KC + ((size_t)(ri.b * 8 + h) * NKEY + ri.pos) * 96 + w) = pack8(lo, hi);
        else *(f16x8*)(VC + ((size_t)(ri.b * 8 + h) * NKEY + ri.pos) * 64 + (w - 64)) = pack8(lo, hi);
    } };
struct EpiQUp { f16* QC; const float* ropeC;
    __device__ __forceinline__ void operator()(int row, int col, f32x4 lo, f32x4 hi) const {
        const RowInfo ri = row_info(row); const int h = col / 96, w = col - h * 96;
        if (w >= 64) {
            f32x4 plo, phi;
#pragma unroll
            for (int e = 0; e < 4; ++e) { plo[e] = __shfl_xor(lo[e], 16); phi[e] = __shfl_xor(hi[e], 16); }
            if (ri.lat) {
                const int j0 = w - 64, part = j0 >> 4, second = (j0 >> 3) & 1, pi = part ? (ri.t & 63) : (ri.t >> 6);
                const float* cc = ropeC + pi * 8; const float* ss = ropeC + 512 + pi * 8;
#pragma unroll
                for (int e = 0; e < 4; ++e) {
                    const float s0 = second ? ss[e] : -ss[e], s1 = second ? ss[4 + e] : -ss[4 + e];
                    lo[e] = lo[e] * cc[e] + plo[e] * s0; hi[e] = hi[e] * cc[4 + e] + phi[e] * s1; }
            }
        }
        lo = lo * QSCALE_C; hi = hi * QSCALE_C;
        f16* dst = ri.lat ? QC + ((size_t)(ri.b * 8 + h) * SEQ + ri.t) * 96 + w : QC + (size_t)NB * 8 * SEQ * 96 + ((size_t)(ri.b * 8 + h) * CTX + ri.t) * 96 + w;
        *(f16x8*)dst = pack8(lo, hi);
    } };
struct EpiGlu { f16* YS;
    __device__ __forceinline__ void operator()(int row, int col, f32x4 lo, f32x4 hi) const {
        f32x4 o;
#pragma unroll
        for (int e = 0; e < 4; ++e) o[e] = lo[e] * sigmoidf_(hi[e]);
        *(f16x4*)(YS + (size_t)row * 512 + (col >> 1)) = pack4(o);
    } };
struct EpiGate { f16* G;
    __device__ __forceinline__ void operator()(int row, int col, f32x4 lo, f32x4 hi) const {
#pragma unroll
        for (int e = 0; e < 4; ++e) { lo[e] = sigmoidf_(lo[e]); hi[e] = sigmoidf_(hi[e]); }
        *(f16x8*)(G + (size_t)row * 1024 + col) = pack8(lo, hi);
    } };
struct EpiBranch { const f16* G; f16* Mg; int first;
    __device__ __forceinline__ void operator()(int row, int col, f32x4 lo, f32x4 hi) const {
        const f16x8 g = *(const f16x8*)(G + (size_t)row * 1024 + col);
        f16x8 m = {0, 0, 0, 0, 0, 0, 0, 0};
        if (!first) m = *(const f16x8*)(Mg + (size_t)row * 1024 + col);
#pragma unroll
        for (int e = 0; e < 4; ++e) { lo[e] = (float)m[e] + (float)g[e] * lo[e]; hi[e] = (float)m[4 + e] + (float)g[4 + e] * hi[e]; }
        *(f16x8*)(Mg + (size_t)row * 1024 + col) = pack8(lo, hi);
    } };
struct EpiWout { const Ctx* C; int l;
    __device__ __forceinline__ void operator()(int row, int col, f32x4 lo, f32x4 hi) const {
        const RowInfo ri = row_info(row); const float* x = C->xsrc(l, row) + col; const float* g = C->mod(l, ri.mrow, 2) + col; float* t = C->ta(row) + col;
        const f32x4 x0 = *(const f32x4*)x, x1 = *(const f32x4*)(x + 4), g0 = *(const f32x4*)g, g1 = *(const f32x4*)(g + 4);
        *(f32x4*)t = x0 * ALPHA + g0 * lo; *(f32x4*)(t + 4) = x1 * ALPHA + g1 * hi;
    } };
struct EpiUp { f16* Hd;
    __device__ __forceinline__ void operator()(int row, int col, f32x4 lo, f32x4 hi) const {
#pragma unroll
        for (int e = 0; e < 4; ++e) { const float a = fmaxf(lo[e], 0.f), b = fmaxf(hi[e], 0.f); lo[e] = a * a; hi[e] = b * b; }
        *(f16x8*)(Hd + (size_t)row * DFF + col) = pack8(lo, hi);
    } };
struct EpiDown { const Ctx* C; int l;
    __device__ __forceinline__ void operator()(int row, int col, f32x4 lo, f32x4 hi) const {
        const RowInfo ri = row_info(row); const float* g = C->mod(l, ri.mrow, 5) + col; float* t = C->ta(row) + col;
        const f32x4 x0 = *(const f32x4*)t, x1 = *(const f32x4*)(t + 4), g0 = *(const f32x4*)g, g1 = *(const f32x4*)(g + 4);
        *(f32x4*)t = x0 * ALPHA + g0 * lo; *(f32x4*)(t + 4) = x1 * ALPHA + g1 * hi;
    } };

typedef _Float16 f16x2 __attribute__((ext_vector_type(2)));
template <int DQK>
__device__ __forceinline__ void attn_naive_query(const f16* q, const f16* Kh, const f16* Vh, int nkeys, f16* out, LAS float* scr, int lane) {
    f16x8 qv[DQK / 8];
#pragma unroll
    for (int c = 0; c < DQK / 8; ++c) qv[c] = *(const f16x8*)(q + 8 * c);
    float m = -1e30f, ls = 0.f; float acc[64];
#pragma unroll
    for (int d = 0; d < 64; ++d) acc[d] = 0.f;
    for (int j = lane; j < nkeys; j += 64) {
        const f16* kr = Kh + (size_t)j * DQK; const f16* vr = Vh + (size_t)j * 64;
        float s = 0.f;
#pragma unroll
        for (int c = 0; c < DQK / 8; ++c) { const f16x8 v = *(const f16x8*)(kr + 8 * c);
#pragma unroll
            for (int e = 0; e < 4; ++e) s = __builtin_amdgcn_fdot2((f16x2){qv[c][2 * e], qv[c][2 * e + 1]}, (f16x2){v[2 * e], v[2 * e + 1]}, s, false); }
        const float mn = fmaxf(m, s), a = exp2f(m - mn), p = exp2f(s - mn);
        ls = ls * a + p; m = mn;
#pragma unroll
        for (int c = 0; c < 8; ++c) { const f16x8 v = *(const f16x8*)(vr + 8 * c);
#pragma unroll
            for (int e = 0; e < 8; ++e) acc[8 * c + e] = acc[8 * c + e] * a + p * (float)v[e]; }
    }
    const float mg = wave_max(m), w = exp2f(m - mg);
    const float L = wave_sum(ls * w);
#pragma unroll
    for (int d = 0; d < 64; ++d) scr[lane * 65 + d] = acc[d] * w;
    asm volatile("s_waitcnt lgkmcnt(0)" ::: "memory");
    float o = 0.f;
#pragma unroll 8
    for (int i = 0; i < 64; ++i) o += scr[i * 65 + lane];
    asm volatile("s_waitcnt lgkmcnt(0)" ::: "memory");
    out[lane] = (f16)(o / L);
}
__device__ __forceinline__ void phase_attn_naive(const Ctx& C, int l) {
    LAS float* scr = (LAS float*)C.lds + C.wid * (64 * 65);
    const f16* QA = (const f16*)(C.ws() + A_QA); const f16* QC = (const f16*)(C.ws() + A_QC);
    const f16* KA = (const f16*)(C.ws() + A_KA); const f16* VA = (const f16*)(C.ws() + A_VA);
    const f16* KC = (const f16*)(C.ws() + A_KC); const f16* VC = (const f16*)(C.ws() + A_VC);
    f16* YA = (f16*)(C.ws() + A_YA); f16* YC = (f16*)(C.ws() + A_YC);
    const int NQL = NB * 8 * SEQ, NQC = NB * 8 * CTX;
    const int total = 2 * NQL + (l == 0 ? 2 * NQC : 0);
    for (int u = C.bid * NWAVES + C.wid; u < total; u += C.nblk * NWAVES) {
        int v = u; int type, lat;
        if (v < 2 * NQL) { type = v / NQL; v -= type * NQL; lat = 1; } else { v -= 2 * NQL; type = v / NQC; v -= type * NQC; lat = 0; }
        const int nq = lat ? SEQ : CTX;
        const int t = v % nq, h = (v / nq) & 7, b = v / (nq * 8);
        const int row = lat ? b * SEQ + t : NLAT + b * CTX + t;
        const int nkeys = lat ? NKEY : CTX;
        if (type == 0) {
            const f16* q = lat ? QA + ((size_t)(b * 8 + h) * SEQ + t) * 64 : QA + (size_t)NB * 8 * SEQ * 64 + ((size_t)(b * 8 + h) * CTX + t) * 64;
            attn_naive_query<64>(q, KA + (size_t)(b * 2 + (h >> 2)) * NKEY * 64, VA + (size_t)(b * 2 + (h >> 2)) * NKEY * 64, nkeys, YA + (size_t)row * 512 + h * 64, scr, C.lane);
        } else {
            const f16* q = lat ? QC + ((size_t)(b * 8 + h) * SEQ + t) * 96 : QC + (size_t)NB * 8 * SEQ * 96 + ((size_t)(b * 8 + h) * CTX + t) * 96;
            attn_naive_query<96>(q, KC + (size_t)(b * 8 + h) * NKEY * 96, VC + (size_t)(b * 8 + h) * NKEY * 64, nkeys, YC + (size_t)row * 512 + h * 64, scr, C.lane);
        }
    }
}

namespace fa {
typedef _Float16 h2 __attribute__((ext_vector_type(2)));
typedef float f2 __attribute__((ext_vector_type(2)));
typedef short s16x4 __attribute__((ext_vector_type(4)));
typedef unsigned u32x4 __attribute__((ext_vector_type(4)));
#define FA_SBAR() __builtin_amdgcn_sched_barrier(0)
constexpr float THR = 8.f;
constexpr int SHM_V = 64 * 64 * 2;
template <int DQK> struct Cfg { static constexpr int KROWB = DQK == 64 ? 128 : 256, SHM_K = 64 * KROWB, NCH = DQK / 8; };
template <int DQK> __device__ __forceinline__ int kswz(int row, int ch) {
    if constexpr (DQK == 64) return row * 128 + ((ch ^ ((row >> 1) & 7)) << 4);
    else return row * 256 + ((ch ^ (row & 15)) << 4);
}
__device__ __forceinline__ int crow(int r, int hi) { return (r & 3) + 8 * (r >> 2) + 4 * hi; }
__device__ __forceinline__ unsigned cvtpk(float lo, float hi) { f2 v = {lo, hi}; h2 h = __builtin_convertvector(v, h2); return __builtin_bit_cast(unsigned, h); }
__device__ __forceinline__ void partialSM(f32x16& p0, f32x16& p1, float& m_reg, float& mn, float& alpha) {
    float pmax = p0[0];
#pragma unroll
    for (int r = 1; r < 16; ++r) pmax = fmaxf(pmax, p0[r]);
#pragma unroll
    for (int r = 0; r < 16; ++r) pmax = fmaxf(pmax, p1[r]);
    { auto rr = __builtin_amdgcn_permlane32_swap(__float_as_uint(pmax), __float_as_uint(pmax), false, false);
      pmax = fmaxf(__uint_as_float(rr[0]), __uint_as_float(rr[1])); }
    if (__builtin_expect(__all(pmax - m_reg <= THR), 1)) { mn = m_reg; alpha = 1.f; }
    else { mn = fmaxf(m_reg, pmax); alpha = __builtin_amdgcn_exp2f(m_reg - mn); m_reg = mn; }
#pragma unroll
    for (int r = 0; r < 16; ++r) { p0[r] = p0[r] - mn; p1[r] = p1[r] - mn; }
#pragma unroll
    for (int r = 0; r < 16; ++r) p0[r] = __builtin_amdgcn_exp2f(p0[r]);
}
__device__ __forceinline__ void finishSM(f32x16& p0, f32x16& p1, float alpha, float& l_reg, f16x8& pa0, f16x8& pa1, f16x8& pa2, f16x8& pa3) {
#pragma unroll
    for (int r = 0; r < 16; ++r) p1[r] = __builtin_amdgcn_exp2f(p1[r]);
    float ps = 0;
#pragma unroll
    for (int r = 0; r < 16; ++r) ps += p0[r];
#pragma unroll
    for (int r = 0; r < 16; ++r) ps += p1[r];
    { auto rr = __builtin_amdgcn_permlane32_swap(__float_as_uint(ps), __float_as_uint(ps), false, false);
      ps = __uint_as_float(rr[0]) + __uint_as_float(rr[1]); }
    l_reg = l_reg * alpha + ps;
#define FA_PK4(P, BASE, OUT) do { unsigned a0 = cvtpk(P[BASE + 0], P[BASE + 1]), a1 = cvtpk(P[BASE + 2], P[BASE + 3]);   \
    unsigned b0 = cvtpk(P[BASE + 4], P[BASE + 5]), b1 = cvtpk(P[BASE + 6], P[BASE + 7]);                              \
    auto r0 = __builtin_amdgcn_permlane32_swap(a0, b0, false, false); auto r1 = __builtin_amdgcn_permlane32_swap(a1, b1, false, false); \
    u32x4 w = {r0[0], r1[0], r0[1], r1[1]}; OUT = __builtin_bit_cast(f16x8, w); } while (0)
    FA_PK4(p0, 0, pa0); FA_PK4(p0, 8, pa1); FA_PK4(p1, 0, pa2); FA_PK4(p1, 8, pa3);
#undef FA_PK4
}
template <int DQK>
__device__ __forceinline__ void qkt(f32x16& p0, f32x16& p1, const LAS unsigned char* Ks, const f16x8* qr, int r32, int hi) {
    p0 = f32x16{}; p1 = f32x16{};
#pragma unroll
    for (int d0 = 0; d0 < DQK / 16; ++d0) {
        const f16x8 b0 = *(const LAS f16x8*)(Ks + kswz<DQK>(r32, d0 * 2 + hi));
        const f16x8 b1 = *(const LAS f16x8*)(Ks + kswz<DQK>(32 + r32, d0 * 2 + hi));
        p0 = __builtin_amdgcn_mfma_f32_32x32x16_f16(b0, qr[d0], p0, 0, 0, 0);
        p1 = __builtin_amdgcn_mfma_f32_32x32x16_f16(b1, qr[d0], p1, 0, 0, 0);
    }
}
__device__ __forceinline__ int v_st(int k, int c) { const int kk = (k & ~0xC) | ((k & 4) << 1) | ((k & 8) >> 1); return ((kk >> 3) * 2 + (c >> 5)) * 512 + ((kk & 7) * 32 + (c & 31)) * 2; }
__device__ __forceinline__ int v_rd_base(int lane) { return ((lane & 3) << 3) | (((lane >> 2) & 3) << 6) | (((lane >> 4) & 1) << 5) | (((lane >> 5) & 1) << 8); }
constexpr int v_rd_off(int d0, int ks, int half) { return d0 * 512 + ks * 2048 + half * 1024; }
template <int OFF> __device__ __forceinline__ s16x4 tr_read(int vb) {
    s16x4 r; asm volatile("ds_read_b64_tr_b16 %0, %1 offset:%2" : "=&v"(r) : "v"(vb), "i"(OFF) : "memory"); return r;
}
template <int D0> __device__ __forceinline__ void pv_one(f32x16& od, int vb, f16x8 pa0, f16x8 pa1, f16x8 pa2, f16x8 pa3) {
    const s16x4 l0 = tr_read<v_rd_off(D0, 0, 0)>(vb), h0 = tr_read<v_rd_off(D0, 0, 1)>(vb), l1 = tr_read<v_rd_off(D0, 1, 0)>(vb), h1 = tr_read<v_rd_off(D0, 1, 1)>(vb);
    const s16x4 l2 = tr_read<v_rd_off(D0, 2, 0)>(vb), h2_ = tr_read<v_rd_off(D0, 2, 1)>(vb), l3 = tr_read<v_rd_off(D0, 3, 0)>(vb), h3 = tr_read<v_rd_off(D0, 3, 1)>(vb);
    asm volatile("s_waitcnt lgkmcnt(0)" ::: "memory"); FA_SBAR();
#define FA_PK(L, H) __builtin_bit_cast(f16x8, (short __attribute__((ext_vector_type(8)))){L[0], L[1], L[2], L[3], H[0], H[1], H[2], H[3]})
    od = __builtin_amdgcn_mfma_f32_32x32x16_f16(pa0, FA_PK(l0, h0), od, 0, 0, 0);
    od = __builtin_amdgcn_mfma_f32_32x32x16_f16(pa1, FA_PK(l1, h1), od, 0, 0, 0);
    od = __builtin_amdgcn_mfma_f32_32x32x16_f16(pa2, FA_PK(l2, h2_), od, 0, 0, 0);
    od = __builtin_amdgcn_mfma_f32_32x32x16_f16(pa3, FA_PK(l3, h3), od, 0, 0, 0);
#undef FA_PK
}
__device__ __forceinline__ void pv_d0(f32x16* o, int vb, f16x8 pa0, f16x8 pa1, f16x8 pa2, f16x8 pa3) {
    pv_one<0>(o[0], vb, pa0, pa1, pa2, pa3); pv_one<1>(o[1], vb, pa0, pa1, pa2, pa3);
}
template <int DQK>
__device__ __forceinline__ void attn_unit(const f16* __restrict__ Qb, const f16* __restrict__ Kh, const f16* __restrict__ Vh, f16* __restrict__ Ob, int nkeys, LAS unsigned char* lds, const int tid) {
    constexpr int SHM_K = Cfg<DQK>::SHM_K, NCH = Cfg<DQK>::NCH, ND0 = DQK / 16;
    const int wid = tid >> 6, lane = tid & 63, r32 = lane & 31, hi = lane >> 5;
    LAS unsigned char* V_lds = lds; LAS unsigned char* K_lds = lds + 2 * SHM_V;
    LAS float* wsx = (LAS float*)(lds + 2 * SHM_V + 2 * SHM_K) + wid * 64; LAS float* li_l = wsx; LAS float* al_l = wsx + 32;
    float m_reg = -1e30f, l_reg = 0; f32x16 o[2] = {}; f16x8 qr[ND0];
    const f16* Qw = Qb + (size_t)(wid * 32 + r32) * DQK + hi * 8;
#pragma unroll
    for (int d0 = 0; d0 < ND0; ++d0) qr[d0] = *(const f16x8*)(Qw + d0 * 16);
    const int vr = tid >> 3, vc = (tid & 7) * 8, vst = v_st(vr, vc);
    const int k0id = tid, k1id = (tid + 512 < 64 * NCH) ? tid + 512 : tid;
    const int k0r = k0id / NCH, k0c = k0id % NCH, k1r = k1id / NCH, k1c = k1id % NCH;
    const bool k1on = (NCH > 8) && (tid + 512 < 64 * NCH);
    const int vb0 = (int)(uintptr_t)V_lds + v_rd_base(lane);
    struct { f16x8 vs, ks0, ks1; } sr_[2];
#define FA_SLOAD(i, kk0) do { sr_[i].vs = *(const f16x8*)(Vh + (size_t)((kk0) + vr) * 64 + vc); sr_[i].ks0 = *(const f16x8*)(Kh + (size_t)((kk0) + k0r) * DQK + k0c * 8); \
    if (NCH > 8) sr_[i].ks1 = *(const f16x8*)(Kh + (size_t)((kk0) + k1r) * DQK + k1c * 8); } while (0)
#define FA_SWRITE(b, i) do { *(LAS f16x8*)(V_lds + (b) * SHM_V + vst) = sr_[i].vs; *(LAS f16x8*)(K_lds + (b) * SHM_K + kswz<DQK>(k0r, k0c)) = sr_[i].ks0; \
    if (k1on) *(LAS f16x8*)(K_lds + (b) * SHM_K + kswz<DQK>(k1r, k1c)) = sr_[i].ks1; } while (0)
#define FA_SWAIT() do { if (NCH > 8) asm volatile("s_waitcnt vmcnt(3)" ::: "memory"); else asm volatile("s_waitcnt vmcnt(2)" ::: "memory"); } while (0)
#define FA_RESC(a) do { if (__any((a) < 1.f)) { if (hi == 0) al_l[r32] = (a); asm volatile("s_waitcnt lgkmcnt(0)" ::: "memory"); \
    _Pragma("unroll") for (int d = 0; d < 2; ++d) _Pragma("unroll") for (int r = 0; r < 16; ++r) o[d][r] *= al_l[crow(r, hi)]; } } while (0)
    f32x16 pA0, pA1, pB0, pB1; float mnA, mnB, alA, alB; f16x8 pa0, pa1, pa2, pa3; const int NT = nkeys / 64;
    constexpr int SE = 0, SO = 1;
    FA_SLOAD(SE, 0); asm volatile("s_waitcnt vmcnt(0)" ::: "memory"); FA_SWRITE(0, SE); __syncthreads();
    qkt<DQK>(pA0, pA1, K_lds, qr, r32, hi); partialSM(pA0, pA1, m_reg, mnA, alA);
    FA_SLOAD(SO, 64); if (2 < NT) FA_SLOAD(SE, 128);
    FA_SWAIT(); FA_SWRITE(1, SO); __syncthreads();
    for (int j = 1; j + 1 < NT; j += 2) {
        FA_SBAR(); qkt<DQK>(pB0, pB1, K_lds + SHM_K, qr, r32, hi);
        finishSM(pA0, pA1, alA, l_reg, pa0, pa1, pa2, pa3); FA_SBAR();
        FA_SLOAD(SO, (j + 2) * 64); FA_SBAR();
        pv_d0(o, vb0, pa0, pa1, pa2, pa3); partialSM(pB0, pB1, m_reg, mnB, alB);
        __syncthreads(); FA_SWAIT(); FA_SWRITE(0, SE);
        FA_RESC(alB); __syncthreads();
        FA_SBAR(); qkt<DQK>(pA0, pA1, K_lds, qr, r32, hi);
        finishSM(pB0, pB1, alB, l_reg, pa0, pa1, pa2, pa3); FA_SBAR();
        if (j + 3 < NT) FA_SLOAD(SE, (j + 3) * 64);
        FA_SBAR();
        pv_d0(o, vb0 + SHM_V, pa0, pa1, pa2, pa3); partialSM(pA0, pA1, m_reg, mnA, alA);
        __syncthreads(); FA_SWAIT(); FA_SWRITE(1, SO);
        FA_RESC(alA); __syncthreads();
    }
    FA_SBAR(); qkt<DQK>(pB0, pB1, K_lds + SHM_K, qr, r32, hi);
    finishSM(pA0, pA1, alA, l_reg, pa0, pa1, pa2, pa3); FA_SBAR();
    pv_d0(o, vb0, pa0, pa1, pa2, pa3); partialSM(pB0, pB1, m_reg, mnB, alB);
    __syncthreads(); FA_RESC(alB);
    finishSM(pB0, pB1, alB, l_reg, pa0, pa1, pa2, pa3); FA_SBAR();
    pv_d0(o, vb0 + SHM_V, pa0, pa1, pa2, pa3);
    if (hi == 0) li_l[r32] = l_reg;
    asm volatile("s_waitcnt lgkmcnt(0)" ::: "memory");
    float rli[16];
#pragma unroll
    for (int r = 0; r < 16; ++r) rli[r] = __builtin_amdgcn_rcpf(li_l[crow(r, hi)]);
    f16* Ow = Ob + (size_t)(wid * 32) * 512;
#pragma unroll
    for (int r = 0; r < 16; ++r) { const int orow = crow(r, hi);
#pragma unroll
        for (int d0 = 0; d0 < 2; ++d0) Ow[(size_t)orow * 512 + d0 * 32 + r32] = (f16)(o[d0][r] * rli[r]); }
#undef FA_SLOAD
#undef FA_SWRITE
#undef FA_SWAIT
#undef FA_RESC
}
}
__device__ __forceinline__ void phase_attn_flash(const Ctx& C, int l) {
    const f16* QA = (const f16*)(C.ws() + A_QA); const f16* QC = (const f16*)(C.ws() + A_QC);
    const f16* KA = (const f16*)(C.ws() + A_KA); const f16* VA = (const f16*)(C.ws() + A_VA);
    const f16* KC = (const f16*)(C.ws() + A_KC); const f16* VC = (const f16*)(C.ws() + A_VC);
    f16* YA = (f16*)(C.ws() + A_YA); f16* YC = (f16*)(C.ws() + A_YC);
    const int vcu = (C.nblk % 8 == 0) ? (C.bid % 8) * (C.nblk / 8) + C.bid / 8 : C.bid;
    const int total = 1024 + (l == 0 ? 64 : 0);
    for (int u = vcu; u < total; u += C.nblk) {
        __syncthreads();
        int typeC, b, h, nkeys; size_t qrow, orow;
        if (u < 1024) { const int v = u & 511; typeC = u >> 9; b = v >> 7; h = (v >> 4) & 7; const int qb = v & 15; qrow = (size_t)(b * 8 + h) * SEQ + qb * 256; orow = (size_t)b * SEQ + qb * 256; nkeys = NKEY; }
        else { const int v = (u - 1024) & 31; typeC = (u - 1024) >> 5; b = v >> 3; h = v & 7; qrow = (size_t)NB * 8 * SEQ + (size_t)(b * 8 + h) * CTX; orow = (size_t)NLAT + b * CTX; nkeys = CTX; }
        if (!typeC) fa::attn_unit<64>(QA + qrow * 64, KA + (size_t)(b * 2 + (h >> 2)) * NKEY * 64, VA + (size_t)(b * 2 + (h >> 2)) * NKEY * 64, YA + orow * 512 + h * 64, nkeys, C.lds, C.tid);
        else fa::attn_unit<96>(QC + qrow * 96, KC + (size_t)(b * 8 + h) * NKEY * 96, VC + (size_t)(b * 8 + h) * NKEY * 64, YC + orow * 512 + h * 64, nkeys, C.lds, C.tid);
    }
}

constexpr float S5SC = 1024.0f, S5ISC = 1.0f / 1024.0f;
__device__ __forceinline__ int chunk_row0(int q) { const int b = q / 272, n = q - b * 272; return n < 16 ? NLAT + b * CTX + 16 * n : b * SEQ + 16 * (n - 16); }
__device__ __forceinline__ void phase_s5tab(const Ctx& C, int l) {
    LAS float* ApR = (LAS float*)C.lds; LAS float* ApI = ApR + 17 * 64; LAS float* BbR = ApI + 17 * 64; LAS float* BbI = BbR + 1024; LAS float* CR = BbI + 1024; LAS float* CI = CR + 1024;
    for (int u = C.bid; u < 64; u += C.nblk) {
        const int dir = u >> 5, g = u & 31; const size_t gi = (size_t)(l * 2 + dir) * 32 + g;
        const float dt = expf(C.in(I_SLDT)[gi]);
        __syncthreads();
        for (int i = C.tid; i < 17 * 64; i += NTHREADS) {
            const int p = i & 63, k = i >> 6; const float are = C.in(I_SARE)[gi * 64 + p], aim = C.in(I_SAIM)[gi * 64 + p];
            const float mag = expf(are * dt * (float)k), ang = (aim * dt) * (float)k;
            ApR[i] = mag * cosf(ang); ApI[i] = mag * sinf(ang);
        }
        for (int i = C.tid; i < 1024; i += NTHREADS) {
            const int p = i >> 4, c = i & 15; const float are = C.in(I_SARE)[gi * 64 + p], aim = C.in(I_SAIM)[gi * 64 + p];
            const float mag = expf(are * dt), th = aim * dt, abr = mag * cosf(th), abi = mag * sinf(th);
            const float den = are * are + aim * aim, nr = abr - 1.0f, cr = (nr * are + abi * aim) / den, ci = (abi * are - nr * aim) / den;
            const float br = C.in(I_SBRE)[(gi * 64 + p) * 16 + c], bi = C.in(I_SBIM)[(gi * 64 + p) * 16 + c];
            BbR[i] = cr * br - ci * bi; BbI[i] = cr * bi + ci * br;
            CR[i] = C.in(I_SCRE)[gi * 1024 + i]; CI[i] = C.in(I_SCIM)[gi * 1024 + i];
        }
        __syncthreads();
        f16* Et = (f16*)(C.ws() + T_E) + (size_t)u * 16 * 16 * 128; f16* Mt = (f16*)(C.ws() + T_M) + (size_t)u * 128 * 256; f16* Kt = (f16*)(C.ws() + T_K) + (size_t)u * 17 * 256;
        for (int i = C.tid; i < 16384; i += NTHREADS) {
            { const int t = i >> 10, c = (i >> 6) & 15, p = i & 63, k = dir == 0 ? t + 1 : 16 - t;
              const float cr = CR[c * 64 + p], ci = CI[c * 64 + p], ar = ApR[k * 64 + p], ai = ApI[k * 64 + p];
              Et[(size_t)(t * 16 + c) * 128 + p] = (f16)((cr * ar - ci * ai) * S5SC); Et[(size_t)(t * 16 + c) * 128 + 64 + p] = (f16)(-(cr * ai + ci * ar) * S5SC); }
            { const int p = i >> 8, sx = (i >> 4) & 15, c = i & 15, k = dir == 0 ? 15 - sx : sx;
              const float ar = ApR[k * 64 + p], ai = ApI[k * 64 + p], br = BbR[p * 16 + c], bi = BbI[p * 16 + c];
              Mt[(size_t)p * 256 + sx * 16 + c] = (f16)((ar * br - ai * bi) * S5SC); Mt[(size_t)(64 + p) * 256 + sx * 16 + c] = (f16)((ar * bi + ai * br) * S5SC); }
        }
        for (int i = C.tid; i < 17 * 256; i += NTHREADS) {
            const int tau = (i >> 8) - 1, c = (i >> 4) & 15, cp = i & 15; float acc = 0.f;
            if (tau >= 0) {
#pragma unroll 8
                for (int p = 0; p < 64; ++p) {
                    const float cr = CR[c * 64 + p], ci = CI[c * 64 + p], ar = ApR[tau * 64 + p], ai = ApI[tau * 64 + p];
                    acc += (cr * ar - ci * ai) * BbR[p * 16 + cp] - (cr * ai + ci * ar) * BbI[p * 16 + cp]; }
            }
            Kt[i] = (f16)(acc * S5SC);
        }
    }
}
__device__ __forceinline__ void phase_s5a(const Ctx& C) {
    const f16* U = (const f16*)(C.ws() + A_U); float* S = (float*)(C.ws() + A_S5S);
    const int r32 = C.lane & 31, hi = C.lane >> 5;
    for (int u = C.bid * NWAVES + C.wid; u < 64 * 34; u += C.nblk * NWAVES) {
        const int dirg = u / 34, nb = u - dirg * 34, g = dirg & 31;
        const int q = nb * 32 + r32, b = q / 272, n = q - b * 272;
        const f16* up = U + (size_t)chunk_row0(q) * 512 + g * 16 + 8 * hi;
        const f16* mp = (const f16*)(C.ws() + T_M) + (size_t)dirg * 128 * 256 + r32 * 256 + 8 * hi;
        f16x8 uf[16];
#pragma unroll
        for (int sx = 0; sx < 16; ++sx) uf[sx] = *(const f16x8*)(up + sx * 512);
        float* sp = S + ((size_t)(dirg * 4 + b) * 128) * 272 + n;
#pragma unroll
        for (int mb = 0; mb < 4; ++mb) {
            f16x8 af[16];
#pragma unroll
            for (int sx = 0; sx < 16; ++sx) af[sx] = *(const f16x8*)(mp + mb * 32 * 256 + sx * 16);
            f32x16 acc = {};
#pragma unroll
            for (int sx = 0; sx < 16; ++sx) acc = __builtin_amdgcn_mfma_f32_32x32x16_f16(af[sx], uf[sx], acc, 0, 0, 0);
#pragma unroll
            for (int r = 0; r < 16; ++r) sp[(size_t)(mb * 32 + fa::crow(r, hi)) * 272] = acc[r] * S5ISC;
        }
    }
}
__device__ __forceinline__ void phase_s5b(const Ctx& C, int l) {
    const float* S = (const float*)(C.ws() + A_S5S); f16* X = (f16*)(C.ws() + A_S5X);
    for (int item = C.wid * C.nblk + C.bid; item < 256; item += C.nblk * NWAVES) {
        const int p = C.lane, db = item, dirg = db >> 2, b = db & 3, dir = dirg >> 5, g = dirg & 31; const size_t gi = (size_t)(l * 2 + dir) * 32 + g;
        const float are = C.in(I_SARE)[gi * 64 + p], aim = C.in(I_SAIM)[gi * 64 + p], dt = expf(C.in(I_SLDT)[gi]);
        const float mag = expf(are * dt * 16.0f), ang = (aim * dt) * 16.0f, ar = mag * cosf(ang), ai = mag * sinf(ang);
        const float* sr = S + ((size_t)db * 128 + p) * 272; const float* si = sr + 64 * 272;
        f16* xo = X + ((size_t)dirg * 1088 + b * 272) * 128 + p;
        float xr = 0.f, xi = 0.f;
        f32x4 cr[4], ci[4], nr[4], ni[4];
        int base = 0;
#pragma unroll
        for (int j = 0; j < 4; ++j) { cr[j] = *(const f32x4*)(sr + base + 4 * j); ci[j] = *(const f32x4*)(si + base + 4 * j); }
#pragma unroll 1
        for (int k = 0; k < 17; ++k) {
            const int nbase = dir == 0 ? 16 * (k + 1) : 272 - 16 * (k + 1);
            if (k < 16) {
#pragma unroll
                for (int j = 0; j < 4; ++j) { nr[j] = *(const f32x4*)(sr + nbase + 4 * j); ni[j] = *(const f32x4*)(si + nbase + 4 * j); }
            }
#pragma unroll
            for (int e = 0; e < 16; ++e) {
                const int ef = e, eb = 15 - e;
                const float sre = dir == 0 ? cr[ef >> 2][ef & 3] : cr[eb >> 2][eb & 3], sim = dir == 0 ? ci[ef >> 2][ef & 3] : ci[eb >> 2][eb & 3];
                const int n = base + (dir == 0 ? ef : eb);
                xo[(size_t)n * 128] = (f16)xr; xo[(size_t)n * 128 + 64] = (f16)xi;
                const float nxr = ar * xr - ai * xi + sre, nxi = ar * xi + ai * xr + sim; xr = nxr; xi = nxi;
            }
#pragma unroll
            for (int j = 0; j < 4; ++j) { cr[j] = nr[j]; ci[j] = ni[j]; }
            base = nbase;
        }
    }
}
__device__ __forceinline__ void phase_s5c(const Ctx& C, int l) {
    const f16* U = (const f16*)(C.ws() + A_U); const f16* X = (const f16*)(C.ws() + A_S5X); f16* G = (f16*)(C.ws() + A_G);
    const int r32 = C.lane & 31, hi = C.lane >> 5, t0 = 2 * C.wid, trow = t0 + (r32 >> 4), crw = r32 & 15;
    const int nnb = l == 0 ? 34 : 32;
    LAS f16* Kl = (LAS f16*)C.lds;
    int cur_g = -1; f16x8 ef[2][8];
    for (int u = C.bid; u < 32 * nnb; u += C.nblk) {
        const int g = u & 31, nb = u >> 5, idx = nb * 32 + r32;
        const int q = l == 0 ? idx : (idx >> 8) * 272 + 16 + (idx & 255);
        const int row0 = chunk_row0(q);
        const f16* up = U + (size_t)row0 * 512 + g * 16 + 8 * hi;
        f16x8 uf[16], xf[2][8]; f16x4 u4[2][2];
#pragma unroll
        for (int sx = 0; sx < 16; ++sx) uf[sx] = *(const f16x8*)(up + sx * 512);
#pragma unroll
        for (int dir = 0; dir < 2; ++dir)
#pragma unroll
            for (int kk = 0; kk < 8; ++kk) xf[dir][kk] = *(const f16x8*)(X + ((size_t)(dir * 32 + g) * 1088 + q) * 128 + kk * 16 + 8 * hi);
#pragma unroll
        for (int tl = 0; tl < 2; ++tl)
#pragma unroll
            for (int gp = 0; gp < 2; ++gp) u4[tl][gp] = *(const f16x4*)(U + (size_t)(row0 + t0 + tl) * 512 + g * 16 + 4 * hi + 8 * gp);
        if (g != cur_g) {
            __syncthreads();
            for (int i = C.tid; i < 2 * 17 * 256 / 8; i += NTHREADS) {
                const int dir = i / (17 * 32), j = i - dir * (17 * 32);
                *(LAS f16x8*)(Kl + (size_t)i * 8) = *(const f16x8*)((const f16*)(C.ws() + T_K) + (size_t)(dir * 32 + g) * 17 * 256 + j * 8);
            }
#pragma unroll
            for (int dir = 0; dir < 2; ++dir)
#pragma unroll
                for (int kk = 0; kk < 8; ++kk) ef[dir][kk] = *(const f16x8*)((const f16*)(C.ws() + T_E) + (size_t)(dir * 32 + g) * 16 * 16 * 128 + (size_t)(trow * 16 + crw) * 128 + kk * 16 + 8 * hi);
            __syncthreads();
            cur_g = g;
        }
        f32x16 acc = {};
        const LAS f16* kb = Kl + crw * 16 + 8 * hi;
#pragma unroll
        for (int sx = 0; sx < 16; ++sx) {
            if (sx <= t0 + 1) { const f16x8 af = *(const LAS f16x8*)(kb + (trow - sx + 1) * 256); acc = __builtin_amdgcn_mfma_f32_32x32x16_f16(af, uf[sx], acc, 0, 0, 0); }
            if (sx >= t0) { const f16x8 af = *(const LAS f16x8*)(kb + (17 + sx - trow + 1) * 256); acc = __builtin_amdgcn_mfma_f32_32x32x16_f16(af, uf[sx], acc, 0, 0, 0); }
        }
#pragma unroll
        for (int dir = 0; dir < 2; ++dir)
#pragma unroll
            for (int kk = 0; kk < 8; ++kk) acc = __builtin_amdgcn_mfma_f32_32x32x16_f16(ef[dir][kk], xf[dir][kk], acc, 0, 0, 0);
#pragma unroll
        for (int tl = 0; tl < 2; ++tl)
#pragma unroll
            for (int gp = 0; gp < 2; ++gp) {
                const size_t off = (size_t)(row0 + t0 + tl) * 512 + g * 16 + 4 * hi + 8 * gp;
                const f32x4 d4 = *(const f32x4*)(C.in(I_SD) + l * 512 + g * 16 + 4 * hi + 8 * gp);
                f32x4 y;
#pragma unroll
                for (int e = 0; e < 4; ++e) y[e] = gelu_tanh(acc[8 * tl + 4 * gp + e] * S5ISC + d4[e] * (float)u4[tl][gp][e]);
                *(f16x4*)(G + off) = pack4(y);
            }
    }
}

__device__ __forceinline__ void phase_s5_naive(const Ctx& C, int l) {
    const f16* U = (const f16*)(C.ws() + A_U); float* YSF = (float*)(C.ws() + A_YSF);
    LAS float* cst = (LAS float*)C.lds + C.wid * (16 * 128 + 4 * 128);
    LAS float* sst = cst + 16 * 128;
    const int lane = C.lane;
    for (int u = C.bid * NWAVES + C.wid; u < NB * 32; u += C.nblk * NWAVES) {
        const int b = u >> 5, g = u & 31;
        for (int dir = 0; dir < 2; ++dir) {
            const size_t gi = ((size_t)(l * 2 + dir) * 32 + g);
            const float are = C.in(I_SARE)[gi * 64 + lane], aim = C.in(I_SAIM)[gi * 64 + lane];
            const float dt = expf(C.in(I_SLDT)[gi]);
            const float mag = expf(are * dt), th = aim * dt;
            const float abr = mag * cosf(th), abi = mag * sinf(th);
            const float den = are * are + aim * aim, nr = abr - 1.0f;
            const float cr = (nr * are + abi * aim) / den, ci = (abi * are - nr * aim) / den;
            float bbr[16], bbi[16];
#pragma unroll
            for (int c = 0; c < 16; ++c) {
                const float br = C.in(I_SBRE)[(gi * 64 + lane) * 16 + c], bi = C.in(I_SBIM)[(gi * 64 + lane) * 16 + c];
                bbr[c] = cr * br - ci * bi; bbi[c] = cr * bi + ci * br; }
#pragma unroll
            for (int c = 0; c < 16; ++c) { cst[c * 128 + lane] = C.in(I_SCRE)[(gi * 16 + c) * 64 + lane]; cst[c * 128 + 64 + lane] = C.in(I_SCIM)[(gi * 16 + c) * 64 + lane]; }
            asm volatile("s_waitcnt lgkmcnt(0)" ::: "memory");
            float xr = 0.f, xi = 0.f;
            const int tk = lane >> 4, cc = lane & 15;
            const float dcoef = C.in(I_SD)[l * 512 + g * 16 + cc];
            for (int i0 = 0; i0 < NKEY; i0 += 4) {
                int rows[4];
#pragma unroll
                for (int k = 0; k < 4; ++k) {
                    const int i = i0 + k; int row;
                    if (dir == 0) row = i < CTX ? NLAT + b * CTX + i : b * SEQ + (i - CTX);
                    else row = i < CTX ? NLAT + b * CTX + (CTX - 1 - i) : b * SEQ + (SEQ - 1 - (i - CTX));
                    rows[k] = row;
                    const f16x8 u0 = *(const f16x8*)(U + (size_t)row * 512 + g * 16), u1 = *(const f16x8*)(U + (size_t)row * 512 + g * 16 + 8);
                    float bur = 0.f, bui = 0.f;
#pragma unroll
                    for (int c = 0; c < 8; ++c) { bur += bbr[c] * (float)u0[c] + bbr[8 + c] * (float)u1[c]; bui += bbi[c] * (float)u0[c] + bbi[8 + c] * (float)u1[c]; }
                    const float nxr = abr * xr - abi * xi + bur, nxi = abr * xi + abi * xr + bui;
                    xr = nxr; xi = nxi;
                    sst[k * 128 + lane] = xr; sst[k * 128 + 64 + lane] = xi;
                }
                asm volatile("s_waitcnt lgkmcnt(0)" ::: "memory");
                float y = 0.f;
#pragma unroll 16
                for (int p = 0; p < 64; ++p) y += cst[cc * 128 + p] * sst[tk * 128 + p] - cst[cc * 128 + 64 + p] * sst[tk * 128 + 64 + p];
                asm volatile("s_waitcnt lgkmcnt(0)" ::: "memory");
                int myrow = rows[0];
#pragma unroll
                for (int k = 1; k < 4; ++k) myrow = (tk == k) ? rows[k] : myrow;
                if (myrow < NLAT || l == 0) {
                    float* dst = YSF + (size_t)myrow * 512 + g * 16 + cc;
                    if (dir == 0) *dst = y + dcoef * (float)U[(size_t)myrow * 512 + g * 16 + cc];
                    else *dst = *dst + y;
                }
            }
            asm volatile("s_waitcnt vmcnt(0)" ::: "memory");
            __builtin_amdgcn_fence(__ATOMIC_RELEASE, "workgroup");
        }
    }
}
__device__ __forceinline__ void phase_s5_gelu(const Ctx& C, int nrows) {
    const float* YSF = (const float*)(C.ws() + A_YSF); f16* G = (f16*)(C.ws() + A_G);
    const size_t n4 = (size_t)nrows * 512 / 4;
    for (size_t i = (size_t)C.bid * NTHREADS + C.tid; i < n4; i += (size_t)C.nblk * NTHREADS) {
        f32x4 v = ((const f32x4*)YSF)[i];
#pragma unroll
        for (int e = 0; e < 4; ++e) v[e] = gelu_tanh(v[e]);
        ((f16x4*)G)[i] = pack4(v);
    }
}

typedef __attribute__((address_space(1))) unsigned gu32;
#define XB_TMO      128
#define XB_XCNT(j)  (256  + 64 * (j))
#define XB_XSUB(j)  (1280 + 64 * (j))
#define XB_XGEN(j)  (2304 + 64 * (j))
#define XB_TOP      3328
#define XB_TOPGEN   3392
#define XCD_BAR_WORDS 3456
#define XB_SPIN_CAP (1u << 26)

__device__ __forceinline__ unsigned xb_ld(unsigned* p)              { return __hip_atomic_load(p, __ATOMIC_RELAXED, __HIP_MEMORY_SCOPE_AGENT); }
__device__ __forceinline__ unsigned xb_add(unsigned* p, unsigned v) { return __hip_atomic_fetch_add(p, v, __ATOMIC_RELAXED, __HIP_MEMORY_SCOPE_AGENT); }
__device__ __forceinline__ unsigned xb_xcc_id() { return (unsigned)__builtin_amdgcn_s_getreg((3 << 11) | 20) & 0xFu; }
#define XB_SPIN(cond, bar) do { unsigned _sp = 0; while (cond) { __builtin_amdgcn_s_sleep(1); \
    if ((++_sp & 255u) == 0u) { if (xb_ld(&(bar)[XB_TMO])) break; if (_sp > XB_SPIN_CAP) { atomicAdd(&(bar)[XB_TMO], 1u); break; } } } } while (0)

struct XcdBarrier {
    unsigned* bar; unsigned x;
    volatile LAS unsigned* st;
};

__device__ __forceinline__ XcdBarrier xcd_barrier_post(unsigned* bar, volatile LAS unsigned* st) {
    XcdBarrier b; b.bar = bar; b.x = xb_xcc_id(); b.st = st;
    if (threadIdx.x == 0) (void)xb_add(&bar[XB_XCNT(b.x)], 1u);
    return b;
}
__device__ __forceinline__ void xcd_barrier_complete(unsigned* bar, unsigned x, unsigned& nloc, unsigned& nx) {
    const unsigned G = gridDim.x * gridDim.y * gridDim.z;
    unsigned sum, cnt, mine, sp = 0u;
    for (;;) {
        sum = 0u; cnt = 0u; mine = 0u;
#pragma unroll
        for (unsigned j = 0; j < 16; ++j) { const unsigned c = xb_ld(&bar[XB_XCNT(j)]); sum += c; cnt += (c > 0u) ? 1u : 0u; mine = (j == x) ? c : mine; }
        if (sum == G) break;
        __builtin_amdgcn_s_sleep(1);
        if ((++sp & 255u) == 0u) { if (xb_ld(&bar[XB_TMO])) break; if (sp > XB_SPIN_CAP) { atomicAdd(&bar[XB_TMO], 1u); break; } }
    }
    nloc = mine > 0u ? mine : 1u; nx = cnt > 0u ? cnt : 1u;
}

__device__ __forceinline__ void xcd_barrier(const XcdBarrier& b, const bool t0) {
    asm volatile("s_waitcnt vmcnt(0)" ::: "memory");
    __syncthreads();
    if (t0) {
        unsigned* bar = b.bar;
        __builtin_amdgcn_s_waitcnt(0);
        unsigned nloc = b.st[0], nx = b.st[1];
        if (nloc == 0u) { xcd_barrier_complete(bar, b.x, nloc, nx); b.st[0] = nloc; b.st[1] = nx; }
        const unsigned old = xb_add(&bar[XB_XSUB(b.x)], 1u);
        const unsigned gen = old / nloc;
        if (old + 1u == (gen + 1u) * nloc) {
            __builtin_amdgcn_fence(__ATOMIC_RELEASE, "agent");
            asm volatile("s_waitcnt vmcnt(0)" ::: "memory");
            const unsigned og = xb_add(&bar[XB_TOP], 1u);
            const unsigned tg = og / nx;
            if (og + 1u == (tg + 1u) * nx) xb_add(&bar[XB_TOPGEN], 1u);
            else XB_SPIN(xb_ld(&bar[XB_TOPGEN]) == tg, bar);
            __builtin_amdgcn_fence(__ATOMIC_ACQUIRE, "agent");
            xb_add(&bar[XB_XGEN(b.x)], 1u);
            asm volatile("s_waitcnt vmcnt(0)" ::: "memory");
        } else {
            XB_SPIN(xb_ld(&bar[XB_XGEN(b.x)]) == gen, bar);
            __builtin_amdgcn_fence(__ATOMIC_ACQUIRE, "agent");
            asm volatile("s_waitcnt vmcnt(0)" ::: "memory");
        }
    }
    __syncthreads();
}

struct Env { XcdBarrier bar; int wid; };
#define GSYNC() do { const Ctx Cb = make_ctx(env.wid); xcd_barrier(env.bar, Cb.tid == 0); } while (0)
constexpr int MISC_OFF = LDS_BYTES - 256;
constexpr int CW_BAR = 4096;
#define CTX() const Ctx C = make_ctx(env.wid); unsigned char* ws = C.ws()
template <int l>
__device__ __forceinline__ void layer_body(const Env& env) {
        const int mrows = l == 0 ? MALL : NLAT;
        { CTX(); (void)ws; if (C.nblk > 128) { if (C.bid < 64) phase_s5tab(C, l); else phase_cvt(C, l, 64); } else { phase_s5tab(C, l); __syncthreads(); phase_cvt(C, l, 0); } phase_p1(C, l); }
        GSYNC();
        { CTX(); EpiStore E{(f16*)(ws + A_PROJ), PLD};
          gemm_pg8(C, (const f16*)(ws + A_H), D, (const f16*)(ws + W_INA), D, MALL, 2560, D, E); }
        GSYNC();
        { CTX(); (void)ws; phase_p3(C, l); }
        GSYNC();
        { CTX(); EpiKvUp E1{(f16*)(ws + A_KC), (f16*)(ws + A_VC)};
          gemm_rows(C, (const f16*)(ws + A_PROJ) + OFF_CKV, PLD, (const f16*)(ws + W_KVB), 256, MALL, 1024, 256, E1); }
        { CTX(); EpiQUp E2{(f16*)(ws + A_QC), (const float*)(ws + WS_ROPE) + 2048};
          gemm_pg8(C, (const f16*)(ws + A_PROJ) + OFF_CQ, PLD, (const f16*)(ws + W_QB), 768, mrows, 768, 768, E2); }
        GSYNC();
        { CTX(); (void)ws; phase_s5a(C); }
        { CTX(); (void)ws; phase_attn_flash(C, l); }
        GSYNC();
        { CTX(); (void)ws; phase_s5b(C, l); }
        GSYNC();
        { CTX(); (void)ws; phase_s5c(C, l); }
        { CTX(); (void)ws; phase_hre(C, l, mrows); }
        GSYNC();
        { CTX(); EpiGlu E{(f16*)(ws + A_YS)};
          gemm_rows(C, (const f16*)(ws + A_G), 512, (const f16*)(ws + W_GLU), 512, mrows, 1024, 512, E); }
        GSYNC();
#pragma unroll
        for (int br = 0; br < 3; ++br) {
            { CTX(); EpiGate Eg{(f16*)(ws + A_GATE)};
              gemm_rows(C, (const f16*)(ws + A_H), D, (const f16*)(ws + W_GATE) + (size_t)br * 1024 * 1024, D, mrows, 1024, D, Eg); }
            { CTX(); const f16* Y = (const f16*)(ws + (br == 0 ? A_YA : br == 1 ? A_YS : A_YC));
              EpiBranch Eb{(const f16*)(ws + A_GATE), (f16*)(ws + A_MERGED), br == 0};
              gemm_rows(C, Y, 512, (const f16*)(ws + W_BR) + (size_t)br * 1024 * 512, 512, mrows, 1024, 512, Eb); }
        }
        GSYNC();
        { CTX(); EpiWout E{&C, l}; gemm_rows(C, (const f16*)(ws + A_MERGED), D, (const f16*)(ws + W_OUT), D, mrows, 1024, D, E); }
        GSYNC();
        { CTX(); (void)ws; phase_p10(C, l, mrows); }
        GSYNC();
        { CTX(); EpiUp E{(f16*)(ws + A_HID)}; gemm_rows(C, (const f16*)(ws + A_H), D, (const f16*)(ws + W_UP), D, mrows, DFF, D, E); }
        GSYNC();
        { CTX(); EpiDown E{&C, l}; gemm_rows(C, (const f16*)(ws + A_HID), DFF, (const f16*)(ws + W_DOWN), DFF, mrows, 1024, DFF, E); }
        GSYNC();
        { CTX(); (void)ws; phase_p13(C, l, mrows); }
        if (l == 0) GSYNC();
}
__global__ void __launch_bounds__(NTHREADS, 2) fwd_all(Args args) {
    cg::grid_group grid = cg::this_grid();
    extern __shared__ __attribute__((aligned(16))) unsigned char lds_raw[];
    volatile LAS unsigned* MISC = (volatile LAS unsigned*)((LAS unsigned char*)lds_raw + MISC_OFF);
    if (threadIdx.x < 64) MISC[threadIdx.x] = 0u;
    __syncthreads();
    Env env; env.wid = __builtin_amdgcn_readfirstlane(threadIdx.x >> 6);
    env.bar = xcd_barrier_post((unsigned*)(args.ws + WS_CTL) + CW_BAR, MISC + 8);
    { CTX(); (void)ws; phase_setup(C); }
    asm volatile("s_waitcnt vmcnt(0)" ::: "memory");
    grid.sync();
    __builtin_amdgcn_fence(__ATOMIC_ACQUIRE, "agent");
    asm volatile("s_waitcnt vmcnt(0)" ::: "memory");
    layer_body<0>(env);
    layer_body<1>(env);
}

extern "C" void kernel_launch(void* const* d_in, const int* in_sizes, int n_in, void* d_out, int out_size, void* d_ws, size_t ws_size, hipStream_t stream) {
    static int grid_blocks = 0;
    if (grid_blocks == 0) {
        if (n_in != 32 || out_size != NLAT * D || ws_size < WS_NEED) { fprintf(stderr, "kernel_launch: unexpected shapes n_in %d out %d ws %zu (need %zu)\n", n_in, out_size, ws_size, (size_t)WS_NEED); grid_blocks = -1; return; }
        int dev = 0, cus = 0, per_cu = 0;
        hipGetDevice(&dev);
        hipDeviceGetAttribute(&cus, hipDeviceAttributeMultiprocessorCount, dev);
        if (hipFuncSetAttribute((const void*)fwd_all, hipFuncAttributeMaxDynamicSharedMemorySize, LDS_BYTES) != hipSuccess) { fprintf(stderr, "kernel_launch: hipFuncSetAttribute failed\n"); grid_blocks = -1; return; }
        hipOccupancyMaxActiveBlocksPerMultiprocessor(&per_cu, (const void*)fwd_all, NTHREADS, LDS_BYTES);
        if (per_cu < 1) { fprintf(stderr, "kernel_launch: occupancy query says %d blocks per CU\n", per_cu); grid_blocks = -1; return; }
        grid_blocks = cus;
    }
    if (grid_blocks < 0) return;
    Args a{};
    for (int i = 0; i < 32; ++i) a.in[i] = (const float*)d_in[i];
    a.out = (float*)d_out; a.ws = (unsigned char*)d_ws;
    if (hipMemsetAsync((char*)d_ws + WS_CTL, 0, 1 * MiB, stream) != hipSuccess) { fprintf(stderr, "kernel_launch: hipMemsetAsync failed\n"); return; }
    void* kargs[] = {&a};
    const hipError_t e = hipLaunchCooperativeKernel((const void*)fwd_all, dim3(grid_blocks), dim3(NTHREADS), kargs, LDS_BYTES, stream);
    if (e != hipSuccess) fprintf(stderr, "kernel_launch: cooperative launch failed: %s (grid %d)\n", hipGetErrorString(e), grid_blocks);
}
```

```cpp
#include <hip/hip_runtime.h>
#include <hip/hip_cooperative_groups.h>
#include <cstdio>
#include <cstdint>
#include <cmath>

namespace cg = cooperative_groups;

#define LAS __attribute__((address_space(3)))
typedef _Float16 f16;
typedef _Float16 f16x8 __attribute__((ext_vector_type(8)));
typedef _Float16 f16x4 __attribute__((ext_vector_type(4)));
typedef float f32x4 __attribute__((ext_vector_type(4)));
typedef float f32x16 __attribute__((ext_vector_type(16)));

constexpr int D = 1024, NB = 4, SEQ = 4096, CTX = 256, NLAT = NB * SEQ, NCTX = NB * CTX, MALL = NLAT + NCTX;
constexpr int NKEY = CTX + SEQ;
constexpr int OFF_AK = 0, OFF_AV = 128, OFF_CKV = 256, OFF_CKR = 512, OFF_U = 544, OFF_AQ = 1056, OFF_CQ = 1568, OFF_GATE = 2336, N_IN = 5408;
constexpr int PLD = 2560;
constexpr int DFF = 4096;
constexpr float EPS = 1e-6f;
constexpr float ALPHA = 1.4142135623730951f;
constexpr float LOG2E = 1.4426950408889634f;
constexpr float QSCALE_A = 0.125f * LOG2E;
constexpr float QSCALE_C = 0.10206207261596575f * LOG2E;

constexpr size_t MiB = 1u << 20;
constexpr size_t WS_CTL = 0;
constexpr size_t WS_MOD = 1 * MiB;
constexpr size_t WS_ROPE = 1 * MiB + 512 * 1024;
constexpr size_t WS_W16 = 2 * MiB;
constexpr size_t W_INA = WS_W16;
constexpr size_t W_GATE = W_INA + (size_t)2560 * 1024 * 2;
constexpr size_t W_QB = W_GATE + (size_t)3072 * 1024 * 2;
constexpr size_t W_KVB = W_QB + (size_t)768 * 768 * 2;
constexpr size_t W_GLU = W_KVB + (size_t)1024 * 256 * 2;
constexpr size_t W_BR = W_GLU + (size_t)1024 * 512 * 2;
constexpr size_t W_OUT = W_BR + (size_t)3 * 1024 * 512 * 2;
constexpr size_t W_UP = W_OUT + (size_t)1024 * 1024 * 2;
constexpr size_t W_DOWN = W_UP + (size_t)4096 * 1024 * 2;
constexpr size_t W_END = W_DOWN + (size_t)1024 * 4096 * 2;
constexpr size_t WS_TACTX = 37 * MiB;
constexpr size_t WS_ACT = 41 * MiB;
static_assert(W_END <= WS_TACTX, "weights fit");
constexpr size_t A_H = WS_ACT + 0 * MiB;
constexpr size_t A_QC = WS_ACT + 0 * MiB;
constexpr size_t A_PROJ = WS_ACT + 34 * MiB;
constexpr size_t A_YA = WS_ACT + 34 * MiB;
constexpr size_t A_YC = WS_ACT + 51 * MiB;
constexpr size_t A_YSF = WS_ACT + 68 * MiB;
constexpr size_t A_G = WS_ACT + 68 * MiB;
constexpr size_t A_QA = WS_ACT + 119 * MiB;
constexpr size_t A_YS = WS_ACT + 119 * MiB;
constexpr size_t A_KA = WS_ACT + 136 * MiB;
constexpr size_t A_VA = A_KA + (size_t)NB * 2 * NKEY * 64 * 2;
constexpr size_t A_U = WS_ACT + 145 * MiB;
constexpr size_t A_KC = WS_ACT + 162 * MiB;
constexpr size_t A_VC = WS_ACT + 188 * MiB;
constexpr size_t A_GATE = WS_ACT + 136 * MiB;
constexpr size_t A_MERGED = WS_ACT + 68 * MiB;
constexpr size_t A_T1H = WS_ACT + 170 * MiB;
constexpr size_t WS_ST1 = 1 * MiB + 768 * 1024;
constexpr size_t A_HID = WS_ACT + 34 * MiB;
constexpr size_t A_S5S = WS_ACT + 68 * MiB;
constexpr size_t A_S5X = WS_ACT + 102 * MiB;
constexpr size_t T_K = WS_ACT + 205 * MiB;
constexpr size_t T_E = T_K + (size_t)64 * 17 * 256 * 2;
constexpr size_t T_M = T_E + (size_t)64 * 16 * 16 * 128 * 2;
constexpr size_t WS_NEED = WS_ACT + 215 * MiB;
static_assert(T_M + (size_t)64 * 128 * 256 * 2 <= WS_NEED, "s5 tables");
static_assert(A_VA + (size_t)NB * 2 * NKEY * 64 * 2 <= A_U && A_VC + 17 * MiB <= WS_NEED && A_MERGED + 34 * MiB <= WS_NEED && A_HID + 136 * MiB <= WS_NEED, "ws map");
static_assert(WS_NEED <= 256 * MiB, "ws budget");

constexpr int LDS_BYTES = 147456;
constexpr int NTHREADS = 512, NWAVES = 8;

struct Args {
    const float* in[32];
    float* out;
    unsigned char* ws;
    int ph_lo, ph_hi;
};
enum { I_X = 0, I_C, I_CTX, I_CCTX, I_WMOD, I_BMOD, I_WIN, I_AQG, I_AKG, I_CQG, I_CKVG, I_WQB, I_WKVB, I_SARE, I_SAIM, I_SLDT, I_SBRE, I_SBIM, I_SCRE, I_SCIM,
       I_SD, I_WGLU, I_WBA, I_WBS, I_WBC, I_WOUT, I_LN1G, I_LN1B, I_WUP, I_WDOWN, I_LN2G, I_LN2B };

__device__ __forceinline__ float wave_sum(float v) {
#pragma unroll
    for (int o = 1; o < 64; o <<= 1) v += __shfl_xor(v, o);
    return v;
}
__device__ __forceinline__ float wave_max(float v) {
#pragma unroll
    for (int o = 1; o < 64; o <<= 1) v = fmaxf(v, __shfl_xor(v, o));
    return v;
}
__device__ __forceinline__ float sigmoidf_(float x) { return 1.0f / (1.0f + __expf(-x)); }
__device__ __forceinline__ float gelu_tanh(float x) {
    const float u = 0.7978845608028654f * (x + 0.044715f * x * x * x);
    const float e = __expf(2.0f * u);
    const float t = 1.0f - 2.0f / (e + 1.0f);
    return 0.5f * x * (1.0f + t);
}
__device__ __forceinline__ f16x8 pack8(f32x4 lo, f32x4 hi) {
    f16x8 r; r[0] = (f16)lo[0]; r[1] = (f16)lo[1]; r[2] = (f16)lo[2]; r[3] = (f16)lo[3]; r[4] = (f16)hi[0]; r[5] = (f16)hi[1]; r[6] = (f16)hi[2]; r[7] = (f16)hi[3]; return r;
}
__device__ __forceinline__ f16x4 pack4(f32x4 v) { f16x4 r; r[0] = (f16)v[0]; r[1] = (f16)v[1]; r[2] = (f16)v[2]; r[3] = (f16)v[3]; return r; }

struct RowInfo { int b, t, pos, lat, mrow; };
__device__ __forceinline__ RowInfo row_info(int r) {
    RowInfo o;
    if (r < NLAT) { o.lat = 1; o.b = r >> 12; o.t = r & 4095; o.pos = CTX + o.t; o.mrow = o.b; }
    else { const int rr = r - NLAT; o.lat = 0; o.b = rr >> 8; o.t = rr & 255; o.pos = o.t; o.mrow = 4; }
    return o;
}

#define CAS __attribute__((address_space(4)))
struct Ctx {
    const CAS unsigned char* kp; LAS unsigned char* lds;
    int tid, lane, wid, nblk, bid;
    __device__ __forceinline__ const float* in(int i) const { return *(const float* const CAS*)(kp + 8 * i); }
    __device__ __forceinline__ float* out() const { return *(float* const CAS*)(kp + 256); }
    __device__ __forceinline__ unsigned char* ws() const { return *(unsigned char* const CAS*)(kp + 264); }
    __device__ __forceinline__ const float* mod(int l, int mrow, int which) const { return (const float*)(ws() + WS_MOD) + ((size_t)(l * 5 + mrow) * 6 + which) * D; }
    __device__ __forceinline__ const float* xsrc(int l, int r) const {
        if (l == 0) return r < NLAT ? in(I_X) + (size_t)r * D : in(I_CTX) + (size_t)(r - NLAT) * D;
        return r < NLAT ? out() + (size_t)r * D : (const float*)(ws() + WS_TACTX) + (size_t)(r - NLAT) * D;
    }
    __device__ __forceinline__ float* ta(int r) const { return r < NLAT ? out() + (size_t)r * D : (float*)(ws() + WS_TACTX) + (size_t)(r - NLAT) * D; }
};
__device__ __forceinline__ Ctx make_ctx(int wid) {
    extern __shared__ __attribute__((aligned(16))) unsigned char lds_raw[];
    Ctx C;
    const CAS unsigned char* kp = (const CAS unsigned char*)__builtin_amdgcn_kernarg_segment_ptr();
    asm volatile("" : "+s"(kp));
    C.kp = kp; C.lds = (LAS unsigned char*)lds_raw;
    int lane = __builtin_amdgcn_mbcnt_hi(~0u, __builtin_amdgcn_mbcnt_lo(~0u, 0u)); asm volatile("" : "+v"(lane));
    asm volatile("" : "+s"(wid));
    C.tid = wid * 64 + lane; C.lane = lane; C.wid = wid;
    int bid = blockIdx.x; asm volatile("" : "+s"(bid));
    C.bid = bid; C.nblk = gridDim.x;
    return C;
}

__device__ __forceinline__ void phase_setup(const Ctx& C) {
    LAS float* sv = (LAS float*)C.lds;
    LAS float* red = sv + 5 * 1024;
    for (int i = C.tid; i < 5 * 1024; i += NTHREADS) {
        const int mr = i >> 10, k = i & 1023;
        const float v = mr < 4 ? C.in(I_C)[mr * D + k] : C.in(I_CCTX)[k];
        sv[i] = v / (1.0f + __expf(-v));
    }
    __syncthreads();
    for (int u = C.bid; u < 192; u += C.nblk) {
        const int l = u / 96, n0 = (u % 96) * 64;
        const float* W = C.in(I_WMOD) + (size_t)l * D * 6144 + n0 + C.lane;
        float acc[5] = {0.f, 0.f, 0.f, 0.f, 0.f};
        const int kb = C.wid * 128;
#pragma unroll 8
        for (int k = 0; k < 128; ++k) {
            const float w = W[(size_t)(kb + k) * 6144];
#pragma unroll
            for (int m = 0; m < 5; ++m) acc[m] += sv[m * 1024 + kb + k] * w;
        }
#pragma unroll
        for (int m = 0; m < 5; ++m) red[(C.wid * 5 + m) * 64 + C.lane] = acc[m];
        __syncthreads();
        if (C.tid < 320) {
            const int m = C.tid >> 6, c = C.tid & 63; float s = 0.f;
#pragma unroll
            for (int w = 0; w < 8; ++w) s += red[(w * 5 + m) * 64 + c];
            ((float*)(C.ws() + WS_MOD))[(size_t)(l * 5 + m) * 6144 + n0 + c] = s + C.in(I_BMOD)[l * 6144 + n0 + c];
        }
        __syncthreads();
    }
    if (C.bid == C.nblk - 1) {
        float* ra = (float*)(C.ws() + WS_ROPE);
        for (int i = C.tid; i < 1024; i += NTHREADS) {
            const int pos = i >> 4, f = i & 15;
            const float inv = powf(10000.0f, -(float)(2 * f) / 32.0f);
            const float ang = (float)pos * inv;
            ra[i] = cosf(ang); ra[1024 + i] = sinf(ang);
        }
        for (int i = C.tid; i < 512; i += NTHREADS) {
            const int pos = i >> 3, f = i & 7;
            const float inv = powf(10000.0f, -(float)(2 * f) / 16.0f);
            const float ang = (float)pos * inv;
            ra[2048 + i] = cosf(ang); ra[2048 + 512 + i] = sinf(ang);
        }
    }
}

__device__ __forceinline__ int glu_row(int n) { const int isg = n >= 512, j = n & 511; return 8 * (j >> 2) + 4 * isg + (j & 3); }
__device__ __forceinline__ void cvt_item(const float* W, int ldw, int coff, int K, int nblk, f16* WT, int mode, LAS float* scr, int item, int lane) {
    const int kb = item / nblk, nb = item % nblk, k0 = 64 * kb, n0 = 32 * nb;
    f32x4 v[8];
#pragma unroll
    for (int i = 0; i < 8; ++i) v[i] = *(const f32x4*)(W + (size_t)(k0 + 8 * i + (lane >> 3)) * ldw + coff + n0 + 4 * (lane & 7));
#pragma unroll
    for (int i = 0; i < 8; ++i) { LAS float* d = scr + (8 * i + (lane >> 3)) * 33 + 4 * (lane & 7); d[0] = v[i][0]; d[1] = v[i][1]; d[2] = v[i][2]; d[3] = v[i][3]; }
    asm volatile("s_waitcnt lgkmcnt(0)" ::: "memory");
    const int c = lane & 7;
#pragma unroll
    for (int j = 0; j < 4; ++j) {
        const int n = (lane >> 3) + 8 * j; const LAS float* sp = scr + (8 * c) * 33 + n;
        f16x8 o;
#pragma unroll
        for (int e = 0; e < 8; ++e) o[e] = (f16)sp[e * 33];
        const int nn = n0 + n; const int row = mode ? glu_row(nn) : nn;
        *(f16x8*)(WT + (size_t)row * K + k0 + 8 * c) = o;
    }
    asm volatile("s_waitcnt lgkmcnt(0)" ::: "memory");
}
__device__ __forceinline__ void cvt_mat(const Ctx& C, const float* src, int ldw, int coff, int K, int N, size_t dst, int mode, int& base, int b0) {
    LAS float* scr = (LAS float*)C.lds + C.wid * (64 * 33);
    const int gw = (C.bid - b0) * NWAVES + C.wid, ngw = (C.nblk - b0) * NWAVES;
    const int nblk = N / 32, items = (K / 64) * nblk;
    int first = gw - (base % ngw); if (first < 0) first += ngw;
    for (int it = first; it < items; it += ngw) cvt_item(src, ldw, coff, K, nblk, (f16*)(C.ws() + dst), mode, scr, it, C.lane);
    base += items;
}
__device__ __forceinline__ void phase_cvt(const Ctx& C, int l, int b0) {
    int base = 0;
    cvt_mat(C, C.in(I_WIN) + (size_t)l * D * N_IN, N_IN, 0, D, OFF_GATE, W_INA, 0, base, b0);
    cvt_mat(C, C.in(I_WIN) + (size_t)l * D * N_IN, N_IN, OFF_GATE, D, 3072, W_GATE, 0, base, b0);
    cvt_mat(C, C.in(I_WQB) + (size_t)l * 768 * 768, 768, 0, 768, 768, W_QB, 0, base, b0);
    cvt_mat(C, C.in(I_WKVB) + (size_t)l * 256 * 1024, 1024, 0, 256, 1024, W_KVB, 0, base, b0);
    cvt_mat(C, C.in(I_WGLU) + (size_t)l * 512 * 1024, 1024, 0, 512, 1024, W_GLU, 1, base, b0);
    cvt_mat(C, C.in(I_WBA) + (size_t)l * 512 * 1024, 1024, 0, 512, 1024, W_BR, 0, base, b0);
    cvt_mat(C, C.in(I_WBS) + (size_t)l * 512 * 1024, 1024, 0, 512, 1024, W_BR + (size_t)1024 * 512 * 2, 0, base, b0);
    cvt_mat(C, C.in(I_WBC) + (size_t)l * 512 * 1024, 1024, 0, 512, 1024, W_BR + (size_t)2 * 1024 * 512 * 2, 0, base, b0);
    cvt_mat(C, C.in(I_WOUT) + (size_t)l * 1024 * 1024, 1024, 0, 1024, 1024, W_OUT, 0, base, b0);
    cvt_mat(C, C.in(I_WUP) + (size_t)l * 1024 * 4096, 4096, 0, 1024, 4096, W_UP, 0, base, b0);
    cvt_mat(C, C.in(I_WDOWN) + (size_t)l * 4096 * 1024, 1024, 0, 4096, 1024, W_DOWN, 0, base, b0);
    f16* pad = (f16*)(C.ws() + W_INA) + (size_t)OFF_GATE * 1024;
    const f16x8 z = {0, 0, 0, 0, 0, 0, 0, 0};
    for (int i = (C.bid - b0) * NTHREADS + C.tid; i < (2560 - OFF_GATE) * 1024 / 8; i += (C.nblk - b0) * NTHREADS) ((f16x8*)pad)[i] = z;
}

__device__ __forceinline__ void row_load(const float* p, int lane, f32x4 (&v)[4]) {
#pragma unroll
    for (int j = 0; j < 4; ++j) v[j] = ((const f32x4*)p)[lane + 64 * j];
}
__device__ __forceinline__ void row_ln(f32x4 (&v)[4]) {
    float s = 0.f;
#pragma unroll
    for (int j = 0; j < 4; ++j) s += (v[j][0] + v[j][1]) + (v[j][2] + v[j][3]);
    const float mean = wave_sum(s) * (1.0f / D);
    float q = 0.f;
#pragma unroll
    for (int j = 0; j < 4; ++j) { v[j] = v[j] - mean; q += (v[j][0] * v[j][0] + v[j][1] * v[j][1]) + (v[j][2] * v[j][2] + v[j][3] * v[j][3]); }
    const float rstd = 1.0f / sqrtf(wave_sum(q) * (1.0f / D) + EPS);
#pragma unroll
    for (int j = 0; j < 4; ++j) v[j] = v[j] * rstd;
}
__device__ __forceinline__ void row_ln_stats(f32x4 (&v)[4], float& mean, float& rstd) {
    float s = 0.f;
#pragma unroll
    for (int j = 0; j < 4; ++j) s += (v[j][0] + v[j][1]) + (v[j][2] + v[j][3]);
    mean = wave_sum(s) * (1.0f / D);
    float q = 0.f;
#pragma unroll
    for (int j = 0; j < 4; ++j) { v[j] = v[j] - mean; q += (v[j][0] * v[j][0] + v[j][1] * v[j][1]) + (v[j][2] * v[j][2] + v[j][3] * v[j][3]); }
    rstd = 1.0f / sqrtf(wave_sum(q) * (1.0f / D) + EPS);
#pragma unroll
    for (int j = 0; j < 4; ++j) v[j] = v[j] * rstd;
}
__device__ __forceinline__ void row_load_h(const f16* p, int lane, f32x4 (&v)[4]) {
#pragma unroll
    for (int j = 0; j < 4; ++j) { const f16x4 h = ((const f16x4*)p)[lane + 64 * j]; v[j] = (f32x4){(float)h[0], (float)h[1], (float)h[2], (float)h[3]}; }
}
__device__ __forceinline__ void row_modulate_store(const f32x4 (&v)[4], const float* sh, const float* sc, f16* o, int lane) {
#pragma unroll
    for (int j = 0; j < 4; ++j) {
        const f32x4 s = ((const f32x4*)sc)[lane + 64 * j], t = ((const f32x4*)sh)[lane + 64 * j];
        const f32x4 y = v[j] * (s + 1.0f) + t;
        ((f16x4*)o)[lane + 64 * j] = pack4(y);
    }
}
__device__ __forceinline__ void phase_p1(const Ctx& C, int l) {
    f16* H = (f16*)(C.ws() + A_H);
    for (int r = C.bid * NWAVES + C.wid; r < MALL; r += C.nblk * NWAVES) {
        const RowInfo ri = row_info(r);
        f32x4 v[4]; row_load(C.xsrc(l, r), C.lane, v); row_ln(v);
        row_modulate_store(v, C.mod(l, ri.mrow, 0), C.mod(l, ri.mrow, 1), H + (size_t)r * D, C.lane);
    }
}
__device__ __forceinline__ void phase_p10(const Ctx& C, int l, int nrows) {
    f16* H = (f16*)(C.ws() + A_H); const f16* T1 = (const f16*)(C.ws() + A_T1H); float* ST = (float*)(C.ws() + WS_ST1);
    const float* g = C.in(I_LN1G) + l * D; const float* bb = C.in(I_LN1B) + l * D;
    for (int r = C.bid * NWAVES + C.wid; r < nrows; r += C.nblk * NWAVES) {
        const RowInfo ri = row_info(r);
        f32x4 v[4]; row_load_h(T1 + (size_t)r * D, C.lane, v);
        float mean, rstd; row_ln_stats(v, mean, rstd);
        if (C.lane == 0) { ST[2 * r] = mean; ST[2 * r + 1] = rstd; }
#pragma unroll
        for (int j = 0; j < 4; ++j) v[j] = v[j] * ((const f32x4*)g)[C.lane + 64 * j] + ((const f32x4*)bb)[C.lane + 64 * j];
        row_ln(v);
        row_modulate_store(v, C.mod(l, ri.mrow, 3), C.mod(l, ri.mrow, 4), H + (size_t)r * D, C.lane);
    }
}
__device__ __forceinline__ void phase_p13(const Ctx& C, int l, int nrows) {
    const float* g = C.in(I_LN2G) + l * D; const float* bb = C.in(I_LN2B) + l * D;
    f16* H = (f16*)(C.ws() + A_H);
    for (int r = C.bid * NWAVES + C.wid; r < nrows; r += C.nblk * NWAVES) {
        float* t = C.ta(r);
        f32x4 v[4]; row_load_h((const f16*)(C.ws() + A_T1H) + (size_t)r * D, C.lane, v); row_ln(v);
#pragma unroll
        for (int j = 0; j < 4; ++j) { v[j] = v[j] * ((const f32x4*)g)[C.lane + 64 * j] + ((const f32x4*)bb)[C.lane + 64 * j]; ((f32x4*)t)[C.lane + 64 * j] = v[j]; }
        if (l == 0) {
            const RowInfo ri = row_info(r);
            row_ln(v);
            row_modulate_store(v, C.mod(1, ri.mrow, 0), C.mod(1, ri.mrow, 1), H + (size_t)r * D, C.lane);
        }
    }
}
__device__ __forceinline__ void phase_hre(const Ctx& C, int l, int nrows) {
    f16* H = (f16*)(C.ws() + A_H);
    for (int r = C.bid * NWAVES + C.wid; r < nrows; r += C.nblk * NWAVES) {
        const RowInfo ri = row_info(r);
        f32x4 v[4]; row_load(C.xsrc(l, r), C.lane, v); row_ln(v);
        row_modulate_store(v, C.mod(l, ri.mrow, 0), C.mod(l, ri.mrow, 1), H + (size_t)r * D, C.lane);
    }
}

__device__ __forceinline__ size_t u3_off(int g, int nb, int sx, int half, int n) { return ((((size_t)(g * 34 + nb) * 16 + sx) * 2 + half) * 32 + n) * 8; }
__device__ __forceinline__ size_t x3_off(int dirg, int nb, int kk, int half, int n) { return ((((size_t)(dirg * 34 + nb) * 8 + kk) * 2 + half) * 32 + n) * 8; }
__device__ __forceinline__ size_t m3_off(int dirg, int mb, int sx, int half, int p32) { return ((((size_t)(dirg * 4 + mb) * 16 + sx) * 2 + half) * 32 + p32) * 8; }
__device__ __forceinline__ void phase_p3(const Ctx& C, int l) {
    f16* PROJ = (f16*)(C.ws() + A_PROJ);
    f16* KA = (f16*)(C.ws() + A_KA); f16* VA = (f16*)(C.ws() + A_VA); f16* KC = (f16*)(C.ws() + A_KC); f16* U = (f16*)(C.ws() + A_U);
    f16* QA = (f16*)(C.ws() + A_QA);
    const float* ropeA = (const float*)(C.ws() + WS_ROPE); const float* ropeC = ropeA + 2048;
    const int lane = C.lane, d32 = lane & 31;
    const float akg = C.in(I_AKG)[l * 64 + lane], aqg = C.in(I_AQG)[l * 64 + lane];
    const f32x4 ckvg = *(const f32x4*)(C.in(I_CKVG) + l * 256 + 4 * lane);
    f32x4 cqg[3];
#pragma unroll
    for (int i = 0; i < 3; ++i) cqg[i] = *(const f32x4*)(C.in(I_CQG) + l * 768 + 256 * i + 4 * lane);
    for (int r = C.bid * NWAVES + C.wid; r < MALL; r += C.nblk * NWAVES) {
        const RowInfo ri = row_info(r);
        f16* prow = PROJ + (size_t)r * PLD;
        const bool needq = ri.lat || l == 0;
        f16 xak[2], xav[2], xaq[8]; f16x4 cq4[3];
#pragma unroll
        for (int hd = 0; hd < 2; ++hd) { xak[hd] = prow[OFF_AK + hd * 64 + lane]; xav[hd] = prow[OFF_AV + hd * 64 + lane]; }
        const f16x4 ckv4 = *(const f16x4*)(prow + OFF_CKV + 4 * lane);
        const f16 xckr = prow[OFF_CKR + d32];
        const f16x8 uu = *(const f16x8*)(prow + OFF_U + 8 * lane);
        if (needq) {
#pragma unroll
            for (int h = 0; h < 8; ++h) xaq[h] = prow[OFF_AQ + h * 64 + lane];
#pragma unroll
            for (int i = 0; i < 3; ++i) cq4[i] = *(const f16x4*)(prow + OFF_CQ + 256 * i + 4 * lane);
        } else {
#pragma unroll
            for (int h = 0; h < 8; ++h) xaq[h] = (f16)0.f;
#pragma unroll
            for (int i = 0; i < 3; ++i) cq4[i] = (f16x4){0, 0, 0, 0};
        }
        const int prow_i = ri.t >> 6, pcol_i = ri.t & 63;
        float cA = 1.f, sA = 0.f, cc = 1.f, sc = 0.f;
        if (ri.lat) {
            { const int part = lane >> 5, j = lane & 15, pi = part ? pcol_i : prow_i; cA = ropeA[pi * 16 + j]; sA = ropeA[1024 + pi * 16 + j]; if (!((lane >> 4) & 1)) sA = -sA; }
            { const int part = d32 >> 4, j = d32 & 7, pi = part ? pcol_i : prow_i; cc = ropeC[pi * 8 + j]; sc = ropeC[512 + pi * 8 + j]; if (!((d32 >> 3) & 1)) sc = -sc; }
        }
        float ss[12];
#pragma unroll
        for (int hd = 0; hd < 2; ++hd) { const float x = (float)xak[hd]; ss[hd] = x * x; }
#pragma unroll
        for (int h = 0; h < 8; ++h) { const float x = (float)xaq[h]; ss[2 + h] = x * x; }
        { float q = 0.f;
#pragma unroll
          for (int e = 0; e < 4; ++e) { const float x = (float)ckv4[e]; q += x * x; }
          ss[10] = q; q = 0.f;
#pragma unroll
          for (int i = 0; i < 3; ++i)
#pragma unroll
              for (int e = 0; e < 4; ++e) { const float x = (float)cq4[i][e]; q += x * x; }
          ss[11] = q; }
#pragma unroll
        for (int o = 1; o < 64; o <<= 1)
#pragma unroll
            for (int i = 0; i < 12; ++i) ss[i] += __shfl_xor(ss[i], o);
#pragma unroll
        for (int hd = 0; hd < 2; ++hd) {
            float y = (float)xak[hd] * (1.0f / sqrtf(ss[hd] * (1.0f / 64.0f) + EPS)) * akg;
            const float p = __shfl_xor(y, 16);
            y = y * cA + p * sA;
            KA[((size_t)(ri.b * 2 + hd) * NKEY + ri.pos) * 64 + lane] = (f16)y;
            VA[((size_t)(ri.b * 2 + hd) * NKEY + ri.pos) * 64 + lane] = xav[hd];
        }
        { const float rs = 1.0f / sqrtf(ss[10] * (1.0f / 256.0f) + EPS); f16x4 o4;
#pragma unroll
          for (int e = 0; e < 4; ++e) o4[e] = (f16)((float)ckv4[e] * rs * ckvg[e]);
          *(f16x4*)(prow + OFF_CKV + 4 * lane) = o4; }
        { float x = (float)xckr; const float p = __shfl_xor(x, 8); x = x * cc + p * sc;
          if (lane < 32) {
#pragma unroll
              for (int h = 0; h < 8; ++h) KC[((size_t)(ri.b * 8 + h) * NKEY + ri.pos) * 96 + 64 + d32] = (f16)x;
          } }
        *(f16x8*)(U + u3_off(lane >> 1, r >> 9, r & 15, lane & 1, (r >> 4) & 31)) = uu;
        if (needq) {
            f16* qdst = ri.lat ? QA + ((size_t)(ri.b * 8) * SEQ + ri.t) * 64 : QA + (size_t)NB * 8 * SEQ * 64 + ((size_t)(ri.b * 8) * CTX + ri.t) * 64;
            const size_t hstride = ri.lat ? (size_t)SEQ * 64 : (size_t)CTX * 64;
#pragma unroll
            for (int h = 0; h < 8; ++h) {
                float y = (float)xaq[h] * (1.0f / sqrtf(ss[2 + h] * (1.0f / 64.0f) + EPS)) * aqg;
                const float p = __shfl_xor(y, 16);
                y = (y * cA + p * sA) * QSCALE_A;
                qdst[h * hstride + lane] = (f16)y;
            }
            const float rs = 1.0f / sqrtf(ss[11] * (1.0f / 768.0f) + EPS);
#pragma unroll
            for (int i = 0; i < 3; ++i) { f16x4 o4;
#pragma unroll
                for (int e = 0; e < 4; ++e) o4[e] = (f16)((float)cq4[i][e] * rs * cqg[i][e]);
                *(f16x4*)(prow + OFF_CQ + 256 * i + 4 * lane) = o4; }
        }
    }
}

namespace pg8 {
#define PG8_LAS __attribute__((address_space(3)))
typedef _Float16 bf16_t;
typedef _Float16 bf16x8 __attribute__((ext_vector_type(8)));
constexpr int BM = 256, BK = 64, HALF = 128, HTB = HALF * BK * 2  , STAGE_BYTES = 8 * HTB, NXCD = 8, WGM = 8;

__host__ __device__ __forceinline__ int lds_byte(int r, int c) { const int st = (r >> 4) * 2 + (c >> 5), rr = r & 15, cc = c & 31, ob = rr * 64 + cc * 2; return st * 1024 + (ob ^ (((ob >> 9) & 1) << 5)); }
__host__ __device__ __forceinline__ void stage_rc(int b, int& R, int& C) { const int st = b / 1024, sb = b % 1024, swz = sb ^ (((sb >> 9) & 1) << 5); R = (st >> 1) * 16 + swz / 64; C = (st & 1) * 32 + (swz % 64) / 2; }
__host__ __device__ __forceinline__ int perm32(int rho) { const int n = rho >> 4, i = rho & 15; return 8 * (i >> 2) + 4 * n + (i & 3); }
struct Unit { int pm, pn; };
struct Gemm { const bf16_t* A; const bf16_t* Bt; int M, N, K, lda, ldb; };

struct StaticOrder {
    int nM, nN, nwg, G, c;
    __host__ __device__ void init(int M, int N, int G_, int c_) { nM = M / BM; nN = N / BM; nwg = nM * nN; G = G_; c = c_; }
    __host__ __device__ bool next(int i, Unit& u) const {
        const long L = (long)i * G + c; if (L >= nwg) return false;
        int wgid = (int)L; { const int q = nwg / NXCD, r = nwg % NXCD, xcd = wgid % NXCD, off = wgid / NXCD; wgid = (xcd < r ? xcd * (q + 1) : r * (q + 1) + (xcd - r) * q) + off; }
        const int nig = WGM * nN, gid = wgid / nig, fm = gid * WGM, gsz = (nM - fm) < WGM ? (nM - fm) : WGM;
        u.pm = fm + ((wgid % nig) % gsz); u.pn = (wgid % nig) / gsz; return true;
    }
    __device__ __forceinline__ void a_ready(const Unit&) const {}
    __device__ __forceinline__ void done(const Unit&) const {}
};

template <class F> struct EpiFn { static constexpr bool PERM = true, AFTER_DRAIN = false; F f;
    __device__ __forceinline__ void operator()(const f32x4 (&acc)[2][2][4][2], const Unit& u, int wr, int wc, int fr, int fq) const {
#pragma unroll
        for (int ai = 0; ai < 2; ++ai)
#pragma unroll
            for (int m = 0; m < 4; ++m) { const int row = u.pm * BM + ai * HALF + wr * 64 + m * 16 + fr;
#pragma unroll
                for (int bj = 0; bj < 2; ++bj) f(row, u.pn * BM + bj * HALF + wc * 32 + 8 * fq, acc[ai][bj][m][0], acc[ai][bj][m][1]);
                asm volatile("" ::: "memory"); }
    } };

template <class Epi, class Sched, bool ALIGN_EPI = false, bool SP2 = false>
__device__ __forceinline__ void gemm_phase(PG8_LAS unsigned char* lds, const Gemm g, const Sched& S, const Epi& E, const int tid) {
    const int wid = __builtin_amdgcn_readfirstlane(tid >> 6), lane = tid & 63, wr = wid >> 2, wc = wid & 3, fr = lane & 15, fq = lane >> 4;
    const int K = g.K, nt = K / BK;
    unsigned voffA[2], voffB[2];
#pragma unroll
    for (int i = 0; i < 2; ++i) { int R, C; stage_rc(tid * 16 + i * 8192, R, C); const int Rb = Epi::PERM ? ((R & ~31) + perm32(R & 31)) : R;
        voffA[i] = (unsigned)(R * g.lda + C) * 2u; voffB[i] = (unsigned)(Rb * g.ldb + C) * 2u; }
    const size_t kstep = (size_t)(BK * 2);
    const size_t hstepA = (size_t)HALF * g.lda * 2, hstepB = (size_t)HALF * g.ldb * 2;
    const size_t tstepA = 2 * hstepA, tstepB = 2 * hstepB;
    const unsigned ldsw = (unsigned)wid * 1024u;
    const int aoff = lds_byte(wr * 64 + fr, fq * 8), boff = lds_byte(wc * 32 + fr, fq * 8);
#define PG8_SA(b, h) (((b) * 2 + (h)) * HTB)
#define PG8_SB(b, h) ((4 + (b) * 2 + (h)) * HTB)
#define PG8_STAGE(bufoff, gbase, voff) do { _Pragma("unroll") for (int _i = 0; _i < 2; ++_i) \
        __builtin_amdgcn_global_load_lds((const unsigned*)((const char*)(gbase) + (voff)[_i]), (PG8_LAS unsigned*)(lds + (bufoff) + ldsw + _i * 8192), 16, 0, 0); } while (0)
#define PG8_LDA(dst, b, h) do { _Pragma("unroll") for (int m = 0; m < 4; ++m) _Pragma("unroll") for (int k = 0; k < 2; ++k) dst[m][k] = *(const PG8_LAS bf16x8*)(lds + PG8_SA(b, h) + aoff + m * 2048 + k * 1024); } while (0)
#define PG8_LDB(dst, b, h) do { _Pragma("unroll") for (int n = 0; n < 2; ++n) _Pragma("unroll") for (int k = 0; k < 2; ++k) dst[n][k] = *(const PG8_LAS bf16x8*)(lds + PG8_SB(b, h) + boff + n * 2048 + k * 1024); } while (0)
#define PG8_MMA(ai, bj, At, Bt) do { __builtin_amdgcn_s_setprio(1); _Pragma("unroll") for (int m = 0; m < 4; ++m) _Pragma("unroll") for (int n = 0; n < 2; ++n) _Pragma("unroll") for (int k = 0; k < 2; ++k) \
        acc[ai][bj][m][n] = __builtin_amdgcn_mfma_f32_16x16x32_f16(Bt[n][k], At[m][k], acc[ai][bj][m][n], 0, 0, 0); __builtin_amdgcn_s_setprio(0); } while (0)
#define PG8_WAIT_V(n) asm volatile("s_waitcnt vmcnt(" #n ")" ::: "memory")
#define PG8_WAIT_L(n) asm volatile("s_waitcnt lgkmcnt(" #n ")" ::: "memory")
#define PG8_BAR __builtin_amdgcn_s_barrier()
#define PG8_SCHED __builtin_amdgcn_sched_barrier(0)
    Unit cur, nxt; int ui = 0;
    if (!S.next(0, cur)) return;
    f32x4 acc[2][2][4][2];
#pragma unroll
    for (int a = 0; a < 2; ++a)
#pragma unroll
        for (int b = 0; b < 2; ++b)
#pragma unroll
            for (int m = 0; m < 4; ++m)
#pragma unroll
                for (int n = 0; n < 2; ++n) acc[a][b][m][n] = (f32x4){0.f, 0.f, 0.f, 0.f};
    bf16x8 At[4][2], B0[2][2], B1[2][2];
    const char* cA = (const char*)g.A + (size_t)cur.pm * tstepA; const char* cB = (const char*)g.Bt + (size_t)cur.pn * tstepB;
    S.a_ready(cur);
    if constexpr (SP2) {
        PG8_STAGE(PG8_SB(0, 0), cB, voffB); PG8_STAGE(PG8_SB(0, 1), cB + hstepB, voffB); PG8_STAGE(PG8_SA(0, 0), cA, voffA); PG8_STAGE(PG8_SA(0, 1), cA + hstepA, voffA);
        if (wr == 1) PG8_BAR;
        PG8_WAIT_V(2); PG8_BAR;
        PG8_STAGE(PG8_SB(1, 0), cB + kstep, voffB); PG8_STAGE(PG8_SA(1, 0), cA + kstep, voffA); PG8_STAGE(PG8_SB(1, 1), cB + hstepB + kstep, voffB);
        PG8_WAIT_V(6); PG8_BAR;
    } else {
        PG8_STAGE(PG8_SB(0, 0), cB, voffB); PG8_STAGE(PG8_SA(0, 0), cA, voffA); PG8_STAGE(PG8_SB(0, 1), cB + hstepB, voffB); PG8_STAGE(PG8_SA(0, 1), cA + hstepA, voffA);
        if (wr == 1) PG8_BAR;
        PG8_WAIT_V(4); PG8_BAR;
        PG8_STAGE(PG8_SB(1, 0), cB + kstep, voffB); PG8_STAGE(PG8_SA(1, 0), cA + kstep, voffA); PG8_STAGE(PG8_SB(1, 1), cB + hstepB + kstep, voffB);
        PG8_WAIT_V(6); PG8_BAR;
    }
    for (;;) {
        const bool has_next = S.next(ui + 1, nxt);
        const char* nA = has_next ? (const char*)g.A + (size_t)nxt.pm * tstepA : cA; const char* nB = has_next ? (const char*)g.Bt + (size_t)nxt.pn * tstepB : cB;
#pragma unroll 1
        for (int t = 0; t < nt; t += 2) {
            const bool last = (t == nt - 2);
            const char* a1 = cA + (size_t)(t + 1) * kstep;
            const char* a2 = last ? nA : cA + (size_t)(t + 2) * kstep; const char* b2 = last ? nB : cB + (size_t)(t + 2) * kstep;
            const char* a3 = a2 + kstep; const char* b3 = b2 + kstep;
            if (last && has_next) S.a_ready(nxt);
            if constexpr (SP2) {
            PG8_LDB(B0, 0, 0); PG8_LDB(B1, 0, 1); PG8_SCHED; PG8_LDA(At, 0, 0); PG8_STAGE(PG8_SA(1, 1), a1 + hstepA, voffA);
            PG8_WAIT_V(8); PG8_WAIT_L(0); PG8_BAR; PG8_MMA(0, 0, At, B0); PG8_MMA(0, 1, At, B1); PG8_BAR; PG8_SCHED;
            PG8_LDA(At, 0, 1); PG8_STAGE(PG8_SB(0, 0), b2, voffB); PG8_STAGE(PG8_SB(0, 1), b2 + hstepB, voffB); PG8_STAGE(PG8_SA(0, 0), a2, voffA);
            PG8_WAIT_V(8); PG8_WAIT_L(0); PG8_BAR; PG8_MMA(1, 0, At, B0); PG8_MMA(1, 1, At, B1); PG8_BAR; PG8_SCHED;
            PG8_LDB(B0, 1, 0); PG8_LDB(B1, 1, 1); PG8_SCHED; PG8_LDA(At, 1, 0); PG8_STAGE(PG8_SA(0, 1), a2 + hstepA, voffA);
            PG8_WAIT_V(8); PG8_WAIT_L(0); PG8_BAR; PG8_MMA(0, 0, At, B0); PG8_MMA(0, 1, At, B1); PG8_BAR; PG8_SCHED;
            PG8_LDA(At, 1, 1); PG8_STAGE(PG8_SB(1, 0), b3, voffB); PG8_STAGE(PG8_SB(1, 1), b3 + hstepB, voffB); PG8_STAGE(PG8_SA(1, 0), a3, voffA);
            PG8_WAIT_V(8); PG8_WAIT_L(0); PG8_BAR; PG8_MMA(1, 0, At, B0); PG8_MMA(1, 1, At, B1); PG8_BAR; PG8_SCHED;
            } else {
            PG8_LDB(B0, 0, 0); PG8_SCHED; PG8_LDA(At, 0, 0); PG8_STAGE(PG8_SA(1, 1), a1 + hstepA, voffA);
            PG8_WAIT_L(8); PG8_BAR; PG8_WAIT_L(0); PG8_MMA(0, 0, At, B0); PG8_BAR; PG8_SCHED;
            PG8_LDB(B1, 0, 1); PG8_STAGE(PG8_SB(0, 0), b2, voffB);
            PG8_BAR; PG8_WAIT_L(0); PG8_MMA(0, 1, At, B1); PG8_BAR;
            PG8_LDA(At, 0, 1); PG8_STAGE(PG8_SA(0, 0), a2, voffA);
            PG8_BAR; PG8_WAIT_L(0); PG8_MMA(1, 0, At, B0); PG8_BAR; PG8_SCHED;
            PG8_STAGE(PG8_SB(0, 1), b2 + hstepB, voffB);
            PG8_WAIT_V(6); PG8_BAR; PG8_MMA(1, 1, At, B1); PG8_BAR;
            PG8_LDB(B0, 1, 0); PG8_SCHED; PG8_LDA(At, 1, 0); PG8_STAGE(PG8_SA(0, 1), a2 + hstepA, voffA);
            PG8_WAIT_L(8); PG8_BAR; PG8_WAIT_L(0); PG8_MMA(0, 0, At, B0); PG8_BAR; PG8_SCHED;
            PG8_LDB(B1, 1, 1); PG8_STAGE(PG8_SB(1, 0), b3, voffB);
            PG8_BAR; PG8_WAIT_L(0); PG8_MMA(0, 1, At, B1); PG8_BAR;
            PG8_LDA(At, 1, 1); PG8_STAGE(PG8_SA(1, 0), a3, voffA);
            PG8_BAR; PG8_WAIT_L(0); PG8_MMA(1, 0, At, B0); PG8_BAR; PG8_SCHED;
            PG8_STAGE(PG8_SB(1, 1), b3 + hstepB, voffB);
            PG8_WAIT_V(6); PG8_BAR; PG8_MMA(1, 1, At, B1); PG8_BAR;
            }
        }
        if constexpr (ALIGN_EPI) { if (wr == 0) PG8_BAR; }
        if constexpr (!Epi::AFTER_DRAIN) { E(acc, cur, wr, wc, fr, fq); S.done(cur); }
        if (!has_next) break;
#pragma unroll
        for (int a = 0; a < 2; ++a)
#pragma unroll
            for (int b = 0; b < 2; ++b)
#pragma unroll
                for (int m = 0; m < 4; ++m)
#pragma unroll
                    for (int n = 0; n < 2; ++n) acc[a][b][m][n] = (f32x4){0.f, 0.f, 0.f, 0.f};
        cur = nxt; cA = nA; cB = nB; ++ui;
        if constexpr (ALIGN_EPI) { if (wr == 1) PG8_BAR; }
    }
    PG8_WAIT_V(0);
    if constexpr (!ALIGN_EPI) { if (wr == 0) PG8_BAR; }
    PG8_BAR;
    if constexpr (Epi::AFTER_DRAIN) { E.fused(acc, cur, wr, wc, fr, fq, lds, wid, lane); S.done(cur); }
#undef PG8_SA
#undef PG8_SB
#undef PG8_STAGE
#undef PG8_LDA
#undef PG8_LDB
#undef PG8_MMA
#undef PG8_WAIT_V
#undef PG8_WAIT_L
#undef PG8_BAR
#undef PG8_SCHED
}
}

template <class Epi>
__device__ __forceinline__ void gemm_simple(const Ctx& C, const f16* A, int lda, const f16* Bt, int ldb, int M, int N, int K, const Epi& E, int mskip_from = 1 << 30, int nskip_from = 1 << 30) {
    const int wr = C.wid >> 2, wc = C.wid & 3, fr = C.lane & 15, fq = C.lane >> 4;
    const int tilesN = N / 256, tilesM = M / 64;
    for (int tile = C.bid; tile < tilesM * tilesN; tile += C.nblk) {
        const int tm = tile / tilesN, tn = tile % tilesN;
        if (tm * 64 >= mskip_from && tn * 256 >= nskip_from) continue;
        const int m0 = tm * 64 + wr * 32, n0 = tn * 256 + wc * 64;
        f32x4 acc[2][2][2];
#pragma unroll
        for (int a = 0; a < 2; ++a)
#pragma unroll
            for (int g = 0; g < 2; ++g)
#pragma unroll
                for (int n = 0; n < 2; ++n) acc[a][g][n] = (f32x4){0.f, 0.f, 0.f, 0.f};
        const f16* ap[2]; const f16* bp[2][2];
#pragma unroll
        for (int a = 0; a < 2; ++a) ap[a] = A + (size_t)(m0 + a * 16 + fr) * lda + fq * 8;
#pragma unroll
        for (int g = 0; g < 2; ++g)
#pragma unroll
            for (int n = 0; n < 2; ++n) bp[g][n] = Bt + (size_t)(n0 + g * 32 + 8 * (fr >> 2) + 4 * n + (fr & 3)) * ldb + fq * 8;
        for (int k0 = 0; k0 < K; k0 += 32) {
            f16x8 av[2], bv[2][2];
#pragma unroll
            for (int a = 0; a < 2; ++a) av[a] = *(const f16x8*)(ap[a] + k0);
#pragma unroll
            for (int g = 0; g < 2; ++g)
#pragma unroll
                for (int n = 0; n < 2; ++n) bv[g][n] = *(const f16x8*)(bp[g][n] + k0);
#pragma unroll
            for (int a = 0; a < 2; ++a)
#pragma unroll
                for (int g = 0; g < 2; ++g)
#pragma unroll
                    for (int n = 0; n < 2; ++n) acc[a][g][n] = __builtin_amdgcn_mfma_f32_16x16x32_f16(bv[g][n], av[a], acc[a][g][n], 0, 0, 0);
        }
#pragma unroll
        for (int a = 0; a < 2; ++a)
#pragma unroll
            for (int g = 0; g < 2; ++g) E(m0 + a * 16 + fr, n0 + g * 32 + 8 * fq, acc[a][g][0], acc[a][g][1]);
    }
}

template <class F>
__device__ __forceinline__ void gemm_pg8(const Ctx& C, const f16* A, int lda, const f16* Bt, int ldb, int M, int N, int K, const F& f) {
    pg8::Gemm g{A, Bt, M, N, K, lda, ldb}; pg8::StaticOrder S; S.init(M, N, C.nblk, C.bid);
    pg8::EpiFn<F> E{f};
    pg8::gemm_phase<pg8::EpiFn<F>, pg8::StaticOrder, true, true>(C.lds, g, S, E, C.tid);
}
template <class F>
__device__ __forceinline__ void gemm_small(const Ctx& C, const f16* A, int lda, const f16* Bt, int ldb, int row0, int N, int K, const F& f) {
    constexpr int PST = 68;
    LAS float* part = (LAS float*)C.lds;
    const int fr = C.lane & 15, fq = C.lane >> 4;
    const int tilesN = N / 64, ntiles = 16 * tilesN, kw = K / 8;
    for (int tile = C.bid; tile < ntiles; tile += C.nblk) {
        const int tm = tile / tilesN, tn = tile - tm * tilesN, m0 = tm * 64, n0 = tn * 64;
        f32x4 acc[4][4];
#pragma unroll
        for (int a = 0; a < 4; ++a)
#pragma unroll
            for (int b = 0; b < 4; ++b) acc[a][b] = (f32x4){0.f, 0.f, 0.f, 0.f};
        const f16* ap = A + (size_t)(m0 + fr) * lda + C.wid * kw + fq * 8;
        const f16* bp = Bt + (size_t)(n0 + fr) * ldb + C.wid * kw + fq * 8;
#pragma unroll 2
        for (int k0 = 0; k0 < kw; k0 += 32) {
            f16x8 av[4], bv[4];
#pragma unroll
            for (int a = 0; a < 4; ++a) av[a] = *(const f16x8*)(ap + (size_t)(a * 16) * lda + k0);
#pragma unroll
            for (int b = 0; b < 4; ++b) bv[b] = *(const f16x8*)(bp + (size_t)(b * 16) * ldb + k0);
#pragma unroll
            for (int a = 0; a < 4; ++a)
#pragma unroll
                for (int b = 0; b < 4; ++b) acc[a][b] = __builtin_amdgcn_mfma_f32_16x16x32_f16(bv[b], av[a], acc[a][b], 0, 0, 0);
        }
        __syncthreads();
        LAS float* pw = part + (size_t)C.wid * 64 * PST;
#pragma unroll
        for (int a = 0; a < 4; ++a)
#pragma unroll
            for (int b = 0; b < 4; ++b) *(LAS f32x4*)(pw + (a * 16 + fr) * PST + b * 16 + 4 * fq) = acc[a][b];
        __syncthreads();
        const int rl = 8 * C.wid + (C.lane & 7), c8 = ((C.lane >> 4) & 1) | (((C.lane >> 5) & 1) << 1) | (((C.lane >> 3) & 1) << 2);
        f32x4 lo = (f32x4){0.f, 0.f, 0.f, 0.f}, hi = lo;
#pragma unroll
        for (int w = 0; w < 8; ++w) { const LAS float* pr = part + ((size_t)w * 64 + rl) * PST + 8 * c8; lo = lo + *(const LAS f32x4*)pr; hi = hi + *(const LAS f32x4*)(pr + 4); }
        f(row0 + m0 + rl, n0 + 8 * c8, lo, hi);
    }
    __syncthreads();
}
template <class F>
__device__ __forceinline__ void gemm_rows(const Ctx& C, const f16* A, int lda, const f16* Bt, int ldb, int mrows, int N, int K, const F& f) {
    gemm_pg8(C, A, lda, Bt, ldb, NLAT, N, K, f);
    if (mrows > NLAT) gemm_small(C, A + (size_t)NLAT * lda, lda, Bt, ldb, NLAT, N, K, f);
}
struct EpiStore { f16* O; int ldo;
    __device__ __forceinline__ void operator()(int row, int col, f32x4 lo, f32x4 hi) const { *(f16x8*)(O + (size_t)row * ldo + col) = pack8(lo, hi); } };
struct EpiKvUp { f16* KC; f16* VC;
    __device__ __forceinline__ void operator()(int row, int col, f32x4 lo, f32x4 hi) const {
        const RowInfo ri = row_info(row); const int h = col >> 7, w = col & 127;
        if (w < 64) *(f16x8*)(KC + ((size_t)(ri.b * 8 + h) * NKEY + ri.pos) * 96 + w) = pack8(lo, hi);
        else *(f16x8*)(VC + ((size_t)(ri.b * 8 + h) * NKEY + ri.pos) * 64 + (w - 64)) = pack8(lo, hi);
    } };
struct EpiQUp { f16* QC; const float* ropeC;
    __device__ __forceinline__ void operator()(int row, int col, f32x4 lo, f32x4 hi) const {
        const RowInfo ri = row_info(row); const int h = col / 96, w = col - h * 96;
        if (w >= 64) {
            f32x4 plo, phi;
#pragma unroll
            for (int e = 0; e < 4; ++e) { plo[e] = __shfl_xor(lo[e], 16); phi[e] = __shfl_xor(hi[e], 16); }
            if (ri.lat) {
                const int j0 = w - 64, part = j0 >> 4, second = (j0 >> 3) & 1, pi = part ? (ri.t & 63) : (ri.t >> 6);
                const float* cc = ropeC + pi * 8; const float* ss = ropeC + 512 + pi * 8;
#pragma unroll
                for (int e = 0; e < 4; ++e) {
                    const float s0 = second ? ss[e] : -ss[e], s1 = second ? ss[4 + e] : -ss[4 + e];
                    lo[e] = lo[e] * cc[e] + plo[e] * s0; hi[e] = hi[e] * cc[4 + e] + phi[e] * s1; }
            }
        }
        lo = lo * QSCALE_C; hi = hi * QSCALE_C;
        f16* dst = ri.lat ? QC + ((size_t)(ri.b * 8 + h) * SEQ + ri.t) * 96 + w : QC + (size_t)NB * 8 * SEQ * 96 + ((size_t)(ri.b * 8 + h) * CTX + ri.t) * 96 + w;
        *(f16x8*)dst = pack8(lo, hi);
    } };
struct EpiGlu { f16* YS;
    __device__ __forceinline__ void operator()(int row, int col, f32x4 lo, f32x4 hi) const {
        f32x4 o;
#pragma unroll
        for (int e = 0; e < 4; ++e) o[e] = lo[e] * sigmoidf_(hi[e]);
        *(f16x4*)(YS + (size_t)row * 512 + (col >> 1)) = pack4(o);
    } };
struct EpiGate { f16* G;
    __device__ __forceinline__ void operator()(int row, int col, f32x4 lo, f32x4 hi) const {
#pragma unroll
        for (int e = 0; e < 4; ++e) { lo[e] = sigmoidf_(lo[e]); hi[e] = sigmoidf_(hi[e]); }
        *(f16x8*)(G + (size_t)row * 1024 + col) = pack8(lo, hi);
    } };
struct EpiBranch { const f16* G; f16* Mg; int first;
    __device__ __forceinline__ void operator()(int row, int col, f32x4 lo, f32x4 hi) const {
        const f16x8 g = *(const f16x8*)(G + (size_t)row * 1024 + col);
        f16x8 m = {0, 0, 0, 0, 0, 0, 0, 0};
        if (!first) m = *(const f16x8*)(Mg + (size_t)row * 1024 + col);
#pragma unroll
        for (int e = 0; e < 4; ++e) { lo[e] = (float)m[e] + (float)g[e] * lo[e]; hi[e] = (float)m[4 + e] + (float)g[4 + e] * hi[e]; }
        *(f16x8*)(Mg + (size_t)row * 1024 + col) = pack8(lo, hi);
    } };
struct EpiWout { const Ctx* C; int l;
    __device__ __forceinline__ void operator()(int row, int col, f32x4 lo, f32x4 hi) const {
        const RowInfo ri = row_info(row); const float* x = C->xsrc(l, row) + col; const float* g = C->mod(l, ri.mrow, 2) + col;
        const f32x4 x0 = *(const f32x4*)x, x1 = *(const f32x4*)(x + 4), g0 = *(const f32x4*)g, g1 = *(const f32x4*)(g + 4);
        *(f16x8*)((f16*)(C->ws() + A_T1H) + (size_t)row * D + col) = pack8(x0 * ALPHA + g0 * lo, x1 * ALPHA + g1 * hi);
    } };
struct EpiUp { f16* Hd;
    __device__ __forceinline__ void operator()(int row, int col, f32x4 lo, f32x4 hi) const {
#pragma unroll
        for (int e = 0; e < 4; ++e) { const float a = fmaxf(lo[e], 0.f), b = fmaxf(hi[e], 0.f); lo[e] = a * a; hi[e] = b * b; }
        *(f16x8*)(Hd + (size_t)row * DFF + col) = pack8(lo, hi);
    } };
struct EpiDown { const Ctx* C; int l;
    __device__ __forceinline__ void operator()(int row, int col, f32x4 lo, f32x4 hi) const {
        const RowInfo ri = row_info(row); const float* g = C->mod(l, ri.mrow, 5) + col; f16* t = (f16*)(C->ws() + A_T1H) + (size_t)row * D + col;
        const float* st = (const float*)(C->ws() + WS_ST1) + 2 * row; const float mean = st[0], rstd = st[1];
        const float* lg = C->in(I_LN1G) + l * D + col; const float* lb = C->in(I_LN1B) + l * D + col;
        const f16x8 t1 = *(const f16x8*)t; const f32x4 g0 = *(const f32x4*)g, g1 = *(const f32x4*)(g + 4);
        const f32x4 a0 = *(const f32x4*)lg, a1 = *(const f32x4*)(lg + 4), b0 = *(const f32x4*)lb, b1 = *(const f32x4*)(lb + 4);
        f32x4 x0, x1;
#pragma unroll
        for (int e = 0; e < 4; ++e) { x0[e] = ((float)t1[e] - mean) * rstd * a0[e] + b0[e]; x1[e] = ((float)t1[4 + e] - mean) * rstd * a1[e] + b1[e]; }
        *(f16x8*)t = pack8(x0 * ALPHA + g0 * lo, x1 * ALPHA + g1 * hi);
    } };

typedef _Float16 f16x2 __attribute__((ext_vector_type(2)));
template <int DQK>
__device__ __forceinline__ void attn_naive_query(const f16* q, const f16* Kh, const f16* Vh, int nkeys, f16* out, LAS float* scr, int lane) {
    f16x8 qv[DQK / 8];
#pragma unroll
    for (int c = 0; c < DQK / 8; ++c) qv[c] = *(const f16x8*)(q + 8 * c);
    float m = -1e30f, ls = 0.f; float acc[64];
#pragma unroll
    for (int d = 0; d < 64; ++d) acc[d] = 0.f;
    for (int j = lane; j < nkeys; j += 64) {
        const f16* kr = Kh + (size_t)j * DQK; const f16* vr = Vh + (size_t)j * 64;
        float s = 0.f;
#pragma unroll
        for (int c = 0; c < DQK / 8; ++c) { const f16x8 v = *(const f16x8*)(kr + 8 * c);
#pragma unroll
            for (int e = 0; e < 4; ++e) s = __builtin_amdgcn_fdot2((f16x2){qv[c][2 * e], qv[c][2 * e + 1]}, (f16x2){v[2 * e], v[2 * e + 1]}, s, false); }
        const float mn = fmaxf(m, s), a = exp2f(m - mn), p = exp2f(s - mn);
        ls = ls * a + p; m = mn;
#pragma unroll
        for (int c = 0; c < 8; ++c) { const f16x8 v = *(const f16x8*)(vr + 8 * c);
#pragma unroll
            for (int e = 0; e < 8; ++e) acc[8 * c + e] = acc[8 * c + e] * a + p * (float)v[e]; }
    }
    const float mg = wave_max(m), w = exp2f(m - mg);
    const float L = wave_sum(ls * w);
#pragma unroll
    for (int d = 0; d < 64; ++d) scr[lane * 65 + d] = acc[d] * w;
    asm volatile("s_waitcnt lgkmcnt(0)" ::: "memory");
    float o = 0.f;
#pragma unroll 8
    for (int i = 0; i < 64; ++i) o += scr[i * 65 + lane];
    asm volatile("s_waitcnt lgkmcnt(0)" ::: "memory");
    out[lane] = (f16)(o / L);
}
__device__ __forceinline__ void phase_attn_naive(const Ctx& C, int l) {
    LAS float* scr = (LAS float*)C.lds + C.wid * (64 * 65);
    const f16* QA = (const f16*)(C.ws() + A_QA); const f16* QC = (const f16*)(C.ws() + A_QC);
    const f16* KA = (const f16*)(C.ws() + A_KA); const f16* VA = (const f16*)(C.ws() + A_VA);
    const f16* KC = (const f16*)(C.ws() + A_KC); const f16* VC = (const f16*)(C.ws() + A_VC);
    f16* YA = (f16*)(C.ws() + A_YA); f16* YC = (f16*)(C.ws() + A_YC);
    const int NQL = NB * 8 * SEQ, NQC = NB * 8 * CTX;
    const int total = 2 * NQL + (l == 0 ? 2 * NQC : 0);
    for (int u = C.bid * NWAVES + C.wid; u < total; u += C.nblk * NWAVES) {
        int v = u; int type, lat;
        if (v < 2 * NQL) { type = v / NQL; v -= type * NQL; lat = 1; } else { v -= 2 * NQL; type = v / NQC; v -= type * NQC; lat = 0; }
        const int nq = lat ? SEQ : CTX;
        const int t = v % nq, h = (v / nq) & 7, b = v / (nq * 8);
        const int row = lat ? b * SEQ + t : NLAT + b * CTX + t;
        const int nkeys = lat ? NKEY : CTX;
        if (type == 0) {
            const f16* q = lat ? QA + ((size_t)(b * 8 + h) * SEQ + t) * 64 : QA + (size_t)NB * 8 * SEQ * 64 + ((size_t)(b * 8 + h) * CTX + t) * 64;
            attn_naive_query<64>(q, KA + (size_t)(b * 2 + (h >> 2)) * NKEY * 64, VA + (size_t)(b * 2 + (h >> 2)) * NKEY * 64, nkeys, YA + (size_t)row * 512 + h * 64, scr, C.lane);
        } else {
            const f16* q = lat ? QC + ((size_t)(b * 8 + h) * SEQ + t) * 96 : QC + (size_t)NB * 8 * SEQ * 96 + ((size_t)(b * 8 + h) * CTX + t) * 96;
            attn_naive_query<96>(q, KC + (size_t)(b * 8 + h) * NKEY * 96, VC + (size_t)(b * 8 + h) * NKEY * 64, nkeys, YC + (size_t)row * 512 + h * 64, scr, C.lane);
        }
    }
}

namespace fa {
typedef _Float16 h2 __attribute__((ext_vector_type(2)));
typedef float f2 __attribute__((ext_vector_type(2)));
typedef short s16x4 __attribute__((ext_vector_type(4)));
typedef unsigned u32x4 __attribute__((ext_vector_type(4)));
#define FA_SBAR() __builtin_amdgcn_sched_barrier(0)
constexpr float THR = 8.f;
constexpr int SHM_V = 64 * 64 * 2;
template <int DQK> struct Cfg { static constexpr int KROWB = DQK == 64 ? 128 : 256, SHM_K = 64 * KROWB, NCH = DQK / 8; };
template <int DQK> __device__ __forceinline__ int kswz(int row, int ch) {
    if constexpr (DQK == 64) return row * 128 + ((ch ^ ((row >> 1) & 7)) << 4);
    else return row * 256 + ((ch ^ (row & 15)) << 4);
}
__device__ __forceinline__ int crow(int r, int hi) { return (r & 3) + 8 * (r >> 2) + 4 * hi; }
__device__ __forceinline__ unsigned cvtpk(float lo, float hi) { f2 v = {lo, hi}; h2 h = __builtin_convertvector(v, h2); return __builtin_bit_cast(unsigned, h); }
__device__ __forceinline__ void partialSM(f32x16& p0, f32x16& p1, float& m_reg, float& mn, float& alpha) {
    float pmax = p0[0];
#pragma unroll
    for (int r = 1; r < 16; ++r) pmax = fmaxf(pmax, p0[r]);
#pragma unroll
    for (int r = 0; r < 16; ++r) pmax = fmaxf(pmax, p1[r]);
    { auto rr = __builtin_amdgcn_permlane32_swap(__float_as_uint(pmax), __float_as_uint(pmax), false, false);
      pmax = fmaxf(__uint_as_float(rr[0]), __uint_as_float(rr[1])); }
    if (__builtin_expect(__all(pmax - m_reg <= THR), 1)) { mn = m_reg; alpha = 1.f; }
    else { mn = fmaxf(m_reg, pmax); alpha = __builtin_amdgcn_exp2f(m_reg - mn); m_reg = mn; }
#pragma unroll
    for (int r = 0; r < 16; ++r) { p0[r] = p0[r] - mn; p1[r] = p1[r] - mn; }
#pragma unroll
    for (int r = 0; r < 16; ++r) p0[r] = __builtin_amdgcn_exp2f(p0[r]);
}
__device__ __forceinline__ void finishSM(f32x16& p0, f32x16& p1, float alpha, float& l_reg, f16x8& pa0, f16x8& pa1, f16x8& pa2, f16x8& pa3) {
#pragma unroll
    for (int r = 0; r < 16; ++r) p1[r] = __builtin_amdgcn_exp2f(p1[r]);
    float ps = 0;
#pragma unroll
    for (int r = 0; r < 16; ++r) ps += p0[r];
#pragma unroll
    for (int r = 0; r < 16; ++r) ps += p1[r];
    { auto rr = __builtin_amdgcn_permlane32_swap(__float_as_uint(ps), __float_as_uint(ps), false, false);
      ps = __uint_as_float(rr[0]) + __uint_as_float(rr[1]); }
    l_reg = l_reg * alpha + ps;
#define FA_PK4(P, BASE, OUT) do { unsigned a0 = cvtpk(P[BASE + 0], P[BASE + 1]), a1 = cvtpk(P[BASE + 2], P[BASE + 3]);   \
    unsigned b0 = cvtpk(P[BASE + 4], P[BASE + 5]), b1 = cvtpk(P[BASE + 6], P[BASE + 7]);                              \
    auto r0 = __builtin_amdgcn_permlane32_swap(a0, b0, false, false); auto r1 = __builtin_amdgcn_permlane32_swap(a1, b1, false, false); \
    u32x4 w = {r0[0], r1[0], r0[1], r1[1]}; OUT = __builtin_bit_cast(f16x8, w); } while (0)
    FA_PK4(p0, 0, pa0); FA_PK4(p0, 8, pa1); FA_PK4(p1, 0, pa2); FA_PK4(p1, 8, pa3);
#undef FA_PK4
}
template <int DQK>
__device__ __forceinline__ void qkt(f32x16& p0, f32x16& p1, const LAS unsigned char* Ks, const f16x8* qr, int r32, int hi) {
    p0 = f32x16{}; p1 = f32x16{};
#pragma unroll
    for (int d0 = 0; d0 < DQK / 16; ++d0) {
        const f16x8 b0 = *(const LAS f16x8*)(Ks + kswz<DQK>(r32, d0 * 2 + hi));
        const f16x8 b1 = *(const LAS f16x8*)(Ks + kswz<DQK>(32 + r32, d0 * 2 + hi));
        p0 = __builtin_amdgcn_mfma_f32_32x32x16_f16(b0, qr[d0], p0, 0, 0, 0);
        p1 = __builtin_amdgcn_mfma_f32_32x32x16_f16(b1, qr[d0], p1, 0, 0, 0);
    }
}
__device__ __forceinline__ int v_st(int k, int c) { const int kk = (k & ~0xC) | ((k & 4) << 1) | ((k & 8) >> 1); return ((kk >> 3) * 2 + (c >> 5)) * 512 + ((kk & 7) * 32 + (c & 31)) * 2; }
__device__ __forceinline__ int v_rd_base(int lane) { return ((lane & 3) << 3) | (((lane >> 2) & 3) << 6) | (((lane >> 4) & 1) << 5) | (((lane >> 5) & 1) << 8); }
constexpr int v_rd_off(int d0, int ks, int half) { return d0 * 512 + ks * 2048 + half * 1024; }
template <int OFF> __device__ __forceinline__ s16x4 tr_read(int vb) {
    s16x4 r; asm volatile("ds_read_b64_tr_b16 %0, %1 offset:%2" : "=&v"(r) : "v"(vb), "i"(OFF) : "memory"); return r;
}
template <int D0> __device__ __forceinline__ void pv_one(f32x16& od, int vb, f16x8 pa0, f16x8 pa1, f16x8 pa2, f16x8 pa3) {
    const s16x4 l0 = tr_read<v_rd_off(D0, 0, 0)>(vb), h0 = tr_read<v_rd_off(D0, 0, 1)>(vb), l1 = tr_read<v_rd_off(D0, 1, 0)>(vb), h1 = tr_read<v_rd_off(D0, 1, 1)>(vb);
    const s16x4 l2 = tr_read<v_rd_off(D0, 2, 0)>(vb), h2_ = tr_read<v_rd_off(D0, 2, 1)>(vb), l3 = tr_read<v_rd_off(D0, 3, 0)>(vb), h3 = tr_read<v_rd_off(D0, 3, 1)>(vb);
    asm volatile("s_waitcnt lgkmcnt(0)" ::: "memory"); FA_SBAR();
#define FA_PK(L, H) __builtin_bit_cast(f16x8, (short __attribute__((ext_vector_type(8)))){L[0], L[1], L[2], L[3], H[0], H[1], H[2], H[3]})
    od = __builtin_amdgcn_mfma_f32_32x32x16_f16(pa0, FA_PK(l0, h0), od, 0, 0, 0);
    od = __builtin_amdgcn_mfma_f32_32x32x16_f16(pa1, FA_PK(l1, h1), od, 0, 0, 0);
    od = __builtin_amdgcn_mfma_f32_32x32x16_f16(pa2, FA_PK(l2, h2_), od, 0, 0, 0);
    od = __builtin_amdgcn_mfma_f32_32x32x16_f16(pa3, FA_PK(l3, h3), od, 0, 0, 0);
#undef FA_PK
}
__device__ __forceinline__ void pv_d0(f32x16* o, int vb, f16x8 pa0, f16x8 pa1, f16x8 pa2, f16x8 pa3) {
    pv_one<0>(o[0], vb, pa0, pa1, pa2, pa3); pv_one<1>(o[1], vb, pa0, pa1, pa2, pa3);
}
template <int DQK>
__device__ __forceinline__ void attn_unit(const f16* __restrict__ Qb, const f16* __restrict__ Kh, const f16* __restrict__ Vh, f16* __restrict__ Ob, int nkeys, LAS unsigned char* lds, const int tid) {
    constexpr int SHM_K = Cfg<DQK>::SHM_K, NCH = Cfg<DQK>::NCH, ND0 = DQK / 16;
    const int wid = tid >> 6, lane = tid & 63, r32 = lane & 31, hi = lane >> 5;
    LAS unsigned char* V_lds = lds; LAS unsigned char* K_lds = lds + 2 * SHM_V;
    LAS float* wsx = (LAS float*)(lds + 2 * SHM_V + 2 * SHM_K) + wid * 64; LAS float* li_l = wsx; LAS float* al_l = wsx + 32;
    float m_reg = -1e30f, l_reg = 0; f32x16 o[2] = {}; f16x8 qr[ND0];
    const f16* Qw = Qb + (size_t)(wid * 32 + r32) * DQK + hi * 8;
#pragma unroll
    for (int d0 = 0; d0 < ND0; ++d0) qr[d0] = *(const f16x8*)(Qw + d0 * 16);
    const int vr = tid >> 3, vc = (tid & 7) * 8, vst = v_st(vr, vc);
    const int k0id = tid, k1id = (tid + 512 < 64 * NCH) ? tid + 512 : tid;
    const int k0r = k0id / NCH, k0c = k0id % NCH, k1r = k1id / NCH, k1c = k1id % NCH;
    const bool k1on = (NCH > 8) && (tid + 512 < 64 * NCH);
    const int vb0 = (int)(uintptr_t)V_lds + v_rd_base(lane);
    struct { f16x8 vs, ks0, ks1; } sr_[2];
#define FA_SLOAD(i, kk0) do { sr_[i].vs = *(const f16x8*)(Vh + (size_t)((kk0) + vr) * 64 + vc); sr_[i].ks0 = *(const f16x8*)(Kh + (size_t)((kk0) + k0r) * DQK + k0c * 8); \
    if (NCH > 8) sr_[i].ks1 = *(const f16x8*)(Kh + (size_t)((kk0) + k1r) * DQK + k1c * 8); } while (0)
#define FA_SWRITE(b, i) do { *(LAS f16x8*)(V_lds + (b) * SHM_V + vst) = sr_[i].vs; *(LAS f16x8*)(K_lds + (b) * SHM_K + kswz<DQK>(k0r, k0c)) = sr_[i].ks0; \
    if (k1on) *(LAS f16x8*)(K_lds + (b) * SHM_K + kswz<DQK>(k1r, k1c)) = sr_[i].ks1; } while (0)
#define FA_SWAIT() do { if (NCH > 8) asm volatile("s_waitcnt vmcnt(3)" ::: "memory"); else asm volatile("s_waitcnt vmcnt(2)" ::: "memory"); } while (0)
#define FA_RESC(a) do { if (__any((a) < 1.f)) { if (hi == 0) al_l[r32] = (a); asm volatile("s_waitcnt lgkmcnt(0)" ::: "memory"); \
    _Pragma("unroll") for (int d = 0; d < 2; ++d) _Pragma("unroll") for (int r = 0; r < 16; ++r) o[d][r] *= al_l[crow(r, hi)]; } } while (0)
    f32x16 pA0, pA1, pB0, pB1; float mnA, mnB, alA, alB; f16x8 pa0, pa1, pa2, pa3; const int NT = nkeys / 64;
    constexpr int SE = 0, SO = 1;
    FA_SLOAD(SE, 0); asm volatile("s_waitcnt vmcnt(0)" ::: "memory"); FA_SWRITE(0, SE); __syncthreads();
    qkt<DQK>(pA0, pA1, K_lds, qr, r32, hi); partialSM(pA0, pA1, m_reg, mnA, alA);
    FA_SLOAD(SO, 64); if (2 < NT) FA_SLOAD(SE, 128);
    FA_SWAIT(); FA_SWRITE(1, SO); __syncthreads();
    for (int j = 1; j + 1 < NT; j += 2) {
        FA_SBAR(); qkt<DQK>(pB0, pB1, K_lds + SHM_K, qr, r32, hi);
        finishSM(pA0, pA1, alA, l_reg, pa0, pa1, pa2, pa3); FA_SBAR();
        FA_SLOAD(SO, (j + 2) * 64); FA_SBAR();
        pv_d0(o, vb0, pa0, pa1, pa2, pa3); partialSM(pB0, pB1, m_reg, mnB, alB);
        __syncthreads(); FA_SWAIT(); FA_SWRITE(0, SE);
        FA_RESC(alB); __syncthreads();
        FA_SBAR(); qkt<DQK>(pA0, pA1, K_lds, qr, r32, hi);
        finishSM(pB0, pB1, alB, l_reg, pa0, pa1, pa2, pa3); FA_SBAR();
        if (j + 3 < NT) FA_SLOAD(SE, (j + 3) * 64);
        FA_SBAR();
        pv_d0(o, vb0 + SHM_V, pa0, pa1, pa2, pa3); partialSM(pA0, pA1, m_reg, mnA, alA);
        __syncthreads(); FA_SWAIT(); FA_SWRITE(1, SO);
        FA_RESC(alA); __syncthreads();
    }
    FA_SBAR(); qkt<DQK>(pB0, pB1, K_lds + SHM_K, qr, r32, hi);
    finishSM(pA0, pA1, alA, l_reg, pa0, pa1, pa2, pa3); FA_SBAR();
    pv_d0(o, vb0, pa0, pa1, pa2, pa3); partialSM(pB0, pB1, m_reg, mnB, alB);
    __syncthreads(); FA_RESC(alB);
    finishSM(pB0, pB1, alB, l_reg, pa0, pa1, pa2, pa3); FA_SBAR();
    pv_d0(o, vb0 + SHM_V, pa0, pa1, pa2, pa3);
    if (hi == 0) li_l[r32] = l_reg;
    asm volatile("s_waitcnt lgkmcnt(0)" ::: "memory");
    float rli[16];
#pragma unroll
    for (int r = 0; r < 16; ++r) rli[r] = __builtin_amdgcn_rcpf(li_l[crow(r, hi)]);
    f16* Ow = Ob + (size_t)(wid * 32) * 512;
#pragma unroll
    for (int r = 0; r < 16; ++r) { const int orow = crow(r, hi);
#pragma unroll
        for (int d0 = 0; d0 < 2; ++d0) Ow[(size_t)orow * 512 + d0 * 32 + r32] = (f16)(o[d0][r] * rli[r]); }
#undef FA_SLOAD
#undef FA_SWRITE
#undef FA_SWAIT
#undef FA_RESC
}
}
__device__ __forceinline__ void phase_attn_flash(const Ctx& C, int l) {
    const f16* QA = (const f16*)(C.ws() + A_QA); const f16* QC = (const f16*)(C.ws() + A_QC);
    const f16* KA = (const f16*)(C.ws() + A_KA); const f16* VA = (const f16*)(C.ws() + A_VA);
    const f16* KC = (const f16*)(C.ws() + A_KC); const f16* VC = (const f16*)(C.ws() + A_VC);
    f16* YA = (f16*)(C.ws() + A_YA); f16* YC = (f16*)(C.ws() + A_YC);
    const int vcu = (C.nblk % 8 == 0) ? (C.bid % 8) * (C.nblk / 8) + C.bid / 8 : C.bid;
    const int total = 1024 + (l == 0 ? 64 : 0);
    for (int u = vcu; u < total; u += C.nblk) {
        __syncthreads();
        int typeC, b, h, nkeys; size_t qrow, orow;
        if (u < 1024) { const int v = u & 511; typeC = u >> 9; b = v >> 7; h = (v >> 4) & 7; const int qb = v & 15; qrow = (size_t)(b * 8 + h) * SEQ + qb * 256; orow = (size_t)b * SEQ + qb * 256; nkeys = NKEY; }
        else { const int v = (u - 1024) & 31; typeC = (u - 1024) >> 5; b = v >> 3; h = v & 7; qrow = (size_t)NB * 8 * SEQ + (size_t)(b * 8 + h) * CTX; orow = (size_t)NLAT + b * CTX; nkeys = CTX; }
        if (!typeC) fa::attn_unit<64>(QA + qrow * 64, KA + (size_t)(b * 2 + (h >> 2)) * NKEY * 64, VA + (size_t)(b * 2 + (h >> 2)) * NKEY * 64, YA + orow * 512 + h * 64, nkeys, C.lds, C.tid);
        else fa::attn_unit<96>(QC + qrow * 96, KC + (size_t)(b * 8 + h) * NKEY * 96, VC + (size_t)(b * 8 + h) * NKEY * 64, YC + orow * 512 + h * 64, nkeys, C.lds, C.tid);
    }
}

constexpr float S5SC = 1024.0f, S5ISC = 1.0f / 1024.0f;
__device__ __forceinline__ void qp_split(int qp, int& b, int& nmem) { if (qp < 1024) { b = qp >> 8; nmem = 16 + (qp & 255); } else { b = (qp - 1024) >> 4; nmem = (qp - 1024) & 15; } }
__device__ __forceinline__ void phase_s5tab(const Ctx& C, int l) {
    LAS float* ApR = (LAS float*)C.lds; LAS float* ApI = ApR + 17 * 64; LAS float* BbR = ApI + 17 * 64; LAS float* BbI = BbR + 1024; LAS float* CR = BbI + 1024; LAS float* CI = CR + 1024;
    for (int u = C.bid; u < 64; u += C.nblk) {
        const int dir = u >> 5, g = u & 31; const size_t gi = (size_t)(l * 2 + dir) * 32 + g;
        const float dt = expf(C.in(I_SLDT)[gi]);
        __syncthreads();
        for (int i = C.tid; i < 17 * 64; i += NTHREADS) {
            const int p = i & 63, k = i >> 6; const float are = C.in(I_SARE)[gi * 64 + p], aim = C.in(I_SAIM)[gi * 64 + p];
            const float mag = expf(are * dt * (float)k), ang = (aim * dt) * (float)k;
            ApR[i] = mag * cosf(ang); ApI[i] = mag * sinf(ang);
        }
        for (int i = C.tid; i < 1024; i += NTHREADS) {
            const int p = i >> 4, c = i & 15; const float are = C.in(I_SARE)[gi * 64 + p], aim = C.in(I_SAIM)[gi * 64 + p];
            const float mag = expf(are * dt), th = aim * dt, abr = mag * cosf(th), abi = mag * sinf(th);
            const float den = are * are + aim * aim, nr = abr - 1.0f, cr = (nr * are + abi * aim) / den, ci = (abi * are - nr * aim) / den;
            const float br = C.in(I_SBRE)[(gi * 64 + p) * 16 + c], bi = C.in(I_SBIM)[(gi * 64 + p) * 16 + c];
            BbR[i] = cr * br - ci * bi; BbI[i] = cr * bi + ci * br;
            CR[i] = C.in(I_SCRE)[gi * 1024 + i]; CI[i] = C.in(I_SCIM)[gi * 1024 + i];
        }
        __syncthreads();
        f16* Et = (f16*)(C.ws() + T_E) + (size_t)u * 16 * 16 * 128; f16* Mt = (f16*)(C.ws() + T_M); f16* Kt = (f16*)(C.ws() + T_K) + (size_t)u * 17 * 256;
        for (int i = C.tid; i < 16384; i += NTHREADS) {
            { const int t = i >> 10, c = (i >> 6) & 15, p = i & 63, k = dir == 0 ? t + 1 : 16 - t;
              const float cr = CR[c * 64 + p], ci = CI[c * 64 + p], ar = ApR[k * 64 + p], ai = ApI[k * 64 + p];
              Et[(size_t)(t * 16 + c) * 128 + p] = (f16)((cr * ar - ci * ai) * S5SC); Et[(size_t)(t * 16 + c) * 128 + 64 + p] = (f16)(-(cr * ai + ci * ar) * S5SC); }
            { const int p = i >> 8, sx = (i >> 4) & 15, c = i & 15, k = dir == 0 ? 15 - sx : sx;
              const float ar = ApR[k * 64 + p], ai = ApI[k * 64 + p], br = BbR[p * 16 + c], bi = BbI[p * 16 + c];
              Mt[m3_off(u, p >> 5, sx, c >> 3, p & 31) + (c & 7)] = (f16)((ar * br - ai * bi) * S5SC);
              Mt[m3_off(u, 2 + (p >> 5), sx, c >> 3, p & 31) + (c & 7)] = (f16)((ar * bi + ai * br) * S5SC); }
        }
        for (int i = C.tid; i < 17 * 256; i += NTHREADS) {
            const int tau = (i >> 8) - 1, c = (i >> 4) & 15, cp = i & 15; float acc = 0.f;
            if (tau >= 0) {
#pragma unroll 8
                for (int p = 0; p < 64; ++p) {
                    const float cr = CR[c * 64 + p], ci = CI[c * 64 + p], ar = ApR[tau * 64 + p], ai = ApI[tau * 64 + p];
                    acc += (cr * ar - ci * ai) * BbR[p * 16 + cp] - (cr * ai + ci * ar) * BbI[p * 16 + cp]; }
            }
            Kt[i] = (f16)(acc * S5SC);
        }
    }
}
__device__ __forceinline__ void phase_s5a(const Ctx& C) {
    const f16* U = (const f16*)(C.ws() + A_U); float* S = (float*)(C.ws() + A_S5S); const f16* Mt = (const f16*)(C.ws() + T_M);
    const int r32 = C.lane & 31, hi = C.lane >> 5;
    for (int u = C.bid * NWAVES + C.wid; u < 64 * 34; u += C.nblk * NWAVES) {
        const int dirg = u / 34, nb = u - dirg * 34, g = dirg & 31;
        int b, nmem; qp_split(nb * 32 + r32, b, nmem);
        f16x8 uf[16];
#pragma unroll
        for (int sx = 0; sx < 16; ++sx) uf[sx] = *(const f16x8*)(U + u3_off(g, nb, sx, hi, r32));
        float* sp = S + ((size_t)(dirg * 4 + b) * 128) * 272 + nmem;
#pragma unroll
        for (int mb = 0; mb < 4; ++mb) {
            f16x8 af[16];
#pragma unroll
            for (int sx = 0; sx < 16; ++sx) af[sx] = *(const f16x8*)(Mt + m3_off(dirg, mb, sx, hi, r32));
            f32x16 acc = {};
#pragma unroll
            for (int sx = 0; sx < 16; ++sx) acc = __builtin_amdgcn_mfma_f32_32x32x16_f16(af[sx], uf[sx], acc, 0, 0, 0);
#pragma unroll
            for (int r = 0; r < 16; ++r) sp[(size_t)(mb * 32 + fa::crow(r, hi)) * 272] = acc[r] * S5ISC;
        }
    }
}
__device__ __forceinline__ void phase_s5b(const Ctx& C, int l) {
    const float* S = (const float*)(C.ws() + A_S5S); f16* X = (f16*)(C.ws() + A_S5X);
    for (int item = C.wid * C.nblk + C.bid; item < 256; item += C.nblk * NWAVES) {
        const int p = C.lane, db = item, dirg = db >> 2, b = db & 3, dir = dirg >> 5, g = dirg & 31; const size_t gi = (size_t)(l * 2 + dir) * 32 + g;
        const float are = C.in(I_SARE)[gi * 64 + p], aim = C.in(I_SAIM)[gi * 64 + p], dt = expf(C.in(I_SLDT)[gi]);
        const float mag = expf(are * dt * 16.0f), ang = (aim * dt) * 16.0f, ar = mag * cosf(ang), ai = mag * sinf(ang);
        const float* sr = S + ((size_t)db * 128 + p) * 272; const float* si = sr + 64 * 272;
        const int kkr = p >> 4, hf = (p >> 3) & 1, jj = p & 7;
        float xr = 0.f, xi = 0.f;
        f32x4 cr[4], ci[4], nr[4], ni[4];
        int base = 0;
#pragma unroll
        for (int j = 0; j < 4; ++j) { cr[j] = *(const f32x4*)(sr + base + 4 * j); ci[j] = *(const f32x4*)(si + base + 4 * j); }
#pragma unroll 1
        for (int k = 0; k < 17; ++k) {
            const int nbase = dir == 0 ? 16 * (k + 1) : 272 - 16 * (k + 1);
            if (k < 16) {
#pragma unroll
                for (int j = 0; j < 4; ++j) { nr[j] = *(const f32x4*)(sr + nbase + 4 * j); ni[j] = *(const f32x4*)(si + nbase + 4 * j); }
            }
#pragma unroll
            for (int e = 0; e < 16; ++e) {
                const int ef = e, eb = 15 - e;
                const float sre = dir == 0 ? cr[ef >> 2][ef & 3] : cr[eb >> 2][eb & 3], sim = dir == 0 ? ci[ef >> 2][ef & 3] : ci[eb >> 2][eb & 3];
                const int nmem = base + (dir == 0 ? ef : eb);
                const int qp = nmem >= 16 ? b * 256 + nmem - 16 : 1024 + b * 16 + nmem;
                X[x3_off(dirg, qp >> 5, kkr, hf, qp & 31) + jj] = (f16)xr; X[x3_off(dirg, qp >> 5, 4 + kkr, hf, qp & 31) + jj] = (f16)xi;
                const float nxr = ar * xr - ai * xi + sre, nxi = ar * xi + ai * xr + sim; xr = nxr; xi = nxi;
            }
#pragma unroll
            for (int j = 0; j < 4; ++j) { cr[j] = nr[j]; ci[j] = ni[j]; }
            base = nbase;
        }
    }
}
__device__ __forceinline__ void phase_s5c(const Ctx& C, int l) {
    const f16* U = (const f16*)(C.ws() + A_U); const f16* X = (const f16*)(C.ws() + A_S5X); f16* G = (f16*)(C.ws() + A_G);
    const int r32 = C.lane & 31, hi = C.lane >> 5, t0 = 2 * C.wid, trow = t0 + (r32 >> 4), crw = r32 & 15;
    const int nnb = l == 0 ? 34 : 32;
    LAS f16* Kl = (LAS f16*)C.lds;
    int cur_g = -1; f16x8 ef[2][8];
    for (int u = C.bid; u < 32 * nnb; u += C.nblk) {
        const int g = u & 31, nb = u >> 5;
        const int row0 = (nb * 32 + r32) * 16;
        f16x8 uf[16], xf[2][8]; f16x4 u4[2][2];
#pragma unroll
        for (int sx = 0; sx < 16; ++sx) uf[sx] = *(const f16x8*)(U + u3_off(g, nb, sx, hi, r32));
#pragma unroll
        for (int dir = 0; dir < 2; ++dir)
#pragma unroll
            for (int kk = 0; kk < 8; ++kk) xf[dir][kk] = *(const f16x8*)(X + x3_off(dir * 32 + g, nb, kk, hi, r32));
#pragma unroll
        for (int tl = 0; tl < 2; ++tl)
#pragma unroll
            for (int gp = 0; gp < 2; ++gp) u4[tl][gp] = *(const f16x4*)(U + u3_off(g, nb, t0 + tl, gp, r32) + 4 * hi);
        if (g != cur_g) {
            __syncthreads();
            for (int i = C.tid; i < 2 * 17 * 256 / 8; i += NTHREADS) {
                const int dir = i / (17 * 32), j = i - dir * (17 * 32);
                *(LAS f16x8*)(Kl + (size_t)i * 8) = *(const f16x8*)((const f16*)(C.ws() + T_K) + (size_t)(dir * 32 + g) * 17 * 256 + j * 8);
            }
#pragma unroll
            for (int dir = 0; dir < 2; ++dir)
#pragma unroll
                for (int kk = 0; kk < 8; ++kk) ef[dir][kk] = *(const f16x8*)((const f16*)(C.ws() + T_E) + (size_t)(dir * 32 + g) * 16 * 16 * 128 + (size_t)(trow * 16 + crw) * 128 + kk * 16 + 8 * hi);
            __syncthreads();
            cur_g = g;
        }
        f32x16 acc = {};
        const LAS f16* kb = Kl + crw * 16 + 8 * hi;
#pragma unroll
        for (int sx = 0; sx < 16; ++sx) {
            if (sx <= t0 + 1) { const f16x8 af = *(const LAS f16x8*)(kb + (trow - sx + 1) * 256); acc = __builtin_amdgcn_mfma_f32_32x32x16_f16(af, uf[sx], acc, 0, 0, 0); }
            if (sx >= t0) { const f16x8 af = *(const LAS f16x8*)(kb + (17 + sx - trow + 1) * 256); acc = __builtin_amdgcn_mfma_f32_32x32x16_f16(af, uf[sx], acc, 0, 0, 0); }
        }
#pragma unroll
        for (int dir = 0; dir < 2; ++dir)
#pragma unroll
            for (int kk = 0; kk < 8; ++kk) acc = __builtin_amdgcn_mfma_f32_32x32x16_f16(ef[dir][kk], xf[dir][kk], acc, 0, 0, 0);
#pragma unroll
        for (int tl = 0; tl < 2; ++tl)
#pragma unroll
            for (int gp = 0; gp < 2; ++gp) {
                const size_t off = (size_t)(row0 + t0 + tl) * 512 + g * 16 + 4 * hi + 8 * gp;
                const f32x4 d4 = *(const f32x4*)(C.in(I_SD) + l * 512 + g * 16 + 4 * hi + 8 * gp);
                f32x4 y;
#pragma unroll
                for (int e = 0; e < 4; ++e) y[e] = gelu_tanh(acc[8 * tl + 4 * gp + e] * S5ISC + d4[e] * (float)u4[tl][gp][e]);
                *(f16x4*)(G + off) = pack4(y);
            }
    }
}

__device__ __forceinline__ void phase_s5_naive(const Ctx& C, int l) {
    const f16* U = (const f16*)(C.ws() + A_U); float* YSF = (float*)(C.ws() + A_YSF);
    LAS float* cst = (LAS float*)C.lds + C.wid * (16 * 128 + 4 * 128);
    LAS float* sst = cst + 16 * 128;
    const int lane = C.lane;
    for (int u = C.bid * NWAVES + C.wid; u < NB * 32; u += C.nblk * NWAVES) {
        const int b = u >> 5, g = u & 31;
        for (int dir = 0; dir < 2; ++dir) {
            const size_t gi = ((size_t)(l * 2 + dir) * 32 + g);
            const float are = C.in(I_SARE)[gi * 64 + lane], aim = C.in(I_SAIM)[gi * 64 + lane];
            const float dt = expf(C.in(I_SLDT)[gi]);
            const float mag = expf(are * dt), th = aim * dt;
            const float abr = mag * cosf(th), abi = mag * sinf(th);
            const float den = are * are + aim * aim, nr = abr - 1.0f;
            const float cr = (nr * are + abi * aim) / den, ci = (abi * are - nr * aim) / den;
            float bbr[16], bbi[16];
#pragma unroll
            for (int c = 0; c < 16; ++c) {
                const float br = C.in(I_SBRE)[(gi * 64 + lane) * 16 + c], bi = C.in(I_SBIM)[(gi * 64 + lane) * 16 + c];
                bbr[c] = cr * br - ci * bi; bbi[c] = cr * bi + ci * br; }
#pragma unroll
            for (int c = 0; c < 16; ++c) { cst[c * 128 + lane] = C.in(I_SCRE)[(gi * 16 + c) * 64 + lane]; cst[c * 128 + 64 + lane] = C.in(I_SCIM)[(gi * 16 + c) * 64 + lane]; }
            asm volatile("s_waitcnt lgkmcnt(0)" ::: "memory");
            float xr = 0.f, xi = 0.f;
            const int tk = lane >> 4, cc = lane & 15;
            const float dcoef = C.in(I_SD)[l * 512 + g * 16 + cc];
            for (int i0 = 0; i0 < NKEY; i0 += 4) {
                int rows[4];
#pragma unroll
                for (int k = 0; k < 4; ++k) {
                    const int i = i0 + k; int row;
                    if (dir == 0) row = i < CTX ? NLAT + b * CTX + i : b * SEQ + (i - CTX);
                    else row = i < CTX ? NLAT + b * CTX + (CTX - 1 - i) : b * SEQ + (SEQ - 1 - (i - CTX));
                    rows[k] = row;
                    const f16x8 u0 = *(const f16x8*)(U + (size_t)row * 512 + g * 16), u1 = *(const f16x8*)(U + (size_t)row * 512 + g * 16 + 8);
                    float bur = 0.f, bui = 0.f;
#pragma unroll
                    for (int c = 0; c < 8; ++c) { bur += bbr[c] * (float)u0[c] + bbr[8 + c] * (float)u1[c]; bui += bbi[c] * (float)u0[c] + bbi[8 + c] * (float)u1[c]; }
                    const float nxr = abr * xr - abi * xi + bur, nxi = abr * xi + abi * xr + bui;
                    xr = nxr; xi = nxi;
                    sst[k * 128 + lane] = xr; sst[k * 128 + 64 + lane] = xi;
                }
                asm volatile("s_waitcnt lgkmcnt(0)" ::: "memory");
                float y = 0.f;
#pragma unroll 16
                for (int p = 0; p < 64; ++p) y += cst[cc * 128 + p] * sst[tk * 128 + p] - cst[cc * 128 + 64 + p] * sst[tk * 128 + 64 + p];
                asm volatile("s_waitcnt lgkmcnt(0)" ::: "memory");
                int myrow = rows[0];
#pragma unroll
                for (int k = 1; k < 4; ++k) myrow = (tk == k) ? rows[k] : myrow;
                if (myrow < NLAT || l == 0) {
                    float* dst = YSF + (size_t)myrow * 512 + g * 16 + cc;
                    if (dir == 0) *dst = y + dcoef * (float)U[(size_t)myrow * 512 + g * 16 + cc];
                    else *dst = *dst + y;
                }
            }
            asm volatile("s_waitcnt vmcnt(0)" ::: "memory");
            __builtin_amdgcn_fence(__ATOMIC_RELEASE, "workgroup");
        }
    }
}
__device__ __forceinline__ void phase_s5_gelu(const Ctx& C, int nrows) {
    const float* YSF = (const float*)(C.ws() + A_YSF); f16* G = (f16*)(C.ws() + A_G);
    const size_t n4 = (size_t)nrows * 512 / 4;
    for (size_t i = (size_t)C.bid * NTHREADS + C.tid; i < n4; i += (size_t)C.nblk * NTHREADS) {
        f32x4 v = ((const f32x4*)YSF)[i];
#pragma unroll
        for (int e = 0; e < 4; ++e) v[e] = gelu_tanh(v[e]);
        ((f16x4*)G)[i] = pack4(v);
    }
}

typedef __attribute__((address_space(1))) unsigned gu32;
#define XB_TMO      128
#define XB_XCNT(j)  (256  + 64 * (j))
#define XB_XSUB(j)  (1280 + 64 * (j))
#define XB_XGEN(j)  (2304 + 64 * (j))
#define XB_TOP      3328
#define XB_TOPGEN   3392
#define XCD_BAR_WORDS 3456
#define XB_SPIN_CAP (1u << 26)

__device__ __forceinline__ unsigned xb_ld(unsigned* p)              { return __hip_atomic_load(p, __ATOMIC_RELAXED, __HIP_MEMORY_SCOPE_AGENT); }
__device__ __forceinline__ unsigned xb_add(unsigned* p, unsigned v) { return __hip_atomic_fetch_add(p, v, __ATOMIC_RELAXED, __HIP_MEMORY_SCOPE_AGENT); }
__device__ __forceinline__ unsigned xb_xcc_id() { return (unsigned)__builtin_amdgcn_s_getreg((3 << 11) | 20) & 0xFu; }
#define XB_SPIN(cond, bar) do { unsigned _sp = 0; while (cond) { __builtin_amdgcn_s_sleep(1); \
    if ((++_sp & 255u) == 0u) { if (xb_ld(&(bar)[XB_TMO])) break; if (_sp > XB_SPIN_CAP) { atomicAdd(&(bar)[XB_TMO], 1u); break; } } } } while (0)

struct XcdBarrier {
    unsigned* bar; unsigned x;
    volatile LAS unsigned* st;
};

__device__ __forceinline__ XcdBarrier xcd_barrier_post(unsigned* bar, volatile LAS unsigned* st) {
    XcdBarrier b; b.bar = bar; b.x = xb_xcc_id(); b.st = st;
    if (threadIdx.x == 0) (void)xb_add(&bar[XB_XCNT(b.x)], 1u);
    return b;
}
__device__ __forceinline__ void xcd_barrier_complete(unsigned* bar, unsigned x, unsigned& nloc, unsigned& nx) {
    const unsigned G = gridDim.x * gridDim.y * gridDim.z;
    unsigned sum, cnt, mine, sp = 0u;
    for (;;) {
        sum = 0u; cnt = 0u; mine = 0u;
#pragma unroll
        for (unsigned j = 0; j < 16; ++j) { const unsigned c = xb_ld(&bar[XB_XCNT(j)]); sum += c; cnt += (c > 0u) ? 1u : 0u; mine = (j == x) ? c : mine; }
        if (sum == G) break;
        __builtin_amdgcn_s_sleep(1);
        if ((++sp & 255u) == 0u) { if (xb_ld(&bar[XB_TMO])) break; if (sp > XB_SPIN_CAP) { atomicAdd(&bar[XB_TMO], 1u); break; } }
    }
    nloc = mine > 0u ? mine : 1u; nx = cnt > 0u ? cnt : 1u;
}

__device__ __forceinline__ void xcd_barrier(const XcdBarrier& b, const bool t0) {
    asm volatile("s_waitcnt vmcnt(0)" ::: "memory");
    __syncthreads();
    if (t0) {
        unsigned* bar = b.bar;
        __builtin_amdgcn_s_waitcnt(0);
        unsigned nloc = b.st[0], nx = b.st[1];
        if (nloc == 0u) { xcd_barrier_complete(bar, b.x, nloc, nx); b.st[0] = nloc; b.st[1] = nx; }
        const unsigned old = xb_add(&bar[XB_XSUB(b.x)], 1u);
        const unsigned gen = old / nloc;
        if (old + 1u == (gen + 1u) * nloc) {
            __builtin_amdgcn_fence(__ATOMIC_RELEASE, "agent");
            asm volatile("s_waitcnt vmcnt(0)" ::: "memory");
            const unsigned og = xb_add(&bar[XB_TOP], 1u);
            const unsigned tg = og / nx;
            if (og + 1u == (tg + 1u) * nx) xb_add(&bar[XB_TOPGEN], 1u);
            else XB_SPIN(xb_ld(&bar[XB_TOPGEN]) == tg, bar);
            __builtin_amdgcn_fence(__ATOMIC_ACQUIRE, "agent");
            xb_add(&bar[XB_XGEN(b.x)], 1u);
            asm volatile("s_waitcnt vmcnt(0)" ::: "memory");
        } else {
            XB_SPIN(xb_ld(&bar[XB_XGEN(b.x)]) == gen, bar);
            __builtin_amdgcn_fence(__ATOMIC_ACQUIRE, "agent");
            asm volatile("s_waitcnt vmcnt(0)" ::: "memory");
        }
    }
    __syncthreads();
}

#ifndef PROBE_PH
#define PROBE_PH -1
#endif
struct Env { XcdBarrier bar; int wid; unsigned long long t_acc; };
#define PH_BEGIN(k) unsigned long long _t0 = 0; if (PROBE_PH == (k)) _t0 = __builtin_amdgcn_s_memrealtime()
#define PH_END(k) if (PROBE_PH == (k)) env.t_acc += __builtin_amdgcn_s_memrealtime() - _t0
#define GSYNC() do { const Ctx Cb = make_ctx(env.wid); xcd_barrier(env.bar, Cb.tid == 0); } while (0)
constexpr int MISC_OFF = LDS_BYTES - 256;
constexpr int CW_BAR = 4096;
#define CTX() const Ctx C = make_ctx(env.wid); unsigned char* ws = C.ws()
template <int l>
__device__ __forceinline__ void layer_body(Env& env) {
        const int mrows = l == 0 ? MALL : NLAT;
        if (l == 0) { PH_BEGIN(0);
        { CTX(); (void)ws; if (C.nblk > 128) { if (C.bid < 64) phase_s5tab(C, 0); else phase_cvt(C, 0, 64); } else { phase_s5tab(C, 0); __syncthreads(); phase_cvt(C, 0, 0); } phase_p1(C, 0); }
        GSYNC(); PH_END(0); }
        { PH_BEGIN(1);
        { CTX(); EpiStore E{(f16*)(ws + A_PROJ), PLD};
          gemm_pg8(C, (const f16*)(ws + A_H), D, (const f16*)(ws + W_INA), D, MALL, 2560, D, E); }
        GSYNC(); PH_END(1); }
        { PH_BEGIN(2);
        { CTX(); (void)ws; phase_p3(C, l); }
        GSYNC(); PH_END(2); }
        { PH_BEGIN(3);
        { CTX(); EpiKvUp E1{(f16*)(ws + A_KC), (f16*)(ws + A_VC)};
          gemm_rows(C, (const f16*)(ws + A_PROJ) + OFF_CKV, PLD, (const f16*)(ws + W_KVB), 256, MALL, 1024, 256, E1); }
        { CTX(); EpiQUp E2{(f16*)(ws + A_QC), (const float*)(ws + WS_ROPE) + 2048};
          gemm_pg8(C, (const f16*)(ws + A_PROJ) + OFF_CQ, PLD, (const f16*)(ws + W_QB), 768, mrows, 768, 768, E2); }
        GSYNC(); PH_END(3); }
        { PH_BEGIN(4);
        { CTX(); (void)ws; phase_s5a(C); }
        { CTX(); (void)ws; phase_attn_flash(C, l); }
        GSYNC(); PH_END(4); }
        { PH_BEGIN(5);
        { CTX(); (void)ws; phase_s5b(C, l); }
        GSYNC(); PH_END(5); }
        { PH_BEGIN(6);
        { CTX(); (void)ws; phase_s5c(C, l); }
        { CTX(); (void)ws; phase_hre(C, l, mrows); }
        GSYNC(); PH_END(6); }
        { PH_BEGIN(7);
        { CTX(); EpiGlu E{(f16*)(ws + A_YS)};
          gemm_rows(C, (const f16*)(ws + A_G), 512, (const f16*)(ws + W_GLU), 512, mrows, 1024, 512, E); }
        GSYNC(); PH_END(7); }
        { PH_BEGIN(8);
#pragma unroll
        for (int br = 0; br < 3; ++br) {
            { CTX(); EpiGate Eg{(f16*)(ws + A_GATE)};
              gemm_rows(C, (const f16*)(ws + A_H), D, (const f16*)(ws + W_GATE) + (size_t)br * 1024 * 1024, D, mrows, 1024, D, Eg); }
            { CTX(); const f16* Y = (const f16*)(ws + (br == 0 ? A_YA : br == 1 ? A_YS : A_YC));
              EpiBranch Eb{(const f16*)(ws + A_GATE), (f16*)(ws + A_MERGED), br == 0};
              gemm_rows(C, Y, 512, (const f16*)(ws + W_BR) + (size_t)br * 1024 * 512, 512, mrows, 1024, 512, Eb); }
        }
        GSYNC(); PH_END(8); }
        { PH_BEGIN(9);
        { CTX(); EpiWout E{&C, l}; gemm_rows(C, (const f16*)(ws + A_MERGED), D, (const f16*)(ws + W_OUT), D, mrows, 1024, D, E); }
        GSYNC(); PH_END(9); }
        { PH_BEGIN(10);
        { CTX(); (void)ws; phase_p10(C, l, mrows); }
        GSYNC(); PH_END(10); }
        { PH_BEGIN(11);
        { CTX(); EpiUp E{(f16*)(ws + A_HID)}; gemm_rows(C, (const f16*)(ws + A_H), D, (const f16*)(ws + W_UP), D, mrows, DFF, D, E); }
        GSYNC(); PH_END(11); }
        { PH_BEGIN(12);
        { CTX(); EpiDown E{&C, l}; gemm_rows(C, (const f16*)(ws + A_HID), DFF, (const f16*)(ws + W_DOWN), DFF, mrows, 1024, DFF, E); }
        GSYNC(); PH_END(12); }
        { PH_BEGIN(13);
        if (l == 0) { CTX(); (void)ws; if (C.nblk > 128) { if (C.bid < 64) phase_s5tab(C, 1); else phase_cvt(C, 1, 64); } else { phase_s5tab(C, 1); __syncthreads(); phase_cvt(C, 1, 0); } }
        { CTX(); (void)ws; phase_p13(C, l, mrows); }
        if (l == 0) GSYNC(); PH_END(13); }
}
__global__ void __launch_bounds__(NTHREADS, 2) fwd_all(Args args) {
    cg::grid_group grid = cg::this_grid();
    extern __shared__ __attribute__((aligned(16))) unsigned char lds_raw[];
    volatile LAS unsigned* MISC = (volatile LAS unsigned*)((LAS unsigned char*)lds_raw + MISC_OFF);
    if (threadIdx.x < 64) MISC[threadIdx.x] = 0u;
    __syncthreads();
    Env env; env.t_acc = 0; env.wid = __builtin_amdgcn_readfirstlane(threadIdx.x >> 6);
    env.bar = xcd_barrier_post((unsigned*)(args.ws + WS_CTL) + CW_BAR, MISC + 8);
    { CTX(); (void)ws; phase_setup(C); }
    asm volatile("s_waitcnt vmcnt(0)" ::: "memory");
    grid.sync();
    __builtin_amdgcn_fence(__ATOMIC_ACQUIRE, "agent");
    asm volatile("s_waitcnt vmcnt(0)" ::: "memory");
    layer_body<0>(env);
    layer_body<1>(env);
    if (PROBE_PH >= 0 && blockIdx.x == 0) { const unsigned long long t0 = __builtin_amdgcn_s_memrealtime(); while (__builtin_amdgcn_s_memrealtime() - t0 < 8ull * env.t_acc) __builtin_amdgcn_s_sleep(8); }
}

extern "C" void kernel_launch(void* const* d_in, const int* in_sizes, int n_in, void* d_out, int out_size, void* d_ws, size_t ws_size, hipStream_t stream) {
    static int grid_blocks = 0;
    if (grid_blocks == 0) {
        if (n_in != 32 || out_size != NLAT * D || ws_size < WS_NEED) { fprintf(stderr, "kernel_launch: unexpected shapes n_in %d out %d ws %zu (need %zu)\n", n_in, out_size, ws_size, (size_t)WS_NEED); grid_blocks = -1; return; }
        int dev = 0, cus = 0, per_cu = 0;
        hipGetDevice(&dev);
        hipDeviceGetAttribute(&cus, hipDeviceAttributeMultiprocessorCount, dev);
        if (hipFuncSetAttribute((const void*)fwd_all, hipFuncAttributeMaxDynamicSharedMemorySize, LDS_BYTES) != hipSuccess) { fprintf(stderr, "kernel_launch: hipFuncSetAttribute failed\n"); grid_blocks = -1; return; }
        hipOccupancyMaxActiveBlocksPerMultiprocessor(&per_cu, (const void*)fwd_all, NTHREADS, LDS_BYTES);
        if (per_cu < 1) { fprintf(stderr, "kernel_launch: occupancy query says %d blocks per CU\n", per_cu); grid_blocks = -1; return; }
        grid_blocks = cus;
    }
    if (grid_blocks < 0) return;
    Args a{};
    for (int i = 0; i < 32; ++i) a.in[i] = (const float*)d_in[i];
    a.out = (float*)d_out; a.ws = (unsigned char*)d_ws;
    if (hipMemsetAsync((char*)d_ws + WS_CTL, 0, 1 * MiB, stream) != hipSuccess) { fprintf(stderr, "kernel_launch: hipMemsetAsync failed\n"); return; }
    void* kargs[] = {&a};
    const hipError_t e = hipLaunchCooperativeKernel((const void*)fwd_all, dim3(grid_blocks), dim3(NTHREADS), kargs, LDS_BYTES, stream);
    if (e != hipSuccess) fprintf(stderr, "kernel_launch: cooperative launch failed: %s (grid %d)\n", hipGetErrorString(e), grid_blocks);
}
```

```cpp
#include <hip/hip_runtime.h>
#include <hip/hip_cooperative_groups.h>
#include <cstdio>
#include <cstdint>
#include <cmath>

namespace cg = cooperative_groups;

#define LAS __attribute__((address_space(3)))
typedef _Float16 f16;
typedef _Float16 f16x8 __attribute__((ext_vector_type(8)));
typedef _Float16 f16x4 __attribute__((ext_vector_type(4)));
typedef float f32x4 __attribute__((ext_vector_type(4)));
typedef float f32x16 __attribute__((ext_vector_type(16)));

constexpr int D = 1024, NB = 4, SEQ = 4096, CTX = 256, NLAT = NB * SEQ, NCTX = NB * CTX, MALL = NLAT + NCTX;
constexpr int NKEY = CTX + SEQ;
constexpr int OFF_AK = 0, OFF_AV = 128, OFF_CKV = 256, OFF_CKR = 512, OFF_U = 544, OFF_AQ = 1056, OFF_CQ = 1568, OFF_GATE = 2336, N_IN = 5408;
constexpr int PLD = 2560;
constexpr int DFF = 4096;
constexpr float EPS = 1e-6f;
constexpr float ALPHA = 1.4142135623730951f;
constexpr float LOG2E = 1.4426950408889634f;
constexpr float QSCALE_A = 0.125f * LOG2E;
constexpr float QSCALE_C = 0.10206207261596575f * LOG2E;

constexpr size_t MiB = 1u << 20;
constexpr size_t WS_CTL = 0;
constexpr size_t WS_MOD = 1 * MiB;
constexpr size_t WS_ROPE = 1 * MiB + 512 * 1024;
constexpr size_t WS_W16 = 2 * MiB;
constexpr size_t W_INA = WS_W16;
constexpr size_t W_GATE = W_INA + (size_t)2560 * 1024 * 2;
constexpr size_t W_QB = W_GATE + (size_t)3072 * 1024 * 2;
constexpr size_t W_KVB = W_QB + (size_t)768 * 768 * 2;
constexpr size_t W_GLU = W_KVB + (size_t)1024 * 256 * 2;
constexpr size_t W_BR = W_GLU + (size_t)1024 * 512 * 2;
constexpr size_t W_OUT = W_BR + (size_t)3 * 1024 * 512 * 2;
constexpr size_t W_UP = W_OUT + (size_t)1024 * 1024 * 2;
constexpr size_t W_DOWN = W_UP + (size_t)4096 * 1024 * 2;
constexpr size_t W_END = W_DOWN + (size_t)1024 * 4096 * 2;
constexpr size_t WS_TACTX = 37 * MiB;
constexpr size_t WS_ACT = 41 * MiB;
static_assert(W_END <= WS_TACTX, "weights fit");
constexpr size_t A_H = WS_ACT + 0 * MiB;
constexpr size_t A_QC = WS_ACT + 0 * MiB;
constexpr size_t A_PROJ = WS_ACT + 34 * MiB;
constexpr size_t A_YA = WS_ACT + 34 * MiB;
constexpr size_t A_YC = WS_ACT + 51 * MiB;
constexpr size_t A_YSF = WS_ACT + 68 * MiB;
constexpr size_t A_G = WS_ACT + 68 * MiB;
constexpr size_t A_QA = WS_ACT + 119 * MiB;
constexpr size_t A_YS = WS_ACT + 119 * MiB;
constexpr size_t A_KA = WS_ACT + 136 * MiB;
constexpr size_t A_VA = A_KA + (size_t)NB * 2 * NKEY * 64 * 2;
constexpr size_t A_U = WS_ACT + 145 * MiB;
constexpr size_t A_KC = WS_ACT + 162 * MiB;
constexpr size_t A_VC = WS_ACT + 188 * MiB;
constexpr size_t A_GATE = WS_ACT + 136 * MiB;
constexpr size_t A_MERGED = WS_ACT + 68 * MiB;
constexpr size_t A_T1H = WS_ACT + 170 * MiB;
constexpr size_t WS_ST1 = 1 * MiB + 768 * 1024;
constexpr size_t A_HID = WS_ACT + 34 * MiB;
constexpr size_t A_S5S = WS_ACT + 68 * MiB;
constexpr size_t A_S5X = WS_ACT + 102 * MiB;
constexpr size_t T_K = WS_ACT + 205 * MiB;
constexpr size_t T_E = T_K + (size_t)64 * 17 * 256 * 2;
constexpr size_t T_M = T_E + (size_t)64 * 16 * 16 * 128 * 2;
constexpr size_t WS_NEED = WS_ACT + 215 * MiB;
static_assert(T_M + (size_t)64 * 128 * 256 * 2 <= WS_NEED, "s5 tables");
static_assert(A_VA + (size_t)NB * 2 * NKEY * 64 * 2 <= A_U && A_VC + 17 * MiB <= WS_NEED && A_MERGED + 34 * MiB <= WS_NEED && A_HID + 136 * MiB <= WS_NEED, "ws map");
static_assert(WS_NEED <= 256 * MiB, "ws budget");

constexpr int LDS_BYTES = 147456;
constexpr int NTHREADS = 512, NWAVES = 8;

struct Args {
    const float* in[32];
    float* out;
    unsigned char* ws;
    int ph_lo, ph_hi;
};
enum { I_X = 0, I_C, I_CTX, I_CCTX, I_WMOD, I_BMOD, I_WIN, I_AQG, I_AKG, I_CQG, I_CKVG, I_WQB, I_WKVB, I_SARE, I_SAIM, I_SLDT, I_SBRE, I_SBIM, I_SCRE, I_SCIM,
       I_SD, I_WGLU, I_WBA, I_WBS, I_WBC, I_WOUT, I_LN1G, I_LN1B, I_WUP, I_WDOWN, I_LN2G, I_LN2B };

__device__ __forceinline__ float wave_sum(float v) {
#pragma unroll
    for (int o = 1; o < 64; o <<= 1) v += __shfl_xor(v, o);
    return v;
}
__device__ __forceinline__ float wave_max(float v) {
#pragma unroll
    for (int o = 1; o < 64; o <<= 1) v = fmaxf(v, __shfl_xor(v, o));
    return v;
}
__device__ __forceinline__ float sigmoidf_(float x) { return 1.0f / (1.0f + __expf(-x)); }
__device__ __forceinline__ float gelu_tanh(float x) {
    const float u = 0.7978845608028654f * (x + 0.044715f * x * x * x);
    const float e = __expf(2.0f * u);
    const float t = 1.0f - 2.0f / (e + 1.0f);
    return 0.5f * x * (1.0f + t);
}
__device__ __forceinline__ f16x8 pack8(f32x4 lo, f32x4 hi) {
    f16x8 r; r[0] = (f16)lo[0]; r[1] = (f16)lo[1]; r[2] = (f16)lo[2]; r[3] = (f16)lo[3]; r[4] = (f16)hi[0]; r[5] = (f16)hi[1]; r[6] = (f16)hi[2]; r[7] = (f16)hi[3]; return r;
}
__device__ __forceinline__ f16x4 pack4(f32x4 v) { f16x4 r; r[0] = (f16)v[0]; r[1] = (f16)v[1]; r[2] = (f16)v[2]; r[3] = (f16)v[3]; return r; }

struct RowInfo { int b, t, pos, lat, mrow; };
__device__ __forceinline__ RowInfo row_info(int r) {
    RowInfo o;
    if (r < NLAT) { o.lat = 1; o.b = r >> 12; o.t = r & 4095; o.pos = CTX + o.t; o.mrow = o.b; }
    else { const int rr = r - NLAT; o.lat = 0; o.b = rr >> 8; o.t = rr & 255; o.pos = o.t; o.mrow = 4; }
    return o;
}

#define CAS __attribute__((address_space(4)))
struct Ctx {
    const CAS unsigned char* kp; LAS unsigned char* lds;
    int tid, lane, wid, nblk, bid;
    __device__ __forceinline__ const float* in(int i) const { return *(const float* const CAS*)(kp + 8 * i); }
    __device__ __forceinline__ float* out() const { return *(float* const CAS*)(kp + 256); }
    __device__ __forceinline__ unsigned char* ws() const { return *(unsigned char* const CAS*)(kp + 264); }
    __device__ __forceinline__ const float* mod(int l, int mrow, int which) const { return (const float*)(ws() + WS_MOD) + ((size_t)(l * 5 + mrow) * 6 + which) * D; }
    __device__ __forceinline__ const float* xsrc(int l, int r) const {
        if (l == 0) return r < NLAT ? in(I_X) + (size_t)r * D : in(I_CTX) + (size_t)(r - NLAT) * D;
        return r < NLAT ? out() + (size_t)r * D : (const float*)(ws() + WS_TACTX) + (size_t)(r - NLAT) * D;
    }
    __device__ __forceinline__ float* ta(int r) const { return r < NLAT ? out() + (size_t)r * D : (float*)(ws() + WS_TACTX) + (size_t)(r - NLAT) * D; }
};
__device__ __forceinline__ Ctx make_ctx(int wid) {
    extern __shared__ __attribute__((aligned(16))) unsigned char lds_raw[];
    Ctx C;
    const CAS unsigned char* kp = (const CAS unsigned char*)__builtin_amdgcn_kernarg_segment_ptr();
    asm volatile("" : "+s"(kp));
    C.kp = kp; C.lds = (LAS unsigned char*)lds_raw;
    int lane = __builtin_amdgcn_mbcnt_hi(~0u, __builtin_amdgcn_mbcnt_lo(~0u, 0u)); asm volatile("" : "+v"(lane));
    asm volatile("" : "+s"(wid));
    C.tid = wid * 64 + lane; C.lane = lane; C.wid = wid;
    int bid = blockIdx.x; asm volatile("" : "+s"(bid));
    C.bid = bid; C.nblk = gridDim.x;
    return C;
}

__device__ __forceinline__ void phase_setup(const Ctx& C, int b0) {
    LAS float* sv = (LAS float*)C.lds;
    LAS float* red = sv + 5 * 1024;
    for (int i = C.tid; i < 5 * 1024; i += NTHREADS) {
        const int mr = i >> 10, k = i & 1023;
        const float v = mr < 4 ? C.in(I_C)[mr * D + k] : C.in(I_CCTX)[k];
        sv[i] = v / (1.0f + __expf(-v));
    }
    __syncthreads();
    for (int u = C.bid - b0; u < 192; u += C.nblk - b0) {
        const int l = u / 96, n0 = (u % 96) * 64;
        const float* W = C.in(I_WMOD) + (size_t)l * D * 6144 + n0 + C.lane;
        float acc[5] = {0.f, 0.f, 0.f, 0.f, 0.f};
        const int kb = C.wid * 128;
#pragma unroll 8
        for (int k = 0; k < 128; ++k) {
            const float w = W[(size_t)(kb + k) * 6144];
#pragma unroll
            for (int m = 0; m < 5; ++m) acc[m] += sv[m * 1024 + kb + k] * w;
        }
#pragma unroll
        for (int m = 0; m < 5; ++m) red[(C.wid * 5 + m) * 64 + C.lane] = acc[m];
        __syncthreads();
        if (C.tid < 320) {
            const int m = C.tid >> 6, c = C.tid & 63; float s = 0.f;
#pragma unroll
            for (int w = 0; w < 8; ++w) s += red[(w * 5 + m) * 64 + c];
            ((float*)(C.ws() + WS_MOD))[(size_t)(l * 5 + m) * 6144 + n0 + c] = s + C.in(I_BMOD)[l * 6144 + n0 + c];
        }
        __syncthreads();
    }
    if (C.bid == C.nblk - 1) {
        float* ra = (float*)(C.ws() + WS_ROPE);
        for (int i = C.tid; i < 1024; i += NTHREADS) {
            const int pos = i >> 4, f = i & 15;
            const float inv = powf(10000.0f, -(float)(2 * f) / 32.0f);
            const float ang = (float)pos * inv;
            ra[i] = cosf(ang); ra[1024 + i] = sinf(ang);
        }
        for (int i = C.tid; i < 512; i += NTHREADS) {
            const int pos = i >> 3, f = i & 7;
            const float inv = powf(10000.0f, -(float)(2 * f) / 16.0f);
            const float ang = (float)pos * inv;
            ra[2048 + i] = cosf(ang); ra[2048 + 512 + i] = sinf(ang);
        }
    }
}

__device__ __forceinline__ int glu_row(int n) { const int isg = n >= 512, j = n & 511; return 8 * (j >> 2) + 4 * isg + (j & 3); }
__device__ __forceinline__ void cvt_item(const float* W, int ldw, int coff, int K, int nblk, f16* WT, int mode, LAS float* scr, int item, int lane) {
    const int kb = item / nblk, nb = item % nblk, k0 = 64 * kb, n0 = 32 * nb;
    f32x4 v[8];
#pragma unroll
    for (int i = 0; i < 8; ++i) v[i] = *(const f32x4*)(W + (size_t)(k0 + 8 * i + (lane >> 3)) * ldw + coff + n0 + 4 * (lane & 7));
#pragma unroll
    for (int i = 0; i < 8; ++i) { LAS float* d = scr + (8 * i + (lane >> 3)) * 33 + 4 * (lane & 7); d[0] = v[i][0]; d[1] = v[i][1]; d[2] = v[i][2]; d[3] = v[i][3]; }
    asm volatile("s_waitcnt lgkmcnt(0)" ::: "memory");
    const int c = lane & 7;
#pragma unroll
    for (int j = 0; j < 4; ++j) {
        const int n = (lane >> 3) + 8 * j; const LAS float* sp = scr + (8 * c) * 33 + n;
        f16x8 o;
#pragma unroll
        for (int e = 0; e < 8; ++e) o[e] = (f16)sp[e * 33];
        const int nn = n0 + n; const int row = mode ? glu_row(nn) : nn;
        *(f16x8*)(WT + (size_t)row * K + k0 + 8 * c) = o;
    }
    asm volatile("s_waitcnt lgkmcnt(0)" ::: "memory");
}
__device__ __forceinline__ void cvt_mat(const Ctx& C, const float* src, int ldw, int coff, int K, int N, size_t dst, int mode, int& base, int b0) {
    LAS float* scr = (LAS float*)C.lds + C.wid * (64 * 33);
    const int gw = (C.bid - b0) * NWAVES + C.wid, ngw = (C.nblk - b0) * NWAVES;
    const int nblk = N / 32, items = (K / 64) * nblk;
    int first = gw - (base % ngw); if (first < 0) first += ngw;
    for (int it = first; it < items; it += ngw) cvt_item(src, ldw, coff, K, nblk, (f16*)(C.ws() + dst), mode, scr, it, C.lane);
    base += items;
}
__device__ __forceinline__ void phase_cvt(const Ctx& C, int l, int b0) {
    int base = 0;
    cvt_mat(C, C.in(I_WIN) + (size_t)l * D * N_IN, N_IN, 0, D, OFF_GATE, W_INA, 0, base, b0);
    cvt_mat(C, C.in(I_WIN) + (size_t)l * D * N_IN, N_IN, OFF_GATE, D, 3072, W_GATE, 0, base, b0);
    cvt_mat(C, C.in(I_WQB) + (size_t)l * 768 * 768, 768, 0, 768, 768, W_QB, 0, base, b0);
    cvt_mat(C, C.in(I_WKVB) + (size_t)l * 256 * 1024, 1024, 0, 256, 1024, W_KVB, 0, base, b0);
    cvt_mat(C, C.in(I_WGLU) + (size_t)l * 512 * 1024, 1024, 0, 512, 1024, W_GLU, 1, base, b0);
    cvt_mat(C, C.in(I_WBA) + (size_t)l * 512 * 1024, 1024, 0, 512, 1024, W_BR, 0, base, b0);
    cvt_mat(C, C.in(I_WBS) + (size_t)l * 512 * 1024, 1024, 0, 512, 1024, W_BR + (size_t)1024 * 512 * 2, 0, base, b0);
    cvt_mat(C, C.in(I_WBC) + (size_t)l * 512 * 1024, 1024, 0, 512, 1024, W_BR + (size_t)2 * 1024 * 512 * 2, 0, base, b0);
    cvt_mat(C, C.in(I_WOUT) + (size_t)l * 1024 * 1024, 1024, 0, 1024, 1024, W_OUT, 0, base, b0);
    cvt_mat(C, C.in(I_WUP) + (size_t)l * 1024 * 4096, 4096, 0, 1024, 4096, W_UP, 0, base, b0);
    cvt_mat(C, C.in(I_WDOWN) + (size_t)l * 4096 * 1024, 1024, 0, 4096, 1024, W_DOWN, 0, base, b0);
    f16* pad = (f16*)(C.ws() + W_INA) + (size_t)OFF_GATE * 1024;
    const f16x8 z = {0, 0, 0, 0, 0, 0, 0, 0};
    for (int i = (C.bid - b0) * NTHREADS + C.tid; i < (2560 - OFF_GATE) * 1024 / 8; i += (C.nblk - b0) * NTHREADS) ((f16x8*)pad)[i] = z;
}

__device__ __forceinline__ void row_load(const float* p, int lane, f32x4 (&v)[4]) {
#pragma unroll
    for (int j = 0; j < 4; ++j) v[j] = ((const f32x4*)p)[lane + 64 * j];
}
__device__ __forceinline__ void row_ln(f32x4 (&v)[4]) {
    float s = 0.f;
#pragma unroll
    for (int j = 0; j < 4; ++j) s += (v[j][0] + v[j][1]) + (v[j][2] + v[j][3]);
    const float mean = wave_sum(s) * (1.0f / D);
    float q = 0.f;
#pragma unroll
    for (int j = 0; j < 4; ++j) { v[j] = v[j] - mean; q += (v[j][0] * v[j][0] + v[j][1] * v[j][1]) + (v[j][2] * v[j][2] + v[j][3] * v[j][3]); }
    const float rstd = 1.0f / sqrtf(wave_sum(q) * (1.0f / D) + EPS);
#pragma unroll
    for (int j = 0; j < 4; ++j) v[j] = v[j] * rstd;
}
__device__ __forceinline__ void row_ln_stats(f32x4 (&v)[4], float& mean, float& rstd) {
    float s = 0.f;
#pragma unroll
    for (int j = 0; j < 4; ++j) s += (v[j][0] + v[j][1]) + (v[j][2] + v[j][3]);
    mean = wave_sum(s) * (1.0f / D);
    float q = 0.f;
#pragma unroll
    for (int j = 0; j < 4; ++j) { v[j] = v[j] - mean; q += (v[j][0] * v[j][0] + v[j][1] * v[j][1]) + (v[j][2] * v[j][2] + v[j][3] * v[j][3]); }
    rstd = 1.0f / sqrtf(wave_sum(q) * (1.0f / D) + EPS);
#pragma unroll
    for (int j = 0; j < 4; ++j) v[j] = v[j] * rstd;
}
__device__ __forceinline__ void row_load_h(const f16* p, int lane, f32x4 (&v)[4]) {
#pragma unroll
    for (int j = 0; j < 4; ++j) { const f16x4 h = ((const f16x4*)p)[lane + 64 * j]; v[j] = (f32x4){(float)h[0], (float)h[1], (float)h[2], (float)h[3]}; }
}
__device__ __forceinline__ void row_modulate_store(const f32x4 (&v)[4], const float* sh, const float* sc, f16* o, int lane) {
#pragma unroll
    for (int j = 0; j < 4; ++j) {
        const f32x4 s = ((const f32x4*)sc)[lane + 64 * j], t = ((const f32x4*)sh)[lane + 64 * j];
        const f32x4 y = v[j] * (s + 1.0f) + t;
        ((f16x4*)o)[lane + 64 * j] = pack4(y);
    }
}
__device__ __forceinline__ void phase_p1(const Ctx& C, int l) {
    f16* H = (f16*)(C.ws() + A_H);
    for (int r = C.bid * NWAVES + C.wid; r < MALL; r += C.nblk * NWAVES) {
        const RowInfo ri = row_info(r);
        f32x4 v[4]; row_load(C.xsrc(l, r), C.lane, v); row_ln(v);
        row_modulate_store(v, C.mod(l, ri.mrow, 0), C.mod(l, ri.mrow, 1), H + (size_t)r * D, C.lane);
    }
}
__device__ __forceinline__ void phase_p10(const Ctx& C, int l, int nrows) {
    f16* H = (f16*)(C.ws() + A_H); const f16* T1 = (const f16*)(C.ws() + A_T1H); float* ST = (float*)(C.ws() + WS_ST1);
    const float* g = C.in(I_LN1G) + l * D; const float* bb = C.in(I_LN1B) + l * D;
    for (int r = C.bid * NWAVES + C.wid; r < nrows; r += C.nblk * NWAVES) {
        const RowInfo ri = row_info(r);
        f32x4 v[4]; row_load_h(T1 + (size_t)r * D, C.lane, v);
        float mean, rstd; row_ln_stats(v, mean, rstd);
        if (C.lane == 0) { ST[2 * r] = mean; ST[2 * r + 1] = rstd; }
#pragma unroll
        for (int j = 0; j < 4; ++j) v[j] = v[j] * ((const f32x4*)g)[C.lane + 64 * j] + ((const f32x4*)bb)[C.lane + 64 * j];
        row_ln(v);
        row_modulate_store(v, C.mod(l, ri.mrow, 3), C.mod(l, ri.mrow, 4), H + (size_t)r * D, C.lane);
    }
}
__device__ __forceinline__ void phase_p13(const Ctx& C, int l, int nrows) {
    const float* g = C.in(I_LN2G) + l * D; const float* bb = C.in(I_LN2B) + l * D;
    f16* H = (f16*)(C.ws() + A_H);
    for (int r = C.bid * NWAVES + C.wid; r < nrows; r += C.nblk * NWAVES) {
        float* t = C.ta(r);
        f32x4 v[4]; row_load_h((const f16*)(C.ws() + A_T1H) + (size_t)r * D, C.lane, v); row_ln(v);
#pragma unroll
        for (int j = 0; j < 4; ++j) { v[j] = v[j] * ((const f32x4*)g)[C.lane + 64 * j] + ((const f32x4*)bb)[C.lane + 64 * j]; ((f32x4*)t)[C.lane + 64 * j] = v[j]; }
        if (l == 0) {
            const RowInfo ri = row_info(r);
            row_ln(v);
            row_modulate_store(v, C.mod(1, ri.mrow, 0), C.mod(1, ri.mrow, 1), H + (size_t)r * D, C.lane);
        }
    }
}
__device__ __forceinline__ void phase_hre(const Ctx& C, int l, int nrows) {
    f16* H = (f16*)(C.ws() + A_H);
    for (int r = C.bid * NWAVES + C.wid; r < nrows; r += C.nblk * NWAVES) {
        const RowInfo ri = row_info(r);
        f32x4 v[4]; row_load(C.xsrc(l, r), C.lane, v); row_ln(v);
        row_modulate_store(v, C.mod(l, ri.mrow, 0), C.mod(l, ri.mrow, 1), H + (size_t)r * D, C.lane);
    }
}

__device__ __forceinline__ size_t u3_off(int g, int nb, int sx, int half, int n) { return ((((size_t)(g * 34 + nb) * 16 + sx) * 2 + half) * 32 + n) * 8; }
__device__ __forceinline__ size_t x3_off(int dirg, int nb, int kk, int half, int n) { return ((((size_t)(dirg * 34 + nb) * 8 + kk) * 2 + half) * 32 + n) * 8; }
__device__ __forceinline__ size_t m3_off(int dirg, int mb, int sx, int half, int p32) { return ((((size_t)(dirg * 4 + mb) * 16 + sx) * 2 + half) * 32 + p32) * 8; }
__device__ __forceinline__ void phase_p3(const Ctx& C, int l) {
    f16* PROJ = (f16*)(C.ws() + A_PROJ);
    f16* KA = (f16*)(C.ws() + A_KA); f16* VA = (f16*)(C.ws() + A_VA); f16* KC = (f16*)(C.ws() + A_KC); f16* U = (f16*)(C.ws() + A_U);
    f16* QA = (f16*)(C.ws() + A_QA);
    const float* ropeA = (const float*)(C.ws() + WS_ROPE); const float* ropeC = ropeA + 2048;
    const int lane = C.lane, d32 = lane & 31;
    const float akg = C.in(I_AKG)[l * 64 + lane], aqg = C.in(I_AQG)[l * 64 + lane];
    const f32x4 ckvg = *(const f32x4*)(C.in(I_CKVG) + l * 256 + 4 * lane);
    f32x4 cqg[3];
#pragma unroll
    for (int i = 0; i < 3; ++i) cqg[i] = *(const f32x4*)(C.in(I_CQG) + l * 768 + 256 * i + 4 * lane);
    for (int r = C.bid * NWAVES + C.wid; r < MALL; r += C.nblk * NWAVES) {
        const RowInfo ri = row_info(r);
        f16* prow = PROJ + (size_t)r * PLD;
        const bool needq = ri.lat || l == 0;
        f16 xak[2], xav[2], xaq[8]; f16x4 cq4[3];
#pragma unroll
        for (int hd = 0; hd < 2; ++hd) { xak[hd] = prow[OFF_AK + hd * 64 + lane]; xav[hd] = prow[OFF_AV + hd * 64 + lane]; }
        const f16x4 ckv4 = *(const f16x4*)(prow + OFF_CKV + 4 * lane);
        const f16 xckr = prow[OFF_CKR + d32];
        const f16x8 uu = *(const f16x8*)(prow + OFF_U + 8 * lane);
        if (needq) {
#pragma unroll
            for (int h = 0; h < 8; ++h) xaq[h] = prow[OFF_AQ + h * 64 + lane];
#pragma unroll
            for (int i = 0; i < 3; ++i) cq4[i] = *(const f16x4*)(prow + OFF_CQ + 256 * i + 4 * lane);
        } else {
#pragma unroll
            for (int h = 0; h < 8; ++h) xaq[h] = (f16)0.f;
#pragma unroll
            for (int i = 0; i < 3; ++i) cq4[i] = (f16x4){0, 0, 0, 0};
        }
        const int prow_i = ri.t >> 6, pcol_i = ri.t & 63;
        float cA = 1.f, sA = 0.f, cc = 1.f, sc = 0.f;
        if (ri.lat) {
            { const int part = lane >> 5, j = lane & 15, pi = part ? pcol_i : prow_i; cA = ropeA[pi * 16 + j]; sA = ropeA[1024 + pi * 16 + j]; if (!((lane >> 4) & 1)) sA = -sA; }
            { const int part = d32 >> 4, j = d32 & 7, pi = part ? pcol_i : prow_i; cc = ropeC[pi * 8 + j]; sc = ropeC[512 + pi * 8 + j]; if (!((d32 >> 3) & 1)) sc = -sc; }
        }
        float ss[12];
#pragma unroll
        for (int hd = 0; hd < 2; ++hd) { const float x = (float)xak[hd]; ss[hd] = x * x; }
#pragma unroll
        for (int h = 0; h < 8; ++h) { const float x = (float)xaq[h]; ss[2 + h] = x * x; }
        { float q = 0.f;
#pragma unroll
          for (int e = 0; e < 4; ++e) { const float x = (float)ckv4[e]; q += x * x; }
          ss[10] = q; q = 0.f;
#pragma unroll
          for (int i = 0; i < 3; ++i)
#pragma unroll
              for (int e = 0; e < 4; ++e) { const float x = (float)cq4[i][e]; q += x * x; }
          ss[11] = q; }
#pragma unroll
        for (int o = 1; o < 64; o <<= 1)
#pragma unroll
            for (int i = 0; i < 12; ++i) ss[i] += __shfl_xor(ss[i], o);
#pragma unroll
        for (int hd = 0; hd < 2; ++hd) {
            float y = (float)xak[hd] * (1.0f / sqrtf(ss[hd] * (1.0f / 64.0f) + EPS)) * akg;
            const float p = __shfl_xor(y, 16);
            y = y * cA + p * sA;
            KA[((size_t)(ri.b * 2 + hd) * NKEY + ri.pos) * 64 + lane] = (f16)y;
            VA[((size_t)(ri.b * 2 + hd) * NKEY + ri.pos) * 64 + lane] = xav[hd];
        }
        { const float rs = 1.0f / sqrtf(ss[10] * (1.0f / 256.0f) + EPS); f16x4 o4;
#pragma unroll
          for (int e = 0; e < 4; ++e) o4[e] = (f16)((float)ckv4[e] * rs * ckvg[e]);
          *(f16x4*)(prow + OFF_CKV + 4 * lane) = o4; }
        { float x = (float)xckr; const float p = __shfl_xor(x, 8); x = x * cc + p * sc;
          if (lane < 32) {
#pragma unroll
              for (int h = 0; h < 8; ++h) KC[((size_t)(ri.b * 8 + h) * NKEY + ri.pos) * 96 + 64 + d32] = (f16)x;
          } }
        *(f16x8*)(U + u3_off(lane >> 1, r >> 9, r & 15, lane & 1, (r >> 4) & 31)) = uu;
        if (needq) {
            f16* qdst = ri.lat ? QA + ((size_t)(ri.b * 8) * SEQ + ri.t) * 64 : QA + (size_t)NB * 8 * SEQ * 64 + ((size_t)(ri.b * 8) * CTX + ri.t) * 64;
            const size_t hstride = ri.lat ? (size_t)SEQ * 64 : (size_t)CTX * 64;
#pragma unroll
            for (int h = 0; h < 8; ++h) {
                float y = (float)xaq[h] * (1.0f / sqrtf(ss[2 + h] * (1.0f / 64.0f) + EPS)) * aqg;
                const float p = __shfl_xor(y, 16);
                y = (y * cA + p * sA) * QSCALE_A;
                qdst[h * hstride + lane] = (f16)y;
            }
            const float rs = 1.0f / sqrtf(ss[11] * (1.0f / 768.0f) + EPS);
#pragma unroll
            for (int i = 0; i < 3; ++i) { f16x4 o4;
#pragma unroll
                for (int e = 0; e < 4; ++e) o4[e] = (f16)((float)cq4[i][e] * rs * cqg[i][e]);
                *(f16x4*)(prow + OFF_CQ + 256 * i + 4 * lane) = o4; }
        }
    }
}

namespace pg8 {
#define PG8_LAS __attribute__((address_space(3)))
typedef _Float16 bf16_t;
typedef _Float16 bf16x8 __attribute__((ext_vector_type(8)));
constexpr int BM = 256, BK = 64, HALF = 128, HTB = HALF * BK * 2  , STAGE_BYTES = 8 * HTB, NXCD = 8, WGM = 8;

__host__ __device__ __forceinline__ int lds_byte(int r, int c) { const int st = (r >> 4) * 2 + (c >> 5), rr = r & 15, cc = c & 31, ob = rr * 64 + cc * 2; return st * 1024 + (ob ^ (((ob >> 9) & 1) << 5)); }
__host__ __device__ __forceinline__ void stage_rc(int b, int& R, int& C) { const int st = b / 1024, sb = b % 1024, swz = sb ^ (((sb >> 9) & 1) << 5); R = (st >> 1) * 16 + swz / 64; C = (st & 1) * 32 + (swz % 64) / 2; }
__host__ __device__ __forceinline__ int perm32(int rho) { const int n = rho >> 4, i = rho & 15; return 8 * (i >> 2) + 4 * n + (i & 3); }
struct Unit { int pm, pn; };
struct Gemm { const bf16_t* A; const bf16_t* Bt; int M, N, K, lda, ldb; };

struct StaticOrder {
    int nM, nN, nwg, G, c;
    __host__ __device__ void init(int M, int N, int G_, int c_) { nM = M / BM; nN = N / BM; nwg = nM * nN; G = G_; c = c_; }
    __host__ __device__ bool next(int i, Unit& u) const {
        const long L = (long)i * G + c; if (L >= nwg) return false;
        int wgid = (int)L; { const int q = nwg / NXCD, r = nwg % NXCD, xcd = wgid % NXCD, off = wgid / NXCD; wgid = (xcd < r ? xcd * (q + 1) : r * (q + 1) + (xcd - r) * q) + off; }
        const int nig = WGM * nN, gid = wgid / nig, fm = gid * WGM, gsz = (nM - fm) < WGM ? (nM - fm) : WGM;
        u.pm = fm + ((wgid % nig) % gsz); u.pn = (wgid % nig) / gsz; return true;
    }
    __device__ __forceinline__ void a_ready(const Unit&) const {}
    __device__ __forceinline__ void done(const Unit&) const {}
};

template <class F> struct EpiFn { static constexpr bool PERM = true, AFTER_DRAIN = false; F f;
    __device__ __forceinline__ void operator()(const f32x4 (&acc)[2][2][4][2], const Unit& u, int wr, int wc, int fr, int fq) const {
        typename F::Pre pre[2][2];
        const int col0 = u.pn * BM + wc * 32 + 8 * fq, rowb = u.pm * BM + wr * 64 + fr;
#pragma unroll
        for (int bj = 0; bj < 2; ++bj) pre[0][bj] = f.pre(rowb, col0 + bj * HALF);
#pragma unroll
        for (int gi = 0; gi < 8; ++gi) {
            const int ai = gi >> 2, m = gi & 3, row = rowb + ai * HALF + m * 16;
            if (gi + 1 < 8) { const int ai2 = (gi + 1) >> 2, m2 = (gi + 1) & 3;
#pragma unroll
                for (int bj = 0; bj < 2; ++bj) pre[(gi + 1) & 1][bj] = f.pre(rowb + ai2 * HALF + m2 * 16, col0 + bj * HALF); }
#pragma unroll
            for (int bj = 0; bj < 2; ++bj) f(row, col0 + bj * HALF, acc[ai][bj][m][0], acc[ai][bj][m][1], pre[gi & 1][bj]);
            asm volatile("" ::: "memory");
        }
    } };

template <class Epi, class Sched, bool ALIGN_EPI = false, bool SP2 = false, bool CH_IN = false, bool CH_OUT = false>
__device__ __forceinline__ void gemm_phase(PG8_LAS unsigned char* lds, const Gemm g, const Sched& S, const Epi& E, const int tid, const Gemm ng = Gemm{}) {
    static_assert(!(CH_IN || CH_OUT) || (SP2 && ALIGN_EPI), "chaining is written for the SP2 + ALIGN_EPI loop");
    const int wid = __builtin_amdgcn_readfirstlane(tid >> 6), lane = tid & 63, wr = wid >> 2, wc = wid & 3, fr = lane & 15, fq = lane >> 4;
    const int K = g.K, nt = K / BK;
    unsigned voffA[2], voffB[2];
#pragma unroll
    for (int i = 0; i < 2; ++i) { int R, C; stage_rc(tid * 16 + i * 8192, R, C); const int Rb = Epi::PERM ? ((R & ~31) + perm32(R & 31)) : R;
        voffA[i] = (unsigned)(R * g.lda + C) * 2u; voffB[i] = (unsigned)(Rb * g.ldb + C) * 2u; }
    unsigned nvA[2] = {0u, 0u}, nvB[2] = {0u, 0u}; size_t n_hstepA = 0, n_hstepB = 0;
    if constexpr (CH_OUT) {
#pragma unroll
        for (int i = 0; i < 2; ++i) { int R, C; stage_rc(tid * 16 + i * 8192, R, C); const int Rb = Epi::PERM ? ((R & ~31) + perm32(R & 31)) : R;
            nvA[i] = (unsigned)(R * ng.lda + C) * 2u; nvB[i] = (unsigned)(Rb * ng.ldb + C) * 2u; }
        n_hstepA = (size_t)HALF * ng.lda * 2; n_hstepB = (size_t)HALF * ng.ldb * 2;
    }
    const size_t kstep = (size_t)(BK * 2);
    const size_t hstepA = (size_t)HALF * g.lda * 2, hstepB = (size_t)HALF * g.ldb * 2;
    const size_t tstepA = 2 * hstepA, tstepB = 2 * hstepB;
    const unsigned ldsw = (unsigned)wid * 1024u;
    const int aoff = lds_byte(wr * 64 + fr, fq * 8), boff = lds_byte(wc * 32 + fr, fq * 8);
#define PG8_SA(b, h) (((b) * 2 + (h)) * HTB)
#define PG8_SB(b, h) ((4 + (b) * 2 + (h)) * HTB)
#define PG8_STAGE(bufoff, gbase, voff) do { _Pragma("unroll") for (int _i = 0; _i < 2; ++_i) \
        __builtin_amdgcn_global_load_lds((const unsigned*)((const char*)(gbase) + (voff)[_i]), (PG8_LAS unsigned*)(lds + (bufoff) + ldsw + _i * 8192), 16, 0, 0); } while (0)
#define PG8_LDA(dst, b, h) do { _Pragma("unroll") for (int m = 0; m < 4; ++m) _Pragma("unroll") for (int k = 0; k < 2; ++k) dst[m][k] = *(const PG8_LAS bf16x8*)(lds + PG8_SA(b, h) + aoff + m * 2048 + k * 1024); } while (0)
#define PG8_LDB(dst, b, h) do { _Pragma("unroll") for (int n = 0; n < 2; ++n) _Pragma("unroll") for (int k = 0; k < 2; ++k) dst[n][k] = *(const PG8_LAS bf16x8*)(lds + PG8_SB(b, h) + boff + n * 2048 + k * 1024); } while (0)
#define PG8_MMA(ai, bj, At, Bt) do { __builtin_amdgcn_s_setprio(1); _Pragma("unroll") for (int m = 0; m < 4; ++m) _Pragma("unroll") for (int n = 0; n < 2; ++n) _Pragma("unroll") for (int k = 0; k < 2; ++k) \
        acc[ai][bj][m][n] = __builtin_amdgcn_mfma_f32_16x16x32_f16(Bt[n][k], At[m][k], acc[ai][bj][m][n], 0, 0, 0); __builtin_amdgcn_s_setprio(0); } while (0)
#define PG8_WAIT_V(n) asm volatile("s_waitcnt vmcnt(" #n ")" ::: "memory")
#define PG8_WAIT_L(n) asm volatile("s_waitcnt lgkmcnt(" #n ")" ::: "memory")
#define PG8_BAR __builtin_amdgcn_s_barrier()
#define PG8_SCHED __builtin_amdgcn_sched_barrier(0)
    Unit cur, nxt; int ui = 0;
    if (!S.next(0, cur)) return;
    f32x4 acc[2][2][4][2];
#pragma unroll
    for (int a = 0; a < 2; ++a)
#pragma unroll
        for (int b = 0; b < 2; ++b)
#pragma unroll
            for (int m = 0; m < 4; ++m)
#pragma unroll
                for (int n = 0; n < 2; ++n) acc[a][b][m][n] = (f32x4){0.f, 0.f, 0.f, 0.f};
    bf16x8 At[4][2], B0[2][2], B1[2][2];
    const char* cA = (const char*)g.A + (size_t)cur.pm * tstepA; const char* cB = (const char*)g.Bt + (size_t)cur.pn * tstepB;
    S.a_ready(cur);
    if constexpr (CH_IN) {   } else
    if constexpr (SP2) {
        PG8_STAGE(PG8_SB(0, 0), cB, voffB); PG8_STAGE(PG8_SB(0, 1), cB + hstepB, voffB); PG8_STAGE(PG8_SA(0, 0), cA, voffA); PG8_STAGE(PG8_SA(0, 1), cA + hstepA, voffA);
        if (wr == 1) PG8_BAR;
        PG8_WAIT_V(2); PG8_BAR;
        PG8_STAGE(PG8_SB(1, 0), cB + kstep, voffB); PG8_STAGE(PG8_SA(1, 0), cA + kstep, voffA); PG8_STAGE(PG8_SB(1, 1), cB + hstepB + kstep, voffB);
        PG8_WAIT_V(6); PG8_BAR;
    } else {
        PG8_STAGE(PG8_SB(0, 0), cB, voffB); PG8_STAGE(PG8_SA(0, 0), cA, voffA); PG8_STAGE(PG8_SB(0, 1), cB + hstepB, voffB); PG8_STAGE(PG8_SA(0, 1), cA + hstepA, voffA);
        if (wr == 1) PG8_BAR;
        PG8_WAIT_V(4); PG8_BAR;
        PG8_STAGE(PG8_SB(1, 0), cB + kstep, voffB); PG8_STAGE(PG8_SA(1, 0), cA + kstep, voffA); PG8_STAGE(PG8_SB(1, 1), cB + hstepB + kstep, voffB);
        PG8_WAIT_V(6); PG8_BAR;
    }
    for (;;) {
        const bool has_next = S.next(ui + 1, nxt);
        Unit u0; (void)S.next(0, u0);
        const char* nA = has_next ? (const char*)g.A + (size_t)nxt.pm * tstepA : (CH_OUT ? (const char*)ng.A + (size_t)u0.pm * 2 * n_hstepA : cA);
        const char* nB = has_next ? (const char*)g.Bt + (size_t)nxt.pn * tstepB : (CH_OUT ? (const char*)ng.Bt + (size_t)u0.pn * 2 * n_hstepB : cB);
#pragma unroll 1
        for (int t = 0; t < nt; t += 2) {
            const bool last = (t == nt - 2);
            const char* a1 = cA + (size_t)(t + 1) * kstep;
            const char* a2 = last ? nA : cA + (size_t)(t + 2) * kstep; const char* b2 = last ? nB : cB + (size_t)(t + 2) * kstep;
            const char* a3 = a2 + kstep; const char* b3 = b2 + kstep;
            const bool xg = CH_OUT && last && !has_next;
            unsigned vA2[2], vB2[2];
#pragma unroll
            for (int i = 0; i < 2; ++i) { vA2[i] = xg ? nvA[i] : voffA[i]; vB2[i] = xg ? nvB[i] : voffB[i]; }
            const size_t hA2 = xg ? n_hstepA : hstepA, hB2 = xg ? n_hstepB : hstepB;
            if (last && has_next) S.a_ready(nxt);
            if constexpr (SP2) {
            PG8_LDB(B0, 0, 0); PG8_LDB(B1, 0, 1); PG8_SCHED; PG8_LDA(At, 0, 0); PG8_STAGE(PG8_SA(1, 1), a1 + hstepA, voffA);
            PG8_WAIT_V(8); PG8_WAIT_L(0); PG8_BAR; PG8_MMA(0, 0, At, B0); PG8_MMA(0, 1, At, B1); PG8_BAR; PG8_SCHED;
            PG8_LDA(At, 0, 1); PG8_STAGE(PG8_SB(0, 0), b2, vB2); PG8_STAGE(PG8_SB(0, 1), b2 + hB2, vB2); PG8_STAGE(PG8_SA(0, 0), a2, vA2);
            PG8_WAIT_V(8); PG8_WAIT_L(0); PG8_BAR; PG8_MMA(1, 0, At, B0); PG8_MMA(1, 1, At, B1); PG8_BAR; PG8_SCHED;
            PG8_LDB(B0, 1, 0); PG8_LDB(B1, 1, 1); PG8_SCHED; PG8_LDA(At, 1, 0); PG8_STAGE(PG8_SA(0, 1), a2 + hA2, vA2);
            PG8_WAIT_V(8); PG8_WAIT_L(0); PG8_BAR; PG8_MMA(0, 0, At, B0); PG8_MMA(0, 1, At, B1); PG8_BAR; PG8_SCHED;
            PG8_LDA(At, 1, 1); PG8_STAGE(PG8_SB(1, 0), b3, vB2); PG8_STAGE(PG8_SB(1, 1), b3 + hB2, vB2); PG8_STAGE(PG8_SA(1, 0), a3, vA2);
            PG8_WAIT_V(8); PG8_WAIT_L(0); PG8_BAR; PG8_MMA(1, 0, At, B0); PG8_MMA(1, 1, At, B1); PG8_BAR; PG8_SCHED;
            } else {
            PG8_LDB(B0, 0, 0); PG8_SCHED; PG8_LDA(At, 0, 0); PG8_STAGE(PG8_SA(1, 1), a1 + hstepA, voffA);
            PG8_WAIT_L(8); PG8_BAR; PG8_WAIT_L(0); PG8_MMA(0, 0, At, B0); PG8_BAR; PG8_SCHED;
            PG8_LDB(B1, 0, 1); PG8_STAGE(PG8_SB(0, 0), b2, voffB);
            PG8_BAR; PG8_WAIT_L(0); PG8_MMA(0, 1, At, B1); PG8_BAR;
            PG8_LDA(At, 0, 1); PG8_STAGE(PG8_SA(0, 0), a2, voffA);
            PG8_BAR; PG8_WAIT_L(0); PG8_MMA(1, 0, At, B0); PG8_BAR; PG8_SCHED;
            PG8_STAGE(PG8_SB(0, 1), b2 + hstepB, voffB);
            PG8_WAIT_V(6); PG8_BAR; PG8_MMA(1, 1, At, B1); PG8_BAR;
            PG8_LDB(B0, 1, 0); PG8_SCHED; PG8_LDA(At, 1, 0); PG8_STAGE(PG8_SA(0, 1), a2 + hstepA, voffA);
            PG8_WAIT_L(8); PG8_BAR; PG8_WAIT_L(0); PG8_MMA(0, 0, At, B0); PG8_BAR; PG8_SCHED;
            PG8_LDB(B1, 1, 1); PG8_STAGE(PG8_SB(1, 0), b3, voffB);
            PG8_BAR; PG8_WAIT_L(0); PG8_MMA(0, 1, At, B1); PG8_BAR;
            PG8_LDA(At, 1, 1); PG8_STAGE(PG8_SA(1, 0), a3, voffA);
            PG8_BAR; PG8_WAIT_L(0); PG8_MMA(1, 0, At, B0); PG8_BAR; PG8_SCHED;
            PG8_STAGE(PG8_SB(1, 1), b3 + hstepB, voffB);
            PG8_WAIT_V(6); PG8_BAR; PG8_MMA(1, 1, At, B1); PG8_BAR;
            }
        }
        if constexpr (ALIGN_EPI) { if (wr == 0) PG8_BAR; }
        if constexpr (!Epi::AFTER_DRAIN) { E(acc, cur, wr, wc, fr, fq); S.done(cur); }
        if (!has_next) break;
#pragma unroll
        for (int a = 0; a < 2; ++a)
#pragma unroll
            for (int b = 0; b < 2; ++b)
#pragma unroll
                for (int m = 0; m < 4; ++m)
#pragma unroll
                    for (int n = 0; n < 2; ++n) acc[a][b][m][n] = (f32x4){0.f, 0.f, 0.f, 0.f};
        cur = nxt; cA = nA; cB = nB; ++ui;
        if constexpr (ALIGN_EPI) { if (wr == 1) PG8_BAR; }
    }
    if constexpr (CH_OUT) { if (wr == 1) PG8_BAR; return; }
    PG8_WAIT_V(0);
    if constexpr (!ALIGN_EPI) { if (wr == 0) PG8_BAR; }
    PG8_BAR;
    if constexpr (Epi::AFTER_DRAIN) { E.fused(acc, cur, wr, wc, fr, fq, lds, wid, lane); S.done(cur); }
#undef PG8_SA
#undef PG8_SB
#undef PG8_STAGE
#undef PG8_LDA
#undef PG8_LDB
#undef PG8_MMA
#undef PG8_WAIT_V
#undef PG8_WAIT_L
#undef PG8_BAR
#undef PG8_SCHED
}
}

template <class Epi>
__device__ __forceinline__ void gemm_simple(const Ctx& C, const f16* A, int lda, const f16* Bt, int ldb, int M, int N, int K, const Epi& E, int mskip_from = 1 << 30, int nskip_from = 1 << 30) {
    const int wr = C.wid >> 2, wc = C.wid & 3, fr = C.lane & 15, fq = C.lane >> 4;
    const int tilesN = N / 256, tilesM = M / 64;
    for (int tile = C.bid; tile < tilesM * tilesN; tile += C.nblk) {
        const int tm = tile / tilesN, tn = tile % tilesN;
        if (tm * 64 >= mskip_from && tn * 256 >= nskip_from) continue;
        const int m0 = tm * 64 + wr * 32, n0 = tn * 256 + wc * 64;
        f32x4 acc[2][2][2];
#pragma unroll
        for (int a = 0; a < 2; ++a)
#pragma unroll
            for (int g = 0; g < 2; ++g)
#pragma unroll
                for (int n = 0; n < 2; ++n) acc[a][g][n] = (f32x4){0.f, 0.f, 0.f, 0.f};
        const f16* ap[2]; const f16* bp[2][2];
#pragma unroll
        for (int a = 0; a < 2; ++a) ap[a] = A + (size_t)(m0 + a * 16 + fr) * lda + fq * 8;
#pragma unroll
        for (int g = 0; g < 2; ++g)
#pragma unroll
            for (int n = 0; n < 2; ++n) bp[g][n] = Bt + (size_t)(n0 + g * 32 + 8 * (fr >> 2) + 4 * n + (fr & 3)) * ldb + fq * 8;
        for (int k0 = 0; k0 < K; k0 += 32) {
            f16x8 av[2], bv[2][2];
#pragma unroll
            for (int a = 0; a < 2; ++a) av[a] = *(const f16x8*)(ap[a] + k0);
#pragma unroll
            for (int g = 0; g < 2; ++g)
#pragma unroll
                for (int n = 0; n < 2; ++n) bv[g][n] = *(const f16x8*)(bp[g][n] + k0);
#pragma unroll
            for (int a = 0; a < 2; ++a)
#pragma unroll
                for (int g = 0; g < 2; ++g)
#pragma unroll
                    for (int n = 0; n < 2; ++n) acc[a][g][n] = __builtin_amdgcn_mfma_f32_16x16x32_f16(bv[g][n], av[a], acc[a][g][n], 0, 0, 0);
        }
#pragma unroll
        for (int a = 0; a < 2; ++a)
#pragma unroll
            for (int g = 0; g < 2; ++g) E(m0 + a * 16 + fr, n0 + g * 32 + 8 * fq, acc[a][g][0], acc[a][g][1]);
    }
}

template <bool CH_IN, bool CH_OUT, class F>
__device__ __forceinline__ void gemm_pg8c(const Ctx& C, const f16* A, int lda, const f16* Bt, int ldb, int M, int N, int K, const F& f, const f16* nA, int nlda, const f16* nBt, int nldb) {
    pg8::Gemm g{A, Bt, M, N, K, lda, ldb}; pg8::Gemm ng{nA, nBt, M, N, 0, nlda, nldb}; pg8::StaticOrder S; S.init(M, N, C.nblk, C.bid);
    pg8::EpiFn<F> E{f};
    pg8::gemm_phase<pg8::EpiFn<F>, pg8::StaticOrder, true, true, CH_IN, CH_OUT>(C.lds, g, S, E, C.tid, ng);
}
template <class F>
__device__ __forceinline__ void gemm_pg8(const Ctx& C, const f16* A, int lda, const f16* Bt, int ldb, int M, int N, int K, const F& f) {
    pg8::Gemm g{A, Bt, M, N, K, lda, ldb}; pg8::StaticOrder S; S.init(M, N, C.nblk, C.bid);
    pg8::EpiFn<F> E{f};
    pg8::gemm_phase<pg8::EpiFn<F>, pg8::StaticOrder, true, true>(C.lds, g, S, E, C.tid);
}
template <class F>
__device__ __forceinline__ void gemm_small(const Ctx& C, const f16* A, int lda, const f16* Bt, int ldb, int row0, int N, int K, const F& f) {
    constexpr int PST = 68;
    LAS float* part = (LAS float*)C.lds;
    const int fr = C.lane & 15, fq = C.lane >> 4;
    const int tilesN = N / 64, ntiles = 16 * tilesN, kw = K / 8;
    for (int tile = C.bid; tile < ntiles; tile += C.nblk) {
        const int tm = tile / tilesN, tn = tile - tm * tilesN, m0 = tm * 64, n0 = tn * 64;
        f32x4 acc[4][4];
#pragma unroll
        for (int a = 0; a < 4; ++a)
#pragma unroll
            for (int b = 0; b < 4; ++b) acc[a][b] = (f32x4){0.f, 0.f, 0.f, 0.f};
        const f16* ap = A + (size_t)(m0 + fr) * lda + C.wid * kw + fq * 8;
        const f16* bp = Bt + (size_t)(n0 + fr) * ldb + C.wid * kw + fq * 8;
#pragma unroll 4
        for (int k0 = 0; k0 < kw; k0 += 32) {
            f16x8 av[4], bv[4];
#pragma unroll
            for (int a = 0; a < 4; ++a) av[a] = *(const f16x8*)(ap + (size_t)(a * 16) * lda + k0);
#pragma unroll
            for (int b = 0; b < 4; ++b) bv[b] = *(const f16x8*)(bp + (size_t)(b * 16) * ldb + k0);
#pragma unroll
            for (int a = 0; a < 4; ++a)
#pragma unroll
                for (int b = 0; b < 4; ++b) acc[a][b] = __builtin_amdgcn_mfma_f32_16x16x32_f16(bv[b], av[a], acc[a][b], 0, 0, 0);
        }
        __syncthreads();
        LAS float* pw = part + (size_t)C.wid * 64 * PST;
#pragma unroll
        for (int a = 0; a < 4; ++a)
#pragma unroll
            for (int b = 0; b < 4; ++b) *(LAS f32x4*)(pw + (a * 16 + fr) * PST + b * 16 + 4 * fq) = acc[a][b];
        __syncthreads();
        const int rl = 8 * C.wid + (C.lane & 7), c8 = ((C.lane >> 4) & 1) | (((C.lane >> 5) & 1) << 1) | (((C.lane >> 3) & 1) << 2);
        f32x4 lo = (f32x4){0.f, 0.f, 0.f, 0.f}, hi = lo;
#pragma unroll
        for (int w = 0; w < 8; ++w) { const LAS float* pr = part + ((size_t)w * 64 + rl) * PST + 8 * c8; lo = lo + *(const LAS f32x4*)pr; hi = hi + *(const LAS f32x4*)(pr + 4); }
        f(row0 + m0 + rl, n0 + 8 * c8, lo, hi, f.pre(row0 + m0 + rl, n0 + 8 * c8));
    }
    __syncthreads();
}
template <class F>
__device__ __forceinline__ void gemm_rows(const Ctx& C, const f16* A, int lda, const f16* Bt, int ldb, int mrows, int N, int K, const F& f) {
    gemm_pg8(C, A, lda, Bt, ldb, NLAT, N, K, f);
    if (mrows > NLAT) gemm_small(C, A + (size_t)NLAT * lda, lda, Bt, ldb, NLAT, N, K, f);
}
struct NoPre {};
#define NOPRE typedef NoPre Pre; __device__ __forceinline__ NoPre pre(int, int) const { return NoPre{}; }
struct EpiStore { f16* O; int ldo;
    NOPRE
    __device__ __forceinline__ void operator()(int row, int col, f32x4 lo, f32x4 hi, NoPre) const { *(f16x8*)(O + (size_t)row * ldo + col) = pack8(lo, hi); } };
struct EpiKvUp { f16* KC; f16* VC;
    NOPRE
    __device__ __forceinline__ void operator()(int row, int col, f32x4 lo, f32x4 hi, NoPre) const {
        const RowInfo ri = row_info(row); const int h = col >> 7, w = col & 127;
        if (w < 64) *(f16x8*)(KC + ((size_t)(ri.b * 8 + h) * NKEY + ri.pos) * 96 + w) = pack8(lo, hi);
        else *(f16x8*)(VC + ((size_t)(ri.b * 8 + h) * NKEY + ri.pos) * 64 + (w - 64)) = pack8(lo, hi);
    } };
struct EpiQUp { f16* QC; const float* ropeC;
    NOPRE
    __device__ __forceinline__ void operator()(int row, int col, f32x4 lo, f32x4 hi, NoPre) const {
        const RowInfo ri = row_info(row); const int h = col / 96, w = col - h * 96;
        if (w >= 64) {
            f32x4 plo, phi;
#pragma unroll
            for (int e = 0; e < 4; ++e) { plo[e] = __shfl_xor(lo[e], 16); phi[e] = __shfl_xor(hi[e], 16); }
            if (ri.lat) {
                const int j0 = w - 64, part = j0 >> 4, second = (j0 >> 3) & 1, pi = part ? (ri.t & 63) : (ri.t >> 6);
                const float* cc = ropeC + pi * 8; const float* ss = ropeC + 512 + pi * 8;
#pragma unroll
                for (int e = 0; e < 4; ++e) {
                    const float s0 = second ? ss[e] : -ss[e], s1 = second ? ss[4 + e] : -ss[4 + e];
                    lo[e] = lo[e] * cc[e] + plo[e] * s0; hi[e] = hi[e] * cc[4 + e] + phi[e] * s1; }
            }
        }
        lo = lo * QSCALE_C; hi = hi * QSCALE_C;
        f16* dst = ri.lat ? QC + ((size_t)(ri.b * 8 + h) * SEQ + ri.t) * 96 + w : QC + (size_t)NB * 8 * SEQ * 96 + ((size_t)(ri.b * 8 + h) * CTX + ri.t) * 96 + w;
        *(f16x8*)dst = pack8(lo, hi);
    } };
struct EpiGlu { f16* YS;
    NOPRE
    __device__ __forceinline__ void operator()(int row, int col, f32x4 lo, f32x4 hi, NoPre) const {
        f32x4 o;
#pragma unroll
        for (int e = 0; e < 4; ++e) o[e] = lo[e] * sigmoidf_(hi[e]);
        *(f16x4*)(YS + (size_t)row * 512 + (col >> 1)) = pack4(o);
    } };
struct EpiGate { f16* G;
    NOPRE
    __device__ __forceinline__ void operator()(int row, int col, f32x4 lo, f32x4 hi, NoPre) const {
#pragma unroll
        for (int e = 0; e < 4; ++e) { lo[e] = sigmoidf_(lo[e]); hi[e] = sigmoidf_(hi[e]); }
        *(f16x8*)(G + (size_t)row * 1024 + col) = pack8(lo, hi);
    } };
struct EpiBranch { const f16* G; f16* Mg; int first;
    struct Pre { f16x8 g, m; };
    __device__ __forceinline__ Pre pre(int row, int col) const { Pre p; p.g = *(const f16x8*)(G + (size_t)row * 1024 + col);
        if (!first) p.m = *(const f16x8*)(Mg + (size_t)row * 1024 + col); else p.m = (f16x8){0, 0, 0, 0, 0, 0, 0, 0}; return p; }
    __device__ __forceinline__ void operator()(int row, int col, f32x4 lo, f32x4 hi, const Pre& p) const {
#pragma unroll
        for (int e = 0; e < 4; ++e) { lo[e] = (float)p.m[e] + (float)p.g[e] * lo[e]; hi[e] = (float)p.m[4 + e] + (float)p.g[4 + e] * hi[e]; }
        *(f16x8*)(Mg + (size_t)row * 1024 + col) = pack8(lo, hi);
    } };
struct EpiWout { const Ctx* C; int l;
    struct Pre { f32x4 x0, x1, g0, g1; };
    __device__ __forceinline__ Pre pre(int row, int col) const { const RowInfo ri = row_info(row); const float* x = C->xsrc(l, row) + col; const float* g = C->mod(l, ri.mrow, 2) + col;
        Pre p; p.x0 = *(const f32x4*)x; p.x1 = *(const f32x4*)(x + 4); p.g0 = *(const f32x4*)g; p.g1 = *(const f32x4*)(g + 4); return p; }
    __device__ __forceinline__ void operator()(int row, int col, f32x4 lo, f32x4 hi, const Pre& p) const {
        *(f16x8*)((f16*)(C->ws() + A_T1H) + (size_t)row * D + col) = pack8(p.x0 * ALPHA + p.g0 * lo, p.x1 * ALPHA + p.g1 * hi);
    } };
struct EpiUp { f16* Hd;
    NOPRE
    __device__ __forceinline__ void operator()(int row, int col, f32x4 lo, f32x4 hi, NoPre) const {
#pragma unroll
        for (int e = 0; e < 4; ++e) { const float a = fmaxf(lo[e], 0.f), b = fmaxf(hi[e], 0.f); lo[e] = a * a; hi[e] = b * b; }
        *(f16x8*)(Hd + (size_t)row * DFF + col) = pack8(lo, hi);
    } };
struct EpiDown { const Ctx* C; int l;
    struct Pre { f16x8 t1; float mean, rstd; };
    __device__ __forceinline__ Pre pre(int row, int col) const { Pre p; p.t1 = *(const f16x8*)((const f16*)(C->ws() + A_T1H) + (size_t)row * D + col);
        const float* st = (const float*)(C->ws() + WS_ST1) + 2 * row; p.mean = st[0]; p.rstd = st[1]; return p; }
    __device__ __forceinline__ void operator()(int row, int col, f32x4 lo, f32x4 hi, const Pre& p) const {
        const RowInfo ri = row_info(row); const float* g = C->mod(l, ri.mrow, 5) + col; f16* t = (f16*)(C->ws() + A_T1H) + (size_t)row * D + col;
        const float* lg = C->in(I_LN1G) + l * D + col; const float* lb = C->in(I_LN1B) + l * D + col;
        const f32x4 g0 = *(const f32x4*)g, g1 = *(const f32x4*)(g + 4);
        const f32x4 a0 = *(const f32x4*)lg, a1 = *(const f32x4*)(lg + 4), b0 = *(const f32x4*)lb, b1 = *(const f32x4*)(lb + 4);
        f32x4 x0, x1;
#pragma unroll
        for (int e = 0; e < 4; ++e) { x0[e] = ((float)p.t1[e] - p.mean) * p.rstd * a0[e] + b0[e]; x1[e] = ((float)p.t1[4 + e] - p.mean) * p.rstd * a1[e] + b1[e]; }
        *(f16x8*)t = pack8(x0 * ALPHA + g0 * lo, x1 * ALPHA + g1 * hi);
    } };

typedef _Float16 f16x2 __attribute__((ext_vector_type(2)));
template <int DQK>
__device__ __forceinline__ void attn_naive_query(const f16* q, const f16* Kh, const f16* Vh, int nkeys, f16* out, LAS float* scr, int lane) {
    f16x8 qv[DQK / 8];
#pragma unroll
    for (int c = 0; c < DQK / 8; ++c) qv[c] = *(const f16x8*)(q + 8 * c);
    float m = -1e30f, ls = 0.f; float acc[64];
#pragma unroll
    for (int d = 0; d < 64; ++d) acc[d] = 0.f;
    for (int j = lane; j < nkeys; j += 64) {
        const f16* kr = Kh + (size_t)j * DQK; const f16* vr = Vh + (size_t)j * 64;
        float s = 0.f;
#pragma unroll
        for (int c = 0; c < DQK / 8; ++c) { const f16x8 v = *(const f16x8*)(kr + 8 * c);
#pragma unroll
            for (int e = 0; e < 4; ++e) s = __builtin_amdgcn_fdot2((f16x2){qv[c][2 * e], qv[c][2 * e + 1]}, (f16x2){v[2 * e], v[2 * e + 1]}, s, false); }
        const float mn = fmaxf(m, s), a = exp2f(m - mn), p = exp2f(s - mn);
        ls = ls * a + p; m = mn;
#pragma unroll
        for (int c = 0; c < 8; ++c) { const f16x8 v = *(const f16x8*)(vr + 8 * c);
#pragma unroll
            for (int e = 0; e < 8; ++e) acc[8 * c + e] = acc[8 * c + e] * a + p * (float)v[e]; }
    }
    const float mg = wave_max(m), w = exp2f(m - mg);
    const float L = wave_sum(ls * w);
#pragma unroll
    for (int d = 0; d < 64; ++d) scr[lane * 65 + d] = acc[d] * w;
    asm volatile("s_waitcnt lgkmcnt(0)" ::: "memory");
    float o = 0.f;
#pragma unroll 8
    for (int i = 0; i < 64; ++i) o += scr[i * 65 + lane];
    asm volatile("s_waitcnt lgkmcnt(0)" ::: "memory");
    out[lane] = (f16)(o / L);
}
__device__ __forceinline__ void phase_attn_naive(const Ctx& C, int l) {
    LAS float* scr = (LAS float*)C.lds + C.wid * (64 * 65);
    const f16* QA = (const f16*)(C.ws() + A_QA); const f16* QC = (const f16*)(C.ws() + A_QC);
    const f16* KA = (const f16*)(C.ws() + A_KA); const f16* VA = (const f16*)(C.ws() + A_VA);
    const f16* KC = (const f16*)(C.ws() + A_KC); const f16* VC = (const f16*)(C.ws() + A_VC);
    f16* YA = (f16*)(C.ws() + A_YA); f16* YC = (f16*)(C.ws() + A_YC);
    const int NQL = NB * 8 * SEQ, NQC = NB * 8 * CTX;
    const int total = 2 * NQL + (l == 0 ? 2 * NQC : 0);
    for (int u = C.bid * NWAVES + C.wid; u < total; u += C.nblk * NWAVES) {
        int v = u; int type, lat;
        if (v < 2 * NQL) { type = v / NQL; v -= type * NQL; lat = 1; } else { v -= 2 * NQL; type = v / NQC; v -= type * NQC; lat = 0; }
        const int nq = lat ? SEQ : CTX;
        const int t = v % nq, h = (v / nq) & 7, b = v / (nq * 8);
        const int row = lat ? b * SEQ + t : NLAT + b * CTX + t;
        const int nkeys = lat ? NKEY : CTX;
        if (type == 0) {
            const f16* q = lat ? QA + ((size_t)(b * 8 + h) * SEQ + t) * 64 : QA + (size_t)NB * 8 * SEQ * 64 + ((size_t)(b * 8 + h) * CTX + t) * 64;
            attn_naive_query<64>(q, KA + (size_t)(b * 2 + (h >> 2)) * NKEY * 64, VA + (size_t)(b * 2 + (h >> 2)) * NKEY * 64, nkeys, YA + (size_t)row * 512 + h * 64, scr, C.lane);
        } else {
            const f16* q = lat ? QC + ((size_t)(b * 8 + h) * SEQ + t) * 96 : QC + (size_t)NB * 8 * SEQ * 96 + ((size_t)(b * 8 + h) * CTX + t) * 96;
            attn_naive_query<96>(q, KC + (size_t)(b * 8 + h) * NKEY * 96, VC + (size_t)(b * 8 + h) * NKEY * 64, nkeys, YC + (size_t)row * 512 + h * 64, scr, C.lane);
        }
    }
}

namespace fa {
typedef _Float16 h2 __attribute__((ext_vector_type(2)));
typedef float f2 __attribute__((ext_vector_type(2)));
typedef short s16x4 __attribute__((ext_vector_type(4)));
typedef unsigned u32x4 __attribute__((ext_vector_type(4)));
#define FA_SBAR() __builtin_amdgcn_sched_barrier(0)
constexpr float THR = 8.f;
constexpr int SHM_V = 64 * 64 * 2;
template <int DQK> struct Cfg { static constexpr int KROWB = DQK == 64 ? 128 : 256, SHM_K = 64 * KROWB, NCH = DQK / 8; };
template <int DQK> __device__ __forceinline__ int kswz(int row, int ch) {
    if constexpr (DQK == 64) return row * 128 + ((ch ^ ((row >> 1) & 7)) << 4);
    else return row * 256 + ((ch ^ (row & 15)) << 4);
}
__device__ __forceinline__ int crow(int r, int hi) { return (r & 3) + 8 * (r >> 2) + 4 * hi; }
__device__ __forceinline__ unsigned cvtpk(float lo, float hi) { f2 v = {lo, hi}; h2 h = __builtin_convertvector(v, h2); return __builtin_bit_cast(unsigned, h); }
__device__ __forceinline__ void partialSM(f32x16& p0, f32x16& p1, float& m_reg, float& mn, float& alpha) {
    float pmax = p0[0];
#pragma unroll
    for (int r = 1; r < 16; ++r) pmax = fmaxf(pmax, p0[r]);
#pragma unroll
    for (int r = 0; r < 16; ++r) pmax = fmaxf(pmax, p1[r]);
    { auto rr = __builtin_amdgcn_permlane32_swap(__float_as_uint(pmax), __float_as_uint(pmax), false, false);
      pmax = fmaxf(__uint_as_float(rr[0]), __uint_as_float(rr[1])); }
    if (__builtin_expect(__all(pmax - m_reg <= THR), 1)) { mn = m_reg; alpha = 1.f; }
    else { mn = fmaxf(m_reg, pmax); alpha = __builtin_amdgcn_exp2f(m_reg - mn); m_reg = mn; }
#pragma unroll
    for (int r = 0; r < 16; ++r) { p0[r] = p0[r] - mn; p1[r] = p1[r] - mn; }
#pragma unroll
    for (int r = 0; r < 16; ++r) p0[r] = __builtin_amdgcn_exp2f(p0[r]);
}
__device__ __forceinline__ void finishSM(f32x16& p0, f32x16& p1, float alpha, float& l_reg, f16x8& pa0, f16x8& pa1, f16x8& pa2, f16x8& pa3) {
#pragma unroll
    for (int r = 0; r < 16; ++r) p1[r] = __builtin_amdgcn_exp2f(p1[r]);
    float ps = 0;
#pragma unroll
    for (int r = 0; r < 16; ++r) ps += p0[r];
#pragma unroll
    for (int r = 0; r < 16; ++r) ps += p1[r];
    { auto rr = __builtin_amdgcn_permlane32_swap(__float_as_uint(ps), __float_as_uint(ps), false, false);
      ps = __uint_as_float(rr[0]) + __uint_as_float(rr[1]); }
    l_reg = l_reg * alpha + ps;
#define FA_PK4(P, BASE, OUT) do { unsigned a0 = cvtpk(P[BASE + 0], P[BASE + 1]), a1 = cvtpk(P[BASE + 2], P[BASE + 3]);   \
    unsigned b0 = cvtpk(P[BASE + 4], P[BASE + 5]), b1 = cvtpk(P[BASE + 6], P[BASE + 7]);                              \
    auto r0 = __builtin_amdgcn_permlane32_swap(a0, b0, false, false); auto r1 = __builtin_amdgcn_permlane32_swap(a1, b1, false, false); \
    u32x4 w = {r0[0], r1[0], r0[1], r1[1]}; OUT = __builtin_bit_cast(f16x8, w); } while (0)
    FA_PK4(p0, 0, pa0); FA_PK4(p0, 8, pa1); FA_PK4(p1, 0, pa2); FA_PK4(p1, 8, pa3);
#undef FA_PK4
}
template <int DQK>
__device__ __forceinline__ void qkt(f32x16& p0, f32x16& p1, const LAS unsigned char* Ks, const f16x8* qr, int r32, int hi) {
    p0 = f32x16{}; p1 = f32x16{};
#pragma unroll
    for (int d0 = 0; d0 < DQK / 16; ++d0) {
        const f16x8 b0 = *(const LAS f16x8*)(Ks + kswz<DQK>(r32, d0 * 2 + hi));
        const f16x8 b1 = *(const LAS f16x8*)(Ks + kswz<DQK>(32 + r32, d0 * 2 + hi));
        p0 = __builtin_amdgcn_mfma_f32_32x32x16_f16(b0, qr[d0], p0, 0, 0, 0);
        p1 = __builtin_amdgcn_mfma_f32_32x32x16_f16(b1, qr[d0], p1, 0, 0, 0);
    }
}
__device__ __forceinline__ int v_st(int k, int c) { const int kk = (k & ~0xC) | ((k & 4) << 1) | ((k & 8) >> 1); return ((kk >> 3) * 2 + (c >> 5)) * 512 + ((kk & 7) * 32 + (c & 31)) * 2; }
__device__ __forceinline__ int v_rd_base(int lane) { return ((lane & 3) << 3) | (((lane >> 2) & 3) << 6) | (((lane >> 4) & 1) << 5) | (((lane >> 5) & 1) << 8); }
constexpr int v_rd_off(int d0, int ks, int half) { return d0 * 512 + ks * 2048 + half * 1024; }
template <int OFF> __device__ __forceinline__ s16x4 tr_read(int vb) {
    s16x4 r; asm volatile("ds_read_b64_tr_b16 %0, %1 offset:%2" : "=&v"(r) : "v"(vb), "i"(OFF) : "memory"); return r;
}
template <int D0> __device__ __forceinline__ void pv_one(f32x16& od, int vb, f16x8 pa0, f16x8 pa1, f16x8 pa2, f16x8 pa3) {
    const s16x4 l0 = tr_read<v_rd_off(D0, 0, 0)>(vb), h0 = tr_read<v_rd_off(D0, 0, 1)>(vb), l1 = tr_read<v_rd_off(D0, 1, 0)>(vb), h1 = tr_read<v_rd_off(D0, 1, 1)>(vb);
    const s16x4 l2 = tr_read<v_rd_off(D0, 2, 0)>(vb), h2_ = tr_read<v_rd_off(D0, 2, 1)>(vb), l3 = tr_read<v_rd_off(D0, 3, 0)>(vb), h3 = tr_read<v_rd_off(D0, 3, 1)>(vb);
    asm volatile("s_waitcnt lgkmcnt(0)" ::: "memory"); FA_SBAR();
#define FA_PK(L, H) __builtin_bit_cast(f16x8, (short __attribute__((ext_vector_type(8)))){L[0], L[1], L[2], L[3], H[0], H[1], H[2], H[3]})
    od = __builtin_amdgcn_mfma_f32_32x32x16_f16(pa0, FA_PK(l0, h0), od, 0, 0, 0);
    od = __builtin_amdgcn_mfma_f32_32x32x16_f16(pa1, FA_PK(l1, h1), od, 0, 0, 0);
    od = __builtin_amdgcn_mfma_f32_32x32x16_f16(pa2, FA_PK(l2, h2_), od, 0, 0, 0);
    od = __builtin_amdgcn_mfma_f32_32x32x16_f16(pa3, FA_PK(l3, h3), od, 0, 0, 0);
#undef FA_PK
}
__device__ __forceinline__ void pv_d0(f32x16* o, int vb, f16x8 pa0, f16x8 pa1, f16x8 pa2, f16x8 pa3) {
    pv_one<0>(o[0], vb, pa0, pa1, pa2, pa3); pv_one<1>(o[1], vb, pa0, pa1, pa2, pa3);
}
template <int DQK>
__device__ __forceinline__ void attn_unit(const f16* __restrict__ Qb, const f16* __restrict__ Kh, const f16* __restrict__ Vh, f16* __restrict__ Ob, int nkeys, LAS unsigned char* lds, const int tid) {
    constexpr int SHM_K = Cfg<DQK>::SHM_K, NCH = Cfg<DQK>::NCH, ND0 = DQK / 16;
    const int wid = tid >> 6, lane = tid & 63, r32 = lane & 31, hi = lane >> 5;
    LAS unsigned char* V_lds = lds; LAS unsigned char* K_lds = lds + 3 * SHM_V;
    LAS float* wsx = (LAS float*)(lds + 3 * SHM_V + 2 * SHM_K) + wid * 64; LAS float* li_l = wsx; LAS float* al_l = wsx + 32;
    float m_reg = -1e30f, l_reg = 0; f32x16 o[2] = {}; f16x8 qr[ND0];
    const f16* Qw = Qb + (size_t)(wid * 32 + r32) * DQK + hi * 8;
#pragma unroll
    for (int d0 = 0; d0 < ND0; ++d0) qr[d0] = *(const f16x8*)(Qw + d0 * 16);
    const int vr = tid >> 3, vc = (tid & 7) * 8, vst = v_st(vr, vc);
    const int k0id = tid, k1id = (tid + 512 < 64 * NCH) ? tid + 512 : tid;
    const int k0r = k0id / NCH, k0c = k0id % NCH, k1r = k1id / NCH, k1c = k1id % NCH;
    const bool k1on = (NCH > 8) && (tid + 512 < 64 * NCH);
    const int vb0 = (int)(uintptr_t)V_lds + v_rd_base(lane);
    struct { f16x8 vs, ks0, ks1; } sr_[2];
#define FA_SLOAD(i, kk0) do { sr_[i].vs = *(const f16x8*)(Vh + (size_t)((kk0) + vr) * 64 + vc); sr_[i].ks0 = *(const f16x8*)(Kh + (size_t)((kk0) + k0r) * DQK + k0c * 8); \
    if (NCH > 8) sr_[i].ks1 = *(const f16x8*)(Kh + (size_t)((kk0) + k1r) * DQK + k1c * 8); } while (0)
#define FA_SWRITE(b, vbo, i) do { *(LAS f16x8*)(V_lds + (vbo) + vst) = sr_[i].vs; *(LAS f16x8*)(K_lds + (b) * SHM_K + kswz<DQK>(k0r, k0c)) = sr_[i].ks0; \
    if (k1on) *(LAS f16x8*)(K_lds + (b) * SHM_K + kswz<DQK>(k1r, k1c)) = sr_[i].ks1; } while (0)
#define FA_SWAIT() do { if (NCH > 8) asm volatile("s_waitcnt vmcnt(3)" ::: "memory"); else asm volatile("s_waitcnt vmcnt(2)" ::: "memory"); } while (0)
#define FA_RESC(a) do { if (__any((a) < 1.f)) { if (hi == 0) al_l[r32] = (a); asm volatile("s_waitcnt lgkmcnt(0)" ::: "memory"); \
    _Pragma("unroll") for (int d = 0; d < 2; ++d) _Pragma("unroll") for (int r = 0; r < 16; ++r) o[d][r] *= al_l[crow(r, hi)]; } } while (0)
    f32x16 pA0, pA1, pB0, pB1; float mnA, mnB, alA, alB; f16x8 pa0, pa1, pa2, pa3; const int NT = nkeys / 64;
    constexpr int SE = 0, SO = 1;
    int vp = 0, vc_ = SHM_V, vn = 2 * SHM_V;
#define FA_VROT() do { const int t_ = vp; vp = vc_; vc_ = vn; vn = t_; } while (0)
    FA_SLOAD(SE, 0); asm volatile("s_waitcnt vmcnt(0)" ::: "memory"); FA_SWRITE(0, 0, SE); __syncthreads();
    qkt<DQK>(pA0, pA1, K_lds, qr, r32, hi); partialSM(pA0, pA1, m_reg, mnA, alA);
    FA_SLOAD(SO, 64); if (2 < NT) FA_SLOAD(SE, 128);
    FA_SWAIT(); FA_SWRITE(1, SHM_V, SO); __syncthreads();
    for (int j = 1; j + 1 < NT; j += 2) {
        FA_SBAR(); qkt<DQK>(pB0, pB1, K_lds + SHM_K, qr, r32, hi);
        finishSM(pA0, pA1, alA, l_reg, pa0, pa1, pa2, pa3); FA_SBAR();
        FA_SLOAD(SO, (j + 2) * 64); FA_SBAR();
        pv_d0(o, vb0 + vp, pa0, pa1, pa2, pa3); partialSM(pB0, pB1, m_reg, mnB, alB);
        FA_SWAIT(); FA_SWRITE(0, vn, SE);
        FA_RESC(alB); __syncthreads(); FA_VROT();
        FA_SBAR(); qkt<DQK>(pA0, pA1, K_lds, qr, r32, hi);
        finishSM(pB0, pB1, alB, l_reg, pa0, pa1, pa2, pa3); FA_SBAR();
        if (j + 3 < NT) FA_SLOAD(SE, (j + 3) * 64);
        FA_SBAR();
        pv_d0(o, vb0 + vp, pa0, pa1, pa2, pa3); partialSM(pA0, pA1, m_reg, mnA, alA);
        FA_SWAIT(); FA_SWRITE(1, vn, SO);
        FA_RESC(alA); __syncthreads(); FA_VROT();
    }
    FA_SBAR(); qkt<DQK>(pB0, pB1, K_lds + SHM_K, qr, r32, hi);
    finishSM(pA0, pA1, alA, l_reg, pa0, pa1, pa2, pa3); FA_SBAR();
    pv_d0(o, vb0 + vp, pa0, pa1, pa2, pa3); partialSM(pB0, pB1, m_reg, mnB, alB);
    FA_RESC(alB);
    finishSM(pB0, pB1, alB, l_reg, pa0, pa1, pa2, pa3); FA_SBAR();
    pv_d0(o, vb0 + vc_, pa0, pa1, pa2, pa3);
    if (hi == 0) li_l[r32] = l_reg;
    asm volatile("s_waitcnt lgkmcnt(0)" ::: "memory");
    float rli[16];
#pragma unroll
    for (int r = 0; r < 16; ++r) rli[r] = __builtin_amdgcn_rcpf(li_l[crow(r, hi)]);
    f16* Ow = Ob + (size_t)(wid * 32) * 512;
#pragma unroll
    for (int r = 0; r < 16; ++r) { const int orow = crow(r, hi);
#pragma unroll
        for (int d0 = 0; d0 < 2; ++d0) Ow[(size_t)orow * 512 + d0 * 32 + r32] = (f16)(o[d0][r] * rli[r]); }
#undef FA_SLOAD
#undef FA_SWRITE
#undef FA_SWAIT
#undef FA_RESC
#undef FA_VROT
}
}
__device__ __forceinline__ void phase_attn_flash(const Ctx& C, int l) {
    const f16* QA = (const f16*)(C.ws() + A_QA); const f16* QC = (const f16*)(C.ws() + A_QC);
    const f16* KA = (const f16*)(C.ws() + A_KA); const f16* VA = (const f16*)(C.ws() + A_VA);
    const f16* KC = (const f16*)(C.ws() + A_KC); const f16* VC = (const f16*)(C.ws() + A_VC);
    f16* YA = (f16*)(C.ws() + A_YA); f16* YC = (f16*)(C.ws() + A_YC);
    const int vcu = (C.nblk % 8 == 0) ? (C.bid % 8) * (C.nblk / 8) + C.bid / 8 : C.bid;
    const int total = 1024 + (l == 0 ? 64 : 0);
    for (int u = vcu; u < total; u += C.nblk) {
        __syncthreads();
        int typeC, b, h, nkeys; size_t qrow, orow;
        if (u < 1024) { const int v = u & 511; typeC = u >> 9; b = v >> 7; h = (v >> 4) & 7; const int qb = v & 15; qrow = (size_t)(b * 8 + h) * SEQ + qb * 256; orow = (size_t)b * SEQ + qb * 256; nkeys = NKEY; }
        else { const int v = (u - 1024) & 31; typeC = (u - 1024) >> 5; b = v >> 3; h = v & 7; qrow = (size_t)NB * 8 * SEQ + (size_t)(b * 8 + h) * CTX; orow = (size_t)NLAT + b * CTX; nkeys = CTX; }
        if (!typeC) fa::attn_unit<64>(QA + qrow * 64, KA + (size_t)(b * 2 + (h >> 2)) * NKEY * 64, VA + (size_t)(b * 2 + (h >> 2)) * NKEY * 64, YA + orow * 512 + h * 64, nkeys, C.lds, C.tid);
        else fa::attn_unit<96>(QC + qrow * 96, KC + (size_t)(b * 8 + h) * NKEY * 96, VC + (size_t)(b * 8 + h) * NKEY * 64, YC + orow * 512 + h * 64, nkeys, C.lds, C.tid);
    }
}

constexpr float S5SC = 1024.0f, S5ISC = 1.0f / 1024.0f;
__device__ __forceinline__ void qp_split(int qp, int& b, int& nmem) { if (qp < 1024) { b = qp >> 8; nmem = 16 + (qp & 255); } else { b = (qp - 1024) >> 4; nmem = (qp - 1024) & 15; } }
__device__ __forceinline__ void phase_s5tab(const Ctx& C, int l) {
    LAS float* ApR = (LAS float*)C.lds; LAS float* ApI = ApR + 17 * 64; LAS float* BbR = ApI + 17 * 64; LAS float* BbI = BbR + 1024; LAS float* CR = BbI + 1024; LAS float* CI = CR + 1024;
    for (int u = C.bid; u < 64; u += C.nblk) {
        const int dir = u >> 5, g = u & 31; const size_t gi = (size_t)(l * 2 + dir) * 32 + g;
        const float dt = expf(C.in(I_SLDT)[gi]);
        __syncthreads();
        for (int i = C.tid; i < 17 * 64; i += NTHREADS) {
            const int p = i & 63, k = i >> 6; const float are = C.in(I_SARE)[gi * 64 + p], aim = C.in(I_SAIM)[gi * 64 + p];
            const float mag = expf(are * dt * (float)k), ang = (aim * dt) * (float)k;
            ApR[i] = mag * cosf(ang); ApI[i] = mag * sinf(ang);
        }
        for (int i = C.tid; i < 1024; i += NTHREADS) {
            const int p = i >> 4, c = i & 15; const float are = C.in(I_SARE)[gi * 64 + p], aim = C.in(I_SAIM)[gi * 64 + p];
            const float mag = expf(are * dt), th = aim * dt, abr = mag * cosf(th), abi = mag * sinf(th);
            const float den = are * are + aim * aim, nr = abr - 1.0f, cr = (nr * are + abi * aim) / den, ci = (abi * are - nr * aim) / den;
            const float br = C.in(I_SBRE)[(gi * 64 + p) * 16 + c], bi = C.in(I_SBIM)[(gi * 64 + p) * 16 + c];
            BbR[i] = cr * br - ci * bi; BbI[i] = cr * bi + ci * br;
            CR[i] = C.in(I_SCRE)[gi * 1024 + i]; CI[i] = C.in(I_SCIM)[gi * 1024 + i];
        }
        __syncthreads();
        f16* Et = (f16*)(C.ws() + T_E) + (size_t)u * 16 * 16 * 128; f16* Mt = (f16*)(C.ws() + T_M); f16* Kt = (f16*)(C.ws() + T_K) + (size_t)u * 17 * 256;
        for (int i = C.tid; i < 16384; i += NTHREADS) {
            { const int t = i >> 10, c = (i >> 6) & 15, p = i & 63, k = dir == 0 ? t + 1 : 16 - t;
              const float cr = CR[c * 64 + p], ci = CI[c * 64 + p], ar = ApR[k * 64 + p], ai = ApI[k * 64 + p];
              Et[(size_t)(t * 16 + c) * 128 + p] = (f16)((cr * ar - ci * ai) * S5SC); Et[(size_t)(t * 16 + c) * 128 + 64 + p] = (f16)(-(cr * ai + ci * ar) * S5SC); }
            { const int p = i >> 8, sx = (i >> 4) & 15, c = i & 15, k = dir == 0 ? 15 - sx : sx;
              const float ar = ApR[k * 64 + p], ai = ApI[k * 64 + p], br = BbR[p * 16 + c], bi = BbI[p * 16 + c];
              Mt[m3_off(u, p >> 5, sx, c >> 3, p & 31) + (c & 7)] = (f16)((ar * br - ai * bi) * S5SC);
              Mt[m3_off(u, 2 + (p >> 5), sx, c >> 3, p & 31) + (c & 7)] = (f16)((ar * bi + ai * br) * S5SC); }
        }
        for (int i = C.tid; i < 17 * 256; i += NTHREADS) {
            const int tau = (i >> 8) - 1, c = (i >> 4) & 15, cp = i & 15; float acc = 0.f;
            if (tau >= 0) {
#pragma unroll 8
                for (int p = 0; p < 64; ++p) {
                    const float cr = CR[c * 64 + p], ci = CI[c * 64 + p], ar = ApR[tau * 64 + p], ai = ApI[tau * 64 + p];
                    acc += (cr * ar - ci * ai) * BbR[p * 16 + cp] - (cr * ai + ci * ar) * BbI[p * 16 + cp]; }
            }
            Kt[i] = (f16)(acc * S5SC);
        }
    }
}
__device__ __forceinline__ void phase_s5a(const Ctx& C) {
    const f16* U = (const f16*)(C.ws() + A_U); float* S = (float*)(C.ws() + A_S5S); const f16* Mt = (const f16*)(C.ws() + T_M);
    const int r32 = C.lane & 31, hi = C.lane >> 5;
    for (int u = C.bid * NWAVES + C.wid; u < 64 * 34; u += C.nblk * NWAVES) {
        const int dirg = u / 34, nb = u - dirg * 34, g = dirg & 31;
        int b, nmem; qp_split(nb * 32 + r32, b, nmem);
        f16x8 uf[16];
#pragma unroll
        for (int sx = 0; sx < 16; ++sx) uf[sx] = *(const f16x8*)(U + u3_off(g, nb, sx, hi, r32));
        float* sp = S + ((size_t)(dirg * 4 + b) * 128) * 272 + nmem;
#pragma unroll
        for (int mb = 0; mb < 4; ++mb) {
            f16x8 af[16];
#pragma unroll
            for (int sx = 0; sx < 16; ++sx) af[sx] = *(const f16x8*)(Mt + m3_off(dirg, mb, sx, hi, r32));
            f32x16 acc = {};
#pragma unroll
            for (int sx = 0; sx < 16; ++sx) acc = __builtin_amdgcn_mfma_f32_32x32x16_f16(af[sx], uf[sx], acc, 0, 0, 0);
#pragma unroll
            for (int r = 0; r < 16; ++r) sp[(size_t)(mb * 32 + fa::crow(r, hi)) * 272] = acc[r] * S5ISC;
        }
    }
}
__device__ __forceinline__ void phase_s5b(const Ctx& C, int l) {
    const float* S = (const float*)(C.ws() + A_S5S); f16* X = (f16*)(C.ws() + A_S5X);
    for (int item = C.wid * C.nblk + C.bid; item < 256; item += C.nblk * NWAVES) {
        const int p = C.lane, db = item, dirg = db >> 2, b = db & 3, dir = dirg >> 5, g = dirg & 31; const size_t gi = (size_t)(l * 2 + dir) * 32 + g;
        const float are = C.in(I_SARE)[gi * 64 + p], aim = C.in(I_SAIM)[gi * 64 + p], dt = expf(C.in(I_SLDT)[gi]);
        const float mag = expf(are * dt * 16.0f), ang = (aim * dt) * 16.0f, ar = mag * cosf(ang), ai = mag * sinf(ang);
        const float* sr = S + ((size_t)db * 128 + p) * 272; const float* si = sr + 64 * 272;
        const int kkr = p >> 4, hf = (p >> 3) & 1, jj = p & 7;
        float xr = 0.f, xi = 0.f;
        f32x4 cr[4], ci[4], nr[4], ni[4];
        int base = 0;
#pragma unroll
        for (int j = 0; j < 4; ++j) { cr[j] = *(const f32x4*)(sr + base + 4 * j); ci[j] = *(const f32x4*)(si + base + 4 * j); }
#pragma unroll 1
        for (int k = 0; k < 17; ++k) {
            const int nbase = dir == 0 ? 16 * (k + 1) : 272 - 16 * (k + 1);
            if (k < 16) {
#pragma unroll
                for (int j = 0; j < 4; ++j) { nr[j] = *(const f32x4*)(sr + nbase + 4 * j); ni[j] = *(const f32x4*)(si + nbase + 4 * j); }
            }
#pragma unroll
            for (int e = 0; e < 16; ++e) {
                const int ef = e, eb = 15 - e;
                const float sre = dir == 0 ? cr[ef >> 2][ef & 3] : cr[eb >> 2][eb & 3], sim = dir == 0 ? ci[ef >> 2][ef & 3] : ci[eb >> 2][eb & 3];
                const int nmem = base + (dir == 0 ? ef : eb);
                const int qp = nmem >= 16 ? b * 256 + nmem - 16 : 1024 + b * 16 + nmem;
                X[x3_off(dirg, qp >> 5, kkr, hf, qp & 31) + jj] = (f16)xr; X[x3_off(dirg, qp >> 5, 4 + kkr, hf, qp & 31) + jj] = (f16)xi;
                const float nxr = ar * xr - ai * xi + sre, nxi = ar * xi + ai * xr + sim; xr = nxr; xi = nxi;
            }
#pragma unroll
            for (int j = 0; j < 4; ++j) { cr[j] = nr[j]; ci[j] = ni[j]; }
            base = nbase;
        }
    }
}
__device__ __forceinline__ void phase_s5c(const Ctx& C, int l) {
    const f16* U = (const f16*)(C.ws() + A_U); const f16* X = (const f16*)(C.ws() + A_S5X); f16* G = (f16*)(C.ws() + A_G);
    const int r32 = C.lane & 31, hi = C.lane >> 5, t0 = 2 * C.wid, trow = t0 + (r32 >> 4), crw = r32 & 15;
    const int nnb = l == 0 ? 34 : 32;
    LAS f16* Kl = (LAS f16*)C.lds;
    int cur_g = -1; f16x8 ef[2][8];
    for (int u = C.bid; u < 32 * nnb; u += C.nblk) {
        const int g = u & 31, nb = u >> 5;
        const int row0 = (nb * 32 + r32) * 16;
        f16x8 uf[16], xf[2][8]; f16x4 u4[2][2];
#pragma unroll
        for (int sx = 0; sx < 16; ++sx) uf[sx] = *(const f16x8*)(U + u3_off(g, nb, sx, hi, r32));
#pragma unroll
        for (int dir = 0; dir < 2; ++dir)
#pragma unroll
            for (int kk = 0; kk < 8; ++kk) xf[dir][kk] = *(const f16x8*)(X + x3_off(dir * 32 + g, nb, kk, hi, r32));
#pragma unroll
        for (int tl = 0; tl < 2; ++tl)
#pragma unroll
            for (int gp = 0; gp < 2; ++gp) u4[tl][gp] = *(const f16x4*)(U + u3_off(g, nb, t0 + tl, gp, r32) + 4 * hi);
        if (g != cur_g) {
            __syncthreads();
            for (int i = C.tid; i < 2 * 17 * 256 / 8; i += NTHREADS) {
                const int dir = i / (17 * 32), j = i - dir * (17 * 32);
                *(LAS f16x8*)(Kl + (size_t)i * 8) = *(const f16x8*)((const f16*)(C.ws() + T_K) + (size_t)(dir * 32 + g) * 17 * 256 + j * 8);
            }
#pragma unroll
            for (int dir = 0; dir < 2; ++dir)
#pragma unroll
                for (int kk = 0; kk < 8; ++kk) ef[dir][kk] = *(const f16x8*)((const f16*)(C.ws() + T_E) + (size_t)(dir * 32 + g) * 16 * 16 * 128 + (size_t)(trow * 16 + crw) * 128 + kk * 16 + 8 * hi);
            __syncthreads();
            cur_g = g;
        }
        f32x16 acc = {};
        const LAS f16* kb = Kl + crw * 16 + 8 * hi;
#pragma unroll
        for (int sx = 0; sx < 16; ++sx) {
            if (sx <= t0 + 1) { const f16x8 af = *(const LAS f16x8*)(kb + (trow - sx + 1) * 256); acc = __builtin_amdgcn_mfma_f32_32x32x16_f16(af, uf[sx], acc, 0, 0, 0); }
            if (sx >= t0) { const f16x8 af = *(const LAS f16x8*)(kb + (17 + sx - trow + 1) * 256); acc = __builtin_amdgcn_mfma_f32_32x32x16_f16(af, uf[sx], acc, 0, 0, 0); }
        }
#pragma unroll
        for (int dir = 0; dir < 2; ++dir)
#pragma unroll
            for (int kk = 0; kk < 8; ++kk) acc = __builtin_amdgcn_mfma_f32_32x32x16_f16(ef[dir][kk], xf[dir][kk], acc, 0, 0, 0);
#pragma unroll
        for (int tl = 0; tl < 2; ++tl)
#pragma unroll
            for (int gp = 0; gp < 2; ++gp) {
                const size_t off = (size_t)(row0 + t0 + tl) * 512 + g * 16 + 4 * hi + 8 * gp;
                const f32x4 d4 = *(const f32x4*)(C.in(I_SD) + l * 512 + g * 16 + 4 * hi + 8 * gp);
                f32x4 y;
#pragma unroll
                for (int e = 0; e < 4; ++e) y[e] = gelu_tanh(acc[8 * tl + 4 * gp + e] * S5ISC + d4[e] * (float)u4[tl][gp][e]);
                *(f16x4*)(G + off) = pack4(y);
            }
    }
}

__device__ __forceinline__ void phase_s5_naive(const Ctx& C, int l) {
    const f16* U = (const f16*)(C.ws() + A_U); float* YSF = (float*)(C.ws() + A_YSF);
    LAS float* cst = (LAS float*)C.lds + C.wid * (16 * 128 + 4 * 128);
    LAS float* sst = cst + 16 * 128;
    const int lane = C.lane;
    for (int u = C.bid * NWAVES + C.wid; u < NB * 32; u += C.nblk * NWAVES) {
        const int b = u >> 5, g = u & 31;
        for (int dir = 0; dir < 2; ++dir) {
            const size_t gi = ((size_t)(l * 2 + dir) * 32 + g);
            const float are = C.in(I_SARE)[gi * 64 + lane], aim = C.in(I_SAIM)[gi * 64 + lane];
            const float dt = expf(C.in(I_SLDT)[gi]);
            const float mag = expf(are * dt), th = aim * dt;
            const float abr = mag * cosf(th), abi = mag * sinf(th);
            const float den = are * are + aim * aim, nr = abr - 1.0f;
            const float cr = (nr * are + abi * aim) / den, ci = (abi * are - nr * aim) / den;
            float bbr[16], bbi[16];
#pragma unroll
            for (int c = 0; c < 16; ++c) {
                const float br = C.in(I_SBRE)[(gi * 64 + lane) * 16 + c], bi = C.in(I_SBIM)[(gi * 64 + lane) * 16 + c];
                bbr[c] = cr * br - ci * bi; bbi[c] = cr * bi + ci * br; }
#pragma unroll
            for (int c = 0; c < 16; ++c) { cst[c * 128 + lane] = C.in(I_SCRE)[(gi * 16 + c) * 64 + lane]; cst[c * 128 + 64 + lane] = C.in(I_SCIM)[(gi * 16 + c) * 64 + lane]; }
            asm volatile("s_waitcnt lgkmcnt(0)" ::: "memory");
            float xr = 0.f, xi = 0.f;
            const int tk = lane >> 4, cc = lane & 15;
            const float dcoef = C.in(I_SD)[l * 512 + g * 16 + cc];
            for (int i0 = 0; i0 < NKEY; i0 += 4) {
                int rows[4];
#pragma unroll
                for (int k = 0; k < 4; ++k) {
                    const int i = i0 + k; int row;
                    if (dir == 0) row = i < CTX ? NLAT + b * CTX + i : b * SEQ + (i - CTX);
                    else row = i < CTX ? NLAT + b * CTX + (CTX - 1 - i) : b * SEQ + (SEQ - 1 - (i - CTX));
                    rows[k] = row;
                    const f16x8 u0 = *(const f16x8*)(U + (size_t)row * 512 + g * 16), u1 = *(const f16x8*)(U + (size_t)row * 512 + g * 16 + 8);
                    float bur = 0.f, bui = 0.f;
#pragma unroll
                    for (int c = 0; c < 8; ++c) { bur += bbr[c] * (float)u0[c] + bbr[8 + c] * (float)u1[c]; bui += bbi[c] * (float)u0[c] + bbi[8 + c] * (float)u1[c]; }
                    const float nxr = abr * xr - abi * xi + bur, nxi = abr * xi + abi * xr + bui;
                    xr = nxr; xi = nxi;
                    sst[k * 128 + lane] = xr; sst[k * 128 + 64 + lane] = xi;
                }
                asm volatile("s_waitcnt lgkmcnt(0)" ::: "memory");
                float y = 0.f;
#pragma unroll 16
                for (int p = 0; p < 64; ++p) y += cst[cc * 128 + p] * sst[tk * 128 + p] - cst[cc * 128 + 64 + p] * sst[tk * 128 + 64 + p];
                asm volatile("s_waitcnt lgkmcnt(0)" ::: "memory");
                int myrow = rows[0];
#pragma unroll
                for (int k = 1; k < 4; ++k) myrow = (tk == k) ? rows[k] : myrow;
                if (myrow < NLAT || l == 0) {
                    float* dst = YSF + (size_t)myrow * 512 + g * 16 + cc;
                    if (dir == 0) *dst = y + dcoef * (float)U[(size_t)myrow * 512 + g * 16 + cc];
                    else *dst = *dst + y;
                }
            }
            asm volatile("s_waitcnt vmcnt(0)" ::: "memory");
            __builtin_amdgcn_fence(__ATOMIC_RELEASE, "workgroup");
        }
    }
}
__device__ __forceinline__ void phase_s5_gelu(const Ctx& C, int nrows) {
    const float* YSF = (const float*)(C.ws() + A_YSF); f16* G = (f16*)(C.ws() + A_G);
    const size_t n4 = (size_t)nrows * 512 / 4;
    for (size_t i = (size_t)C.bid * NTHREADS + C.tid; i < n4; i += (size_t)C.nblk * NTHREADS) {
        f32x4 v = ((const f32x4*)YSF)[i];
#pragma unroll
        for (int e = 0; e < 4; ++e) v[e] = gelu_tanh(v[e]);
        ((f16x4*)G)[i] = pack4(v);
    }
}

typedef __attribute__((address_space(1))) unsigned gu32;
#define XB_TMO      128
#define XB_XCNT(j)  (256  + 64 * (j))
#define XB_XSUB(j)  (1280 + 64 * (j))
#define XB_XGEN(j)  (2304 + 64 * (j))
#define XB_TOP      3328
#define XB_TOPGEN   3392
#define XCD_BAR_WORDS 3456
#define XB_SPIN_CAP (1u << 26)

__device__ __forceinline__ unsigned xb_ld(unsigned* p)              { return __hip_atomic_load(p, __ATOMIC_RELAXED, __HIP_MEMORY_SCOPE_AGENT); }
__device__ __forceinline__ unsigned xb_add(unsigned* p, unsigned v) { return __hip_atomic_fetch_add(p, v, __ATOMIC_RELAXED, __HIP_MEMORY_SCOPE_AGENT); }
__device__ __forceinline__ unsigned xb_xcc_id() { return (unsigned)__builtin_amdgcn_s_getreg((3 << 11) | 20) & 0xFu; }
#define XB_SPIN(cond, bar) do { unsigned _sp = 0; while (cond) { __builtin_amdgcn_s_sleep(1); \
    if ((++_sp & 255u) == 0u) { if (xb_ld(&(bar)[XB_TMO])) break; if (_sp > XB_SPIN_CAP) { atomicAdd(&(bar)[XB_TMO], 1u); break; } } } } while (0)

struct XcdBarrier {
    unsigned* bar; unsigned x;
    volatile LAS unsigned* st;
};

__device__ __forceinline__ XcdBarrier xcd_barrier_post(unsigned* bar, volatile LAS unsigned* st) {
    XcdBarrier b; b.bar = bar; b.x = xb_xcc_id(); b.st = st;
    if (threadIdx.x == 0) (void)xb_add(&bar[XB_XCNT(b.x)], 1u);
    return b;
}
__device__ __forceinline__ void xcd_barrier_complete(unsigned* bar, unsigned x, unsigned& nloc, unsigned& nx) {
    const unsigned G = gridDim.x * gridDim.y * gridDim.z;
    unsigned sum, cnt, mine, sp = 0u;
    for (;;) {
        sum = 0u; cnt = 0u; mine = 0u;
#pragma unroll
        for (unsigned j = 0; j < 16; ++j) { const unsigned c = xb_ld(&bar[XB_XCNT(j)]); sum += c; cnt += (c > 0u) ? 1u : 0u; mine = (j == x) ? c : mine; }
        if (sum == G) break;
        __builtin_amdgcn_s_sleep(1);
        if ((++sp & 255u) == 0u) { if (xb_ld(&bar[XB_TMO])) break; if (sp > XB_SPIN_CAP) { atomicAdd(&bar[XB_TMO], 1u); break; } }
    }
    nloc = mine > 0u ? mine : 1u; nx = cnt > 0u ? cnt : 1u;
}

__device__ __forceinline__ void xcd_barrier(const XcdBarrier& b, const bool t0) {
    asm volatile("s_waitcnt vmcnt(0)" ::: "memory");
    __syncthreads();
    if (t0) {
        unsigned* bar = b.bar;
        __builtin_amdgcn_s_waitcnt(0);
        unsigned nloc = b.st[0], nx = b.st[1];
        if (nloc == 0u) { xcd_barrier_complete(bar, b.x, nloc, nx); b.st[0] = nloc; b.st[1] = nx; }
        const unsigned old = xb_add(&bar[XB_XSUB(b.x)], 1u);
        const unsigned gen = old / nloc;
        if (old + 1u == (gen + 1u) * nloc) {
            __builtin_amdgcn_fence(__ATOMIC_RELEASE, "agent");
            asm volatile("s_waitcnt vmcnt(0)" ::: "memory");
            const unsigned og = xb_add(&bar[XB_TOP], 1u);
            const unsigned tg = og / nx;
            if (og + 1u == (tg + 1u) * nx) xb_add(&bar[XB_TOPGEN], 1u);
            else XB_SPIN(xb_ld(&bar[XB_TOPGEN]) == tg, bar);
            __builtin_amdgcn_fence(__ATOMIC_ACQUIRE, "agent");
            xb_add(&bar[XB_XGEN(b.x)], 1u);
            asm volatile("s_waitcnt vmcnt(0)" ::: "memory");
        } else {
            XB_SPIN(xb_ld(&bar[XB_XGEN(b.x)]) == gen, bar);
            __builtin_amdgcn_fence(__ATOMIC_ACQUIRE, "agent");
            asm volatile("s_waitcnt vmcnt(0)" ::: "memory");
        }
    }
    __syncthreads();
}

#ifndef PROBE_PH
#define PROBE_PH -1
#endif
struct Env { XcdBarrier bar; int wid; unsigned long long t_acc; };
#define PH_BEGIN(k) unsigned long long _t0 = 0; if (PROBE_PH == (k)) _t0 = __builtin_amdgcn_s_memrealtime()
#define PH_END(k) if (PROBE_PH == (k)) env.t_acc += __builtin_amdgcn_s_memrealtime() - _t0
#define GSYNC() do { const Ctx Cb = make_ctx(env.wid); xcd_barrier(env.bar, Cb.tid == 0); } while (0)
constexpr int MISC_OFF = LDS_BYTES - 256;
constexpr int CW_BAR = 4096;
#define CTX() const Ctx C = make_ctx(env.wid); unsigned char* ws = C.ws()
template <int l>
__device__ __forceinline__ void layer_body(Env& env) {
        const int mrows = l == 0 ? MALL : NLAT;
        if (l == 0) { PH_BEGIN(0);
        { CTX(); (void)ws; phase_p1(C, 0); }
        GSYNC(); PH_END(0); }
        { PH_BEGIN(1);
        { CTX(); EpiStore E{(f16*)(ws + A_PROJ), PLD};
          gemm_pg8(C, (const f16*)(ws + A_H), D, (const f16*)(ws + W_INA), D, MALL, 2560, D, E); }
        GSYNC(); PH_END(1); }
        { PH_BEGIN(2);
        { CTX(); (void)ws; phase_p3(C, l); }
        GSYNC(); PH_END(2); }
        { PH_BEGIN(3);
        { CTX(); EpiKvUp E1{(f16*)(ws + A_KC), (f16*)(ws + A_VC)};
          gemm_rows(C, (const f16*)(ws + A_PROJ) + OFF_CKV, PLD, (const f16*)(ws + W_KVB), 256, MALL, 1024, 256, E1); }
        { CTX(); EpiQUp E2{(f16*)(ws + A_QC), (const float*)(ws + WS_ROPE) + 2048};
          gemm_pg8(C, (const f16*)(ws + A_PROJ) + OFF_CQ, PLD, (const f16*)(ws + W_QB), 768, mrows, 768, 768, E2); }
        GSYNC(); PH_END(3); }
        { PH_BEGIN(4);
        { CTX(); (void)ws; phase_s5a(C); }
        { CTX(); (void)ws; phase_attn_flash(C, l); }
        GSYNC(); PH_END(4); }
        { PH_BEGIN(5);
        { CTX(); (void)ws; phase_s5b(C, l); }
        GSYNC(); PH_END(5); }
        { PH_BEGIN(6);
        { CTX(); (void)ws; phase_s5c(C, l); }
        { CTX(); (void)ws; phase_hre(C, l, mrows); }
        GSYNC(); PH_END(6); }
        { PH_BEGIN(7);
        { CTX(); EpiGlu E{(f16*)(ws + A_YS)};
          gemm_rows(C, (const f16*)(ws + A_G), 512, (const f16*)(ws + W_GLU), 512, mrows, 1024, 512, E); }
        GSYNC(); PH_END(7); }
        { PH_BEGIN(8);
        {
            CTX();
            const f16* Hh = (const f16*)(ws + A_H); const f16* Wg = (const f16*)(ws + W_GATE); const f16* Wb = (const f16*)(ws + W_BR);
            const f16* Y0 = (const f16*)(ws + A_YA); const f16* Y1 = (const f16*)(ws + A_YS); const f16* Y2 = (const f16*)(ws + A_YC);
            EpiGate Eg{(f16*)(ws + A_GATE)}; EpiBranch Eb0{(const f16*)(ws + A_GATE), (f16*)(ws + A_MERGED), 1}; EpiBranch Eb{(const f16*)(ws + A_GATE), (f16*)(ws + A_MERGED), 0};
            constexpr size_t WGS = (size_t)1024 * 1024, WBS = (size_t)1024 * 512;
            gemm_pg8c<false, true>(C, Hh, D, Wg, D, NLAT, 1024, D, Eg, Y0, 512, Wb, 512);
            gemm_pg8c<true, true>(C, Y0, 512, Wb, 512, NLAT, 1024, 512, Eb0, Hh, D, Wg + WGS, D);
            gemm_pg8c<true, true>(C, Hh, D, Wg + WGS, D, NLAT, 1024, D, Eg, Y1, 512, Wb + WBS, 512);
            gemm_pg8c<true, true>(C, Y1, 512, Wb + WBS, 512, NLAT, 1024, 512, Eb, Hh, D, Wg + 2 * WGS, D);
            gemm_pg8c<true, true>(C, Hh, D, Wg + 2 * WGS, D, NLAT, 1024, D, Eg, Y2, 512, Wb + 2 * WBS, 512);
            gemm_pg8c<true, false>(C, Y2, 512, Wb + 2 * WBS, 512, NLAT, 1024, 512, Eb, Hh, D, Wg, D);
        }
        if (mrows > NLAT) {
#pragma unroll
            for (int br = 0; br < 3; ++br) {
                { CTX(); EpiGate Eg{(f16*)(ws + A_GATE)};
                  gemm_small(C, (const f16*)(ws + A_H) + (size_t)NLAT * D, D, (const f16*)(ws + W_GATE) + (size_t)br * 1024 * 1024, D, NLAT, 1024, D, Eg); }
                { CTX(); const f16* Y = (const f16*)(ws + (br == 0 ? A_YA : br == 1 ? A_YS : A_YC));
                  EpiBranch Eb{(const f16*)(ws + A_GATE), (f16*)(ws + A_MERGED), br == 0};
                  gemm_small(C, Y + (size_t)NLAT * 512, 512, (const f16*)(ws + W_BR) + (size_t)br * 1024 * 512, 512, NLAT, 1024, 512, Eb); }
            }
        }
        GSYNC(); PH_END(8); }
        { PH_BEGIN(9);
        { CTX(); EpiWout E{&C, l}; gemm_rows(C, (const f16*)(ws + A_MERGED), D, (const f16*)(ws + W_OUT), D, mrows, 1024, D, E); }
        GSYNC(); PH_END(9); }
        { PH_BEGIN(10);
        { CTX(); (void)ws; phase_p10(C, l, mrows); }
        GSYNC(); PH_END(10); }
        { PH_BEGIN(11);
        { CTX(); EpiUp E{(f16*)(ws + A_HID)}; gemm_rows(C, (const f16*)(ws + A_H), D, (const f16*)(ws + W_UP), D, mrows, DFF, D, E); }
        GSYNC(); PH_END(11); }
        { PH_BEGIN(12);
        { CTX(); EpiDown E{&C, l}; gemm_rows(C, (const f16*)(ws + A_HID), DFF, (const f16*)(ws + W_DOWN), DFF, mrows, 1024, DFF, E); }
        GSYNC(); PH_END(12); }
        { PH_BEGIN(13);
        if (l == 0) { CTX(); (void)ws; if (C.nblk > 128) { if (C.bid < 64) phase_s5tab(C, 1); else phase_cvt(C, 1, 64); } else { phase_s5tab(C, 1); __syncthreads(); phase_cvt(C, 1, 0); } }
        { CTX(); (void)ws; phase_p13(C, l, mrows); }
        if (l == 0) GSYNC(); PH_END(13); }
}
__global__ void __launch_bounds__(NTHREADS, 2) fwd_all(Args args) {
    cg::grid_group grid = cg::this_grid();
    extern __shared__ __attribute__((aligned(16))) unsigned char lds_raw[];
    volatile LAS unsigned* MISC = (volatile LAS unsigned*)((LAS unsigned char*)lds_raw + MISC_OFF);
    if (threadIdx.x < 64) MISC[threadIdx.x] = 0u;
    __syncthreads();
    Env env; env.t_acc = 0; env.wid = __builtin_amdgcn_readfirstlane(threadIdx.x >> 6);
    env.bar = xcd_barrier_post((unsigned*)(args.ws + WS_CTL) + CW_BAR, MISC + 8);
    { CTX(); (void)ws; if (C.nblk > 128) { if (C.bid < 64) phase_s5tab(C, 0); else { phase_setup(C, 64); __syncthreads(); phase_cvt(C, 0, 64); } } else { phase_setup(C, 0); __syncthreads(); phase_s5tab(C, 0); __syncthreads(); phase_cvt(C, 0, 0); } }
    asm volatile("s_waitcnt vmcnt(0)" ::: "memory");
    grid.sync();
    __builtin_amdgcn_fence(__ATOMIC_ACQUIRE, "agent");
    asm volatile("s_waitcnt vmcnt(0)" ::: "memory");
    layer_body<0>(env);
    layer_body<1>(env);
    if (PROBE_PH >= 0 && blockIdx.x == 0) { const unsigned long long t0 = __builtin_amdgcn_s_memrealtime(); while (__builtin_amdgcn_s_memrealtime() - t0 < 8ull * env.t_acc) __builtin_amdgcn_s_sleep(8); }
}

extern "C" void kernel_launch(void* const* d_in, const int* in_sizes, int n_in, void* d_out, int out_size, void* d_ws, size_t ws_size, hipStream_t stream) {
    static int grid_blocks = 0;
    if (grid_blocks == 0) {
        if (n_in != 32 || out_size != NLAT * D || ws_size < WS_NEED) { fprintf(stderr, "kernel_launch: unexpected shapes n_in %d out %d ws %zu (need %zu)\n", n_in, out_size, ws_size, (size_t)WS_NEED); grid_blocks = -1; return; }
        int dev = 0, cus = 0, per_cu = 0;
        hipGetDevice(&dev);
        hipDeviceGetAttribute(&cus, hipDeviceAttributeMultiprocessorCount, dev);
        if (hipFuncSetAttribute((const void*)fwd_all, hipFuncAttributeMaxDynamicSharedMemorySize, LDS_BYTES) != hipSuccess) { fprintf(stderr, "kernel_launch: hipFuncSetAttribute failed\n"); grid_blocks = -1; return; }
        hipOccupancyMaxActiveBlocksPerMultiprocessor(&per_cu, (const void*)fwd_all, NTHREADS, LDS_BYTES);
        if (per_cu < 1) { fprintf(stderr, "kernel_launch: occupancy query says %d blocks per CU\n", per_cu); grid_blocks = -1; return; }
        grid_blocks = cus;
    }
    if (grid_blocks < 0) return;
    Args a{};
    for (int i = 0; i < 32; ++i) a.in[i] = (const float*)d_in[i];
    a.out = (float*)d_out; a.ws = (unsigned char*)d_ws;
    if (hipMemsetAsync((char*)d_ws + WS_CTL, 0, 1 * MiB, stream) != hipSuccess) { fprintf(stderr, "kernel_launch: hipMemsetAsync failed\n"); return; }
    void* kargs[] = {&a};
    const hipError_t e = hipLaunchCooperativeKernel((const void*)fwd_all, dim3(grid_blocks), dim3(NTHREADS), kargs, LDS_BYTES, stream);
    if (e != hipSuccess) fprintf(stderr, "kernel_launch: cooperative launch failed: %s (grid %d)\n", hipGetErrorString(e), grid_blocks);
}
```

```cpp
#include <hip/hip_runtime.h>
#include <hip/hip_cooperative_groups.h>
#include <cstdio>
#include <cstdint>
#include <cmath>

namespace cg = cooperative_groups;

#define LAS __attribute__((address_space(3)))
typedef _Float16 f16;
typedef _Float16 f16x8 __attribute__((ext_vector_type(8)));
typedef _Float16 f16x4 __attribute__((ext_vector_type(4)));
typedef float f32x4 __attribute__((ext_vector_type(4)));
typedef float f32x16 __attribute__((ext_vector_type(16)));

constexpr int D = 1024, NB = 4, SEQ = 4096, CTX = 256, NLAT = NB * SEQ, NCTX = NB * CTX, MALL = NLAT + NCTX;
constexpr int NKEY = CTX + SEQ;
constexpr int OFF_AK = 0, OFF_AV = 128, OFF_CKV = 256, OFF_CKR = 512, OFF_U = 544, OFF_AQ = 1056, OFF_CQ = 1568, OFF_GATE = 2336, N_IN = 5408;
constexpr int GC_AV = 128, GC_CKV = 256, GC_CKR = 512, GC_PAD = 544, GC_U = 768, GC_AQ = 1280, GC_CQ = 1792;
constexpr int PC_AK = 0, PC_CKV = 128, PC_CKR = 384, PC_AQ = 416, PC_CQ = 928, PLD2 = 1696;
constexpr int DFF = 4096;
constexpr float EPS = 1e-6f;
constexpr float ALPHA = 1.4142135623730951f;
constexpr float LOG2E = 1.4426950408889634f;
constexpr float QSCALE_A = 0.125f * LOG2E;
constexpr float QSCALE_C = 0.10206207261596575f * LOG2E;

constexpr size_t MiB = 1u << 20;
constexpr size_t WS_CTL = 0;
constexpr size_t WS_MOD = 1 * MiB;
constexpr size_t WS_ROPE = 1 * MiB + 512 * 1024;
constexpr size_t WS_W16 = 2 * MiB;
constexpr size_t W_INA = WS_W16;
constexpr size_t W_GATE = W_INA + (size_t)2560 * 1024 * 2;
constexpr size_t W_QB = W_GATE + (size_t)3072 * 1024 * 2;
constexpr size_t W_KVB = W_QB + (size_t)768 * 768 * 2;
constexpr size_t W_GLU = W_KVB + (size_t)1024 * 256 * 2;
constexpr size_t W_BR = W_GLU + (size_t)1024 * 512 * 2;
constexpr size_t W_OUT = W_BR + (size_t)3 * 1024 * 512 * 2;
constexpr size_t W_UP = W_OUT + (size_t)1024 * 1024 * 2;
constexpr size_t W_DOWN = W_UP + (size_t)4096 * 1024 * 2;
constexpr size_t W_END = W_DOWN + (size_t)1024 * 4096 * 2;
constexpr size_t WS_TACTX = 37 * MiB;
constexpr size_t WS_ACT = 41 * MiB;
static_assert(W_END <= WS_TACTX, "weights fit");
constexpr size_t A_H = WS_ACT + 0 * MiB;
constexpr size_t A_PROJ = WS_ACT + 34 * MiB;
constexpr size_t A_YC = WS_ACT + 34 * MiB;
constexpr size_t A_T1H = WS_ACT + 34 * MiB;
constexpr size_t A_S5S = WS_ACT + 51 * MiB;
constexpr size_t A_G = WS_ACT + 51 * MiB;
constexpr size_t A_YS = WS_ACT + 68 * MiB;
constexpr size_t A_HID = WS_ACT + 68 * MiB;
constexpr size_t A_QA = WS_ACT + 91 * MiB;
constexpr size_t A_YA = A_QA;
constexpr size_t A_QC = WS_ACT + 108 * MiB;
constexpr size_t A_S5X = WS_ACT + 108 * MiB;
constexpr size_t A_GATE = WS_ACT + 108 * MiB;
constexpr size_t A_KA = WS_ACT + 134 * MiB;
constexpr size_t A_VA = A_KA + (size_t)NB * 2 * NKEY * 64 * 2;
constexpr size_t A_U = WS_ACT + 143 * MiB;
constexpr size_t A_MERGED = WS_ACT + 143 * MiB;
constexpr size_t A_KC = WS_ACT + 160 * MiB;
constexpr size_t A_VC = WS_ACT + 186 * MiB;
constexpr size_t WS_ST1 = 1 * MiB + 768 * 1024;
constexpr size_t T_K = WS_ACT + 205 * MiB;
constexpr size_t T_E = T_K + (size_t)64 * 17 * 256 * 2;
constexpr size_t T_M = T_E + (size_t)64 * 16 * 16 * 128 * 2;
constexpr size_t WS_NEED = WS_ACT + 215 * MiB;
static_assert(T_M + (size_t)64 * 128 * 256 * 2 <= WS_NEED, "s5 tables");
static_assert(A_PROJ + (size_t)MALL * PLD2 * 2 <= A_QA && A_VA + (size_t)NB * 2 * NKEY * 64 * 2 <= A_U && A_VC + 17 * MiB <= T_K && A_HID + 136 * MiB <= T_K && A_MERGED + 34 * MiB <= T_K && A_GATE + 34 * MiB <= A_MERGED, "ws map");
static_assert(WS_NEED <= 256 * MiB, "ws budget");

constexpr int LDS_BYTES = 147456;
constexpr int NTHREADS = 512, NWAVES = 8;

struct Args {
    const float* in[32];
    float* out;
    unsigned char* ws;
    int ph_lo, ph_hi;
};
enum { I_X = 0, I_C, I_CTX, I_CCTX, I_WMOD, I_BMOD, I_WIN, I_AQG, I_AKG, I_CQG, I_CKVG, I_WQB, I_WKVB, I_SARE, I_SAIM, I_SLDT, I_SBRE, I_SBIM, I_SCRE, I_SCIM,
       I_SD, I_WGLU, I_WBA, I_WBS, I_WBC, I_WOUT, I_LN1G, I_LN1B, I_WUP, I_WDOWN, I_LN2G, I_LN2B };

template <int CTRL> __device__ __forceinline__ float dpp_mov(float v) { return __builtin_bit_cast(float, __builtin_amdgcn_update_dpp(0, __builtin_bit_cast(int, v), CTRL, 0xF, 0xF, true)); }
__device__ __forceinline__ float lane_bcast(float v, int l) { return __builtin_bit_cast(float, __builtin_amdgcn_readlane(__builtin_bit_cast(int, v), l)); }
__device__ __forceinline__ float wave_sum(float v) {
    v += dpp_mov<0xB1>(v); v += dpp_mov<0x4E>(v); v += dpp_mov<0x141>(v); v += dpp_mov<0x140>(v);
    return (lane_bcast(v, 0) + lane_bcast(v, 16)) + (lane_bcast(v, 32) + lane_bcast(v, 48));
}
__device__ __forceinline__ float wave_max(float v) {
#pragma unroll
    for (int o = 1; o < 64; o <<= 1) v = fmaxf(v, __shfl_xor(v, o));
    return v;
}
__device__ __forceinline__ float sigmoidf_(float x) { return 1.0f / (1.0f + __expf(-x)); }
__device__ __forceinline__ float gelu_tanh(float x) {
    const float u = 0.7978845608028654f * (x + 0.044715f * x * x * x);
    const float e = __expf(2.0f * u);
    const float t = 1.0f - 2.0f / (e + 1.0f);
    return 0.5f * x * (1.0f + t);
}
__device__ __forceinline__ f16x8 pack8(f32x4 lo, f32x4 hi) {
    f16x8 r; r[0] = (f16)lo[0]; r[1] = (f16)lo[1]; r[2] = (f16)lo[2]; r[3] = (f16)lo[3]; r[4] = (f16)hi[0]; r[5] = (f16)hi[1]; r[6] = (f16)hi[2]; r[7] = (f16)hi[3]; return r;
}
__device__ __forceinline__ f16x4 pack4(f32x4 v) { f16x4 r; r[0] = (f16)v[0]; r[1] = (f16)v[1]; r[2] = (f16)v[2]; r[3] = (f16)v[3]; return r; }

struct RowInfo { int b, t, pos, lat, mrow; };
__device__ __forceinline__ RowInfo row_info(int r) {
    RowInfo o;
    if (r < NLAT) { o.lat = 1; o.b = r >> 12; o.t = r & 4095; o.pos = CTX + o.t; o.mrow = o.b; }
    else { const int rr = r - NLAT; o.lat = 0; o.b = rr >> 8; o.t = rr & 255; o.pos = o.t; o.mrow = 4; }
    return o;
}

#define CAS __attribute__((address_space(4)))
struct Ctx {
    const CAS unsigned char* kp; LAS unsigned char* lds;
    int tid, lane, wid, nblk, bid;
    __device__ __forceinline__ const float* in(int i) const { return *(const float* const CAS*)(kp + 8 * i); }
    __device__ __forceinline__ float* out() const { return *(float* const CAS*)(kp + 256); }
    __device__ __forceinline__ unsigned char* ws() const { return *(unsigned char* const CAS*)(kp + 264); }
    __device__ __forceinline__ const float* mod(int l, int mrow, int which) const { return (const float*)(ws() + WS_MOD) + ((size_t)(l * 5 + mrow) * 6 + which) * D; }
    __device__ __forceinline__ const float* xsrc(int l, int r) const {
        if (l == 0) return r < NLAT ? in(I_X) + (size_t)r * D : in(I_CTX) + (size_t)(r - NLAT) * D;
        return r < NLAT ? out() + (size_t)r * D : (const float*)(ws() + WS_TACTX) + (size_t)(r - NLAT) * D;
    }
    __device__ __forceinline__ float* ta(int r) const { return r < NLAT ? out() + (size_t)r * D : (float*)(ws() + WS_TACTX) + (size_t)(r - NLAT) * D; }
};
__device__ __forceinline__ Ctx make_ctx(int wid) {
    extern __shared__ __attribute__((aligned(16))) unsigned char lds_raw[];
    Ctx C;
    const CAS unsigned char* kp = (const CAS unsigned char*)__builtin_amdgcn_kernarg_segment_ptr();
    asm volatile("" : "+s"(kp));
    C.kp = kp; C.lds = (LAS unsigned char*)lds_raw;
    int lane = __builtin_amdgcn_mbcnt_hi(~0u, __builtin_amdgcn_mbcnt_lo(~0u, 0u)); asm volatile("" : "+v"(lane));
    asm volatile("" : "+s"(wid));
    C.tid = wid * 64 + lane; C.lane = lane; C.wid = wid;
    int bid = blockIdx.x; asm volatile("" : "+s"(bid));
    C.bid = bid; C.nblk = gridDim.x;
    return C;
}

__device__ __forceinline__ void phase_setup(const Ctx& C, int b0) {
    LAS float* sv = (LAS float*)C.lds;
    LAS float* red = sv + 5 * 1024;
    for (int i = C.tid; i < 5 * 1024; i += NTHREADS) {
        const int mr = i >> 10, k = i & 1023;
        const float v = mr < 4 ? C.in(I_C)[mr * D + k] : C.in(I_CCTX)[k];
        sv[i] = v / (1.0f + __expf(-v));
    }
    __syncthreads();
    for (int u = C.bid - b0; u < 192; u += C.nblk - b0) {
        const int l = u / 96, n0 = (u % 96) * 64;
        const float* W = C.in(I_WMOD) + (size_t)l * D * 6144 + n0 + C.lane;
        float acc[5] = {0.f, 0.f, 0.f, 0.f, 0.f};
        const int kb = C.wid * 128;
#pragma unroll 8
        for (int k = 0; k < 128; ++k) {
            const float w = W[(size_t)(kb + k) * 6144];
#pragma unroll
            for (int m = 0; m < 5; ++m) acc[m] += sv[m * 1024 + kb + k] * w;
        }
#pragma unroll
        for (int m = 0; m < 5; ++m) red[(C.wid * 5 + m) * 64 + C.lane] = acc[m];
        __syncthreads();
        if (C.tid < 320) {
            const int m = C.tid >> 6, c = C.tid & 63; float s = 0.f;
#pragma unroll
            for (int w = 0; w < 8; ++w) s += red[(w * 5 + m) * 64 + c];
            ((float*)(C.ws() + WS_MOD))[(size_t)(l * 5 + m) * 6144 + n0 + c] = s + C.in(I_BMOD)[l * 6144 + n0 + c];
        }
        __syncthreads();
    }
    if (C.bid == C.nblk - 1) {
        float* ra = (float*)(C.ws() + WS_ROPE);
        for (int i = C.tid; i < 1024; i += NTHREADS) {
            const int pos = i >> 4, f = i & 15;
            const float inv = powf(10000.0f, -(float)(2 * f) / 32.0f);
            const float ang = (float)pos * inv;
            ra[i] = cosf(ang); ra[1024 + i] = sinf(ang);
        }
        for (int i = C.tid; i < 512; i += NTHREADS) {
            const int pos = i >> 3, f = i & 7;
            const float inv = powf(10000.0f, -(float)(2 * f) / 16.0f);
            const float ang = (float)pos * inv;
            ra[2048 + i] = cosf(ang); ra[2048 + 512 + i] = sinf(ang);
        }
    }
}

__device__ __forceinline__ int glu_row(int n) { const int isg = n >= 512, j = n & 511; return 8 * (j >> 2) + 4 * isg + (j & 3); }
__device__ __forceinline__ void cvt_load(const float* W, int ldw, int coff, int nblk, int item, int lane, f32x4 (&v)[8]) {
    const int kb = item / nblk, nb = item % nblk, k0 = 64 * kb, n0 = 32 * nb;
#pragma unroll
    for (int i = 0; i < 8; ++i) v[i] = *(const f32x4*)(W + (size_t)(k0 + 8 * i + (lane >> 3)) * ldw + coff + n0 + 4 * (lane & 7));
}
__device__ __forceinline__ void cvt_store(const f32x4 (&v)[8], int K, int nblk, f16* WT, int mode, LAS float* scr, int item, int lane) {
    const int kb = item / nblk, nb = item % nblk, k0 = 64 * kb, n0 = 32 * nb;
#pragma unroll
    for (int i = 0; i < 8; ++i) { LAS float* d = scr + (8 * i + (lane >> 3)) * 33 + 4 * (lane & 7); d[0] = v[i][0]; d[1] = v[i][1]; d[2] = v[i][2]; d[3] = v[i][3]; }
    asm volatile("s_waitcnt lgkmcnt(0)" ::: "memory");
    const int c = lane & 7;
#pragma unroll
    for (int j = 0; j < 4; ++j) {
        const int n = (lane >> 3) + 8 * j; const LAS float* sp = scr + (8 * c) * 33 + n;
        f16x8 o;
#pragma unroll
        for (int e = 0; e < 8; ++e) o[e] = (f16)sp[e * 33];
        const int nn = n0 + n; const int row = mode ? glu_row(nn) : nn;
        *(f16x8*)(WT + (size_t)row * K + k0 + 8 * c) = o;
    }
    asm volatile("s_waitcnt lgkmcnt(0)" ::: "memory");
}
__device__ __forceinline__ void cvt_mat(const Ctx& C, const float* src, int ldw, int coff, int K, int N, size_t dst, int mode, int& base, int b0) {
    LAS float* scr = (LAS float*)C.lds + C.wid * (64 * 33);
    const int gw = (C.bid - b0) * NWAVES + C.wid, ngw = (C.nblk - b0) * NWAVES;
    const int nblk = N / 32, items = (K / 64) * nblk;
    int first = gw - (base % ngw); if (first < 0) first += ngw;
    f16* WT = (f16*)(C.ws() + dst);
    f32x4 va[8], vb[8];
    if (first < items) cvt_load(src, ldw, coff, nblk, first, C.lane, va);
    for (int it = first; it < items; it += 2 * ngw) {
        const int it2 = it + ngw, it3 = it + 2 * ngw;
        if (it2 < items) cvt_load(src, ldw, coff, nblk, it2, C.lane, vb);
        cvt_store(va, K, nblk, WT, mode, scr, it, C.lane);
        if (it3 < items) cvt_load(src, ldw, coff, nblk, it3, C.lane, va);
        if (it2 < items) cvt_store(vb, K, nblk, WT, mode, scr, it2, C.lane);
    }
    base += items;
}
__device__ __forceinline__ void phase_cvt(const Ctx& C, int l, int b0) {
    int base = 0;
    cvt_mat(C, C.in(I_WIN) + (size_t)l * D * N_IN, N_IN, 0, D, GC_PAD, W_INA, 0, base, b0);
    cvt_mat(C, C.in(I_WIN) + (size_t)l * D * N_IN, N_IN, GC_PAD, D, OFF_GATE - GC_PAD, W_INA + (size_t)GC_U * 1024 * 2, 0, base, b0);
    cvt_mat(C, C.in(I_WIN) + (size_t)l * D * N_IN, N_IN, OFF_GATE, D, 3072, W_GATE, 0, base, b0);
    cvt_mat(C, C.in(I_WQB) + (size_t)l * 768 * 768, 768, 0, 768, 768, W_QB, 0, base, b0);
    cvt_mat(C, C.in(I_WKVB) + (size_t)l * 256 * 1024, 1024, 0, 256, 1024, W_KVB, 0, base, b0);
    cvt_mat(C, C.in(I_WGLU) + (size_t)l * 512 * 1024, 1024, 0, 512, 1024, W_GLU, 1, base, b0);
    cvt_mat(C, C.in(I_WBA) + (size_t)l * 512 * 1024, 1024, 0, 512, 1024, W_BR, 0, base, b0);
    cvt_mat(C, C.in(I_WBS) + (size_t)l * 512 * 1024, 1024, 0, 512, 1024, W_BR + (size_t)1024 * 512 * 2, 0, base, b0);
    cvt_mat(C, C.in(I_WBC) + (size_t)l * 512 * 1024, 1024, 0, 512, 1024, W_BR + (size_t)2 * 1024 * 512 * 2, 0, base, b0);
    cvt_mat(C, C.in(I_WOUT) + (size_t)l * 1024 * 1024, 1024, 0, 1024, 1024, W_OUT, 0, base, b0);
    cvt_mat(C, C.in(I_WUP) + (size_t)l * 1024 * 4096, 4096, 0, 1024, 4096, W_UP, 0, base, b0);
    cvt_mat(C, C.in(I_WDOWN) + (size_t)l * 4096 * 1024, 1024, 0, 4096, 1024, W_DOWN, 0, base, b0);
    f16* pad = (f16*)(C.ws() + W_INA) + (size_t)GC_PAD * 1024;
    const f16x8 z = {0, 0, 0, 0, 0, 0, 0, 0};
    for (int i = (C.bid - b0) * NTHREADS + C.tid; i < (GC_U - GC_PAD) * 1024 / 8; i += (C.nblk - b0) * NTHREADS) ((f16x8*)pad)[i] = z;
}

__device__ __forceinline__ void row_load(const float* p, int lane, f32x4 (&v)[4]) {
#pragma unroll
    for (int j = 0; j < 4; ++j) v[j] = ((const f32x4*)p)[lane + 64 * j];
}
__device__ __forceinline__ void row_ln(f32x4 (&v)[4]) {
    float s = 0.f;
#pragma unroll
    for (int j = 0; j < 4; ++j) s += (v[j][0] + v[j][1]) + (v[j][2] + v[j][3]);
    const float mean = wave_sum(s) * (1.0f / D);
    float q = 0.f;
#pragma unroll
    for (int j = 0; j < 4; ++j) { v[j] = v[j] - mean; q += (v[j][0] * v[j][0] + v[j][1] * v[j][1]) + (v[j][2] * v[j][2] + v[j][3] * v[j][3]); }
    const float rstd = 1.0f / sqrtf(wave_sum(q) * (1.0f / D) + EPS);
#pragma unroll
    for (int j = 0; j < 4; ++j) v[j] = v[j] * rstd;
}
__device__ __forceinline__ void row_ln_stats(f32x4 (&v)[4], float& mean, float& rstd) {
    float s = 0.f;
#pragma unroll
    for (int j = 0; j < 4; ++j) s += (v[j][0] + v[j][1]) + (v[j][2] + v[j][3]);
    mean = wave_sum(s) * (1.0f / D);
    float q = 0.f;
#pragma unroll
    for (int j = 0; j < 4; ++j) { v[j] = v[j] - mean; q += (v[j][0] * v[j][0] + v[j][1] * v[j][1]) + (v[j][2] * v[j][2] + v[j][3] * v[j][3]); }
    rstd = 1.0f / sqrtf(wave_sum(q) * (1.0f / D) + EPS);
#pragma unroll
    for (int j = 0; j < 4; ++j) v[j] = v[j] * rstd;
}
__device__ __forceinline__ void row_load_h(const f16* p, int lane, f32x4 (&v)[4]) {
#pragma unroll
    for (int j = 0; j < 4; ++j) { const f16x4 h = ((const f16x4*)p)[lane + 64 * j]; v[j] = (f32x4){(float)h[0], (float)h[1], (float)h[2], (float)h[3]}; }
}
__device__ __forceinline__ void row_modulate_store(const f32x4 (&v)[4], const float* sh, const float* sc, f16* o, int lane) {
#pragma unroll
    for (int j = 0; j < 4; ++j) {
        const f32x4 s = ((const f32x4*)sc)[lane + 64 * j], t = ((const f32x4*)sh)[lane + 64 * j];
        const f32x4 y = v[j] * (s + 1.0f) + t;
        ((f16x4*)o)[lane + 64 * j] = pack4(y);
    }
}
__device__ __forceinline__ void phase_p1(const Ctx& C, int l) {
    f16* H = (f16*)(C.ws() + A_H);
    const int nw = C.nblk * NWAVES;
    for (int r = C.bid * NWAVES + C.wid; r < MALL; r += 2 * nw) {
        const int r2 = r + nw; const bool has2 = r2 < MALL;
        f32x4 v[4], w[4]; row_load(C.xsrc(l, r), C.lane, v); if (has2) row_load(C.xsrc(l, r2), C.lane, w);
        { const RowInfo ri = row_info(r); row_ln(v); row_modulate_store(v, C.mod(l, ri.mrow, 0), C.mod(l, ri.mrow, 1), H + (size_t)r * D, C.lane); }
        if (has2) { const RowInfo ri = row_info(r2); row_ln(w); row_modulate_store(w, C.mod(l, ri.mrow, 0), C.mod(l, ri.mrow, 1), H + (size_t)r2 * D, C.lane); }
    }
}
__device__ __forceinline__ void p10_row(const Ctx& C, int l, int r, f32x4 (&v)[4], const float* g, const float* bb) {
    f16* H = (f16*)(C.ws() + A_H); float* ST = (float*)(C.ws() + WS_ST1);
    const RowInfo ri = row_info(r);
    float mean, rstd; row_ln_stats(v, mean, rstd);
    if (C.lane == 0) { ST[2 * r] = mean; ST[2 * r + 1] = rstd; }
#pragma unroll
    for (int j = 0; j < 4; ++j) v[j] = v[j] * ((const f32x4*)g)[C.lane + 64 * j] + ((const f32x4*)bb)[C.lane + 64 * j];
    row_ln(v);
    row_modulate_store(v, C.mod(l, ri.mrow, 3), C.mod(l, ri.mrow, 4), H + (size_t)r * D, C.lane);
}
__device__ __forceinline__ void phase_p10(const Ctx& C, int l, int nrows) {
    const f16* T1 = (const f16*)(C.ws() + A_T1H);
    const float* g = C.in(I_LN1G) + l * D; const float* bb = C.in(I_LN1B) + l * D;
    const int nw = C.nblk * NWAVES;
    for (int r = C.bid * NWAVES + C.wid; r < nrows; r += 2 * nw) {
        const int r2 = r + nw; const bool has2 = r2 < nrows;
        f32x4 v[4], w[4]; row_load_h(T1 + (size_t)r * D, C.lane, v); if (has2) row_load_h(T1 + (size_t)r2 * D, C.lane, w);
        p10_row(C, l, r, v, g, bb);
        if (has2) p10_row(C, l, r2, w, g, bb);
    }
}
__device__ __forceinline__ void p13_row(const Ctx& C, int l, int r, f32x4 (&v)[4], const float* g, const float* bb) {
    f16* H = (f16*)(C.ws() + A_H); float* t = C.ta(r);
    row_ln(v);
#pragma unroll
    for (int j = 0; j < 4; ++j) { v[j] = v[j] * ((const f32x4*)g)[C.lane + 64 * j] + ((const f32x4*)bb)[C.lane + 64 * j]; ((f32x4*)t)[C.lane + 64 * j] = v[j]; }
    if (l == 0) {
        const RowInfo ri = row_info(r);
        row_ln(v);
        row_modulate_store(v, C.mod(1, ri.mrow, 0), C.mod(1, ri.mrow, 1), H + (size_t)r * D, C.lane);
    }
}
__device__ __forceinline__ void phase_p13(const Ctx& C, int l, int nrows) {
    const float* g = C.in(I_LN2G) + l * D; const float* bb = C.in(I_LN2B) + l * D; const f16* T2 = (const f16*)(C.ws() + A_T1H);
    const int nw = C.nblk * NWAVES;
    for (int r = C.bid * NWAVES + C.wid; r < nrows; r += 2 * nw) {
        const int r2 = r + nw; const bool has2 = r2 < nrows;
        f32x4 v[4], w[4]; row_load_h(T2 + (size_t)r * D, C.lane, v); if (has2) row_load_h(T2 + (size_t)r2 * D, C.lane, w);
        p13_row(C, l, r, v, g, bb);
        if (has2) p13_row(C, l, r2, w, g, bb);
    }
}
__device__ __forceinline__ void phase_hre(const Ctx& C, int l, int nrows) {
    f16* H = (f16*)(C.ws() + A_H);
    const int nw = C.nblk * NWAVES;
    for (int r = C.bid * NWAVES + C.wid; r < nrows; r += 2 * nw) {
        const int r2 = r + nw; const bool has2 = r2 < nrows;
        f32x4 v[4], w[4]; row_load(C.xsrc(l, r), C.lane, v); if (has2) row_load(C.xsrc(l, r2), C.lane, w);
        { const RowInfo ri = row_info(r); row_ln(v); row_modulate_store(v, C.mod(l, ri.mrow, 0), C.mod(l, ri.mrow, 1), H + (size_t)r * D, C.lane); }
        if (has2) { const RowInfo ri = row_info(r2); row_ln(w); row_modulate_store(w, C.mod(l, ri.mrow, 0), C.mod(l, ri.mrow, 1), H + (size_t)r2 * D, C.lane); }
    }
}

__device__ __forceinline__ size_t u3_off(int g, int nb, int sx, int half, int n) { return ((((size_t)(g * 34 + nb) * 16 + sx) * 2 + half) * 32 + n) * 8; }
__device__ __forceinline__ size_t x3_off(int dirg, int nb, int kk, int half, int n) { return ((((size_t)(dirg * 34 + nb) * 8 + kk) * 2 + half) * 32 + n) * 8; }
__device__ __forceinline__ size_t m3_off(int dirg, int mb, int sx, int half, int p32) { return ((((size_t)(dirg * 4 + mb) * 16 + sx) * 2 + half) * 32 + p32) * 8; }
__device__ __forceinline__ void phase_p3(const Ctx& C, int l) {
    f16* PROJ = (f16*)(C.ws() + A_PROJ);
    f16* KA = (f16*)(C.ws() + A_KA); f16* KC = (f16*)(C.ws() + A_KC);
    f16* QA = (f16*)(C.ws() + A_QA);
    const float* ropeA = (const float*)(C.ws() + WS_ROPE); const float* ropeC = ropeA + 2048;
    const int lane = C.lane, d32 = lane & 31;
    const float akg = C.in(I_AKG)[l * 64 + lane], aqg = C.in(I_AQG)[l * 64 + lane];
    const f32x4 ckvg = *(const f32x4*)(C.in(I_CKVG) + l * 256 + 4 * lane);
    f32x4 cqg[3];
#pragma unroll
    for (int i = 0; i < 3; ++i) cqg[i] = *(const f32x4*)(C.in(I_CQG) + l * 768 + 256 * i + 4 * lane);
    for (int r = C.bid * NWAVES + C.wid; r < MALL; r += C.nblk * NWAVES) {
        const RowInfo ri = row_info(r);
        f16* prow = PROJ + (size_t)r * PLD2;
        const bool needq = ri.lat || l == 0;
        f16 xak[2], xaq[8]; f16x4 cq4[3];
#pragma unroll
        for (int hd = 0; hd < 2; ++hd) xak[hd] = prow[PC_AK + hd * 64 + lane];
        const f16x4 ckv4 = *(const f16x4*)(prow + PC_CKV + 4 * lane);
        const f16 xckr = prow[PC_CKR + d32];
        if (needq) {
#pragma unroll
            for (int h = 0; h < 8; ++h) xaq[h] = prow[PC_AQ + h * 64 + lane];
#pragma unroll
            for (int i = 0; i < 3; ++i) cq4[i] = *(const f16x4*)(prow + PC_CQ + 256 * i + 4 * lane);
        } else {
#pragma unroll
            for (int h = 0; h < 8; ++h) xaq[h] = (f16)0.f;
#pragma unroll
            for (int i = 0; i < 3; ++i) cq4[i] = (f16x4){0, 0, 0, 0};
        }
        const int prow_i = ri.t >> 6, pcol_i = ri.t & 63;
        float cA = 1.f, sA = 0.f, cc = 1.f, sc = 0.f;
        if (ri.lat) {
            { const int part = lane >> 5, j = lane & 15, pi = part ? pcol_i : prow_i; cA = ropeA[pi * 16 + j]; sA = ropeA[1024 + pi * 16 + j]; if (!((lane >> 4) & 1)) sA = -sA; }
            { const int part = d32 >> 4, j = d32 & 7, pi = part ? pcol_i : prow_i; cc = ropeC[pi * 8 + j]; sc = ropeC[512 + pi * 8 + j]; if (!((d32 >> 3) & 1)) sc = -sc; }
        }
        float ss[12];
#pragma unroll
        for (int hd = 0; hd < 2; ++hd) { const float x = (float)xak[hd]; ss[hd] = x * x; }
#pragma unroll
        for (int h = 0; h < 8; ++h) { const float x = (float)xaq[h]; ss[2 + h] = x * x; }
        { float q = 0.f;
#pragma unroll
          for (int e = 0; e < 4; ++e) { const float x = (float)ckv4[e]; q += x * x; }
          ss[10] = q; q = 0.f;
#pragma unroll
          for (int i = 0; i < 3; ++i)
#pragma unroll
              for (int e = 0; e < 4; ++e) { const float x = (float)cq4[i][e]; q += x * x; }
          ss[11] = q; }
#pragma unroll
        for (int i = 0; i < 12; ++i) ss[i] = wave_sum(ss[i]);
#pragma unroll
        for (int hd = 0; hd < 2; ++hd) {
            float y = (float)xak[hd] * (1.0f / sqrtf(ss[hd] * (1.0f / 64.0f) + EPS)) * akg;
            const float p = __shfl_xor(y, 16);
            y = y * cA + p * sA;
            KA[((size_t)(ri.b * 2 + hd) * NKEY + ri.pos) * 64 + lane] = (f16)y;
        }
        { const float rs = 1.0f / sqrtf(ss[10] * (1.0f / 256.0f) + EPS); f16x4 o4;
#pragma unroll
          for (int e = 0; e < 4; ++e) o4[e] = (f16)((float)ckv4[e] * rs * ckvg[e]);
          *(f16x4*)(prow + PC_CKV + 4 * lane) = o4; }
        { float x = (float)xckr; const float p = __shfl_xor(x, 8); x = x * cc + p * sc;
          if (lane < 32) {
#pragma unroll
              for (int h = 0; h < 8; ++h) KC[((size_t)(ri.b * 8 + h) * NKEY + ri.pos) * 96 + 64 + d32] = (f16)x;
          } }
        if (needq) {
            f16* qdst = QA + (size_t)r * 512; const size_t hstride = 64;
#pragma unroll
            for (int h = 0; h < 8; ++h) {
                float y = (float)xaq[h] * (1.0f / sqrtf(ss[2 + h] * (1.0f / 64.0f) + EPS)) * aqg;
                const float p = __shfl_xor(y, 16);
                y = (y * cA + p * sA) * QSCALE_A;
                qdst[h * hstride + lane] = (f16)y;
            }
            const float rs = 1.0f / sqrtf(ss[11] * (1.0f / 768.0f) + EPS);
#pragma unroll
            for (int i = 0; i < 3; ++i) { f16x4 o4;
#pragma unroll
                for (int e = 0; e < 4; ++e) o4[e] = (f16)((float)cq4[i][e] * rs * cqg[i][e]);
                *(f16x4*)(prow + PC_CQ + 256 * i + 4 * lane) = o4; }
        }
    }
}

namespace pg8 {
#define PG8_LAS __attribute__((address_space(3)))
typedef _Float16 bf16_t;
typedef _Float16 bf16x8 __attribute__((ext_vector_type(8)));
constexpr int BM = 256, BK = 64, HALF = 128, HTB = HALF * BK * 2  , STAGE_BYTES = 8 * HTB, NXCD = 8, WGM = 8;

__host__ __device__ __forceinline__ int lds_byte(int r, int c) { const int st = (r >> 4) * 2 + (c >> 5), rr = r & 15, cc = c & 31, ob = rr * 64 + cc * 2; return st * 1024 + (ob ^ (((ob >> 9) & 1) << 5)); }
__host__ __device__ __forceinline__ void stage_rc(int b, int& R, int& C) { const int st = b / 1024, sb = b % 1024, swz = sb ^ (((sb >> 9) & 1) << 5); R = (st >> 1) * 16 + swz / 64; C = (st & 1) * 32 + (swz % 64) / 2; }
__host__ __device__ __forceinline__ int perm32(int rho) { const int n = rho >> 4, i = rho & 15; return 8 * (i >> 2) + 4 * n + (i & 3); }
struct Unit { int pm, pn; };
struct Gemm { const bf16_t* A; const bf16_t* Bt; int M, N, K, lda, ldb; };

struct StaticOrder {
    int nM, nN, nwg, G, c;
    __host__ __device__ void init(int M, int N, int G_, int c_) { nM = M / BM; nN = N / BM; nwg = nM * nN; G = G_; c = c_; }
    __host__ __device__ bool next(int i, Unit& u) const {
        const long L = (long)i * G + c; if (L >= nwg) return false;
        int wgid = (int)L; { const int q = nwg / NXCD, r = nwg % NXCD, xcd = wgid % NXCD, off = wgid / NXCD; wgid = (xcd < r ? xcd * (q + 1) : r * (q + 1) + (xcd - r) * q) + off; }
        const int nig = WGM * nN, gid = wgid / nig, fm = gid * WGM, gsz = (nM - fm) < WGM ? (nM - fm) : WGM;
        u.pm = fm + ((wgid % nig) % gsz); u.pn = (wgid % nig) / gsz; return true;
    }
    __device__ __forceinline__ void a_ready(const Unit&) const {}
    __device__ __forceinline__ void done(const Unit&) const {}
};

template <class F> struct EpiFn { static constexpr bool PERM = true, AFTER_DRAIN = false; F f;
    __device__ __forceinline__ void operator()(const f32x4 (&acc)[2][2][4][2], const Unit& u, int wr, int wc, int fr, int fq) const {
        typename F::Pre pre[2][2];
        const int col0 = u.pn * BM + wc * 32 + 8 * fq, rowb = u.pm * BM + wr * 64 + fr;
#pragma unroll
        for (int bj = 0; bj < 2; ++bj) pre[0][bj] = f.pre(rowb, col0 + bj * HALF);
#pragma unroll
        for (int gi = 0; gi < 8; ++gi) {
            const int ai = gi >> 2, m = gi & 3, row = rowb + ai * HALF + m * 16;
            if (gi + 1 < 8) { const int ai2 = (gi + 1) >> 2, m2 = (gi + 1) & 3;
#pragma unroll
                for (int bj = 0; bj < 2; ++bj) pre[(gi + 1) & 1][bj] = f.pre(rowb + ai2 * HALF + m2 * 16, col0 + bj * HALF); }
#pragma unroll
            for (int bj = 0; bj < 2; ++bj) f(row, col0 + bj * HALF, acc[ai][bj][m][0], acc[ai][bj][m][1], pre[gi & 1][bj]);
            asm volatile("" ::: "memory");
        }
    } };

template <class Epi, class Sched, bool ALIGN_EPI = false, bool SP2 = false, bool CH_IN = false, bool CH_OUT = false>
__device__ __forceinline__ void gemm_phase(PG8_LAS unsigned char* lds, const Gemm g, const Sched& S, const Epi& E, const int tid, const Gemm ng = Gemm{}) {
    static_assert(!(CH_IN || CH_OUT) || (SP2 && ALIGN_EPI), "chaining is written for the SP2 + ALIGN_EPI loop");
    const int wid = __builtin_amdgcn_readfirstlane(tid >> 6), lane = tid & 63, wr = wid >> 2, wc = wid & 3, fr = lane & 15, fq = lane >> 4;
    const int K = g.K, nt = K / BK;
    unsigned voffA[2], voffB[2];
#pragma unroll
    for (int i = 0; i < 2; ++i) { int R, C; stage_rc(tid * 16 + i * 8192, R, C); const int Rb = Epi::PERM ? ((R & ~31) + perm32(R & 31)) : R;
        voffA[i] = (unsigned)(R * g.lda + C) * 2u; voffB[i] = (unsigned)(Rb * g.ldb + C) * 2u; }
    unsigned nvA[2] = {0u, 0u}, nvB[2] = {0u, 0u}; size_t n_hstepA = 0, n_hstepB = 0;
    if constexpr (CH_OUT) {
#pragma unroll
        for (int i = 0; i < 2; ++i) { int R, C; stage_rc(tid * 16 + i * 8192, R, C); const int Rb = Epi::PERM ? ((R & ~31) + perm32(R & 31)) : R;
            nvA[i] = (unsigned)(R * ng.lda + C) * 2u; nvB[i] = (unsigned)(Rb * ng.ldb + C) * 2u; }
        n_hstepA = (size_t)HALF * ng.lda * 2; n_hstepB = (size_t)HALF * ng.ldb * 2;
    }
    const size_t kstep = (size_t)(BK * 2);
    const size_t hstepA = (size_t)HALF * g.lda * 2, hstepB = (size_t)HALF * g.ldb * 2;
    const size_t tstepA = 2 * hstepA, tstepB = 2 * hstepB;
    const unsigned ldsw = (unsigned)wid * 1024u;
    const int aoff = lds_byte(wr * 64 + fr, fq * 8), boff = lds_byte(wc * 32 + fr, fq * 8);
#define PG8_SA(b, h) (((b) * 2 + (h)) * HTB)
#define PG8_SB(b, h) ((4 + (b) * 2 + (h)) * HTB)
#define PG8_STAGE(bufoff, gbase, voff) do { _Pragma("unroll") for (int _i = 0; _i < 2; ++_i) \
        __builtin_amdgcn_global_load_lds((const unsigned*)((const char*)(gbase) + (voff)[_i]), (PG8_LAS unsigned*)(lds + (bufoff) + ldsw + _i * 8192), 16, 0, 0); } while (0)
#define PG8_LDA(dst, b, h) do { _Pragma("unroll") for (int m = 0; m < 4; ++m) _Pragma("unroll") for (int k = 0; k < 2; ++k) dst[m][k] = *(const PG8_LAS bf16x8*)(lds + PG8_SA(b, h) + aoff + m * 2048 + k * 1024); } while (0)
#define PG8_LDB(dst, b, h) do { _Pragma("unroll") for (int n = 0; n < 2; ++n) _Pragma("unroll") for (int k = 0; k < 2; ++k) dst[n][k] = *(const PG8_LAS bf16x8*)(lds + PG8_SB(b, h) + boff + n * 2048 + k * 1024); } while (0)
#define PG8_MMA(ai, bj, At, Bt) do { __builtin_amdgcn_s_setprio(1); _Pragma("unroll") for (int m = 0; m < 4; ++m) _Pragma("unroll") for (int n = 0; n < 2; ++n) _Pragma("unroll") for (int k = 0; k < 2; ++k) \
        acc[ai][bj][m][n] = __builtin_amdgcn_mfma_f32_16x16x32_f16(Bt[n][k], At[m][k], acc[ai][bj][m][n], 0, 0, 0); __builtin_amdgcn_s_setprio(0); } while (0)
#define PG8_WAIT_V(n) asm volatile("s_waitcnt vmcnt(" #n ")" ::: "memory")
#define PG8_WAIT_L(n) asm volatile("s_waitcnt lgkmcnt(" #n ")" ::: "memory")
#define PG8_BAR __builtin_amdgcn_s_barrier()
#define PG8_SCHED __builtin_amdgcn_sched_barrier(0)
    Unit cur, nxt; int ui = 0;
    if (!S.next(0, cur)) return;
    f32x4 acc[2][2][4][2];
#pragma unroll
    for (int a = 0; a < 2; ++a)
#pragma unroll
        for (int b = 0; b < 2; ++b)
#pragma unroll
            for (int m = 0; m < 4; ++m)
#pragma unroll
                for (int n = 0; n < 2; ++n) acc[a][b][m][n] = (f32x4){0.f, 0.f, 0.f, 0.f};
    bf16x8 At[4][2], B0[2][2], B1[2][2];
    const char* cA = (const char*)g.A + (size_t)cur.pm * tstepA; const char* cB = (const char*)g.Bt + (size_t)cur.pn * tstepB;
    S.a_ready(cur);
    if constexpr (CH_IN) {   } else
    if constexpr (SP2) {
        PG8_STAGE(PG8_SB(0, 0), cB, voffB); PG8_STAGE(PG8_SB(0, 1), cB + hstepB, voffB); PG8_STAGE(PG8_SA(0, 0), cA, voffA); PG8_STAGE(PG8_SA(0, 1), cA + hstepA, voffA);
        if (wr == 1) PG8_BAR;
        PG8_WAIT_V(2); PG8_BAR;
        PG8_STAGE(PG8_SB(1, 0), cB + kstep, voffB); PG8_STAGE(PG8_SA(1, 0), cA + kstep, voffA); PG8_STAGE(PG8_SB(1, 1), cB + hstepB + kstep, voffB);
        PG8_WAIT_V(6); PG8_BAR;
    } else {
        PG8_STAGE(PG8_SB(0, 0), cB, voffB); PG8_STAGE(PG8_SA(0, 0), cA, voffA); PG8_STAGE(PG8_SB(0, 1), cB + hstepB, voffB); PG8_STAGE(PG8_SA(0, 1), cA + hstepA, voffA);
        if (wr == 1) PG8_BAR;
        PG8_WAIT_V(4); PG8_BAR;
        PG8_STAGE(PG8_SB(1, 0), cB + kstep, voffB); PG8_STAGE(PG8_SA(1, 0), cA + kstep, voffA); PG8_STAGE(PG8_SB(1, 1), cB + hstepB + kstep, voffB);
        PG8_WAIT_V(6); PG8_BAR;
    }
    for (;;) {
        const bool has_next = S.next(ui + 1, nxt);
        Unit u0; (void)S.next(0, u0);
        const char* nA = has_next ? (const char*)g.A + (size_t)nxt.pm * tstepA : (CH_OUT ? (const char*)ng.A + (size_t)u0.pm * 2 * n_hstepA : cA);
        const char* nB = has_next ? (const char*)g.Bt + (size_t)nxt.pn * tstepB : (CH_OUT ? (const char*)ng.Bt + (size_t)u0.pn * 2 * n_hstepB : cB);
#pragma unroll 1
        for (int t = 0; t < nt; t += 2) {
            const bool last = (t == nt - 2);
            const char* a1 = cA + (size_t)(t + 1) * kstep;
            const char* a2 = last ? nA : cA + (size_t)(t + 2) * kstep; const char* b2 = last ? nB : cB + (size_t)(t + 2) * kstep;
            const char* a3 = a2 + kstep; const char* b3 = b2 + kstep;
            const bool xg = CH_OUT && last && !has_next;
            unsigned vA2[2], vB2[2];
#pragma unroll
            for (int i = 0; i < 2; ++i) { vA2[i] = xg ? nvA[i] : voffA[i]; vB2[i] = xg ? nvB[i] : voffB[i]; }
            const size_t hA2 = xg ? n_hstepA : hstepA, hB2 = xg ? n_hstepB : hstepB;
            if (last && has_next) S.a_ready(nxt);
            if constexpr (SP2) {
            PG8_LDB(B0, 0, 0); PG8_LDB(B1, 0, 1); PG8_SCHED; PG8_LDA(At, 0, 0); PG8_STAGE(PG8_SA(1, 1), a1 + hstepA, voffA);
            PG8_WAIT_V(8); PG8_WAIT_L(0); PG8_BAR; PG8_MMA(0, 0, At, B0); PG8_MMA(0, 1, At, B1); PG8_BAR; PG8_SCHED;
            PG8_LDA(At, 0, 1); PG8_STAGE(PG8_SB(0, 0), b2, vB2); PG8_STAGE(PG8_SB(0, 1), b2 + hB2, vB2); PG8_STAGE(PG8_SA(0, 0), a2, vA2);
            PG8_WAIT_V(8); PG8_WAIT_L(0); PG8_BAR; PG8_MMA(1, 0, At, B0); PG8_MMA(1, 1, At, B1); PG8_BAR; PG8_SCHED;
            PG8_LDB(B0, 1, 0); PG8_LDB(B1, 1, 1); PG8_SCHED; PG8_LDA(At, 1, 0); PG8_STAGE(PG8_SA(0, 1), a2 + hA2, vA2);
            PG8_WAIT_V(8); PG8_WAIT_L(0); PG8_BAR; PG8_MMA(0, 0, At, B0); PG8_MMA(0, 1, At, B1); PG8_BAR; PG8_SCHED;
            PG8_LDA(At, 1, 1); PG8_STAGE(PG8_SB(1, 0), b3, vB2); PG8_STAGE(PG8_SB(1, 1), b3 + hB2, vB2); PG8_STAGE(PG8_SA(1, 0), a3, vA2);
            PG8_WAIT_V(8); PG8_WAIT_L(0); PG8_BAR; PG8_MMA(1, 0, At, B0); PG8_MMA(1, 1, At, B1); PG8_BAR; PG8_SCHED;
            } else {
            PG8_LDB(B0, 0, 0); PG8_SCHED; PG8_LDA(At, 0, 0); PG8_STAGE(PG8_SA(1, 1), a1 + hstepA, voffA);
            PG8_WAIT_L(8); PG8_BAR; PG8_WAIT_L(0); PG8_MMA(0, 0, At, B0); PG8_BAR; PG8_SCHED;
            PG8_LDB(B1, 0, 1); PG8_STAGE(PG8_SB(0, 0), b2, voffB);
            PG8_BAR; PG8_WAIT_L(0); PG8_MMA(0, 1, At, B1); PG8_BAR;
            PG8_LDA(At, 0, 1); PG8_STAGE(PG8_SA(0, 0), a2, voffA);
            PG8_BAR; PG8_WAIT_L(0); PG8_MMA(1, 0, At, B0); PG8_BAR; PG8_SCHED;
            PG8_STAGE(PG8_SB(0, 1), b2 + hstepB, voffB);
            PG8_WAIT_V(6); PG8_BAR; PG8_MMA(1, 1, At, B1); PG8_BAR;
            PG8_LDB(B0, 1, 0); PG8_SCHED; PG8_LDA(At, 1, 0); PG8_STAGE(PG8_SA(0, 1), a2 + hstepA, voffA);
            PG8_WAIT_L(8); PG8_BAR; PG8_WAIT_L(0); PG8_MMA(0, 0, At, B0); PG8_BAR; PG8_SCHED;
            PG8_LDB(B1, 1, 1); PG8_STAGE(PG8_SB(1, 0), b3, voffB);
            PG8_BAR; PG8_WAIT_L(0); PG8_MMA(0, 1, At, B1); PG8_BAR;
            PG8_LDA(At, 1, 1); PG8_STAGE(PG8_SA(1, 0), a3, voffA);
            PG8_BAR; PG8_WAIT_L(0); PG8_MMA(1, 0, At, B0); PG8_BAR; PG8_SCHED;
            PG8_STAGE(PG8_SB(1, 1), b3 + hstepB, voffB);
            PG8_WAIT_V(6); PG8_BAR; PG8_MMA(1, 1, At, B1); PG8_BAR;
            }
        }
        if constexpr (ALIGN_EPI) { if (wr == 0) PG8_BAR; }
        if constexpr (!Epi::AFTER_DRAIN) { E(acc, cur, wr, wc, fr, fq); S.done(cur); }
        if (!has_next) break;
#pragma unroll
        for (int a = 0; a < 2; ++a)
#pragma unroll
            for (int b = 0; b < 2; ++b)
#pragma unroll
                for (int m = 0; m < 4; ++m)
#pragma unroll
                    for (int n = 0; n < 2; ++n) acc[a][b][m][n] = (f32x4){0.f, 0.f, 0.f, 0.f};
        cur = nxt; cA = nA; cB = nB; ++ui;
        if constexpr (ALIGN_EPI) { if (wr == 1) PG8_BAR; }
    }
    if constexpr (CH_OUT) { if (wr == 1) PG8_BAR; return; }
    PG8_WAIT_V(0);
    if constexpr (!ALIGN_EPI) { if (wr == 0) PG8_BAR; }
    PG8_BAR;
    if constexpr (Epi::AFTER_DRAIN) { E.fused(acc, cur, wr, wc, fr, fq, lds, wid, lane); S.done(cur); }
#undef PG8_SA
#undef PG8_SB
#undef PG8_STAGE
#undef PG8_LDA
#undef PG8_LDB
#undef PG8_MMA
#undef PG8_WAIT_V
#undef PG8_WAIT_L
#undef PG8_BAR
#undef PG8_SCHED
}
}

template <bool CH_IN, bool CH_OUT, class F>
__device__ __forceinline__ void gemm_pg8c(const Ctx& C, const f16* A, int lda, const f16* Bt, int ldb, int M, int N, int K, const F& f, const f16* nA, int nlda, const f16* nBt, int nldb) {
    pg8::Gemm g{A, Bt, M, N, K, lda, ldb}; pg8::Gemm ng{nA, nBt, M, N, 0, nlda, nldb}; pg8::StaticOrder S; S.init(M, N, C.nblk, C.bid);
    pg8::EpiFn<F> E{f};
    pg8::gemm_phase<pg8::EpiFn<F>, pg8::StaticOrder, true, true, CH_IN, CH_OUT>(C.lds, g, S, E, C.tid, ng);
}
template <class F>
__device__ __forceinline__ void gemm_pg8(const Ctx& C, const f16* A, int lda, const f16* Bt, int ldb, int M, int N, int K, const F& f) {
    pg8::Gemm g{A, Bt, M, N, K, lda, ldb}; pg8::StaticOrder S; S.init(M, N, C.nblk, C.bid);
    pg8::EpiFn<F> E{f};
    pg8::gemm_phase<pg8::EpiFn<F>, pg8::StaticOrder, true, true>(C.lds, g, S, E, C.tid);
}
template <class F>
__device__ __forceinline__ void gemm_small(const Ctx& C, const f16* A, int lda, const f16* Bt, int ldb, int row0, int N, int K, const F& f) {
    constexpr int PST = 68;
    LAS float* part = (LAS float*)C.lds;
    const int fr = C.lane & 15, fq = C.lane >> 4;
    const int tilesN = N / 64, ntiles = 16 * tilesN, kw = K / 8;
    for (int tile = C.bid; tile < ntiles; tile += C.nblk) {
        const int tm = tile / tilesN, tn = tile - tm * tilesN, m0 = tm * 64, n0 = tn * 64;
        f32x4 acc[4][4];
#pragma unroll
        for (int a = 0; a < 4; ++a)
#pragma unroll
            for (int b = 0; b < 4; ++b) acc[a][b] = (f32x4){0.f, 0.f, 0.f, 0.f};
        const f16* ap = A + (size_t)(m0 + fr) * lda + C.wid * kw + fq * 8;
        const f16* bp = Bt + (size_t)(n0 + fr) * ldb + C.wid * kw + fq * 8;
#pragma unroll 4
        for (int k0 = 0; k0 < kw; k0 += 32) {
            f16x8 av[4], bv[4];
#pragma unroll
            for (int a = 0; a < 4; ++a) av[a] = *(const f16x8*)(ap + (size_t)(a * 16) * lda + k0);
#pragma unroll
            for (int b = 0; b < 4; ++b) bv[b] = *(const f16x8*)(bp + (size_t)(b * 16) * ldb + k0);
#pragma unroll
            for (int a = 0; a < 4; ++a)
#pragma unroll
                for (int b = 0; b < 4; ++b) acc[a][b] = __builtin_amdgcn_mfma_f32_16x16x32_f16(bv[b], av[a], acc[a][b], 0, 0, 0);
        }
        __syncthreads();
        LAS float* pw = part + (size_t)C.wid * 64 * PST;
#pragma unroll
        for (int a = 0; a < 4; ++a)
#pragma unroll
            for (int b = 0; b < 4; ++b) *(LAS f32x4*)(pw + (a * 16 + fr) * PST + b * 16 + 4 * fq) = acc[a][b];
        __syncthreads();
        const int rl = 8 * C.wid + (C.lane & 7), c8 = ((C.lane >> 4) & 1) | (((C.lane >> 5) & 1) << 1) | (((C.lane >> 3) & 1) << 2);
        f32x4 lo = (f32x4){0.f, 0.f, 0.f, 0.f}, hi = lo;
#pragma unroll
        for (int w = 0; w < 8; ++w) { const LAS float* pr = part + ((size_t)w * 64 + rl) * PST + 8 * c8; lo = lo + *(const LAS f32x4*)pr; hi = hi + *(const LAS f32x4*)(pr + 4); }
        f(row0 + m0 + rl, n0 + 8 * c8, lo, hi, f.pre(row0 + m0 + rl, n0 + 8 * c8));
    }
    __syncthreads();
}
template <class F>
__device__ __forceinline__ void gemm_rows(const Ctx& C, const f16* A, int lda, const f16* Bt, int ldb, int mrows, int N, int K, const F& f) {
    gemm_pg8(C, A, lda, Bt, ldb, NLAT, N, K, f);
    if (mrows > NLAT) gemm_small(C, A + (size_t)NLAT * lda, lda, Bt, ldb, NLAT, N, K, f);
}
struct NoPre {};
#define NOPRE typedef NoPre Pre; __device__ __forceinline__ NoPre pre(int, int) const { return NoPre{}; }
struct EpiProj { f16* P; f16* VA; f16* U3;
    NOPRE
    __device__ __forceinline__ void operator()(int row, int col, f32x4 lo, f32x4 hi, NoPre) const {
        const f16x8 v = pack8(lo, hi); f16* pr = P + (size_t)row * PLD2;
        if (col < GC_AV) *(f16x8*)(pr + PC_AK + col) = v;
        else if (col < GC_CKV) { const RowInfo ri = row_info(row); const int c = col - GC_AV; *(f16x8*)(VA + ((size_t)(ri.b * 2 + (c >> 6)) * NKEY + ri.pos) * 64 + (c & 63)) = v; }
        else if (col < GC_CKR) *(f16x8*)(pr + PC_CKV + (col - GC_CKV)) = v;
        else if (col < GC_PAD) *(f16x8*)(pr + PC_CKR + (col - GC_CKR)) = v;
        else if (col < GC_U) { }
        else if (col < GC_AQ) { const int c = col - GC_U; *(f16x8*)(U3 + u3_off(c >> 4, row >> 9, row & 15, (c >> 3) & 1, (row >> 4) & 31)) = v; }
        else if (col < GC_CQ) *(f16x8*)(pr + PC_AQ + (col - GC_AQ)) = v;
        else *(f16x8*)(pr + PC_CQ + (col - GC_CQ)) = v;
    } };
struct EpiKvUp { f16* KC; f16* VC;
    NOPRE
    __device__ __forceinline__ void operator()(int row, int col, f32x4 lo, f32x4 hi, NoPre) const {
        const RowInfo ri = row_info(row); const int h = col >> 7, w = col & 127;
        if (w < 64) *(f16x8*)(KC + ((size_t)(ri.b * 8 + h) * NKEY + ri.pos) * 96 + w) = pack8(lo, hi);
        else *(f16x8*)(VC + ((size_t)(ri.b * 8 + h) * NKEY + ri.pos) * 64 + (w - 64)) = pack8(lo, hi);
    } };
struct EpiQUp { f16* QC; const float* ropeC;
    NOPRE
    __device__ __forceinline__ void operator()(int row, int col, f32x4 lo, f32x4 hi, NoPre) const {
        const RowInfo ri = row_info(row); const int h = col / 96, w = col - h * 96;
        if (w >= 64) {
            f32x4 plo, phi;
#pragma unroll
            for (int e = 0; e < 4; ++e) { plo[e] = __shfl_xor(lo[e], 16); phi[e] = __shfl_xor(hi[e], 16); }
            if (ri.lat) {
                const int j0 = w - 64, part = j0 >> 4, second = (j0 >> 3) & 1, pi = part ? (ri.t & 63) : (ri.t >> 6);
                const float* cc = ropeC + pi * 8; const float* ss = ropeC + 512 + pi * 8;
#pragma unroll
                for (int e = 0; e < 4; ++e) {
                    const float s0 = second ? ss[e] : -ss[e], s1 = second ? ss[4 + e] : -ss[4 + e];
                    lo[e] = lo[e] * cc[e] + plo[e] * s0; hi[e] = hi[e] * cc[4 + e] + phi[e] * s1; }
            }
        }
        lo = lo * QSCALE_C; hi = hi * QSCALE_C;
        f16* dst = ri.lat ? QC + ((size_t)(ri.b * 8 + h) * SEQ + ri.t) * 96 + w : QC + (size_t)NB * 8 * SEQ * 96 + ((size_t)(ri.b * 8 + h) * CTX + ri.t) * 96 + w;
        *(f16x8*)dst = pack8(lo, hi);
    } };
struct EpiGlu { f16* YS;
    NOPRE
    __device__ __forceinline__ void operator()(int row, int col, f32x4 lo, f32x4 hi, NoPre) const {
        f32x4 o;
#pragma unroll
        for (int e = 0; e < 4; ++e) o[e] = lo[e] * sigmoidf_(hi[e]);
        *(f16x4*)(YS + (size_t)row * 512 + (col >> 1)) = pack4(o);
    } };
struct EpiGate { f16* G;
    NOPRE
    __device__ __forceinline__ void operator()(int row, int col, f32x4 lo, f32x4 hi, NoPre) const {
#pragma unroll
        for (int e = 0; e < 4; ++e) { lo[e] = sigmoidf_(lo[e]); hi[e] = sigmoidf_(hi[e]); }
        *(f16x8*)(G + (size_t)row * 1024 + col) = pack8(lo, hi);
    } };
struct EpiBranch { const f16* G; f16* Mg; int first;
    struct Pre { f16x8 g, m; };
    __device__ __forceinline__ Pre pre(int row, int col) const { Pre p; p.g = *(const f16x8*)(G + (size_t)row * 1024 + col);
        if (!first) p.m = *(const f16x8*)(Mg + (size_t)row * 1024 + col); else p.m = (f16x8){0, 0, 0, 0, 0, 0, 0, 0}; return p; }
    __device__ __forceinline__ void operator()(int row, int col, f32x4 lo, f32x4 hi, const Pre& p) const {
#pragma unroll
        for (int e = 0; e < 4; ++e) { lo[e] = (float)p.m[e] + (float)p.g[e] * lo[e]; hi[e] = (float)p.m[4 + e] + (float)p.g[4 + e] * hi[e]; }
        *(f16x8*)(Mg + (size_t)row * 1024 + col) = pack8(lo, hi);
    } };
struct EpiWout { const Ctx* C; int l;
    struct Pre { f32x4 x0, x1, g0, g1; };
    __device__ __forceinline__ Pre pre(int row, int col) const { const RowInfo ri = row_info(row); const float* x = C->xsrc(l, row) + col; const float* g = C->mod(l, ri.mrow, 2) + col;
        Pre p; p.x0 = *(const f32x4*)x; p.x1 = *(const f32x4*)(x + 4); p.g0 = *(const f32x4*)g; p.g1 = *(const f32x4*)(g + 4); return p; }
    __device__ __forceinline__ void operator()(int row, int col, f32x4 lo, f32x4 hi, const Pre& p) const {
        *(f16x8*)((f16*)(C->ws() + A_T1H) + (size_t)row * D + col) = pack8(p.x0 * ALPHA + p.g0 * lo, p.x1 * ALPHA + p.g1 * hi);
    } };
struct EpiUp { f16* Hd;
    NOPRE
    __device__ __forceinline__ void operator()(int row, int col, f32x4 lo, f32x4 hi, NoPre) const {
#pragma unroll
        for (int e = 0; e < 4; ++e) { const float a = fmaxf(lo[e], 0.f), b = fmaxf(hi[e], 0.f); lo[e] = a * a; hi[e] = b * b; }
        *(f16x8*)(Hd + (size_t)row * DFF + col) = pack8(lo, hi);
    } };
struct EpiDown { const Ctx* C; int l;
    struct Pre { f16x8 t1; float mean, rstd; };
    __device__ __forceinline__ Pre pre(int row, int col) const { Pre p; p.t1 = *(const f16x8*)((const f16*)(C->ws() + A_T1H) + (size_t)row * D + col);
        const float* st = (const float*)(C->ws() + WS_ST1) + 2 * row; p.mean = st[0]; p.rstd = st[1]; return p; }
    __device__ __forceinline__ void operator()(int row, int col, f32x4 lo, f32x4 hi, const Pre& p) const {
        const RowInfo ri = row_info(row); const float* g = C->mod(l, ri.mrow, 5) + col; f16* t = (f16*)(C->ws() + A_T1H) + (size_t)row * D + col;
        const float* lg = C->in(I_LN1G) + l * D + col; const float* lb = C->in(I_LN1B) + l * D + col;
        const f32x4 g0 = *(const f32x4*)g, g1 = *(const f32x4*)(g + 4);
        const f32x4 a0 = *(const f32x4*)lg, a1 = *(const f32x4*)(lg + 4), b0 = *(const f32x4*)lb, b1 = *(const f32x4*)(lb + 4);
        f32x4 x0, x1;
#pragma unroll
        for (int e = 0; e < 4; ++e) { x0[e] = ((float)p.t1[e] - p.mean) * p.rstd * a0[e] + b0[e]; x1[e] = ((float)p.t1[4 + e] - p.mean) * p.rstd * a1[e] + b1[e]; }
        *(f16x8*)t = pack8(x0 * ALPHA + g0 * lo, x1 * ALPHA + g1 * hi);
    } };

namespace fa {
typedef _Float16 h2 __attribute__((ext_vector_type(2)));
typedef float f2 __attribute__((ext_vector_type(2)));
typedef short s16x4 __attribute__((ext_vector_type(4)));
typedef unsigned u32x4 __attribute__((ext_vector_type(4)));
#define FA_SBAR() __builtin_amdgcn_sched_barrier(0)
constexpr float THR = 8.f;
constexpr int SHM_V = 64 * 64 * 2;
template <int DQK> struct Cfg { static constexpr int KROWB = DQK == 64 ? 128 : 256, SHM_K = 64 * KROWB, NCH = DQK / 8; };
template <int DQK> __device__ __forceinline__ int kswz(int row, int ch) {
    if constexpr (DQK == 64) return row * 128 + ((ch ^ ((row >> 1) & 7)) << 4);
    else return row * 256 + ((ch ^ (row & 15)) << 4);
}
__device__ __forceinline__ int crow(int r, int hi) { return (r & 3) + 8 * (r >> 2) + 4 * hi; }
__device__ __forceinline__ unsigned cvtpk(float lo, float hi) { f2 v = {lo, hi}; h2 h = __builtin_convertvector(v, h2); return __builtin_bit_cast(unsigned, h); }
__device__ __forceinline__ void partialSM(f32x16& p0, f32x16& p1, float& m_reg, float& mn, float& alpha) {
    float pmax = p0[0];
#pragma unroll
    for (int r = 1; r < 16; ++r) pmax = fmaxf(pmax, p0[r]);
#pragma unroll
    for (int r = 0; r < 16; ++r) pmax = fmaxf(pmax, p1[r]);
    { auto rr = __builtin_amdgcn_permlane32_swap(__float_as_uint(pmax), __float_as_uint(pmax), false, false);
      pmax = fmaxf(__uint_as_float(rr[0]), __uint_as_float(rr[1])); }
    if (__builtin_expect(__all(pmax - m_reg <= THR), 1)) { mn = m_reg; alpha = 1.f; }
    else { mn = fmaxf(m_reg, pmax); alpha = __builtin_amdgcn_exp2f(m_reg - mn); m_reg = mn; }
#pragma unroll
    for (int r = 0; r < 16; ++r) { p0[r] = p0[r] - mn; p1[r] = p1[r] - mn; }
#pragma unroll
    for (int r = 0; r < 16; ++r) p0[r] = __builtin_amdgcn_exp2f(p0[r]);
}
__device__ __forceinline__ void finishSM(f32x16& p0, f32x16& p1, float alpha, float& l_reg, f16x8& pa0, f16x8& pa1, f16x8& pa2, f16x8& pa3) {
#pragma unroll
    for (int r = 0; r < 16; ++r) p1[r] = __builtin_amdgcn_exp2f(p1[r]);
    float ps = 0;
#pragma unroll
    for (int r = 0; r < 16; ++r) ps += p0[r];
#pragma unroll
    for (int r = 0; r < 16; ++r) ps += p1[r];
    { auto rr = __builtin_amdgcn_permlane32_swap(__float_as_uint(ps), __float_as_uint(ps), false, false);
      ps = __uint_as_float(rr[0]) + __uint_as_float(rr[1]); }
    l_reg = l_reg * alpha + ps;
#define FA_PK4(P, BASE, OUT) do { unsigned a0 = cvtpk(P[BASE + 0], P[BASE + 1]), a1 = cvtpk(P[BASE + 2], P[BASE + 3]);   \
    unsigned b0 = cvtpk(P[BASE + 4], P[BASE + 5]), b1 = cvtpk(P[BASE + 6], P[BASE + 7]);                              \
    auto r0 = __builtin_amdgcn_permlane32_swap(a0, b0, false, false); auto r1 = __builtin_amdgcn_permlane32_swap(a1, b1, false, false); \
    u32x4 w = {r0[0], r1[0], r0[1], r1[1]}; OUT = __builtin_bit_cast(f16x8, w); } while (0)
    FA_PK4(p0, 0, pa0); FA_PK4(p0, 8, pa1); FA_PK4(p1, 0, pa2); FA_PK4(p1, 8, pa3);
#undef FA_PK4
}
template <int DQK>
__device__ __forceinline__ void qkt(f32x16& p0, f32x16& p1, const LAS unsigned char* Ks, const f16x8* qr, int r32, int hi) {
    p0 = f32x16{}; p1 = f32x16{};
#pragma unroll
    for (int d0 = 0; d0 < DQK / 16; ++d0) {
        const f16x8 b0 = *(const LAS f16x8*)(Ks + kswz<DQK>(r32, d0 * 2 + hi));
        const f16x8 b1 = *(const LAS f16x8*)(Ks + kswz<DQK>(32 + r32, d0 * 2 + hi));
        p0 = __builtin_amdgcn_mfma_f32_32x32x16_f16(b0, qr[d0], p0, 0, 0, 0);
        p1 = __builtin_amdgcn_mfma_f32_32x32x16_f16(b1, qr[d0], p1, 0, 0, 0);
    }
}
__device__ __forceinline__ int v_st(int k, int c) { const int kk = (k & ~0xC) | ((k & 4) << 1) | ((k & 8) >> 1); return ((kk >> 3) * 2 + (c >> 5)) * 512 + ((kk & 7) * 32 + (c & 31)) * 2; }
__device__ __forceinline__ int v_rd_base(int lane) { return ((lane & 3) << 3) | (((lane >> 2) & 3) << 6) | (((lane >> 4) & 1) << 5) | (((lane >> 5) & 1) << 8); }
constexpr int v_rd_off(int d0, int ks, int half) { return d0 * 512 + ks * 2048 + half * 1024; }
template <int OFF> __device__ __forceinline__ s16x4 tr_read(int vb) {
    s16x4 r; asm volatile("ds_read_b64_tr_b16 %0, %1 offset:%2" : "=&v"(r) : "v"(vb), "i"(OFF) : "memory"); return r;
}
template <int D0> __device__ __forceinline__ void pv_one(f32x16& od, int vb, f16x8 pa0, f16x8 pa1, f16x8 pa2, f16x8 pa3) {
    const s16x4 l0 = tr_read<v_rd_off(D0, 0, 0)>(vb), h0 = tr_read<v_rd_off(D0, 0, 1)>(vb), l1 = tr_read<v_rd_off(D0, 1, 0)>(vb), h1 = tr_read<v_rd_off(D0, 1, 1)>(vb);
    const s16x4 l2 = tr_read<v_rd_off(D0, 2, 0)>(vb), h2_ = tr_read<v_rd_off(D0, 2, 1)>(vb), l3 = tr_read<v_rd_off(D0, 3, 0)>(vb), h3 = tr_read<v_rd_off(D0, 3, 1)>(vb);
    asm volatile("s_waitcnt lgkmcnt(0)" ::: "memory"); FA_SBAR();
#define FA_PK(L, H) __builtin_bit_cast(f16x8, (short __attribute__((ext_vector_type(8)))){L[0], L[1], L[2], L[3], H[0], H[1], H[2], H[3]})
    od = __builtin_amdgcn_mfma_f32_32x32x16_f16(pa0, FA_PK(l0, h0), od, 0, 0, 0);
    od = __builtin_amdgcn_mfma_f32_32x32x16_f16(pa1, FA_PK(l1, h1), od, 0, 0, 0);
    od = __builtin_amdgcn_mfma_f32_32x32x16_f16(pa2, FA_PK(l2, h2_), od, 0, 0, 0);
    od = __builtin_amdgcn_mfma_f32_32x32x16_f16(pa3, FA_PK(l3, h3), od, 0, 0, 0);
#undef FA_PK
}
__device__ __forceinline__ void pv_d0(f32x16* o, int vb, f16x8 pa0, f16x8 pa1, f16x8 pa2, f16x8 pa3) {
    pv_one<0>(o[0], vb, pa0, pa1, pa2, pa3); pv_one<1>(o[1], vb, pa0, pa1, pa2, pa3);
}
template <int DQK>
__device__ __forceinline__ void attn_unit(const f16* Qb, int qstride, const f16* __restrict__ Kh, const f16* __restrict__ Vh, f16* Ob, int nkeys, LAS unsigned char* lds, const int tid) {
    constexpr int SHM_K = Cfg<DQK>::SHM_K, NCH = Cfg<DQK>::NCH, ND0 = DQK / 16;
    const int wid = tid >> 6, lane = tid & 63, r32 = lane & 31, hi = lane >> 5;
    LAS unsigned char* V_lds = lds; LAS unsigned char* K_lds = lds + 3 * SHM_V;
    LAS float* wsx = (LAS float*)(lds + 3 * SHM_V + 2 * SHM_K) + wid * 64; LAS float* li_l = wsx; LAS float* al_l = wsx + 32;
    float m_reg = -1e30f, l_reg = 0; f32x16 o[2] = {}; f16x8 qr[ND0];
    const f16* Qw = Qb + (size_t)(wid * 32 + r32) * qstride + hi * 8;
#pragma unroll
    for (int d0 = 0; d0 < ND0; ++d0) qr[d0] = *(const f16x8*)(Qw + d0 * 16);
    const int vr = tid >> 3, vc = (tid & 7) * 8, vst = v_st(vr, vc);
    const int k0id = tid, k1id = (tid + 512 < 64 * NCH) ? tid + 512 : tid;
    const int k0r = k0id / NCH, k0c = k0id % NCH, k1r = k1id / NCH, k1c = k1id % NCH;
    const bool k1on = (NCH > 8) && (tid + 512 < 64 * NCH);
    const int vb0 = (int)(uintptr_t)V_lds + v_rd_base(lane);
    struct { f16x8 vs, ks0, ks1; } sr_[2];
#define FA_SLOAD(i, kk0) do { sr_[i].vs = *(const f16x8*)(Vh + (size_t)((kk0) + vr) * 64 + vc); sr_[i].ks0 = *(const f16x8*)(Kh + (size_t)((kk0) + k0r) * DQK + k0c * 8); \
    if (NCH > 8) sr_[i].ks1 = *(const f16x8*)(Kh + (size_t)((kk0) + k1r) * DQK + k1c * 8); } while (0)
#define FA_SWRITE(b, vbo, i) do { *(LAS f16x8*)(V_lds + (vbo) + vst) = sr_[i].vs; *(LAS f16x8*)(K_lds + (b) * SHM_K + kswz<DQK>(k0r, k0c)) = sr_[i].ks0; \
    if (k1on) *(LAS f16x8*)(K_lds + (b) * SHM_K + kswz<DQK>(k1r, k1c)) = sr_[i].ks1; } while (0)
#define FA_SWAIT() do { if (NCH > 8) asm volatile("s_waitcnt vmcnt(3)" ::: "memory"); else asm volatile("s_waitcnt vmcnt(2)" ::: "memory"); } while (0)
#define FA_RESC(a) do { if (__any((a) < 1.f)) { if (hi == 0) al_l[r32] = (a); asm volatile("s_waitcnt lgkmcnt(0)" ::: "memory"); \
    _Pragma("unroll") for (int d = 0; d < 2; ++d) _Pragma("unroll") for (int r = 0; r < 16; ++r) o[d][r] *= al_l[crow(r, hi)]; } } while (0)
    f32x16 pA0, pA1, pB0, pB1; float mnA, mnB, alA, alB; f16x8 pa0, pa1, pa2, pa3; const int NT = nkeys / 64;
    constexpr int SE = 0, SO = 1;
    int vp = 0, vc_ = SHM_V, vn = 2 * SHM_V;
#define FA_VROT() do { const int t_ = vp; vp = vc_; vc_ = vn; vn = t_; } while (0)
    FA_SLOAD(SE, 0); asm volatile("s_waitcnt vmcnt(0)" ::: "memory"); FA_SWRITE(0, 0, SE); __syncthreads();
    qkt<DQK>(pA0, pA1, K_lds, qr, r32, hi); partialSM(pA0, pA1, m_reg, mnA, alA);
    FA_SLOAD(SO, 64); if (2 < NT) FA_SLOAD(SE, 128);
    FA_SWAIT(); FA_SWRITE(1, SHM_V, SO); __syncthreads();
    for (int j = 1; j + 1 < NT; j += 2) {
        FA_SBAR(); qkt<DQK>(pB0, pB1, K_lds + SHM_K, qr, r32, hi);
        finishSM(pA0, pA1, alA, l_reg, pa0, pa1, pa2, pa3); FA_SBAR();
        FA_SLOAD(SO, (j + 2) * 64); FA_SBAR();
        pv_d0(o, vb0 + vp, pa0, pa1, pa2, pa3); partialSM(pB0, pB1, m_reg, mnB, alB);
        FA_SWAIT(); FA_SWRITE(0, vn, SE);
        FA_RESC(alB); __syncthreads(); FA_VROT();
        FA_SBAR(); qkt<DQK>(pA0, pA1, K_lds, qr, r32, hi);
        finishSM(pB0, pB1, alB, l_reg, pa0, pa1, pa2, pa3); FA_SBAR();
        if (j + 3 < NT) FA_SLOAD(SE, (j + 3) * 64);
        FA_SBAR();
        pv_d0(o, vb0 + vp, pa0, pa1, pa2, pa3); partialSM(pA0, pA1, m_reg, mnA, alA);
        FA_SWAIT(); FA_SWRITE(1, vn, SO);
        FA_RESC(alA); __syncthreads(); FA_VROT();
    }
    FA_SBAR(); qkt<DQK>(pB0, pB1, K_lds + SHM_K, qr, r32, hi);
    finishSM(pA0, pA1, alA, l_reg, pa0, pa1, pa2, pa3); FA_SBAR();
    pv_d0(o, vb0 + vp, pa0, pa1, pa2, pa3); partialSM(pB0, pB1, m_reg, mnB, alB);
    FA_RESC(alB);
    finishSM(pB0, pB1, alB, l_reg, pa0, pa1, pa2, pa3); FA_SBAR();
    pv_d0(o, vb0 + vc_, pa0, pa1, pa2, pa3);
    if (hi == 0) li_l[r32] = l_reg;
    asm volatile("s_waitcnt lgkmcnt(0)" ::: "memory");
    float rli[16];
#pragma unroll
    for (int r = 0; r < 16; ++r) rli[r] = __builtin_amdgcn_rcpf(li_l[crow(r, hi)]);
    f16* Ow = Ob + (size_t)(wid * 32) * 512;
#pragma unroll
    for (int r = 0; r < 16; ++r) { const int orow = crow(r, hi);
#pragma unroll
        for (int d0 = 0; d0 < 2; ++d0) Ow[(size_t)orow * 512 + d0 * 32 + r32] = (f16)(o[d0][r] * rli[r]); }
#undef FA_SLOAD
#undef FA_SWRITE
#undef FA_SWAIT
#undef FA_RESC
#undef FA_VROT
}
}
__device__ __forceinline__ void phase_attn_flash(const Ctx& C, int l) {
    f16* QA = (f16*)(C.ws() + A_QA); const f16* QC = (const f16*)(C.ws() + A_QC);
    const f16* KA = (const f16*)(C.ws() + A_KA); const f16* VA = (const f16*)(C.ws() + A_VA);
    const f16* KC = (const f16*)(C.ws() + A_KC); const f16* VC = (const f16*)(C.ws() + A_VC);
    f16* YC = (f16*)(C.ws() + A_YC);
    const int vcu = (C.nblk % 8 == 0) ? (C.bid % 8) * (C.nblk / 8) + C.bid / 8 : C.bid;
    const int total = 1024 + (l == 0 ? 64 : 0);
    for (int u = vcu; u < total; u += C.nblk) {
        __syncthreads();
        int typeC, b, h, nkeys; size_t qrow, orow;
        if (u < 1024) { const int v = u & 511; typeC = u >> 9; b = v >> 7; h = (v >> 4) & 7; const int qb = v & 15; qrow = (size_t)(b * 8 + h) * SEQ + qb * 256; orow = (size_t)b * SEQ + qb * 256; nkeys = NKEY; }
        else { const int v = (u - 1024) & 31; typeC = (u - 1024) >> 5; b = v >> 3; h = v & 7; qrow = (size_t)NB * 8 * SEQ + (size_t)(b * 8 + h) * CTX; orow = (size_t)NLAT + b * CTX; nkeys = CTX; }
        if (!typeC) fa::attn_unit<64>(QA + orow * 512 + h * 64, 512, KA + (size_t)(b * 2 + (h >> 2)) * NKEY * 64, VA + (size_t)(b * 2 + (h >> 2)) * NKEY * 64, QA + orow * 512 + h * 64, nkeys, C.lds, C.tid);
        else fa::attn_unit<96>(QC + qrow * 96, 96, KC + (size_t)(b * 8 + h) * NKEY * 96, VC + (size_t)(b * 8 + h) * NKEY * 64, YC + orow * 512 + h * 64, nkeys, C.lds, C.tid);
    }
}

constexpr float S5SC = 1024.0f, S5ISC = 1.0f / 1024.0f;
__device__ __forceinline__ void qp_split(int qp, int& b, int& nmem) { if (qp < 1024) { b = qp >> 8; nmem = 16 + (qp & 255); } else { b = (qp - 1024) >> 4; nmem = (qp - 1024) & 15; } }
__device__ __forceinline__ void phase_s5tab(const Ctx& C, int l) {
    LAS float* ApR = (LAS float*)C.lds; LAS float* ApI = ApR + 17 * 64; LAS float* BbR = ApI + 17 * 64; LAS float* BbI = BbR + 1024; LAS float* CR = BbI + 1024; LAS float* CI = CR + 1024;
    for (int u = C.bid; u < 64; u += C.nblk) {
        const int dir = u >> 5, g = u & 31; const size_t gi = (size_t)(l * 2 + dir) * 32 + g;
        const float dt = expf(C.in(I_SLDT)[gi]);
        __syncthreads();
        for (int i = C.tid; i < 17 * 64; i += NTHREADS) {
            const int p = i & 63, k = i >> 6; const float are = C.in(I_SARE)[gi * 64 + p], aim = C.in(I_SAIM)[gi * 64 + p];
            const float mag = expf(are * dt * (float)k), ang = (aim * dt) * (float)k;
            ApR[i] = mag * cosf(ang); ApI[i] = mag * sinf(ang);
        }
        for (int i = C.tid; i < 1024; i += NTHREADS) {
            const int p = i >> 4, c = i & 15; const float are = C.in(I_SARE)[gi * 64 + p], aim = C.in(I_SAIM)[gi * 64 + p];
            const float mag = expf(are * dt), th = aim * dt, abr = mag * cosf(th), abi = mag * sinf(th);
            const float den = are * are + aim * aim, nr = abr - 1.0f, cr = (nr * are + abi * aim) / den, ci = (abi * are - nr * aim) / den;
            const float br = C.in(I_SBRE)[(gi * 64 + p) * 16 + c], bi = C.in(I_SBIM)[(gi * 64 + p) * 16 + c];
            BbR[i] = cr * br - ci * bi; BbI[i] = cr * bi + ci * br;
            CR[i] = C.in(I_SCRE)[gi * 1024 + i]; CI[i] = C.in(I_SCIM)[gi * 1024 + i];
        }
        __syncthreads();
        f16* Et = (f16*)(C.ws() + T_E) + (size_t)u * 16 * 16 * 128; f16* Mt = (f16*)(C.ws() + T_M); f16* Kt = (f16*)(C.ws() + T_K) + (size_t)u * 17 * 256;
        for (int i = C.tid; i < 16384; i += NTHREADS) {
            { const int t = i >> 10, c = (i >> 6) & 15, p = i & 63, k = dir == 0 ? t + 1 : 16 - t;
              const float cr = CR[c * 64 + p], ci = CI[c * 64 + p], ar = ApR[k * 64 + p], ai = ApI[k * 64 + p];
              Et[(size_t)(t * 16 + c) * 128 + p] = (f16)((cr * ar - ci * ai) * S5SC); Et[(size_t)(t * 16 + c) * 128 + 64 + p] = (f16)(-(cr * ai + ci * ar) * S5SC); }
            { const int p = i >> 8, sx = (i >> 4) & 15, c = i & 15, k = dir == 0 ? 15 - sx : sx;
              const float ar = ApR[k * 64 + p], ai = ApI[k * 64 + p], br = BbR[p * 16 + c], bi = BbI[p * 16 + c];
              Mt[m3_off(u, p >> 5, sx, c >> 3, p & 31) + (c & 7)] = (f16)((ar * br - ai * bi) * S5SC);
              Mt[m3_off(u, 2 + (p >> 5), sx, c >> 3, p & 31) + (c & 7)] = (f16)((ar * bi + ai * br) * S5SC); }
        }
        for (int i = C.tid; i < 17 * 256; i += NTHREADS) {
            const int tau = (i >> 8) - 1, c = (i >> 4) & 15, cp = i & 15; float acc = 0.f;
            if (tau >= 0) {
#pragma unroll 8
                for (int p = 0; p < 64; ++p) {
                    const float cr = CR[c * 64 + p], ci = CI[c * 64 + p], ar = ApR[tau * 64 + p], ai = ApI[tau * 64 + p];
                    acc += (cr * ar - ci * ai) * BbR[p * 16 + cp] - (cr * ai + ci * ar) * BbI[p * 16 + cp]; }
            }
            Kt[i] = (f16)(acc * S5SC);
        }
    }
}
__device__ __forceinline__ void phase_s5a(const Ctx& C) {
    const f16* U = (const f16*)(C.ws() + A_U); float* S = (float*)(C.ws() + A_S5S); const f16* Mt = (const f16*)(C.ws() + T_M);
    const int r32 = C.lane & 31, hi = C.lane >> 5;
    for (int u = C.bid * NWAVES + C.wid; u < 64 * 34; u += C.nblk * NWAVES) {
        const int dirg = u / 34, nb = u - dirg * 34, g = dirg & 31;
        int b, nmem; qp_split(nb * 32 + r32, b, nmem);
        f16x8 uf[16];
#pragma unroll
        for (int sx = 0; sx < 16; ++sx) uf[sx] = *(const f16x8*)(U + u3_off(g, nb, sx, hi, r32));
        float* sp = S + ((size_t)(dirg * 4 + b) * 128) * 272 + nmem;
#pragma unroll
        for (int mb = 0; mb < 4; ++mb) {
            f16x8 af[16];
#pragma unroll
            for (int sx = 0; sx < 16; ++sx) af[sx] = *(const f16x8*)(Mt + m3_off(dirg, mb, sx, hi, r32));
            f32x16 acc = {};
#pragma unroll
            for (int sx = 0; sx < 16; ++sx) acc = __builtin_amdgcn_mfma_f32_32x32x16_f16(af[sx], uf[sx], acc, 0, 0, 0);
#pragma unroll
            for (int r = 0; r < 16; ++r) sp[(size_t)(mb * 32 + fa::crow(r, hi)) * 272] = acc[r] * S5ISC;
        }
    }
}
__device__ __forceinline__ void phase_s5b(const Ctx& C, int l) {
    const float* S = (const float*)(C.ws() + A_S5S); f16* X = (f16*)(C.ws() + A_S5X);
    LAS float* ex = (LAS float*)C.lds;
    for (int item = C.bid; item < 256; item += C.nblk) {
        const int p = C.lane, w = C.wid, db = item, dirg = db >> 2, b = db & 3, dir = dirg >> 5, g = dirg & 31; const size_t gi = (size_t)(l * 2 + dir) * 32 + g;
        const float are = C.in(I_SARE)[gi * 64 + p], aim = C.in(I_SAIM)[gi * 64 + p], dt = expf(C.in(I_SLDT)[gi]);
        const float mag = expf(are * dt * 16.0f), ang = (aim * dt) * 16.0f, ar = mag * cosf(ang), ai = mag * sinf(ang);
        const float mag32 = expf(are * dt * 512.0f), ang32 = (aim * dt) * 512.0f, br_ = mag32 * cosf(ang32), bi_ = mag32 * sinf(ang32);
        const float* sr = S + ((size_t)db * 128 + p) * 272; const float* si = sr + 64 * 272;
        const int kkr = p >> 4, hf = (p >> 3) & 1, jj = p & 7;
        const int lo = dir == 0 ? 16 + 32 * w : 16 + 32 * (7 - w);
        f32x4 cr[4], ci[4], gr[8], gq[8];
#pragma unroll
        for (int j = 0; j < 4; ++j) { cr[j] = *(const f32x4*)(sr + 4 * j); ci[j] = *(const f32x4*)(si + 4 * j); }
#pragma unroll
        for (int j = 0; j < 8; ++j) { gr[j] = *(const f32x4*)(sr + lo + 4 * j); gq[j] = *(const f32x4*)(si + lo + 4 * j); }
        float xr = 0.f, xi = 0.f;
#pragma unroll
        for (int e = 0; e < 16; ++e) {
            const int ef = e, eb = 15 - e;
            const float sre = dir == 0 ? cr[ef >> 2][ef & 3] : cr[eb >> 2][eb & 3], sim = dir == 0 ? ci[ef >> 2][ef & 3] : ci[eb >> 2][eb & 3];
            if (w == 0) { const int nmem = dir == 0 ? ef : eb, qp = 1024 + b * 16 + nmem;
                X[x3_off(dirg, qp >> 5, kkr, hf, qp & 31) + jj] = (f16)xr; X[x3_off(dirg, qp >> 5, 4 + kkr, hf, qp & 31) + jj] = (f16)xi; }
            const float nxr = ar * xr - ai * xi + sre, nxi = ar * xi + ai * xr + sim; xr = nxr; xi = nxi;
        }
        const float c0r = xr, c0i = xi;
        xr = 0.f; xi = 0.f;
#pragma unroll
        for (int e = 0; e < 32; ++e) {
            const int ef = e, eb = 31 - e;
            const float sre = dir == 0 ? gr[ef >> 2][ef & 3] : gr[eb >> 2][eb & 3], sim = dir == 0 ? gq[ef >> 2][ef & 3] : gq[eb >> 2][eb & 3];
            const float nxr = ar * xr - ai * xi + sre, nxi = ar * xi + ai * xr + sim; xr = nxr; xi = nxi;
        }
        __syncthreads();
        ex[w * 128 + p] = xr; ex[w * 128 + 64 + p] = xi;
        __syncthreads();
        xr = c0r; xi = c0i;
        for (int v = 0; v < w; ++v) { const float er = ex[v * 128 + p], ei = ex[v * 128 + 64 + p];
            const float nxr = br_ * xr - bi_ * xi + er, nxi = br_ * xi + bi_ * xr + ei; xr = nxr; xi = nxi; }
#pragma unroll
        for (int e = 0; e < 32; ++e) {
            const int ef = e, eb = 31 - e;
            const float sre = dir == 0 ? gr[ef >> 2][ef & 3] : gr[eb >> 2][eb & 3], sim = dir == 0 ? gq[ef >> 2][ef & 3] : gq[eb >> 2][eb & 3];
            const int nmem = lo + (dir == 0 ? ef : eb), qp = b * 256 + nmem - 16;
            X[x3_off(dirg, qp >> 5, kkr, hf, qp & 31) + jj] = (f16)xr; X[x3_off(dirg, qp >> 5, 4 + kkr, hf, qp & 31) + jj] = (f16)xi;
            const float nxr = ar * xr - ai * xi + sre, nxi = ar * xi + ai * xr + sim; xr = nxr; xi = nxi;
        }
    }
}
__device__ __forceinline__ void phase_s5c(const Ctx& C, int l) {
    const f16* U = (const f16*)(C.ws() + A_U); const f16* X = (const f16*)(C.ws() + A_S5X); f16* G = (f16*)(C.ws() + A_G);
    const int r32 = C.lane & 31, hi = C.lane >> 5, t0 = 2 * C.wid, trow = t0 + (r32 >> 4), crw = r32 & 15;
    const int nnb = l == 0 ? 34 : 32;
    LAS f16* Kl = (LAS f16*)C.lds;
    int cur_g = -1; f16x8 ef[2][8];
    for (int u = C.bid; u < 32 * nnb; u += C.nblk) {
        const int g = u & 31, nb = u >> 5;
        const int row0 = (nb * 32 + r32) * 16;
        f16x8 uf[16], xf[2][8]; f16x4 u4[2][2];
#pragma unroll
        for (int sx = 0; sx < 16; ++sx) uf[sx] = *(const f16x8*)(U + u3_off(g, nb, sx, hi, r32));
#pragma unroll
        for (int dir = 0; dir < 2; ++dir)
#pragma unroll
            for (int kk = 0; kk < 8; ++kk) xf[dir][kk] = *(const f16x8*)(X + x3_off(dir * 32 + g, nb, kk, hi, r32));
#pragma unroll
        for (int tl = 0; tl < 2; ++tl)
#pragma unroll
            for (int gp = 0; gp < 2; ++gp) u4[tl][gp] = *(const f16x4*)(U + u3_off(g, nb, t0 + tl, gp, r32) + 4 * hi);
        if (g != cur_g) {
            __syncthreads();
            for (int i = C.tid; i < 2 * 17 * 256 / 8; i += NTHREADS) {
                const int dir = i / (17 * 32), j = i - dir * (17 * 32);
                *(LAS f16x8*)(Kl + (size_t)i * 8) = *(const f16x8*)((const f16*)(C.ws() + T_K) + (size_t)(dir * 32 + g) * 17 * 256 + j * 8);
            }
#pragma unroll
            for (int dir = 0; dir < 2; ++dir)
#pragma unroll
                for (int kk = 0; kk < 8; ++kk) ef[dir][kk] = *(const f16x8*)((const f16*)(C.ws() + T_E) + (size_t)(dir * 32 + g) * 16 * 16 * 128 + (size_t)(trow * 16 + crw) * 128 + kk * 16 + 8 * hi);
            __syncthreads();
            cur_g = g;
        }
        f32x16 acc = {};
        const LAS f16* kb = Kl + crw * 16 + 8 * hi;
#pragma unroll
        for (int sx = 0; sx < 16; ++sx) {
            if (sx <= t0 + 1) { const f16x8 af = *(const LAS f16x8*)(kb + (trow - sx + 1) * 256); acc = __builtin_amdgcn_mfma_f32_32x32x16_f16(af, uf[sx], acc, 0, 0, 0); }
            if (sx >= t0) { const f16x8 af = *(const LAS f16x8*)(kb + (17 + sx - trow + 1) * 256); acc = __builtin_amdgcn_mfma_f32_32x32x16_f16(af, uf[sx], acc, 0, 0, 0); }
        }
#pragma unroll
        for (int dir = 0; dir < 2; ++dir)
#pragma unroll
            for (int kk = 0; kk < 8; ++kk) acc = __builtin_amdgcn_mfma_f32_32x32x16_f16(ef[dir][kk], xf[dir][kk], acc, 0, 0, 0);
#pragma unroll
        for (int tl = 0; tl < 2; ++tl)
#pragma unroll
            for (int gp = 0; gp < 2; ++gp) {
                const size_t off = (size_t)(row0 + t0 + tl) * 512 + g * 16 + 4 * hi + 8 * gp;
                const f32x4 d4 = *(const f32x4*)(C.in(I_SD) + l * 512 + g * 16 + 4 * hi + 8 * gp);
                f32x4 y;
#pragma unroll
                for (int e = 0; e < 4; ++e) y[e] = gelu_tanh(acc[8 * tl + 4 * gp + e] * S5ISC + d4[e] * (float)u4[tl][gp][e]);
                *(f16x4*)(G + off) = pack4(y);
            }
    }
}

typedef __attribute__((address_space(1))) unsigned gu32;
#define XB_TMO      128
#define XB_XCNT(j)  (256  + 64 * (j))
#define XB_XSUB(j)  (1280 + 64 * (j))
#define XB_XGEN(j)  (2304 + 64 * (j))
#define XB_TOP      3328
#define XB_TOPGEN   3392
#define XCD_BAR_WORDS 3456
#define XB_SPIN_CAP (1u << 26)

__device__ __forceinline__ unsigned xb_ld(unsigned* p)              { return __hip_atomic_load(p, __ATOMIC_RELAXED, __HIP_MEMORY_SCOPE_AGENT); }
__device__ __forceinline__ unsigned xb_add(unsigned* p, unsigned v) { return __hip_atomic_fetch_add(p, v, __ATOMIC_RELAXED, __HIP_MEMORY_SCOPE_AGENT); }
__device__ __forceinline__ unsigned xb_xcc_id() { return (unsigned)__builtin_amdgcn_s_getreg((3 << 11) | 20) & 0xFu; }
#define XB_SPIN(cond, bar) do { unsigned _sp = 0; while (cond) { __builtin_amdgcn_s_sleep(1); \
    if ((++_sp & 255u) == 0u) { if (xb_ld(&(bar)[XB_TMO])) break; if (_sp > XB_SPIN_CAP) { atomicAdd(&(bar)[XB_TMO], 1u); break; } } } } while (0)

struct XcdBarrier {
    unsigned* bar; unsigned x;
    volatile LAS unsigned* st;
};

__device__ __forceinline__ XcdBarrier xcd_barrier_post(unsigned* bar, volatile LAS unsigned* st) {
    XcdBarrier b; b.bar = bar; b.x = xb_xcc_id(); b.st = st;
    if (threadIdx.x == 0) (void)xb_add(&bar[XB_XCNT(b.x)], 1u);
    return b;
}
__device__ __forceinline__ void xcd_barrier_complete(unsigned* bar, unsigned x, unsigned& nloc, unsigned& nx) {
    const unsigned G = gridDim.x * gridDim.y * gridDim.z;
    unsigned sum, cnt, mine, sp = 0u;
    for (;;) {
        sum = 0u; cnt = 0u; mine = 0u;
#pragma unroll
        for (unsigned j = 0; j < 16; ++j) { const unsigned c = xb_ld(&bar[XB_XCNT(j)]); sum += c; cnt += (c > 0u) ? 1u : 0u; mine = (j == x) ? c : mine; }
        if (sum == G) break;
        __builtin_amdgcn_s_sleep(1);
        if ((++sp & 255u) == 0u) { if (xb_ld(&bar[XB_TMO])) break; if (sp > XB_SPIN_CAP) { atomicAdd(&bar[XB_TMO], 1u); break; } }
    }
    nloc = mine > 0u ? mine : 1u; nx = cnt > 0u ? cnt : 1u;
}

__device__ __forceinline__ void xcd_barrier(const XcdBarrier& b, const bool t0) {
    asm volatile("s_waitcnt vmcnt(0)" ::: "memory");
    __syncthreads();
    if (t0) {
        unsigned* bar = b.bar;
        __builtin_amdgcn_s_waitcnt(0);
        unsigned nloc = b.st[0], nx = b.st[1];
        if (nloc == 0u) { xcd_barrier_complete(bar, b.x, nloc, nx); b.st[0] = nloc; b.st[1] = nx; }
        const unsigned old = xb_add(&bar[XB_XSUB(b.x)], 1u);
        const unsigned gen = old / nloc;
        if (old + 1u == (gen + 1u) * nloc) {
            __builtin_amdgcn_fence(__ATOMIC_RELEASE, "agent");
            asm volatile("s_waitcnt vmcnt(0)" ::: "memory");
            const unsigned og = xb_add(&bar[XB_TOP], 1u);
            const unsigned tg = og / nx;
            if (og + 1u == (tg + 1u) * nx) xb_add(&bar[XB_TOPGEN], 1u);
            else XB_SPIN(xb_ld(&bar[XB_TOPGEN]) == tg, bar);
            __builtin_amdgcn_fence(__ATOMIC_ACQUIRE, "agent");
            xb_add(&bar[XB_XGEN(b.x)], 1u);
            asm volatile("s_waitcnt vmcnt(0)" ::: "memory");
        } else {
            XB_SPIN(xb_ld(&bar[XB_XGEN(b.x)]) == gen, bar);
            __builtin_amdgcn_fence(__ATOMIC_ACQUIRE, "agent");
            asm volatile("s_waitcnt vmcnt(0)" ::: "memory");
        }
    }
    __syncthreads();
}

#ifndef PROBE_PH
#define PROBE_PH -1
#endif
struct Env { XcdBarrier bar; int wid; unsigned long long t_acc; };
#define PH_BEGIN(k) unsigned long long _t0 = 0; if (PROBE_PH == (k)) _t0 = __builtin_amdgcn_s_memrealtime()
#define PH_END(k) if (PROBE_PH == (k)) env.t_acc += __builtin_amdgcn_s_memrealtime() - _t0
#define GSYNC() do { const Ctx Cb = make_ctx(env.wid); xcd_barrier(env.bar, Cb.tid == 0); } while (0)
constexpr int MISC_OFF = LDS_BYTES - 256;
constexpr int CW_BAR = 4096;
#define CTX() const Ctx C = make_ctx(env.wid); unsigned char* ws = C.ws()
template <int l>
__device__ __forceinline__ void layer_body(Env& env) {
        const int mrows = l == 0 ? MALL : NLAT;
        if (l == 0) { PH_BEGIN(0);
        { CTX(); (void)ws; phase_p1(C, 0); }
        GSYNC(); PH_END(0); }
        { PH_BEGIN(1);
        { CTX(); EpiProj E{(f16*)(ws + A_PROJ), (f16*)(ws + A_VA), (f16*)(ws + A_U)};
          gemm_pg8(C, (const f16*)(ws + A_H), D, (const f16*)(ws + W_INA), D, MALL, 2560, D, E); }
        GSYNC(); PH_END(1); }
        { PH_BEGIN(2);
        { CTX(); (void)ws; phase_p3(C, l); }
        GSYNC(); PH_END(2); }
        { PH_BEGIN(3);
        { CTX(); EpiKvUp E1{(f16*)(ws + A_KC), (f16*)(ws + A_VC)};
          gemm_rows(C, (const f16*)(ws + A_PROJ) + PC_CKV, PLD2, (const f16*)(ws + W_KVB), 256, MALL, 1024, 256, E1); }
        { CTX(); EpiQUp E2{(f16*)(ws + A_QC), (const float*)(ws + WS_ROPE) + 2048};
          gemm_pg8(C, (const f16*)(ws + A_PROJ) + PC_CQ, PLD2, (const f16*)(ws + W_QB), 768, mrows, 768, 768, E2); }
        GSYNC(); PH_END(3); }
        { PH_BEGIN(4);
        { CTX(); (void)ws; phase_s5a(C); }
        { CTX(); (void)ws; phase_attn_flash(C, l); }
        GSYNC(); PH_END(4); }
        { PH_BEGIN(5);
        { CTX(); (void)ws; phase_s5b(C, l); }
        GSYNC(); PH_END(5); }
        { PH_BEGIN(6);
        { CTX(); (void)ws; phase_s5c(C, l); }
        GSYNC(); PH_END(6); }
        { PH_BEGIN(7);
        { CTX(); EpiGlu E{(f16*)(ws + A_YS)};
          gemm_rows(C, (const f16*)(ws + A_G), 512, (const f16*)(ws + W_GLU), 512, mrows, 1024, 512, E); }
        GSYNC(); PH_END(7); }
        { PH_BEGIN(8);
        {
            CTX();
            const f16* Hh = (const f16*)(ws + A_H); const f16* Wg = (const f16*)(ws + W_GATE); const f16* Wb = (const f16*)(ws + W_BR);
            const f16* Y0 = (const f16*)(ws + A_YA); const f16* Y1 = (const f16*)(ws + A_YS); const f16* Y2 = (const f16*)(ws + A_YC);
            EpiGate Eg{(f16*)(ws + A_GATE)}; EpiBranch Eb0{(const f16*)(ws + A_GATE), (f16*)(ws + A_MERGED), 1}; EpiBranch Eb{(const f16*)(ws + A_GATE), (f16*)(ws + A_MERGED), 0};
            constexpr size_t WGS = (size_t)1024 * 1024, WBS = (size_t)1024 * 512;
            gemm_pg8c<false, true>(C, Hh, D, Wg, D, NLAT, 1024, D, Eg, Y0, 512, Wb, 512);
            gemm_pg8c<true, true>(C, Y0, 512, Wb, 512, NLAT, 1024, 512, Eb0, Hh, D, Wg + WGS, D);
            gemm_pg8c<true, true>(C, Hh, D, Wg + WGS, D, NLAT, 1024, D, Eg, Y1, 512, Wb + WBS, 512);
            gemm_pg8c<true, true>(C, Y1, 512, Wb + WBS, 512, NLAT, 1024, 512, Eb, Hh, D, Wg + 2 * WGS, D);
            gemm_pg8c<true, true>(C, Hh, D, Wg + 2 * WGS, D, NLAT, 1024, D, Eg, Y2, 512, Wb + 2 * WBS, 512);
            gemm_pg8c<true, false>(C, Y2, 512, Wb + 2 * WBS, 512, NLAT, 1024, 512, Eb, Hh, D, Wg, D);
        }
        if (mrows > NLAT) {
#pragma unroll
            for (int br = 0; br < 3; ++br) {
                { CTX(); EpiGate Eg{(f16*)(ws + A_GATE)};
                  gemm_small(C, (const f16*)(ws + A_H) + (size_t)NLAT * D, D, (const f16*)(ws + W_GATE) + (size_t)br * 1024 * 1024, D, NLAT, 1024, D, Eg); }
                { CTX(); const f16* Y = (const f16*)(ws + (br == 0 ? A_YA : br == 1 ? A_YS : A_YC));
                  EpiBranch Eb{(const f16*)(ws + A_GATE), (f16*)(ws + A_MERGED), br == 0};
                  gemm_small(C, Y + (size_t)NLAT * 512, 512, (const f16*)(ws + W_BR) + (size_t)br * 1024 * 512, 512, NLAT, 1024, 512, Eb); }
            }
        }
        GSYNC(); PH_END(8); }
        { PH_BEGIN(9);
        { CTX(); EpiWout E{&C, l}; gemm_rows(C, (const f16*)(ws + A_MERGED), D, (const f16*)(ws + W_OUT), D, mrows, 1024, D, E); }
        GSYNC(); PH_END(9); }
        { PH_BEGIN(10);
        { CTX(); (void)ws; phase_p10(C, l, mrows); }
        GSYNC(); PH_END(10); }
        { PH_BEGIN(11);
        { CTX(); EpiUp E{(f16*)(ws + A_HID)}; gemm_rows(C, (const f16*)(ws + A_H), D, (const f16*)(ws + W_UP), D, mrows, DFF, D, E); }
        GSYNC(); PH_END(11); }
        { PH_BEGIN(12);
        { CTX(); EpiDown E{&C, l}; gemm_rows(C, (const f16*)(ws + A_HID), DFF, (const f16*)(ws + W_DOWN), DFF, mrows, 1024, DFF, E); }
        GSYNC(); PH_END(12); }
        { PH_BEGIN(13);
        if (l == 0) { CTX(); (void)ws; if (C.nblk > 128) { if (C.bid < 64) phase_s5tab(C, 1); else phase_cvt(C, 1, 64); } else { phase_s5tab(C, 1); __syncthreads(); phase_cvt(C, 1, 0); } }
        { CTX(); (void)ws; phase_p13(C, l, mrows); }
        if (l == 0) GSYNC(); PH_END(13); }
}
__global__ void __launch_bounds__(NTHREADS, 2) fwd_all(Args args) {
    cg::grid_group grid = cg::this_grid();
    extern __shared__ __attribute__((aligned(16))) unsigned char lds_raw[];
    volatile LAS unsigned* MISC = (volatile LAS unsigned*)((LAS unsigned char*)lds_raw + MISC_OFF);
    if (threadIdx.x < 64) MISC[threadIdx.x] = 0u;
    __syncthreads();
    Env env; env.t_acc = 0; env.wid = __builtin_amdgcn_readfirstlane(threadIdx.x >> 6);
    env.bar = xcd_barrier_post((unsigned*)(args.ws + WS_CTL) + CW_BAR, MISC + 8);
    { CTX(); (void)ws; if (C.nblk > 128) { if (C.bid < 64) phase_s5tab(C, 0); else { phase_setup(C, 64); __syncthreads(); phase_cvt(C, 0, 64); } } else { phase_setup(C, 0); __syncthreads(); phase_s5tab(C, 0); __syncthreads(); phase_cvt(C, 0, 0); } }
    asm volatile("s_waitcnt vmcnt(0)" ::: "memory");
    grid.sync();
    __builtin_amdgcn_fence(__ATOMIC_ACQUIRE, "agent");
    asm volatile("s_waitcnt vmcnt(0)" ::: "memory");
    layer_body<0>(env);
    layer_body<1>(env);
    if (PROBE_PH >= 0 && blockIdx.x == 0) { const unsigned long long t0 = __builtin_amdgcn_s_memrealtime(); while (__builtin_amdgcn_s_memrealtime() - t0 < 8ull * env.t_acc) __builtin_amdgcn_s_sleep(8); }
}

extern "C" void kernel_launch(void* const* d_in, const int* in_sizes, int n_in, void* d_out, int out_size, void* d_ws, size_t ws_size, hipStream_t stream) {
    static int grid_blocks = 0;
    if (grid_blocks == 0) {
        if (n_in != 32 || out_size != NLAT * D || ws_size < WS_NEED) { fprintf(stderr, "kernel_launch: unexpected shapes n_in %d out %d ws %zu (need %zu)\n", n_in, out_size, ws_size, (size_t)WS_NEED); grid_blocks = -1; return; }
        int dev = 0, cus = 0, per_cu = 0;
        hipGetDevice(&dev);
        hipDeviceGetAttribute(&cus, hipDeviceAttributeMultiprocessorCount, dev);
        if (hipFuncSetAttribute((const void*)fwd_all, hipFuncAttributeMaxDynamicSharedMemorySize, LDS_BYTES) != hipSuccess) { fprintf(stderr, "kernel_launch: hipFuncSetAttribute failed\n"); grid_blocks = -1; return; }
        hipOccupancyMaxActiveBlocksPerMultiprocessor(&per_cu, (const void*)fwd_all, NTHREADS, LDS_BYTES);
        if (per_cu < 1) { fprintf(stderr, "kernel_launch: occupancy query says %d blocks per CU\n", per_cu); grid_blocks = -1; return; }
        grid_blocks = cus;
    }
    if (grid_blocks < 0) return;
    Args a{};
    for (int i = 0; i < 32; ++i) a.in[i] = (const float*)d_in[i];
    a.out = (float*)d_out; a.ws = (unsigned char*)d_ws;
    if (hipMemsetAsync((char*)d_ws + WS_CTL, 0, 1 * MiB, stream) != hipSuccess) { fprintf(stderr, "kernel_launch: hipMemsetAsync failed\n"); return; }
    void* kargs[] = {&a};
    const hipError_t e = hipLaunchCooperativeKernel((const void*)fwd_all, dim3(grid_blocks), dim3(NTHREADS), kargs, LDS_BYTES, stream);
    if (e != hipSuccess) fprintf(stderr, "kernel_launch: cooperative launch failed: %s (grid %d)\n", hipGetErrorString(e), grid_blocks);
}
```

```cpp
#include <hip/hip_runtime.h>
#include <hip/hip_cooperative_groups.h>
#include <cstdio>
#include <cstdint>
#include <cmath>

namespace cg = cooperative_groups;

#define LAS __attribute__((address_space(3)))
typedef _Float16 f16;
typedef _Float16 f16x8 __attribute__((ext_vector_type(8)));
typedef _Float16 f16x4 __attribute__((ext_vector_type(4)));
typedef float f32x4 __attribute__((ext_vector_type(4)));
typedef float f32x16 __attribute__((ext_vector_type(16)));

constexpr int D = 1024, NB = 4, SEQ = 4096, CTX = 256, NLAT = NB * SEQ, NCTX = NB * CTX, MALL = NLAT + NCTX;
constexpr int NKEY = CTX + SEQ;
constexpr int OFF_AK = 0, OFF_AV = 128, OFF_CKV = 256, OFF_CKR = 512, OFF_U = 544, OFF_AQ = 1056, OFF_CQ = 1568, OFF_GATE = 2336, N_IN = 5408;
constexpr int GC_AV = 128, GC_CKV = 256, GC_CKR = 512, GC_PAD = 544, GC_U = 768, GC_AQ = 1280, GC_CQ = 1792;
constexpr int PC_AK = 0, PC_CKV = 128, PC_CKR = 384, PC_AQ = 416, PC_CQ = 928, PLD2 = 1696;
constexpr int DFF = 4096;
constexpr float EPS = 1e-6f;
constexpr float ALPHA = 1.4142135623730951f;
constexpr float LOG2E = 1.4426950408889634f;
constexpr float QSCALE_A = 0.125f * LOG2E;
constexpr float QSCALE_C = 0.10206207261596575f * LOG2E;

constexpr size_t MiB = 1u << 20;
constexpr size_t WS_CTL = 0;
constexpr size_t WS_MOD = 1 * MiB;
constexpr size_t WS_ROPE = 1 * MiB + 512 * 1024;
constexpr size_t WS_W16 = 2 * MiB;
constexpr size_t W_INA = WS_W16;
constexpr size_t W_GATE = W_INA + (size_t)2560 * 1024 * 2;
constexpr size_t W_QB = W_GATE + (size_t)3072 * 1024 * 2;
constexpr size_t W_KVB = W_QB + (size_t)768 * 768 * 2;
constexpr size_t W_GLU = W_KVB + (size_t)1024 * 256 * 2;
constexpr size_t W_BR = W_GLU + (size_t)1024 * 512 * 2;
constexpr size_t W_OUT = W_BR + (size_t)3 * 1024 * 512 * 2;
constexpr size_t W_UP = W_OUT + (size_t)1024 * 1024 * 2;
constexpr size_t W_DOWN = W_UP + (size_t)4096 * 1024 * 2;
constexpr size_t W_END = W_DOWN + (size_t)1024 * 4096 * 2;
constexpr size_t WS_TACTX = 37 * MiB;
constexpr size_t WS_ACT = 41 * MiB;
static_assert(W_END <= WS_TACTX, "weights fit");
constexpr size_t A_H = WS_ACT + 0 * MiB;
constexpr size_t A_PROJ = WS_ACT + 34 * MiB;
constexpr size_t A_YC = WS_ACT + 34 * MiB;
constexpr size_t A_T1H = WS_ACT + 34 * MiB;
constexpr size_t A_G = WS_ACT + 68 * MiB;
constexpr size_t A_YS = WS_ACT + 51 * MiB;
constexpr size_t A_HID = WS_ACT + 68 * MiB;
constexpr size_t A_QA = WS_ACT + 91 * MiB;
constexpr size_t A_YA = A_QA;
constexpr size_t A_QC = WS_ACT + 108 * MiB;
constexpr size_t A_S5X = WS_ACT + 51 * MiB;
constexpr size_t A_GATE = WS_ACT + 108 * MiB;
constexpr size_t A_KA = WS_ACT + 134 * MiB;
constexpr size_t A_VA = A_KA + (size_t)NB * 2 * NKEY * 64 * 2;
constexpr size_t A_U = WS_ACT + 143 * MiB;
constexpr size_t A_MERGED = WS_ACT + 143 * MiB;
constexpr size_t A_KC = WS_ACT + 160 * MiB;
constexpr size_t A_VC = WS_ACT + 186 * MiB;
constexpr size_t WS_ST1 = 1 * MiB + 768 * 1024;
constexpr size_t T_K = WS_ACT + 205 * MiB;
constexpr size_t T_E = T_K + (size_t)64 * 17 * 256 * 2;
constexpr size_t T_M = T_E + (size_t)64 * 16 * 16 * 128 * 2;
constexpr size_t WS_NEED = WS_ACT + 215 * MiB;
static_assert(T_M + (size_t)64 * 128 * 256 * 2 <= WS_NEED, "s5 tables");
static_assert(A_PROJ + (size_t)MALL * PLD2 * 2 <= A_QA && A_VA + (size_t)NB * 2 * NKEY * 64 * 2 <= A_U && A_VC + 17 * MiB <= T_K && A_HID + 136 * MiB <= T_K && A_MERGED + 34 * MiB <= T_K && A_GATE + 34 * MiB <= A_MERGED, "ws map");
static_assert(WS_NEED <= 256 * MiB, "ws budget");

constexpr int LDS_BYTES = 147456;
constexpr int NTHREADS = 512, NWAVES = 8;

struct Args {
    const float* in[32];
    float* out;
    unsigned char* ws;
    int ph_lo, ph_hi;
};
enum { I_X = 0, I_C, I_CTX, I_CCTX, I_WMOD, I_BMOD, I_WIN, I_AQG, I_AKG, I_CQG, I_CKVG, I_WQB, I_WKVB, I_SARE, I_SAIM, I_SLDT, I_SBRE, I_SBIM, I_SCRE, I_SCIM,
       I_SD, I_WGLU, I_WBA, I_WBS, I_WBC, I_WOUT, I_LN1G, I_LN1B, I_WUP, I_WDOWN, I_LN2G, I_LN2B };

template <int CTRL> __device__ __forceinline__ float dpp_mov(float v) { return __builtin_bit_cast(float, __builtin_amdgcn_update_dpp(0, __builtin_bit_cast(int, v), CTRL, 0xF, 0xF, true)); }
__device__ __forceinline__ float lane_bcast(float v, int l) { return __builtin_bit_cast(float, __builtin_amdgcn_readlane(__builtin_bit_cast(int, v), l)); }
__device__ __forceinline__ float wave_sum(float v) {
    v += dpp_mov<0xB1>(v); v += dpp_mov<0x4E>(v); v += dpp_mov<0x141>(v); v += dpp_mov<0x140>(v);
    return (lane_bcast(v, 0) + lane_bcast(v, 16)) + (lane_bcast(v, 32) + lane_bcast(v, 48));
}
__device__ __forceinline__ float wave_max(float v) {
#pragma unroll
    for (int o = 1; o < 64; o <<= 1) v = fmaxf(v, __shfl_xor(v, o));
    return v;
}
__device__ __forceinline__ float sigmoidf_(float x) { return 1.0f / (1.0f + __expf(-x)); }
__device__ __forceinline__ float gelu_tanh(float x) {
    const float u = 0.7978845608028654f * (x + 0.044715f * x * x * x);
    const float e = __expf(2.0f * u);
    const float t = 1.0f - 2.0f / (e + 1.0f);
    return 0.5f * x * (1.0f + t);
}
__device__ __forceinline__ f16x8 pack8(f32x4 lo, f32x4 hi) {
    f16x8 r; r[0] = (f16)lo[0]; r[1] = (f16)lo[1]; r[2] = (f16)lo[2]; r[3] = (f16)lo[3]; r[4] = (f16)hi[0]; r[5] = (f16)hi[1]; r[6] = (f16)hi[2]; r[7] = (f16)hi[3]; return r;
}
__device__ __forceinline__ f16x4 pack4(f32x4 v) { f16x4 r; r[0] = (f16)v[0]; r[1] = (f16)v[1]; r[2] = (f16)v[2]; r[3] = (f16)v[3]; return r; }

struct RowInfo { int b, t, pos, lat, mrow; };
__device__ __forceinline__ RowInfo row_info(int r) {
    RowInfo o;
    if (r < NLAT) { o.lat = 1; o.b = r >> 12; o.t = r & 4095; o.pos = CTX + o.t; o.mrow = o.b; }
    else { const int rr = r - NLAT; o.lat = 0; o.b = rr >> 8; o.t = rr & 255; o.pos = o.t; o.mrow = 4; }
    return o;
}

#define CAS __attribute__((address_space(4)))
struct Ctx {
    const CAS unsigned char* kp; LAS unsigned char* lds;
    int tid, lane, wid, nblk, bid;
    __device__ __forceinline__ const float* in(int i) const { return *(const float* const CAS*)(kp + 8 * i); }
    __device__ __forceinline__ float* out() const { return *(float* const CAS*)(kp + 256); }
    __device__ __forceinline__ unsigned char* ws() const { return *(unsigned char* const CAS*)(kp + 264); }
    __device__ __forceinline__ const float* mod(int l, int mrow, int which) const { return (const float*)(ws() + WS_MOD) + ((size_t)(l * 5 + mrow) * 6 + which) * D; }
    __device__ __forceinline__ const float* xsrc(int l, int r) const {
        if (l == 0) return r < NLAT ? in(I_X) + (size_t)r * D : in(I_CTX) + (size_t)(r - NLAT) * D;
        return r < NLAT ? out() + (size_t)r * D : (const float*)(ws() + WS_TACTX) + (size_t)(r - NLAT) * D;
    }
    __device__ __forceinline__ float* ta(int r) const { return r < NLAT ? out() + (size_t)r * D : (float*)(ws() + WS_TACTX) + (size_t)(r - NLAT) * D; }
};
__device__ __forceinline__ Ctx make_ctx(int wid) {
    extern __shared__ __attribute__((aligned(16))) unsigned char lds_raw[];
    Ctx C;
    const CAS unsigned char* kp = (const CAS unsigned char*)__builtin_amdgcn_kernarg_segment_ptr();
    asm volatile("" : "+s"(kp));
    C.kp = kp; C.lds = (LAS unsigned char*)lds_raw;
    int lane = __builtin_amdgcn_mbcnt_hi(~0u, __builtin_amdgcn_mbcnt_lo(~0u, 0u)); asm volatile("" : "+v"(lane));
    asm volatile("" : "+s"(wid));
    C.tid = wid * 64 + lane; C.lane = lane; C.wid = wid;
    int bid = blockIdx.x; asm volatile("" : "+s"(bid));
    C.bid = bid; C.nblk = gridDim.x;
    return C;
}

__device__ __forceinline__ void phase_setup(const Ctx& C, int b0) {
    LAS float* sv = (LAS float*)C.lds;
    LAS float* red = sv + 5 * 1024;
    for (int i = C.tid; i < 5 * 1024; i += NTHREADS) {
        const int mr = i >> 10, k = i & 1023;
        const float v = mr < 4 ? C.in(I_C)[mr * D + k] : C.in(I_CCTX)[k];
        sv[i] = v / (1.0f + __expf(-v));
    }
    __syncthreads();
    for (int u = C.bid - b0; u < 192; u += C.nblk - b0) {
        const int l = u / 96, n0 = (u % 96) * 64;
        const float* W = C.in(I_WMOD) + (size_t)l * D * 6144 + n0 + C.lane;
        float acc[5] = {0.f, 0.f, 0.f, 0.f, 0.f};
        const int kb = C.wid * 128;
#pragma unroll 8
        for (int k = 0; k < 128; ++k) {
            const float w = W[(size_t)(kb + k) * 6144];
#pragma unroll
            for (int m = 0; m < 5; ++m) acc[m] += sv[m * 1024 + kb + k] * w;
        }
#pragma unroll
        for (int m = 0; m < 5; ++m) red[(C.wid * 5 + m) * 64 + C.lane] = acc[m];
        __syncthreads();
        if (C.tid < 320) {
            const int m = C.tid >> 6, c = C.tid & 63; float s = 0.f;
#pragma unroll
            for (int w = 0; w < 8; ++w) s += red[(w * 5 + m) * 64 + c];
            ((float*)(C.ws() + WS_MOD))[(size_t)(l * 5 + m) * 6144 + n0 + c] = s + C.in(I_BMOD)[l * 6144 + n0 + c];
        }
        __syncthreads();
    }
    if (C.bid == C.nblk - 1) {
        float* ra = (float*)(C.ws() + WS_ROPE);
        for (int i = C.tid; i < 1024; i += NTHREADS) {
            const int pos = i >> 4, f = i & 15;
            const float inv = powf(10000.0f, -(float)(2 * f) / 32.0f);
            const float ang = (float)pos * inv;
            ra[i] = cosf(ang); ra[1024 + i] = sinf(ang);
        }
        for (int i = C.tid; i < 512; i += NTHREADS) {
            const int pos = i >> 3, f = i & 7;
            const float inv = powf(10000.0f, -(float)(2 * f) / 16.0f);
            const float ang = (float)pos * inv;
            ra[2048 + i] = cosf(ang); ra[2048 + 512 + i] = sinf(ang);
        }
    }
}

__device__ __forceinline__ int glu_row(int n) { const int isg = n >= 512, j = n & 511; return 8 * (j >> 2) + 4 * isg + (j & 3); }
__device__ __forceinline__ void cvt_load(const float* W, int ldw, int coff, int nblk, int item, int lane, f32x4 (&v)[8]) {
    const int kb = item / nblk, nb = item % nblk, k0 = 64 * kb, n0 = 32 * nb;
#pragma unroll
    for (int i = 0; i < 8; ++i) v[i] = *(const f32x4*)(W + (size_t)(k0 + 8 * i + (lane >> 3)) * ldw + coff + n0 + 4 * (lane & 7));
}
__device__ __forceinline__ void cvt_store(const f32x4 (&v)[8], int K, int nblk, f16* WT, int mode, LAS float* scr, int item, int lane) {
    const int kb = item / nblk, nb = item % nblk, k0 = 64 * kb, n0 = 32 * nb;
#pragma unroll
    for (int i = 0; i < 8; ++i) { LAS float* d = scr + (8 * i + (lane >> 3)) * 33 + 4 * (lane & 7); d[0] = v[i][0]; d[1] = v[i][1]; d[2] = v[i][2]; d[3] = v[i][3]; }
    asm volatile("s_waitcnt lgkmcnt(0)" ::: "memory");
    const int c = lane & 7;
#pragma unroll
    for (int j = 0; j < 4; ++j) {
        const int n = (lane >> 3) + 8 * j; const LAS float* sp = scr + (8 * c) * 33 + n;
        f16x8 o;
#pragma unroll
        for (int e = 0; e < 8; ++e) o[e] = (f16)sp[e * 33];
        const int nn = n0 + n; const int row = mode ? glu_row(nn) : nn;
        *(f16x8*)(WT + (size_t)row * K + k0 + 8 * c) = o;
    }
    asm volatile("s_waitcnt lgkmcnt(0)" ::: "memory");
}
__device__ __forceinline__ void cvt_mat(const Ctx& C, const float* src, int ldw, int coff, int K, int N, size_t dst, int mode, int& base, int b0) {
    LAS float* scr = (LAS float*)C.lds + C.wid * (64 * 33);
    const int gw = (C.bid - b0) * NWAVES + C.wid, ngw = (C.nblk - b0) * NWAVES;
    const int nblk = N / 32, items = (K / 64) * nblk;
    int first = gw - (base % ngw); if (first < 0) first += ngw;
    f16* WT = (f16*)(C.ws() + dst);
    f32x4 va[8], vb[8];
    if (first < items) cvt_load(src, ldw, coff, nblk, first, C.lane, va);
    for (int it = first; it < items; it += 2 * ngw) {
        const int it2 = it + ngw, it3 = it + 2 * ngw;
        if (it2 < items) cvt_load(src, ldw, coff, nblk, it2, C.lane, vb);
        cvt_store(va, K, nblk, WT, mode, scr, it, C.lane);
        if (it3 < items) cvt_load(src, ldw, coff, nblk, it3, C.lane, va);
        if (it2 < items) cvt_store(vb, K, nblk, WT, mode, scr, it2, C.lane);
    }
    base += items;
}
__device__ __forceinline__ void phase_cvt(const Ctx& C, int l, int b0) {
    int base = 0;
    cvt_mat(C, C.in(I_WIN) + (size_t)l * D * N_IN, N_IN, 0, D, GC_PAD, W_INA, 0, base, b0);
    cvt_mat(C, C.in(I_WIN) + (size_t)l * D * N_IN, N_IN, GC_PAD, D, OFF_GATE - GC_PAD, W_INA + (size_t)GC_U * 1024 * 2, 0, base, b0);
    cvt_mat(C, C.in(I_WIN) + (size_t)l * D * N_IN, N_IN, OFF_GATE, D, 3072, W_GATE, 0, base, b0);
    cvt_mat(C, C.in(I_WQB) + (size_t)l * 768 * 768, 768, 0, 768, 768, W_QB, 0, base, b0);
    cvt_mat(C, C.in(I_WKVB) + (size_t)l * 256 * 1024, 1024, 0, 256, 1024, W_KVB, 0, base, b0);
    cvt_mat(C, C.in(I_WGLU) + (size_t)l * 512 * 1024, 1024, 0, 512, 1024, W_GLU, 1, base, b0);
    cvt_mat(C, C.in(I_WBA) + (size_t)l * 512 * 1024, 1024, 0, 512, 1024, W_BR, 0, base, b0);
    cvt_mat(C, C.in(I_WBS) + (size_t)l * 512 * 1024, 1024, 0, 512, 1024, W_BR + (size_t)1024 * 512 * 2, 0, base, b0);
    cvt_mat(C, C.in(I_WBC) + (size_t)l * 512 * 1024, 1024, 0, 512, 1024, W_BR + (size_t)2 * 1024 * 512 * 2, 0, base, b0);
    cvt_mat(C, C.in(I_WOUT) + (size_t)l * 1024 * 1024, 1024, 0, 1024, 1024, W_OUT, 0, base, b0);
    cvt_mat(C, C.in(I_WUP) + (size_t)l * 1024 * 4096, 4096, 0, 1024, 4096, W_UP, 0, base, b0);
    cvt_mat(C, C.in(I_WDOWN) + (size_t)l * 4096 * 1024, 1024, 0, 4096, 1024, W_DOWN, 0, base, b0);
    f16* pad = (f16*)(C.ws() + W_INA) + (size_t)GC_PAD * 1024;
    const f16x8 z = {0, 0, 0, 0, 0, 0, 0, 0};
    for (int i = (C.bid - b0) * NTHREADS + C.tid; i < (GC_U - GC_PAD) * 1024 / 8; i += (C.nblk - b0) * NTHREADS) ((f16x8*)pad)[i] = z;
}

__device__ __forceinline__ void row_load(const float* p, int lane, f32x4 (&v)[4]) {
#pragma unroll
    for (int j = 0; j < 4; ++j) v[j] = ((const f32x4*)p)[lane + 64 * j];
}
__device__ __forceinline__ void row_ln(f32x4 (&v)[4]) {
    float s = 0.f;
#pragma unroll
    for (int j = 0; j < 4; ++j) s += (v[j][0] + v[j][1]) + (v[j][2] + v[j][3]);
    const float mean = wave_sum(s) * (1.0f / D);
    float q = 0.f;
#pragma unroll
    for (int j = 0; j < 4; ++j) { v[j] = v[j] - mean; q += (v[j][0] * v[j][0] + v[j][1] * v[j][1]) + (v[j][2] * v[j][2] + v[j][3] * v[j][3]); }
    const float rstd = 1.0f / sqrtf(wave_sum(q) * (1.0f / D) + EPS);
#pragma unroll
    for (int j = 0; j < 4; ++j) v[j] = v[j] * rstd;
}
__device__ __forceinline__ void row_ln_stats(f32x4 (&v)[4], float& mean, float& rstd) {
    float s = 0.f;
#pragma unroll
    for (int j = 0; j < 4; ++j) s += (v[j][0] + v[j][1]) + (v[j][2] + v[j][3]);
    mean = wave_sum(s) * (1.0f / D);
    float q = 0.f;
#pragma unroll
    for (int j = 0; j < 4; ++j) { v[j] = v[j] - mean; q += (v[j][0] * v[j][0] + v[j][1] * v[j][1]) + (v[j][2] * v[j][2] + v[j][3] * v[j][3]); }
    rstd = 1.0f / sqrtf(wave_sum(q) * (1.0f / D) + EPS);
#pragma unroll
    for (int j = 0; j < 4; ++j) v[j] = v[j] * rstd;
}
__device__ __forceinline__ void row_load_h(const f16* p, int lane, f32x4 (&v)[4]) {
#pragma unroll
    for (int j = 0; j < 4; ++j) { const f16x4 h = ((const f16x4*)p)[lane + 64 * j]; v[j] = (f32x4){(float)h[0], (float)h[1], (float)h[2], (float)h[3]}; }
}
__device__ __forceinline__ void row_modulate_store(const f32x4 (&v)[4], const float* sh, const float* sc, f16* o, int lane) {
#pragma unroll
    for (int j = 0; j < 4; ++j) {
        const f32x4 s = ((const f32x4*)sc)[lane + 64 * j], t = ((const f32x4*)sh)[lane + 64 * j];
        const f32x4 y = v[j] * (s + 1.0f) + t;
        ((f16x4*)o)[lane + 64 * j] = pack4(y);
    }
}
__device__ __forceinline__ void phase_p1(const Ctx& C, int l) {
    f16* H = (f16*)(C.ws() + A_H);
    const int nw = C.nblk * NWAVES;
    for (int r = C.bid * NWAVES + C.wid; r < MALL; r += 2 * nw) {
        const int r2 = r + nw; const bool has2 = r2 < MALL;
        f32x4 v[4], w[4]; row_load(C.xsrc(l, r), C.lane, v); if (has2) row_load(C.xsrc(l, r2), C.lane, w);
        { const RowInfo ri = row_info(r); row_ln(v); row_modulate_store(v, C.mod(l, ri.mrow, 0), C.mod(l, ri.mrow, 1), H + (size_t)r * D, C.lane); }
        if (has2) { const RowInfo ri = row_info(r2); row_ln(w); row_modulate_store(w, C.mod(l, ri.mrow, 0), C.mod(l, ri.mrow, 1), H + (size_t)r2 * D, C.lane); }
    }
}
__device__ __forceinline__ void p10_row(const Ctx& C, int l, int r, f32x4 (&v)[4], const float* g, const float* bb) {
    f16* H = (f16*)(C.ws() + A_H); float* ST = (float*)(C.ws() + WS_ST1);
    const RowInfo ri = row_info(r);
    float mean, rstd; row_ln_stats(v, mean, rstd);
    if (C.lane == 0) { ST[2 * r] = mean; ST[2 * r + 1] = rstd; }
#pragma unroll
    for (int j = 0; j < 4; ++j) v[j] = v[j] * ((const f32x4*)g)[C.lane + 64 * j] + ((const f32x4*)bb)[C.lane + 64 * j];
    row_ln(v);
    row_modulate_store(v, C.mod(l, ri.mrow, 3), C.mod(l, ri.mrow, 4), H + (size_t)r * D, C.lane);
}
__device__ __forceinline__ void phase_p10(const Ctx& C, int l, int nrows) {
    const f16* T1 = (const f16*)(C.ws() + A_T1H);
    const float* g = C.in(I_LN1G) + l * D; const float* bb = C.in(I_LN1B) + l * D;
    const int nw = C.nblk * NWAVES;
    for (int r = C.bid * NWAVES + C.wid; r < nrows; r += 2 * nw) {
        const int r2 = r + nw; const bool has2 = r2 < nrows;
        f32x4 v[4], w[4]; row_load_h(T1 + (size_t)r * D, C.lane, v); if (has2) row_load_h(T1 + (size_t)r2 * D, C.lane, w);
        p10_row(C, l, r, v, g, bb);
        if (has2) p10_row(C, l, r2, w, g, bb);
    }
}
__device__ __forceinline__ void p13_row(const Ctx& C, int l, int r, f32x4 (&v)[4], const float* g, const float* bb) {
    f16* H = (f16*)(C.ws() + A_H); float* t = C.ta(r);
    row_ln(v);
#pragma unroll
    for (int j = 0; j < 4; ++j) { v[j] = v[j] * ((const f32x4*)g)[C.lane + 64 * j] + ((const f32x4*)bb)[C.lane + 64 * j]; ((f32x4*)t)[C.lane + 64 * j] = v[j]; }
    if (l == 0) {
        const RowInfo ri = row_info(r);
        row_ln(v);
        row_modulate_store(v, C.mod(1, ri.mrow, 0), C.mod(1, ri.mrow, 1), H + (size_t)r * D, C.lane);
    }
}
__device__ __forceinline__ void phase_p13(const Ctx& C, int l, int nrows) {
    const float* g = C.in(I_LN2G) + l * D; const float* bb = C.in(I_LN2B) + l * D; const f16* T2 = (const f16*)(C.ws() + A_T1H);
    const int nw = C.nblk * NWAVES;
    for (int r = C.bid * NWAVES + C.wid; r < nrows; r += 2 * nw) {
        const int r2 = r + nw; const bool has2 = r2 < nrows;
        f32x4 v[4], w[4]; row_load_h(T2 + (size_t)r * D, C.lane, v); if (has2) row_load_h(T2 + (size_t)r2 * D, C.lane, w);
        p13_row(C, l, r, v, g, bb);
        if (has2) p13_row(C, l, r2, w, g, bb);
    }
}
__device__ __forceinline__ void phase_hre(const Ctx& C, int l, int nrows) {
    f16* H = (f16*)(C.ws() + A_H);
    const int nw = C.nblk * NWAVES;
    for (int r = C.bid * NWAVES + C.wid; r < nrows; r += 2 * nw) {
        const int r2 = r + nw; const bool has2 = r2 < nrows;
        f32x4 v[4], w[4]; row_load(C.xsrc(l, r), C.lane, v); if (has2) row_load(C.xsrc(l, r2), C.lane, w);
        { const RowInfo ri = row_info(r); row_ln(v); row_modulate_store(v, C.mod(l, ri.mrow, 0), C.mod(l, ri.mrow, 1), H + (size_t)r * D, C.lane); }
        if (has2) { const RowInfo ri = row_info(r2); row_ln(w); row_modulate_store(w, C.mod(l, ri.mrow, 0), C.mod(l, ri.mrow, 1), H + (size_t)r2 * D, C.lane); }
    }
}

__device__ __forceinline__ size_t u3_off(int g, int nb, int sx, int half, int n) { return ((((size_t)(g * 34 + nb) * 16 + sx) * 2 + half) * 32 + n) * 8; }
__device__ __forceinline__ size_t x3_off(int dirg, int nb, int kk, int half, int n) { return ((((size_t)(dirg * 34 + nb) * 8 + kk) * 2 + half) * 32 + n) * 8; }
__device__ __forceinline__ size_t m3_off(int dirg, int mb, int sx, int half, int p32) { return ((((size_t)(dirg * 4 + mb) * 16 + sx) * 2 + half) * 32 + p32) * 8; }
__device__ __forceinline__ void phase_p3(const Ctx& C, int l) {
    f16* PROJ = (f16*)(C.ws() + A_PROJ);
    f16* KA = (f16*)(C.ws() + A_KA); f16* KC = (f16*)(C.ws() + A_KC);
    f16* QA = (f16*)(C.ws() + A_QA);
    const float* ropeA = (const float*)(C.ws() + WS_ROPE); const float* ropeC = ropeA + 2048;
    const int lane = C.lane, d32 = lane & 31;
    const float akg = C.in(I_AKG)[l * 64 + lane], aqg = C.in(I_AQG)[l * 64 + lane];
    const f32x4 ckvg = *(const f32x4*)(C.in(I_CKVG) + l * 256 + 4 * lane);
    f32x4 cqg[3];
#pragma unroll
    for (int i = 0; i < 3; ++i) cqg[i] = *(const f32x4*)(C.in(I_CQG) + l * 768 + 256 * i + 4 * lane);
    for (int r = C.bid * NWAVES + C.wid; r < MALL; r += C.nblk * NWAVES) {
        const RowInfo ri = row_info(r);
        f16* prow = PROJ + (size_t)r * PLD2;
        const bool needq = ri.lat || l == 0;
        f16 xak[2], xaq[8]; f16x4 cq4[3];
#pragma unroll
        for (int hd = 0; hd < 2; ++hd) xak[hd] = prow[PC_AK + hd * 64 + lane];
        const f16x4 ckv4 = *(const f16x4*)(prow + PC_CKV + 4 * lane);
        const f16 xckr = prow[PC_CKR + d32];
        if (needq) {
#pragma unroll
            for (int h = 0; h < 8; ++h) xaq[h] = prow[PC_AQ + h * 64 + lane];
#pragma unroll
            for (int i = 0; i < 3; ++i) cq4[i] = *(const f16x4*)(prow + PC_CQ + 256 * i + 4 * lane);
        } else {
#pragma unroll
            for (int h = 0; h < 8; ++h) xaq[h] = (f16)0.f;
#pragma unroll
            for (int i = 0; i < 3; ++i) cq4[i] = (f16x4){0, 0, 0, 0};
        }
        const int prow_i = ri.t >> 6, pcol_i = ri.t & 63;
        float cA = 1.f, sA = 0.f, cc = 1.f, sc = 0.f;
        if (ri.lat) {
            { const int part = lane >> 5, j = lane & 15, pi = part ? pcol_i : prow_i; cA = ropeA[pi * 16 + j]; sA = ropeA[1024 + pi * 16 + j]; if (!((lane >> 4) & 1)) sA = -sA; }
            { const int part = d32 >> 4, j = d32 & 7, pi = part ? pcol_i : prow_i; cc = ropeC[pi * 8 + j]; sc = ropeC[512 + pi * 8 + j]; if (!((d32 >> 3) & 1)) sc = -sc; }
        }
        float ss[12];
#pragma unroll
        for (int hd = 0; hd < 2; ++hd) { const float x = (float)xak[hd]; ss[hd] = x * x; }
#pragma unroll
        for (int h = 0; h < 8; ++h) { const float x = (float)xaq[h]; ss[2 + h] = x * x; }
        { float q = 0.f;
#pragma unroll
          for (int e = 0; e < 4; ++e) { const float x = (float)ckv4[e]; q += x * x; }
          ss[10] = q; q = 0.f;
#pragma unroll
          for (int i = 0; i < 3; ++i)
#pragma unroll
              for (int e = 0; e < 4; ++e) { const float x = (float)cq4[i][e]; q += x * x; }
          ss[11] = q; }
#pragma unroll
        for (int i = 0; i < 12; ++i) ss[i] = wave_sum(ss[i]);
#pragma unroll
        for (int hd = 0; hd < 2; ++hd) {
            float y = (float)xak[hd] * (1.0f / sqrtf(ss[hd] * (1.0f / 64.0f) + EPS)) * akg;
            const float p = __shfl_xor(y, 16);
            y = y * cA + p * sA;
            KA[((size_t)(ri.b * 2 + hd) * NKEY + ri.pos) * 64 + lane] = (f16)y;
        }
        { const float rs = 1.0f / sqrtf(ss[10] * (1.0f / 256.0f) + EPS); f16x4 o4;
#pragma unroll
          for (int e = 0; e < 4; ++e) o4[e] = (f16)((float)ckv4[e] * rs * ckvg[e]);
          *(f16x4*)(prow + PC_CKV + 4 * lane) = o4; }
        { float x = (float)xckr; const float p = __shfl_xor(x, 8); x = x * cc + p * sc;
          if (lane < 32) {
#pragma unroll
              for (int h = 0; h < 8; ++h) KC[((size_t)(ri.b * 8 + h) * NKEY + ri.pos) * 96 + 64 + d32] = (f16)x;
          } }
        if (needq) {
            f16* qdst = QA + (size_t)r * 512; const size_t hstride = 64;
#pragma unroll
            for (int h = 0; h < 8; ++h) {
                float y = (float)xaq[h] * (1.0f / sqrtf(ss[2 + h] * (1.0f / 64.0f) + EPS)) * aqg;
                const float p = __shfl_xor(y, 16);
                y = (y * cA + p * sA) * QSCALE_A;
                qdst[h * hstride + lane] = (f16)y;
            }
            const float rs = 1.0f / sqrtf(ss[11] * (1.0f / 768.0f) + EPS);
#pragma unroll
            for (int i = 0; i < 3; ++i) { f16x4 o4;
#pragma unroll
                for (int e = 0; e < 4; ++e) o4[e] = (f16)((float)cq4[i][e] * rs * cqg[i][e]);
                *(f16x4*)(prow + PC_CQ + 256 * i + 4 * lane) = o4; }
        }
    }
}

namespace pg8 {
#define PG8_LAS __attribute__((address_space(3)))
typedef _Float16 bf16_t;
typedef _Float16 bf16x8 __attribute__((ext_vector_type(8)));
constexpr int BM = 256, BK = 64, HALF = 128, HTB = HALF * BK * 2  , STAGE_BYTES = 8 * HTB, NXCD = 8, WGM = 8;

__host__ __device__ __forceinline__ int lds_byte(int r, int c) { const int st = (r >> 4) * 2 + (c >> 5), rr = r & 15, cc = c & 31, ob = rr * 64 + cc * 2; return st * 1024 + (ob ^ (((ob >> 9) & 1) << 5)); }
__host__ __device__ __forceinline__ void stage_rc(int b, int& R, int& C) { const int st = b / 1024, sb = b % 1024, swz = sb ^ (((sb >> 9) & 1) << 5); R = (st >> 1) * 16 + swz / 64; C = (st & 1) * 32 + (swz % 64) / 2; }
__host__ __device__ __forceinline__ int perm32(int rho) { const int n = rho >> 4, i = rho & 15; return 8 * (i >> 2) + 4 * n + (i & 3); }
struct Unit { int pm, pn; };
struct Gemm { const bf16_t* A; const bf16_t* Bt; int M, N, K, lda, ldb; };

struct StaticOrder {
    int nM, nN, nwg, G, c;
    __host__ __device__ void init(int M, int N, int G_, int c_) { nM = M / BM; nN = N / BM; nwg = nM * nN; G = G_; c = c_; }
    __host__ __device__ bool next(int i, Unit& u) const {
        const long L = (long)i * G + c; if (L >= nwg) return false;
        int wgid = (int)L; { const int q = nwg / NXCD, r = nwg % NXCD, xcd = wgid % NXCD, off = wgid / NXCD; wgid = (xcd < r ? xcd * (q + 1) : r * (q + 1) + (xcd - r) * q) + off; }
        const int nig = WGM * nN, gid = wgid / nig, fm = gid * WGM, gsz = (nM - fm) < WGM ? (nM - fm) : WGM;
        u.pm = fm + ((wgid % nig) % gsz); u.pn = (wgid % nig) / gsz; return true;
    }
    __device__ __forceinline__ void a_ready(const Unit&) const {}
    __device__ __forceinline__ void done(const Unit&) const {}
};

template <class F> struct EpiFn { static constexpr bool PERM = true, AFTER_DRAIN = false; F f;
    __device__ __forceinline__ void operator()(const f32x4 (&acc)[2][2][4][2], const Unit& u, int wr, int wc, int fr, int fq) const {
        typename F::Pre pre[2][2];
        const int col0 = u.pn * BM + wc * 32 + 8 * fq, rowb = u.pm * BM + wr * 64 + fr;
#pragma unroll
        for (int bj = 0; bj < 2; ++bj) pre[0][bj] = f.pre(rowb, col0 + bj * HALF);
#pragma unroll
        for (int gi = 0; gi < 8; ++gi) {
            const int ai = gi >> 2, m = gi & 3, row = rowb + ai * HALF + m * 16;
            if (gi + 1 < 8) { const int ai2 = (gi + 1) >> 2, m2 = (gi + 1) & 3;
#pragma unroll
                for (int bj = 0; bj < 2; ++bj) pre[(gi + 1) & 1][bj] = f.pre(rowb + ai2 * HALF + m2 * 16, col0 + bj * HALF); }
#pragma unroll
            for (int bj = 0; bj < 2; ++bj) f(row, col0 + bj * HALF, acc[ai][bj][m][0], acc[ai][bj][m][1], pre[gi & 1][bj]);
            asm volatile("" ::: "memory");
        }
    } };

template <class Epi, class Sched, bool ALIGN_EPI = false, bool SP2 = false, bool CH_IN = false, bool CH_OUT = false>
__device__ __forceinline__ void gemm_phase(PG8_LAS unsigned char* lds, const Gemm g, const Sched& S, const Epi& E, const int tid, const Gemm ng = Gemm{}) {
    static_assert(!(CH_IN || CH_OUT) || (SP2 && ALIGN_EPI), "chaining is written for the SP2 + ALIGN_EPI loop");
    const int wid = __builtin_amdgcn_readfirstlane(tid >> 6), lane = tid & 63, wr = wid >> 2, wc = wid & 3, fr = lane & 15, fq = lane >> 4;
    const int K = g.K, nt = K / BK;
    unsigned voffA[2], voffB[2];
#pragma unroll
    for (int i = 0; i < 2; ++i) { int R, C; stage_rc(tid * 16 + i * 8192, R, C); const int Rb = Epi::PERM ? ((R & ~31) + perm32(R & 31)) : R;
        voffA[i] = (unsigned)(R * g.lda + C) * 2u; voffB[i] = (unsigned)(Rb * g.ldb + C) * 2u; }
    unsigned nvA[2] = {0u, 0u}, nvB[2] = {0u, 0u}; size_t n_hstepA = 0, n_hstepB = 0;
    if constexpr (CH_OUT) {
#pragma unroll
        for (int i = 0; i < 2; ++i) { int R, C; stage_rc(tid * 16 + i * 8192, R, C); const int Rb = Epi::PERM ? ((R & ~31) + perm32(R & 31)) : R;
            nvA[i] = (unsigned)(R * ng.lda + C) * 2u; nvB[i] = (unsigned)(Rb * ng.ldb + C) * 2u; }
        n_hstepA = (size_t)HALF * ng.lda * 2; n_hstepB = (size_t)HALF * ng.ldb * 2;
    }
    const size_t kstep = (size_t)(BK * 2);
    const size_t hstepA = (size_t)HALF * g.lda * 2, hstepB = (size_t)HALF * g.ldb * 2;
    const size_t tstepA = 2 * hstepA, tstepB = 2 * hstepB;
    const unsigned ldsw = (unsigned)wid * 1024u;
    const int aoff = lds_byte(wr * 64 + fr, fq * 8), boff = lds_byte(wc * 32 + fr, fq * 8);
#define PG8_SA(b, h) (((b) * 2 + (h)) * HTB)
#define PG8_SB(b, h) ((4 + (b) * 2 + (h)) * HTB)
#define PG8_STAGE(bufoff, gbase, voff) do { _Pragma("unroll") for (int _i = 0; _i < 2; ++_i) \
        __builtin_amdgcn_global_load_lds((const unsigned*)((const char*)(gbase) + (voff)[_i]), (PG8_LAS unsigned*)(lds + (bufoff) + ldsw + _i * 8192), 16, 0, 0); } while (0)
#define PG8_LDA(dst, b, h) do { _Pragma("unroll") for (int m = 0; m < 4; ++m) _Pragma("unroll") for (int k = 0; k < 2; ++k) dst[m][k] = *(const PG8_LAS bf16x8*)(lds + PG8_SA(b, h) + aoff + m * 2048 + k * 1024); } while (0)
#define PG8_LDB(dst, b, h) do { _Pragma("unroll") for (int n = 0; n < 2; ++n) _Pragma("unroll") for (int k = 0; k < 2; ++k) dst[n][k] = *(const PG8_LAS bf16x8*)(lds + PG8_SB(b, h) + boff + n * 2048 + k * 1024); } while (0)
#define PG8_MMA(ai, bj, At, Bt) do { __builtin_amdgcn_s_setprio(1); _Pragma("unroll") for (int m = 0; m < 4; ++m) _Pragma("unroll") for (int n = 0; n < 2; ++n) _Pragma("unroll") for (int k = 0; k < 2; ++k) \
        acc[ai][bj][m][n] = __builtin_amdgcn_mfma_f32_16x16x32_f16(Bt[n][k], At[m][k], acc[ai][bj][m][n], 0, 0, 0); __builtin_amdgcn_s_setprio(0); } while (0)
#define PG8_WAIT_V(n) asm volatile("s_waitcnt vmcnt(" #n ")" ::: "memory")
#define PG8_WAIT_L(n) asm volatile("s_waitcnt lgkmcnt(" #n ")" ::: "memory")
#define PG8_BAR __builtin_amdgcn_s_barrier()
#define PG8_SCHED __builtin_amdgcn_sched_barrier(0)
    Unit cur, nxt; int ui = 0;
    if (!S.next(0, cur)) return;
    f32x4 acc[2][2][4][2];
#pragma unroll
    for (int a = 0; a < 2; ++a)
#pragma unroll
        for (int b = 0; b < 2; ++b)
#pragma unroll
            for (int m = 0; m < 4; ++m)
#pragma unroll
                for (int n = 0; n < 2; ++n) acc[a][b][m][n] = (f32x4){0.f, 0.f, 0.f, 0.f};
    bf16x8 At[4][2], B0[2][2], B1[2][2];
    const char* cA = (const char*)g.A + (size_t)cur.pm * tstepA; const char* cB = (const char*)g.Bt + (size_t)cur.pn * tstepB;
    S.a_ready(cur);
    if constexpr (CH_IN) {   } else
    if constexpr (SP2) {
        PG8_STAGE(PG8_SB(0, 0), cB, voffB); PG8_STAGE(PG8_SB(0, 1), cB + hstepB, voffB); PG8_STAGE(PG8_SA(0, 0), cA, voffA); PG8_STAGE(PG8_SA(0, 1), cA + hstepA, voffA);
        if (wr == 1) PG8_BAR;
        PG8_WAIT_V(2); PG8_BAR;
        PG8_STAGE(PG8_SB(1, 0), cB + kstep, voffB); PG8_STAGE(PG8_SA(1, 0), cA + kstep, voffA); PG8_STAGE(PG8_SB(1, 1), cB + hstepB + kstep, voffB);
        PG8_WAIT_V(6); PG8_BAR;
    } else {
        PG8_STAGE(PG8_SB(0, 0), cB, voffB); PG8_STAGE(PG8_SA(0, 0), cA, voffA); PG8_STAGE(PG8_SB(0, 1), cB + hstepB, voffB); PG8_STAGE(PG8_SA(0, 1), cA + hstepA, voffA);
        if (wr == 1) PG8_BAR;
        PG8_WAIT_V(4); PG8_BAR;
        PG8_STAGE(PG8_SB(1, 0), cB + kstep, voffB); PG8_STAGE(PG8_SA(1, 0), cA + kstep, voffA); PG8_STAGE(PG8_SB(1, 1), cB + hstepB + kstep, voffB);
        PG8_WAIT_V(6); PG8_BAR;
    }
    for (;;) {
        const bool has_next = S.next(ui + 1, nxt);
        Unit u0; (void)S.next(0, u0);
        const char* nA = has_next ? (const char*)g.A + (size_t)nxt.pm * tstepA : (CH_OUT ? (const char*)ng.A + (size_t)u0.pm * 2 * n_hstepA : cA);
        const char* nB = has_next ? (const char*)g.Bt + (size_t)nxt.pn * tstepB : (CH_OUT ? (const char*)ng.Bt + (size_t)u0.pn * 2 * n_hstepB : cB);
#pragma unroll 1
        for (int t = 0; t < nt; t += 2) {
            const bool last = (t == nt - 2);
            const char* a1 = cA + (size_t)(t + 1) * kstep;
            const char* a2 = last ? nA : cA + (size_t)(t + 2) * kstep; const char* b2 = last ? nB : cB + (size_t)(t + 2) * kstep;
            const char* a3 = a2 + kstep; const char* b3 = b2 + kstep;
            const bool xg = CH_OUT && last && !has_next;
            unsigned vA2[2], vB2[2];
#pragma unroll
            for (int i = 0; i < 2; ++i) { vA2[i] = xg ? nvA[i] : voffA[i]; vB2[i] = xg ? nvB[i] : voffB[i]; }
            const size_t hA2 = xg ? n_hstepA : hstepA, hB2 = xg ? n_hstepB : hstepB;
            if (last && has_next) S.a_ready(nxt);
            if constexpr (SP2) {
            PG8_LDB(B0, 0, 0); PG8_LDB(B1, 0, 1); PG8_SCHED; PG8_LDA(At, 0, 0); PG8_STAGE(PG8_SA(1, 1), a1 + hstepA, voffA);
            PG8_WAIT_V(8); PG8_WAIT_L(0); PG8_BAR; PG8_MMA(0, 0, At, B0); PG8_MMA(0, 1, At, B1); PG8_BAR; PG8_SCHED;
            PG8_LDA(At, 0, 1); PG8_STAGE(PG8_SB(0, 0), b2, vB2); PG8_STAGE(PG8_SB(0, 1), b2 + hB2, vB2); PG8_STAGE(PG8_SA(0, 0), a2, vA2);
            PG8_WAIT_V(8); PG8_WAIT_L(0); PG8_BAR; PG8_MMA(1, 0, At, B0); PG8_MMA(1, 1, At, B1); PG8_BAR; PG8_SCHED;
            PG8_LDB(B0, 1, 0); PG8_LDB(B1, 1, 1); PG8_SCHED; PG8_LDA(At, 1, 0); PG8_STAGE(PG8_SA(0, 1), a2 + hA2, vA2);
            PG8_WAIT_V(8); PG8_WAIT_L(0); PG8_BAR; PG8_MMA(0, 0, At, B0); PG8_MMA(0, 1, At, B1); PG8_BAR; PG8_SCHED;
            PG8_LDA(At, 1, 1); PG8_STAGE(PG8_SB(1, 0), b3, vB2); PG8_STAGE(PG8_SB(1, 1), b3 + hB2, vB2); PG8_STAGE(PG8_SA(1, 0), a3, vA2);
            PG8_WAIT_V(8); PG8_WAIT_L(0); PG8_BAR; PG8_MMA(1, 0, At, B0); PG8_MMA(1, 1, At, B1); PG8_BAR; PG8_SCHED;
            } else {
            PG8_LDB(B0, 0, 0); PG8_SCHED; PG8_LDA(At, 0, 0); PG8_STAGE(PG8_SA(1, 1), a1 + hstepA, voffA);
            PG8_WAIT_L(8); PG8_BAR; PG8_WAIT_L(0); PG8_MMA(0, 0, At, B0); PG8_BAR; PG8_SCHED;
            PG8_LDB(B1, 0, 1); PG8_STAGE(PG8_SB(0, 0), b2, voffB);
            PG8_BAR; PG8_WAIT_L(0); PG8_MMA(0, 1, At, B1); PG8_BAR;
            PG8_LDA(At, 0, 1); PG8_STAGE(PG8_SA(0, 0), a2, voffA);
            PG8_BAR; PG8_WAIT_L(0); PG8_MMA(1, 0, At, B0); PG8_BAR; PG8_SCHED;
            PG8_STAGE(PG8_SB(0, 1), b2 + hstepB, voffB);
            PG8_WAIT_V(6); PG8_BAR; PG8_MMA(1, 1, At, B1); PG8_BAR;
            PG8_LDB(B0, 1, 0); PG8_SCHED; PG8_LDA(At, 1, 0); PG8_STAGE(PG8_SA(0, 1), a2 + hstepA, voffA);
            PG8_WAIT_L(8); PG8_BAR; PG8_WAIT_L(0); PG8_MMA(0, 0, At, B0); PG8_BAR; PG8_SCHED;
            PG8_LDB(B1, 1, 1); PG8_STAGE(PG8_SB(1, 0), b3, voffB);
            PG8_BAR; PG8_WAIT_L(0); PG8_MMA(0, 1, At, B1); PG8_BAR;
            PG8_LDA(At, 1, 1); PG8_STAGE(PG8_SA(1, 0), a3, voffA);
            PG8_BAR; PG8_WAIT_L(0); PG8_MMA(1, 0, At, B0); PG8_BAR; PG8_SCHED;
            PG8_STAGE(PG8_SB(1, 1), b3 + hstepB, voffB);
            PG8_WAIT_V(6); PG8_BAR; PG8_MMA(1, 1, At, B1); PG8_BAR;
            }
        }
        if constexpr (ALIGN_EPI) { if (wr == 0) PG8_BAR; }
        if constexpr (!Epi::AFTER_DRAIN) { E(acc, cur, wr, wc, fr, fq); S.done(cur); }
        if (!has_next) break;
#pragma unroll
        for (int a = 0; a < 2; ++a)
#pragma unroll
            for (int b = 0; b < 2; ++b)
#pragma unroll
                for (int m = 0; m < 4; ++m)
#pragma unroll
                    for (int n = 0; n < 2; ++n) acc[a][b][m][n] = (f32x4){0.f, 0.f, 0.f, 0.f};
        cur = nxt; cA = nA; cB = nB; ++ui;
        if constexpr (ALIGN_EPI) { if (wr == 1) PG8_BAR; }
    }
    if constexpr (CH_OUT) { if (wr == 1) PG8_BAR; return; }
    PG8_WAIT_V(0);
    if constexpr (!ALIGN_EPI) { if (wr == 0) PG8_BAR; }
    PG8_BAR;
    if constexpr (Epi::AFTER_DRAIN) { E.fused(acc, cur, wr, wc, fr, fq, lds, wid, lane); S.done(cur); }
#undef PG8_SA
#undef PG8_SB
#undef PG8_STAGE
#undef PG8_LDA
#undef PG8_LDB
#undef PG8_MMA
#undef PG8_WAIT_V
#undef PG8_WAIT_L
#undef PG8_BAR
#undef PG8_SCHED
}
}

template <bool CH_IN, bool CH_OUT, class F>
__device__ __forceinline__ void gemm_pg8c(const Ctx& C, const f16* A, int lda, const f16* Bt, int ldb, int M, int N, int K, const F& f, const f16* nA, int nlda, const f16* nBt, int nldb) {
    pg8::Gemm g{A, Bt, M, N, K, lda, ldb}; pg8::Gemm ng{nA, nBt, M, N, 0, nlda, nldb}; pg8::StaticOrder S; S.init(M, N, C.nblk, C.bid);
    pg8::EpiFn<F> E{f};
    pg8::gemm_phase<pg8::EpiFn<F>, pg8::StaticOrder, true, true, CH_IN, CH_OUT>(C.lds, g, S, E, C.tid, ng);
}
template <class F>
__device__ __forceinline__ void gemm_pg8(const Ctx& C, const f16* A, int lda, const f16* Bt, int ldb, int M, int N, int K, const F& f) {
    pg8::Gemm g{A, Bt, M, N, K, lda, ldb}; pg8::StaticOrder S; S.init(M, N, C.nblk, C.bid);
    pg8::EpiFn<F> E{f};
    pg8::gemm_phase<pg8::EpiFn<F>, pg8::StaticOrder, true, true>(C.lds, g, S, E, C.tid);
}
template <class F>
__device__ __forceinline__ void gemm_small(const Ctx& C, const f16* A, int lda, const f16* Bt, int ldb, int row0, int N, int K, const F& f) {
    constexpr int PST = 68;
    LAS float* part = (LAS float*)C.lds;
    const int fr = C.lane & 15, fq = C.lane >> 4;
    const int tilesN = N / 64, ntiles = 16 * tilesN, kw = K / 8;
    for (int tile = C.bid; tile < ntiles; tile += C.nblk) {
        const int tm = tile / tilesN, tn = tile - tm * tilesN, m0 = tm * 64, n0 = tn * 64;
        f32x4 acc[4][4];
#pragma unroll
        for (int a = 0; a < 4; ++a)
#pragma unroll
            for (int b = 0; b < 4; ++b) acc[a][b] = (f32x4){0.f, 0.f, 0.f, 0.f};
        const f16* ap = A + (size_t)(m0 + fr) * lda + C.wid * kw + fq * 8;
        const f16* bp = Bt + (size_t)(n0 + fr) * ldb + C.wid * kw + fq * 8;
#pragma unroll 4
        for (int k0 = 0; k0 < kw; k0 += 32) {
            f16x8 av[4], bv[4];
#pragma unroll
            for (int a = 0; a < 4; ++a) av[a] = *(const f16x8*)(ap + (size_t)(a * 16) * lda + k0);
#pragma unroll
            for (int b = 0; b < 4; ++b) bv[b] = *(const f16x8*)(bp + (size_t)(b * 16) * ldb + k0);
#pragma unroll
            for (int a = 0; a < 4; ++a)
#pragma unroll
                for (int b = 0; b < 4; ++b) acc[a][b] = __builtin_amdgcn_mfma_f32_16x16x32_f16(bv[b], av[a], acc[a][b], 0, 0, 0);
        }
        __syncthreads();
        LAS float* pw = part + (size_t)C.wid * 64 * PST;
#pragma unroll
        for (int a = 0; a < 4; ++a)
#pragma unroll
            for (int b = 0; b < 4; ++b) *(LAS f32x4*)(pw + (a * 16 + fr) * PST + b * 16 + 4 * fq) = acc[a][b];
        __syncthreads();
        const int rl = 8 * C.wid + (C.lane & 7), c8 = ((C.lane >> 4) & 1) | (((C.lane >> 5) & 1) << 1) | (((C.lane >> 3) & 1) << 2);
        f32x4 lo = (f32x4){0.f, 0.f, 0.f, 0.f}, hi = lo;
#pragma unroll
        for (int w = 0; w < 8; ++w) { const LAS float* pr = part + ((size_t)w * 64 + rl) * PST + 8 * c8; lo = lo + *(const LAS f32x4*)pr; hi = hi + *(const LAS f32x4*)(pr + 4); }
        f(row0 + m0 + rl, n0 + 8 * c8, lo, hi, f.pre(row0 + m0 + rl, n0 + 8 * c8));
    }
    __syncthreads();
}
template <class F>
__device__ __forceinline__ void gemm_pg8s(const Ctx& C, const f16* A, int lda, const f16* Bt, int ldb, int M, int N, int K, const F& f) {
    pg8::Gemm g{A, Bt, M, N, K, lda, ldb}; pg8::StaticOrder S; S.init(M, N, C.nblk, C.bid);
    pg8::EpiFn<F> E{f};
    pg8::gemm_phase<pg8::EpiFn<F>, pg8::StaticOrder, false, true>(C.lds, g, S, E, C.tid);
}
template <class F>
__device__ __forceinline__ void gemm_rows(const Ctx& C, const f16* A, int lda, const f16* Bt, int ldb, int mrows, int N, int K, const F& f) {
    if (N == 1024) gemm_pg8s(C, A, lda, Bt, ldb, NLAT, N, K, f); else gemm_pg8(C, A, lda, Bt, ldb, NLAT, N, K, f);
    if (mrows > NLAT) gemm_small(C, A + (size_t)NLAT * lda, lda, Bt, ldb, NLAT, N, K, f);
}
struct NoPre {};
#define NOPRE typedef NoPre Pre; __device__ __forceinline__ NoPre pre(int, int) const { return NoPre{}; }
struct EpiProj { f16* P; f16* VA; f16* U3;
    NOPRE
    __device__ __forceinline__ void operator()(int row, int col, f32x4 lo, f32x4 hi, NoPre) const {
        const f16x8 v = pack8(lo, hi); f16* pr = P + (size_t)row * PLD2;
        if (col < GC_AV) *(f16x8*)(pr + PC_AK + col) = v;
        else if (col < GC_CKV) { const RowInfo ri = row_info(row); const int c = col - GC_AV; *(f16x8*)(VA + ((size_t)(ri.b * 2 + (c >> 6)) * NKEY + ri.pos) * 64 + (c & 63)) = v; }
        else if (col < GC_CKR) *(f16x8*)(pr + PC_CKV + (col - GC_CKV)) = v;
        else if (col < GC_PAD) *(f16x8*)(pr + PC_CKR + (col - GC_CKR)) = v;
        else if (col < GC_U) { }
        else if (col < GC_AQ) { const int c = col - GC_U; *(f16x8*)(U3 + u3_off(c >> 4, row >> 9, row & 15, (c >> 3) & 1, (row >> 4) & 31)) = v; }
        else if (col < GC_CQ) *(f16x8*)(pr + PC_AQ + (col - GC_AQ)) = v;
        else *(f16x8*)(pr + PC_CQ + (col - GC_CQ)) = v;
    } };
struct EpiKvUp { f16* KC; f16* VC;
    NOPRE
    __device__ __forceinline__ void operator()(int row, int col, f32x4 lo, f32x4 hi, NoPre) const {
        const RowInfo ri = row_info(row); const int h = col >> 7, w = col & 127;
        if (w < 64) *(f16x8*)(KC + ((size_t)(ri.b * 8 + h) * NKEY + ri.pos) * 96 + w) = pack8(lo, hi);
        else *(f16x8*)(VC + ((size_t)(ri.b * 8 + h) * NKEY + ri.pos) * 64 + (w - 64)) = pack8(lo, hi);
    } };
struct EpiQUp { f16* QC; const float* ropeC;
    NOPRE
    __device__ __forceinline__ void operator()(int row, int col, f32x4 lo, f32x4 hi, NoPre) const {
        const RowInfo ri = row_info(row); const int h = col / 96, w = col - h * 96;
        if (w >= 64) {
            f32x4 plo, phi;
#pragma unroll
            for (int e = 0; e < 4; ++e) { plo[e] = __shfl_xor(lo[e], 16); phi[e] = __shfl_xor(hi[e], 16); }
            if (ri.lat) {
                const int j0 = w - 64, part = j0 >> 4, second = (j0 >> 3) & 1, pi = part ? (ri.t & 63) : (ri.t >> 6);
                const float* cc = ropeC + pi * 8; const float* ss = ropeC + 512 + pi * 8;
#pragma unroll
                for (int e = 0; e < 4; ++e) {
                    const float s0 = second ? ss[e] : -ss[e], s1 = second ? ss[4 + e] : -ss[4 + e];
                    lo[e] = lo[e] * cc[e] + plo[e] * s0; hi[e] = hi[e] * cc[4 + e] + phi[e] * s1; }
            }
        }
        lo = lo * QSCALE_C; hi = hi * QSCALE_C;
        f16* dst = ri.lat ? QC + ((size_t)(ri.b * 8 + h) * SEQ + ri.t) * 96 + w : QC + (size_t)NB * 8 * SEQ * 96 + ((size_t)(ri.b * 8 + h) * CTX + ri.t) * 96 + w;
        *(f16x8*)dst = pack8(lo, hi);
    } };
struct EpiGlu { f16* YS;
    NOPRE
    __device__ __forceinline__ void operator()(int row, int col, f32x4 lo, f32x4 hi, NoPre) const {
        f32x4 o;
#pragma unroll
        for (int e = 0; e < 4; ++e) o[e] = lo[e] * sigmoidf_(hi[e]);
        *(f16x4*)(YS + (size_t)row * 512 + (col >> 1)) = pack4(o);
    } };
struct EpiGate { f16* G;
    NOPRE
    __device__ __forceinline__ void operator()(int row, int col, f32x4 lo, f32x4 hi, NoPre) const {
#pragma unroll
        for (int e = 0; e < 4; ++e) { lo[e] = sigmoidf_(lo[e]); hi[e] = sigmoidf_(hi[e]); }
        *(f16x8*)(G + (size_t)row * 1024 + col) = pack8(lo, hi);
    } };
struct EpiBranch { const f16* G; f16* Mg; int first;
    struct Pre { f16x8 g, m; };
    __device__ __forceinline__ Pre pre(int row, int col) const { Pre p; p.g = *(const f16x8*)(G + (size_t)row * 1024 + col);
        if (!first) p.m = *(const f16x8*)(Mg + (size_t)row * 1024 + col); else p.m = (f16x8){0, 0, 0, 0, 0, 0, 0, 0}; return p; }
    __device__ __forceinline__ void operator()(int row, int col, f32x4 lo, f32x4 hi, const Pre& p) const {
#pragma unroll
        for (int e = 0; e < 4; ++e) { lo[e] = (float)p.m[e] + (float)p.g[e] * lo[e]; hi[e] = (float)p.m[4 + e] + (float)p.g[4 + e] * hi[e]; }
        *(f16x8*)(Mg + (size_t)row * 1024 + col) = pack8(lo, hi);
    } };
struct EpiWout { const Ctx* C; int l;
    struct Pre { f32x4 x0, x1, g0, g1; };
    __device__ __forceinline__ Pre pre(int row, int col) const { const RowInfo ri = row_info(row); const float* x = C->xsrc(l, row) + col; const float* g = C->mod(l, ri.mrow, 2) + col;
        Pre p; p.x0 = *(const f32x4*)x; p.x1 = *(const f32x4*)(x + 4); p.g0 = *(const f32x4*)g; p.g1 = *(const f32x4*)(g + 4); return p; }
    __device__ __forceinline__ void operator()(int row, int col, f32x4 lo, f32x4 hi, const Pre& p) const {
        *(f16x8*)((f16*)(C->ws() + A_T1H) + (size_t)row * D + col) = pack8(p.x0 * ALPHA + p.g0 * lo, p.x1 * ALPHA + p.g1 * hi);
    } };
struct EpiUp { f16* Hd;
    NOPRE
    __device__ __forceinline__ void operator()(int row, int col, f32x4 lo, f32x4 hi, NoPre) const {
#pragma unroll
        for (int e = 0; e < 4; ++e) { const float a = fmaxf(lo[e], 0.f), b = fmaxf(hi[e], 0.f); lo[e] = a * a; hi[e] = b * b; }
        *(f16x8*)(Hd + (size_t)row * DFF + col) = pack8(lo, hi);
    } };
struct EpiDown { const Ctx* C; int l;
    struct Pre { f16x8 t1; float mean, rstd; };
    __device__ __forceinline__ Pre pre(int row, int col) const { Pre p; p.t1 = *(const f16x8*)((const f16*)(C->ws() + A_T1H) + (size_t)row * D + col);
        const float* st = (const float*)(C->ws() + WS_ST1) + 2 * row; p.mean = st[0]; p.rstd = st[1]; return p; }
    __device__ __forceinline__ void operator()(int row, int col, f32x4 lo, f32x4 hi, const Pre& p) const {
        const RowInfo ri = row_info(row); const float* g = C->mod(l, ri.mrow, 5) + col; f16* t = (f16*)(C->ws() + A_T1H) + (size_t)row * D + col;
        const float* lg = C->in(I_LN1G) + l * D + col; const float* lb = C->in(I_LN1B) + l * D + col;
        const f32x4 g0 = *(const f32x4*)g, g1 = *(const f32x4*)(g + 4);
        const f32x4 a0 = *(const f32x4*)lg, a1 = *(const f32x4*)(lg + 4), b0 = *(const f32x4*)lb, b1 = *(const f32x4*)(lb + 4);
        f32x4 x0, x1;
#pragma unroll
        for (int e = 0; e < 4; ++e) { x0[e] = ((float)p.t1[e] - p.mean) * p.rstd * a0[e] + b0[e]; x1[e] = ((float)p.t1[4 + e] - p.mean) * p.rstd * a1[e] + b1[e]; }
        *(f16x8*)t = pack8(x0 * ALPHA + g0 * lo, x1 * ALPHA + g1 * hi);
    } };

namespace fa {
typedef _Float16 h2 __attribute__((ext_vector_type(2)));
typedef float f2 __attribute__((ext_vector_type(2)));
typedef short s16x4 __attribute__((ext_vector_type(4)));
typedef unsigned u32x4 __attribute__((ext_vector_type(4)));
#define FA_SBAR() __builtin_amdgcn_sched_barrier(0)
constexpr float THR = 8.f;
constexpr int SHM_V = 64 * 64 * 2;
template <int DQK> struct Cfg { static constexpr int KROWB = DQK == 64 ? 128 : 256, SHM_K = 64 * KROWB, NCH = DQK / 8; };
template <int DQK> __device__ __forceinline__ int kswz(int row, int ch) {
    if constexpr (DQK == 64) return row * 128 + ((ch ^ ((row >> 1) & 7)) << 4);
    else return row * 256 + ((ch ^ (row & 15)) << 4);
}
__device__ __forceinline__ int crow(int r, int hi) { return (r & 3) + 8 * (r >> 2) + 4 * hi; }
__device__ __forceinline__ unsigned cvtpk(float lo, float hi) { f2 v = {lo, hi}; h2 h = __builtin_convertvector(v, h2); return __builtin_bit_cast(unsigned, h); }
__device__ __forceinline__ void partialSM(f32x16& p0, f32x16& p1, float& m_reg, float& mn, float& alpha) {
    float pmax = p0[0];
#pragma unroll
    for (int r = 1; r < 16; ++r) pmax = fmaxf(pmax, p0[r]);
#pragma unroll
    for (int r = 0; r < 16; ++r) pmax = fmaxf(pmax, p1[r]);
    { auto rr = __builtin_amdgcn_permlane32_swap(__float_as_uint(pmax), __float_as_uint(pmax), false, false);
      pmax = fmaxf(__uint_as_float(rr[0]), __uint_as_float(rr[1])); }
    if (__builtin_expect(__all(pmax - m_reg <= THR), 1)) { mn = m_reg; alpha = 1.f; }
    else { mn = fmaxf(m_reg, pmax); alpha = __builtin_amdgcn_exp2f(m_reg - mn); m_reg = mn; }
#pragma unroll
    for (int r = 0; r < 16; ++r) { p0[r] = p0[r] - mn; p1[r] = p1[r] - mn; }
#pragma unroll
    for (int r = 0; r < 16; ++r) p0[r] = __builtin_amdgcn_exp2f(p0[r]);
}
__device__ __forceinline__ void finishSM(f32x16& p0, f32x16& p1, float alpha, float& l_reg, f16x8& pa0, f16x8& pa1, f16x8& pa2, f16x8& pa3) {
#pragma unroll
    for (int r = 0; r < 16; ++r) p1[r] = __builtin_amdgcn_exp2f(p1[r]);
    float ps = 0;
#pragma unroll
    for (int r = 0; r < 16; ++r) ps += p0[r];
#pragma unroll
    for (int r = 0; r < 16; ++r) ps += p1[r];
    { auto rr = __builtin_amdgcn_permlane32_swap(__float_as_uint(ps), __float_as_uint(ps), false, false);
      ps = __uint_as_float(rr[0]) + __uint_as_float(rr[1]); }
    l_reg = l_reg * alpha + ps;
#define FA_PK4(P, BASE, OUT) do { unsigned a0 = cvtpk(P[BASE + 0], P[BASE + 1]), a1 = cvtpk(P[BASE + 2], P[BASE + 3]);   \
    unsigned b0 = cvtpk(P[BASE + 4], P[BASE + 5]), b1 = cvtpk(P[BASE + 6], P[BASE + 7]);                              \
    auto r0 = __builtin_amdgcn_permlane32_swap(a0, b0, false, false); auto r1 = __builtin_amdgcn_permlane32_swap(a1, b1, false, false); \
    u32x4 w = {r0[0], r1[0], r0[1], r1[1]}; OUT = __builtin_bit_cast(f16x8, w); } while (0)
    FA_PK4(p0, 0, pa0); FA_PK4(p0, 8, pa1); FA_PK4(p1, 0, pa2); FA_PK4(p1, 8, pa3);
#undef FA_PK4
}
template <int DQK>
__device__ __forceinline__ void qkt(f32x16& p0, f32x16& p1, const LAS unsigned char* Ks, const f16x8* qr, int r32, int hi) {
    p0 = f32x16{}; p1 = f32x16{};
#pragma unroll
    for (int d0 = 0; d0 < DQK / 16; ++d0) {
        const f16x8 b0 = *(const LAS f16x8*)(Ks + kswz<DQK>(r32, d0 * 2 + hi));
        const f16x8 b1 = *(const LAS f16x8*)(Ks + kswz<DQK>(32 + r32, d0 * 2 + hi));
        p0 = __builtin_amdgcn_mfma_f32_32x32x16_f16(b0, qr[d0], p0, 0, 0, 0);
        p1 = __builtin_amdgcn_mfma_f32_32x32x16_f16(b1, qr[d0], p1, 0, 0, 0);
    }
}
__device__ __forceinline__ int v_st(int k, int c) { const int kk = (k & ~0xC) | ((k & 4) << 1) | ((k & 8) >> 1); return ((kk >> 3) * 2 + (c >> 5)) * 512 + ((kk & 7) * 32 + (c & 31)) * 2; }
__device__ __forceinline__ int v_rd_base(int lane) { return ((lane & 3) << 3) | (((lane >> 2) & 3) << 6) | (((lane >> 4) & 1) << 5) | (((lane >> 5) & 1) << 8); }
constexpr int v_rd_off(int d0, int ks, int half) { return d0 * 512 + ks * 2048 + half * 1024; }
template <int OFF> __device__ __forceinline__ s16x4 tr_read(int vb) {
    s16x4 r; asm volatile("ds_read_b64_tr_b16 %0, %1 offset:%2" : "=&v"(r) : "v"(vb), "i"(OFF) : "memory"); return r;
}
template <int D0> __device__ __forceinline__ void pv_one(f32x16& od, int vb, f16x8 pa0, f16x8 pa1, f16x8 pa2, f16x8 pa3) {
    const s16x4 l0 = tr_read<v_rd_off(D0, 0, 0)>(vb), h0 = tr_read<v_rd_off(D0, 0, 1)>(vb), l1 = tr_read<v_rd_off(D0, 1, 0)>(vb), h1 = tr_read<v_rd_off(D0, 1, 1)>(vb);
    const s16x4 l2 = tr_read<v_rd_off(D0, 2, 0)>(vb), h2_ = tr_read<v_rd_off(D0, 2, 1)>(vb), l3 = tr_read<v_rd_off(D0, 3, 0)>(vb), h3 = tr_read<v_rd_off(D0, 3, 1)>(vb);
    asm volatile("s_waitcnt lgkmcnt(0)" ::: "memory"); FA_SBAR();
#define FA_PK(L, H) __builtin_bit_cast(f16x8, (short __attribute__((ext_vector_type(8)))){L[0], L[1], L[2], L[3], H[0], H[1], H[2], H[3]})
    od = __builtin_amdgcn_mfma_f32_32x32x16_f16(pa0, FA_PK(l0, h0), od, 0, 0, 0);
    od = __builtin_amdgcn_mfma_f32_32x32x16_f16(pa1, FA_PK(l1, h1), od, 0, 0, 0);
    od = __builtin_amdgcn_mfma_f32_32x32x16_f16(pa2, FA_PK(l2, h2_), od, 0, 0, 0);
    od = __builtin_amdgcn_mfma_f32_32x32x16_f16(pa3, FA_PK(l3, h3), od, 0, 0, 0);
#undef FA_PK
}
__device__ __forceinline__ void pv_d0(f32x16* o, int vb, f16x8 pa0, f16x8 pa1, f16x8 pa2, f16x8 pa3) {
    pv_one<0>(o[0], vb, pa0, pa1, pa2, pa3); pv_one<1>(o[1], vb, pa0, pa1, pa2, pa3);
}
template <int DQK>
__device__ __forceinline__ void attn_unit(const f16* Qb, int qstride, const f16* __restrict__ Kh, const f16* __restrict__ Vh, f16* Ob, int nkeys, LAS unsigned char* lds, const int tid) {
    constexpr int SHM_K = Cfg<DQK>::SHM_K, NCH = Cfg<DQK>::NCH, ND0 = DQK / 16;
    const int wid = tid >> 6, lane = tid & 63, r32 = lane & 31, hi = lane >> 5;
    LAS unsigned char* V_lds = lds; LAS unsigned char* K_lds = lds + 3 * SHM_V;
    LAS float* wsx = (LAS float*)(lds + 3 * SHM_V + 2 * SHM_K) + wid * 64; LAS float* li_l = wsx; LAS float* al_l = wsx + 32;
    float m_reg = -1e30f, l_reg = 0; f32x16 o[2] = {}; f16x8 qr[ND0];
    const f16* Qw = Qb + (size_t)(wid * 32 + r32) * qstride + hi * 8;
#pragma unroll
    for (int d0 = 0; d0 < ND0; ++d0) qr[d0] = *(const f16x8*)(Qw + d0 * 16);
    const int vr = tid >> 3, vc = (tid & 7) * 8, vst = v_st(vr, vc);
    const int k0id = tid, k1id = (tid + 512 < 64 * NCH) ? tid + 512 : tid;
    const int k0r = k0id / NCH, k0c = k0id % NCH, k1r = k1id / NCH, k1c = k1id % NCH;
    const bool k1on = (NCH > 8) && (tid + 512 < 64 * NCH);
    const int vb0 = (int)(uintptr_t)V_lds + v_rd_base(lane);
    struct { f16x8 vs, ks0, ks1; } sr_[2];
#define FA_SLOAD(i, kk0) do { sr_[i].vs = *(const f16x8*)(Vh + (size_t)((kk0) + vr) * 64 + vc); sr_[i].ks0 = *(const f16x8*)(Kh + (size_t)((kk0) + k0r) * DQK + k0c * 8); \
    if (NCH > 8) sr_[i].ks1 = *(const f16x8*)(Kh + (size_t)((kk0) + k1r) * DQK + k1c * 8); } while (0)
#define FA_SWRITE(b, vbo, i) do { *(LAS f16x8*)(V_lds + (vbo) + vst) = sr_[i].vs; *(LAS f16x8*)(K_lds + (b) * SHM_K + kswz<DQK>(k0r, k0c)) = sr_[i].ks0; \
    if (k1on) *(LAS f16x8*)(K_lds + (b) * SHM_K + kswz<DQK>(k1r, k1c)) = sr_[i].ks1; } while (0)
#define FA_SWAIT() do { if (NCH > 8) asm volatile("s_waitcnt vmcnt(3)" ::: "memory"); else asm volatile("s_waitcnt vmcnt(2)" ::: "memory"); } while (0)
#define FA_RESC(a) do { if (__any((a) < 1.f)) { if (hi == 0) al_l[r32] = (a); asm volatile("s_waitcnt lgkmcnt(0)" ::: "memory"); \
    _Pragma("unroll") for (int d = 0; d < 2; ++d) _Pragma("unroll") for (int r = 0; r < 16; ++r) o[d][r] *= al_l[crow(r, hi)]; } } while (0)
    f32x16 pA0, pA1, pB0, pB1; float mnA, mnB, alA, alB; f16x8 pa0, pa1, pa2, pa3; const int NT = nkeys / 64;
    constexpr int SE = 0, SO = 1;
    int vp = 0, vc_ = SHM_V, vn = 2 * SHM_V;
#define FA_VROT() do { const int t_ = vp; vp = vc_; vc_ = vn; vn = t_; } while (0)
    FA_SLOAD(SE, 0); FA_SLOAD(SO, 64);
    FA_SWAIT(); FA_SWRITE(0, 0, SE); __syncthreads();
    qkt<DQK>(pA0, pA1, K_lds, qr, r32, hi); partialSM(pA0, pA1, m_reg, mnA, alA);
    if (2 < NT) FA_SLOAD(SE, 128);
    FA_SWAIT(); FA_SWRITE(1, SHM_V, SO); __syncthreads();
    for (int j = 1; j + 1 < NT; j += 2) {
        FA_SBAR(); qkt<DQK>(pB0, pB1, K_lds + SHM_K, qr, r32, hi);
        finishSM(pA0, pA1, alA, l_reg, pa0, pa1, pa2, pa3); FA_SBAR();
        FA_SLOAD(SO, (j + 2) * 64); FA_SBAR();
        pv_d0(o, vb0 + vp, pa0, pa1, pa2, pa3); partialSM(pB0, pB1, m_reg, mnB, alB);
        FA_SWAIT(); FA_SWRITE(0, vn, SE);
        FA_RESC(alB); __syncthreads(); FA_VROT();
        FA_SBAR(); qkt<DQK>(pA0, pA1, K_lds, qr, r32, hi);
        finishSM(pB0, pB1, alB, l_reg, pa0, pa1, pa2, pa3); FA_SBAR();
        if (j + 3 < NT) FA_SLOAD(SE, (j + 3) * 64);
        FA_SBAR();
        pv_d0(o, vb0 + vp, pa0, pa1, pa2, pa3); partialSM(pA0, pA1, m_reg, mnA, alA);
        FA_SWAIT(); FA_SWRITE(1, vn, SO);
        FA_RESC(alA); __syncthreads(); FA_VROT();
    }
    FA_SBAR(); qkt<DQK>(pB0, pB1, K_lds + SHM_K, qr, r32, hi);
    finishSM(pA0, pA1, alA, l_reg, pa0, pa1, pa2, pa3); FA_SBAR();
    pv_d0(o, vb0 + vp, pa0, pa1, pa2, pa3); partialSM(pB0, pB1, m_reg, mnB, alB);
    FA_RESC(alB);
    finishSM(pB0, pB1, alB, l_reg, pa0, pa1, pa2, pa3); FA_SBAR();
    pv_d0(o, vb0 + vc_, pa0, pa1, pa2, pa3);
    if (hi == 0) li_l[r32] = l_reg;
    asm volatile("s_waitcnt lgkmcnt(0)" ::: "memory");
    float rli[16];
#pragma unroll
    for (int r = 0; r < 16; ++r) rli[r] = __builtin_amdgcn_rcpf(li_l[crow(r, hi)]);
    f16* Ow = Ob + (size_t)(wid * 32) * 512;
#pragma unroll
    for (int r = 0; r < 16; ++r) { const int orow = crow(r, hi);
#pragma unroll
        for (int d0 = 0; d0 < 2; ++d0) Ow[(size_t)orow * 512 + d0 * 32 + r32] = (f16)(o[d0][r] * rli[r]); }
#undef FA_SLOAD
#undef FA_SWRITE
#undef FA_SWAIT
#undef FA_RESC
#undef FA_VROT
}
}
__device__ __forceinline__ void phase_attn_flash(const Ctx& C, int l) {
    f16* QA = (f16*)(C.ws() + A_QA); const f16* QC = (const f16*)(C.ws() + A_QC);
    const f16* KA = (const f16*)(C.ws() + A_KA); const f16* VA = (const f16*)(C.ws() + A_VA);
    const f16* KC = (const f16*)(C.ws() + A_KC); const f16* VC = (const f16*)(C.ws() + A_VC);
    f16* YC = (f16*)(C.ws() + A_YC);
    const int vcu = (C.nblk % 8 == 0) ? (C.bid % 8) * (C.nblk / 8) + C.bid / 8 : C.bid;
    const int total = 1024 + (l == 0 ? 64 : 0);
    for (int u = vcu; u < total; u += C.nblk) {
        __syncthreads();
        int typeC, b, h, nkeys; size_t qrow, orow;
        if (u < 1024) { const int v = u & 511; typeC = u >> 9; b = v >> 7; h = (v >> 4) & 7; const int qb = v & 15; qrow = (size_t)(b * 8 + h) * SEQ + qb * 256; orow = (size_t)b * SEQ + qb * 256; nkeys = NKEY; }
        else { const int v = (u - 1024) & 31; typeC = (u - 1024) >> 5; b = v >> 3; h = v & 7; qrow = (size_t)NB * 8 * SEQ + (size_t)(b * 8 + h) * CTX; orow = (size_t)NLAT + b * CTX; nkeys = CTX; }
        if (!typeC) fa::attn_unit<64>(QA + orow * 512 + h * 64, 512, KA + (size_t)(b * 2 + (h >> 2)) * NKEY * 64, VA + (size_t)(b * 2 + (h >> 2)) * NKEY * 64, QA + orow * 512 + h * 64, nkeys, C.lds, C.tid);
        else fa::attn_unit<96>(QC + qrow * 96, 96, KC + (size_t)(b * 8 + h) * NKEY * 96, VC + (size_t)(b * 8 + h) * NKEY * 64, YC + orow * 512 + h * 64, nkeys, C.lds, C.tid);
    }
}

constexpr float S5SC = 1024.0f, S5ISC = 1.0f / 1024.0f;
__device__ __forceinline__ void qp_split(int qp, int& b, int& nmem) { if (qp < 1024) { b = qp >> 8; nmem = 16 + (qp & 255); } else { b = (qp - 1024) >> 4; nmem = (qp - 1024) & 15; } }
__device__ __forceinline__ void phase_s5tab(const Ctx& C, int l) {
    LAS float* ApR = (LAS float*)C.lds; LAS float* ApI = ApR + 17 * 64; LAS float* BbR = ApI + 17 * 64; LAS float* BbI = BbR + 1024; LAS float* CR = BbI + 1024; LAS float* CI = CR + 1024;
    for (int u = C.bid; u < 64; u += C.nblk) {
        const int dir = u >> 5, g = u & 31; const size_t gi = (size_t)(l * 2 + dir) * 32 + g;
        const float dt = expf(C.in(I_SLDT)[gi]);
        __syncthreads();
        for (int i = C.tid; i < 17 * 64; i += NTHREADS) {
            const int p = i & 63, k = i >> 6; const float are = C.in(I_SARE)[gi * 64 + p], aim = C.in(I_SAIM)[gi * 64 + p];
            const float mag = expf(are * dt * (float)k), ang = (aim * dt) * (float)k;
            ApR[i] = mag * cosf(ang); ApI[i] = mag * sinf(ang);
        }
        for (int i = C.tid; i < 1024; i += NTHREADS) {
            const int p = i >> 4, c = i & 15; const float are = C.in(I_SARE)[gi * 64 + p], aim = C.in(I_SAIM)[gi * 64 + p];
            const float mag = expf(are * dt), th = aim * dt, abr = mag * cosf(th), abi = mag * sinf(th);
            const float den = are * are + aim * aim, nr = abr - 1.0f, cr = (nr * are + abi * aim) / den, ci = (abi * are - nr * aim) / den;
            const float br = C.in(I_SBRE)[(gi * 64 + p) * 16 + c], bi = C.in(I_SBIM)[(gi * 64 + p) * 16 + c];
            BbR[i] = cr * br - ci * bi; BbI[i] = cr * bi + ci * br;
            CR[i] = C.in(I_SCRE)[gi * 1024 + i]; CI[i] = C.in(I_SCIM)[gi * 1024 + i];
        }
        __syncthreads();
        f16* Et = (f16*)(C.ws() + T_E) + (size_t)u * 16 * 16 * 128; f16* Mt = (f16*)(C.ws() + T_M); f16* Kt = (f16*)(C.ws() + T_K) + (size_t)u * 17 * 256;
        for (int i = C.tid; i < 16384; i += NTHREADS) {
            { const int t = i >> 10, c = (i >> 6) & 15, p = i & 63, k = dir == 0 ? t + 1 : 16 - t;
              const float cr = CR[c * 64 + p], ci = CI[c * 64 + p], ar = ApR[k * 64 + p], ai = ApI[k * 64 + p];
              Et[(size_t)(t * 16 + c) * 128 + p] = (f16)((cr * ar - ci * ai) * S5SC); Et[(size_t)(t * 16 + c) * 128 + 64 + p] = (f16)(-(cr * ai + ci * ar) * S5SC); }
            { const int p = i >> 8, sx = (i >> 4) & 15, c = i & 15, k = dir == 0 ? 15 - sx : sx;
              const float ar = ApR[k * 64 + p], ai = ApI[k * 64 + p], br = BbR[p * 16 + c], bi = BbI[p * 16 + c];
              Mt[m3_off(u, p >> 5, sx, c >> 3, p & 31) + (c & 7)] = (f16)((ar * br - ai * bi) * S5SC);
              Mt[m3_off(u, 2 + (p >> 5), sx, c >> 3, p & 31) + (c & 7)] = (f16)((ar * bi + ai * br) * S5SC); }
        }
        for (int i = C.tid; i < 17 * 256; i += NTHREADS) {
            const int tau = (i >> 8) - 1, c = (i >> 4) & 15, cp = i & 15; float acc = 0.f;
            if (tau >= 0) {
#pragma unroll 8
                for (int p = 0; p < 64; ++p) {
                    const float cr = CR[c * 64 + p], ci = CI[c * 64 + p], ar = ApR[tau * 64 + p], ai = ApI[tau * 64 + p];
                    acc += (cr * ar - ci * ai) * BbR[p * 16 + cp] - (cr * ai + ci * ar) * BbI[p * 16 + cp]; }
            }
            Kt[i] = (f16)(acc * S5SC);
        }
    }
}
__device__ __forceinline__ void phase_s5ab(const Ctx& C, int l) {
    constexpr int SST = 273;
    const f16* U = (const f16*)(C.ws() + A_U); f16* X = (f16*)(C.ws() + A_S5X); const f16* Mt = (const f16*)(C.ws() + T_M);
    LAS float* Sl = (LAS float*)C.lds;
    LAS float* ex = Sl + 128 * SST;
    const int r32 = C.lane & 31, hi = C.lane >> 5;
    for (int item = C.bid; item < 256; item += C.nblk) {
        const int db = item, dirg = db >> 2, b = db & 3, dir = dirg >> 5, g = dirg & 31; const size_t gi = (size_t)(l * 2 + dir) * 32 + g;
        __syncthreads();
        for (int idx = C.wid; idx < 36; idx += NWAVES) {
            const int cb = idx >> 2, mb = idx & 3, nb = cb < 8 ? 8 * b + cb : 32 + (b >> 1);
            int bq, nmem; qp_split(nb * 32 + r32, bq, nmem);
            f16x8 uf[16], af[16];
#pragma unroll
            for (int sx = 0; sx < 16; ++sx) { uf[sx] = *(const f16x8*)(U + u3_off(g, nb, sx, hi, r32)); af[sx] = *(const f16x8*)(Mt + m3_off(dirg, mb, sx, hi, r32)); }
            f32x16 acc = {};
#pragma unroll
            for (int sx = 0; sx < 16; ++sx) acc = __builtin_amdgcn_mfma_f32_32x32x16_f16(af[sx], uf[sx], acc, 0, 0, 0);
            if (bq == b) {
#pragma unroll
                for (int r = 0; r < 16; ++r) Sl[(mb * 32 + fa::crow(r, hi)) * SST + nmem] = acc[r] * S5ISC;
            }
        }
        __syncthreads();
        const int p = C.lane, w = C.wid;
        const float are = C.in(I_SARE)[gi * 64 + p], aim = C.in(I_SAIM)[gi * 64 + p], dt = expf(C.in(I_SLDT)[gi]);
        const float mag = expf(are * dt * 16.0f), ang = (aim * dt) * 16.0f, ar = mag * cosf(ang), ai = mag * sinf(ang);
        const float mag32 = expf(are * dt * 512.0f), ang32 = (aim * dt) * 512.0f, br_ = mag32 * cosf(ang32), bi_ = mag32 * sinf(ang32);
        const LAS float* sr = Sl + p * SST; const LAS float* si = Sl + (64 + p) * SST;
        const int kkr = p >> 4, hf = (p >> 3) & 1, jj = p & 7;
        const int lo = dir == 0 ? 16 + 32 * w : 16 + 32 * (7 - w);
        float xr = 0.f, xi = 0.f;
#pragma unroll 4
        for (int e = 0; e < 16; ++e) {
            const int nmem = dir == 0 ? e : 15 - e;
            if (w == 0) { const int qp = 1024 + b * 16 + nmem;
                X[x3_off(dirg, qp >> 5, kkr, hf, qp & 31) + jj] = (f16)xr; X[x3_off(dirg, qp >> 5, 4 + kkr, hf, qp & 31) + jj] = (f16)xi; }
            const float sre = sr[nmem], sim = si[nmem];
            const float nxr = ar * xr - ai * xi + sre, nxi = ar * xi + ai * xr + sim; xr = nxr; xi = nxi;
        }
        const float c0r = xr, c0i = xi;
        xr = 0.f; xi = 0.f;
#pragma unroll 8
        for (int e = 0; e < 32; ++e) {
            const int nmem = lo + (dir == 0 ? e : 31 - e);
            const float sre = sr[nmem], sim = si[nmem];
            const float nxr = ar * xr - ai * xi + sre, nxi = ar * xi + ai * xr + sim; xr = nxr; xi = nxi;
        }
        ex[w * 128 + p] = xr; ex[w * 128 + 64 + p] = xi;
        __syncthreads();
        xr = c0r; xi = c0i;
        for (int v = 0; v < w; ++v) { const float er = ex[v * 128 + p], ei = ex[v * 128 + 64 + p];
            const float nxr = br_ * xr - bi_ * xi + er, nxi = br_ * xi + bi_ * xr + ei; xr = nxr; xi = nxi; }
#pragma unroll 8
        for (int e = 0; e < 32; ++e) {
            const int nmem = lo + (dir == 0 ? e : 31 - e), qp = b * 256 + nmem - 16;
            X[x3_off(dirg, qp >> 5, kkr, hf, qp & 31) + jj] = (f16)xr; X[x3_off(dirg, qp >> 5, 4 + kkr, hf, qp & 31) + jj] = (f16)xi;
            const float sre = sr[nmem], sim = si[nmem];
            const float nxr = ar * xr - ai * xi + sre, nxi = ar * xi + ai * xr + sim; xr = nxr; xi = nxi;
        }
    }
    __syncthreads();
}
__device__ __forceinline__ void phase_s5c(const Ctx& C, int l) {
    const f16* U = (const f16*)(C.ws() + A_U); const f16* X = (const f16*)(C.ws() + A_S5X); f16* G = (f16*)(C.ws() + A_G);
    const int r32 = C.lane & 31, hi = C.lane >> 5, t0 = 2 * C.wid, trow = t0 + (r32 >> 4), crw = r32 & 15;
    const int nnb = l == 0 ? 34 : 32;
    LAS f16* Kl = (LAS f16*)C.lds;
    int cur_g = -1; f16x8 ef[2][8];
    for (int u = C.bid; u < 32 * nnb; u += C.nblk) {
        const int g = u & 31, nb = u >> 5;
        const int row0 = (nb * 32 + r32) * 16;
        f16x8 uf[16], xf[2][8]; f16x4 u4[2][2];
#pragma unroll
        for (int sx = 0; sx < 16; ++sx) uf[sx] = *(const f16x8*)(U + u3_off(g, nb, sx, hi, r32));
#pragma unroll
        for (int dir = 0; dir < 2; ++dir)
#pragma unroll
            for (int kk = 0; kk < 8; ++kk) xf[dir][kk] = *(const f16x8*)(X + x3_off(dir * 32 + g, nb, kk, hi, r32));
#pragma unroll
        for (int tl = 0; tl < 2; ++tl)
#pragma unroll
            for (int gp = 0; gp < 2; ++gp) u4[tl][gp] = *(const f16x4*)(U + u3_off(g, nb, t0 + tl, gp, r32) + 4 * hi);
        if (g != cur_g) {
            __syncthreads();
            for (int i = C.tid; i < 2 * 17 * 256 / 8; i += NTHREADS) {
                const int dir = i / (17 * 32), j = i - dir * (17 * 32);
                *(LAS f16x8*)(Kl + (size_t)i * 8) = *(const f16x8*)((const f16*)(C.ws() + T_K) + (size_t)(dir * 32 + g) * 17 * 256 + j * 8);
            }
#pragma unroll
            for (int dir = 0; dir < 2; ++dir)
#pragma unroll
                for (int kk = 0; kk < 8; ++kk) ef[dir][kk] = *(const f16x8*)((const f16*)(C.ws() + T_E) + (size_t)(dir * 32 + g) * 16 * 16 * 128 + (size_t)(trow * 16 + crw) * 128 + kk * 16 + 8 * hi);
            __syncthreads();
            cur_g = g;
        }
        f32x16 acc = {};
        const LAS f16* kb = Kl + crw * 16 + 8 * hi;
#pragma unroll
        for (int sx = 0; sx < 16; ++sx) {
            if (sx <= t0 + 1) { const f16x8 af = *(const LAS f16x8*)(kb + (trow - sx + 1) * 256); acc = __builtin_amdgcn_mfma_f32_32x32x16_f16(af, uf[sx], acc, 0, 0, 0); }
            if (sx >= t0) { const f16x8 af = *(const LAS f16x8*)(kb + (17 + sx - trow + 1) * 256); acc = __builtin_amdgcn_mfma_f32_32x32x16_f16(af, uf[sx], acc, 0, 0, 0); }
        }
#pragma unroll
        for (int dir = 0; dir < 2; ++dir)
#pragma unroll
            for (int kk = 0; kk < 8; ++kk) acc = __builtin_amdgcn_mfma_f32_32x32x16_f16(ef[dir][kk], xf[dir][kk], acc, 0, 0, 0);
#pragma unroll
        for (int tl = 0; tl < 2; ++tl)
#pragma unroll
            for (int gp = 0; gp < 2; ++gp) {
                const size_t off = (size_t)(row0 + t0 + tl) * 512 + g * 16 + 4 * hi + 8 * gp;
                const f32x4 d4 = *(const f32x4*)(C.in(I_SD) + l * 512 + g * 16 + 4 * hi + 8 * gp);
                f32x4 y;
#pragma unroll
                for (int e = 0; e < 4; ++e) y[e] = gelu_tanh(acc[8 * tl + 4 * gp + e] * S5ISC + d4[e] * (float)u4[tl][gp][e]);
                *(f16x4*)(G + off) = pack4(y);
            }
    }
}

typedef __attribute__((address_space(1))) unsigned gu32;
#define XB_TMO      128
#define XB_XCNT(j)  (256  + 64 * (j))
#define XB_XSUB(j)  (1280 + 64 * (j))
#define XB_XGEN(j)  (2304 + 64 * (j))
#define XB_TOP      3328
#define XB_TOPGEN   3392
#define XCD_BAR_WORDS 3456
#define XB_SPIN_CAP (1u << 26)

__device__ __forceinline__ unsigned xb_ld(unsigned* p)              { return __hip_atomic_load(p, __ATOMIC_RELAXED, __HIP_MEMORY_SCOPE_AGENT); }
__device__ __forceinline__ unsigned xb_add(unsigned* p, unsigned v) { return __hip_atomic_fetch_add(p, v, __ATOMIC_RELAXED, __HIP_MEMORY_SCOPE_AGENT); }
__device__ __forceinline__ unsigned xb_xcc_id() { return (unsigned)__builtin_amdgcn_s_getreg((3 << 11) | 20) & 0xFu; }
#define XB_SPIN(cond, bar) do { unsigned _sp = 0; while (cond) { __builtin_amdgcn_s_sleep(1); \
    if ((++_sp & 255u) == 0u) { if (xb_ld(&(bar)[XB_TMO])) break; if (_sp > XB_SPIN_CAP) { atomicAdd(&(bar)[XB_TMO], 1u); break; } } } } while (0)

struct XcdBarrier {
    unsigned* bar; unsigned x;
    volatile LAS unsigned* st;
};

__device__ __forceinline__ XcdBarrier xcd_barrier_post(unsigned* bar, volatile LAS unsigned* st) {
    XcdBarrier b; b.bar = bar; b.x = xb_xcc_id(); b.st = st;
    if (threadIdx.x == 0) (void)xb_add(&bar[XB_XCNT(b.x)], 1u);
    return b;
}
__device__ __forceinline__ void xcd_barrier_complete(unsigned* bar, unsigned x, unsigned& nloc, unsigned& nx) {
    const unsigned G = gridDim.x * gridDim.y * gridDim.z;
    unsigned sum, cnt, mine, sp = 0u;
    for (;;) {
        sum = 0u; cnt = 0u; mine = 0u;
#pragma unroll
        for (unsigned j = 0; j < 16; ++j) { const unsigned c = xb_ld(&bar[XB_XCNT(j)]); sum += c; cnt += (c > 0u) ? 1u : 0u; mine = (j == x) ? c : mine; }
        if (sum == G) break;
        __builtin_amdgcn_s_sleep(1);
        if ((++sp & 255u) == 0u) { if (xb_ld(&bar[XB_TMO])) break; if (sp > XB_SPIN_CAP) { atomicAdd(&bar[XB_TMO], 1u); break; } }
    }
    nloc = mine > 0u ? mine : 1u; nx = cnt > 0u ? cnt : 1u;
}

__device__ __forceinline__ void xcd_barrier(const XcdBarrier& b, const bool t0) {
    asm volatile("s_waitcnt vmcnt(0)" ::: "memory");
    __syncthreads();
    if (t0) {
        unsigned* bar = b.bar;
        __builtin_amdgcn_s_waitcnt(0);
        unsigned nloc = b.st[0], nx = b.st[1];
        if (nloc == 0u) { xcd_barrier_complete(bar, b.x, nloc, nx); b.st[0] = nloc; b.st[1] = nx; }
        const unsigned old = xb_add(&bar[XB_XSUB(b.x)], 1u);
        const unsigned gen = old / nloc;
        if (old + 1u == (gen + 1u) * nloc) {
            __builtin_amdgcn_fence(__ATOMIC_RELEASE, "agent");
            asm volatile("s_waitcnt vmcnt(0)" ::: "memory");
            const unsigned og = xb_add(&bar[XB_TOP], 1u);
            const unsigned tg = og / nx;
            if (og + 1u == (tg + 1u) * nx) xb_add(&bar[XB_TOPGEN], 1u);
            else XB_SPIN(xb_ld(&bar[XB_TOPGEN]) == tg, bar);
            __builtin_amdgcn_fence(__ATOMIC_ACQUIRE, "agent");
            xb_add(&bar[XB_XGEN(b.x)], 1u);
            asm volatile("s_waitcnt vmcnt(0)" ::: "memory");
        } else {
            XB_SPIN(xb_ld(&bar[XB_XGEN(b.x)]) == gen, bar);
            __builtin_amdgcn_fence(__ATOMIC_ACQUIRE, "agent");
            asm volatile("s_waitcnt vmcnt(0)" ::: "memory");
        }
    }
    __syncthreads();
}

#ifndef PROBE_PH
#define PROBE_PH -1
#endif
struct Env { XcdBarrier bar; int wid; unsigned long long t_acc; };
#ifndef PROBE_L
#define PROBE_L -1
#endif
#define PH_BEGIN(k) unsigned long long _t0 = 0; if (PROBE_PH == (k) && (PROBE_L < 0 || PROBE_L == l)) _t0 = __builtin_amdgcn_s_memrealtime()
#define PH_END(k) if (PROBE_PH == (k) && (PROBE_L < 0 || PROBE_L == l)) env.t_acc += __builtin_amdgcn_s_memrealtime() - _t0
#define GSYNC() do { const Ctx Cb = make_ctx(env.wid); xcd_barrier(env.bar, Cb.tid == 0); } while (0)
constexpr int MISC_OFF = LDS_BYTES - 256;
constexpr int CW_BAR = 4096;
#define CTX() const Ctx C = make_ctx(env.wid); unsigned char* ws = C.ws()
template <int l>
__device__ __forceinline__ void layer_body(Env& env) {
        const int mrows = l == 0 ? MALL : NLAT;
        if (l == 0) { PH_BEGIN(0);
        { CTX(); (void)ws; phase_p1(C, 0); }
        GSYNC(); PH_END(0); }
        { PH_BEGIN(1);
        { CTX(); EpiProj E{(f16*)(ws + A_PROJ), (f16*)(ws + A_VA), (f16*)(ws + A_U)};
          gemm_pg8(C, (const f16*)(ws + A_H), D, (const f16*)(ws + W_INA), D, MALL, 2560, D, E); }
        GSYNC(); PH_END(1); }
        { PH_BEGIN(2);
        { CTX(); (void)ws; phase_p3(C, l); }
        GSYNC(); PH_END(2); }
        { PH_BEGIN(3);
        { CTX(); EpiKvUp E1{(f16*)(ws + A_KC), (f16*)(ws + A_VC)};
          gemm_rows(C, (const f16*)(ws + A_PROJ) + PC_CKV, PLD2, (const f16*)(ws + W_KVB), 256, MALL, 1024, 256, E1); }
        { CTX(); EpiQUp E2{(f16*)(ws + A_QC), (const float*)(ws + WS_ROPE) + 2048};
          gemm_pg8(C, (const f16*)(ws + A_PROJ) + PC_CQ, PLD2, (const f16*)(ws + W_QB), 768, mrows, 768, 768, E2); }
        GSYNC(); PH_END(3); }
        { PH_BEGIN(4);
        { CTX(); (void)ws; phase_s5ab(C, l); }
        { CTX(); (void)ws; phase_attn_flash(C, l); }
        GSYNC(); PH_END(4); }
        { PH_BEGIN(6);
        { CTX(); (void)ws; phase_s5c(C, l); }
        GSYNC(); PH_END(6); }
        { PH_BEGIN(7);
        { CTX(); EpiGlu E{(f16*)(ws + A_YS)};
          gemm_rows(C, (const f16*)(ws + A_G), 512, (const f16*)(ws + W_GLU), 512, mrows, 1024, 512, E); }
        GSYNC(); PH_END(7); }
        { PH_BEGIN(8);
        {
            CTX();
            const f16* Hh = (const f16*)(ws + A_H); const f16* Wg = (const f16*)(ws + W_GATE); const f16* Wb = (const f16*)(ws + W_BR);
            const f16* Y0 = (const f16*)(ws + A_YA); const f16* Y1 = (const f16*)(ws + A_YS); const f16* Y2 = (const f16*)(ws + A_YC);
            EpiGate Eg{(f16*)(ws + A_GATE)}; EpiBranch Eb0{(const f16*)(ws + A_GATE), (f16*)(ws + A_MERGED), 1}; EpiBranch Eb{(const f16*)(ws + A_GATE), (f16*)(ws + A_MERGED), 0};
            constexpr size_t WGS = (size_t)1024 * 1024, WBS = (size_t)1024 * 512;
            gemm_pg8c<false, true>(C, Hh, D, Wg, D, NLAT, 1024, D, Eg, Y0, 512, Wb, 512);
            gemm_pg8c<true, true>(C, Y0, 512, Wb, 512, NLAT, 1024, 512, Eb0, Hh, D, Wg + WGS, D);
            gemm_pg8c<true, true>(C, Hh, D, Wg + WGS, D, NLAT, 1024, D, Eg, Y1, 512, Wb + WBS, 512);
            gemm_pg8c<true, true>(C, Y1, 512, Wb + WBS, 512, NLAT, 1024, 512, Eb, Hh, D, Wg + 2 * WGS, D);
            gemm_pg8c<true, true>(C, Hh, D, Wg + 2 * WGS, D, NLAT, 1024, D, Eg, Y2, 512, Wb + 2 * WBS, 512);
            gemm_pg8c<true, false>(C, Y2, 512, Wb + 2 * WBS, 512, NLAT, 1024, 512, Eb, Hh, D, Wg, D);
        }
        if (mrows > NLAT) {
#pragma unroll
            for (int br = 0; br < 3; ++br) {
                { CTX(); EpiGate Eg{(f16*)(ws + A_GATE)};
                  gemm_small(C, (const f16*)(ws + A_H) + (size_t)NLAT * D, D, (const f16*)(ws + W_GATE) + (size_t)br * 1024 * 1024, D, NLAT, 1024, D, Eg); }
                { CTX(); const f16* Y = (const f16*)(ws + (br == 0 ? A_YA : br == 1 ? A_YS : A_YC));
                  EpiBranch Eb{(const f16*)(ws + A_GATE), (f16*)(ws + A_MERGED), br == 0};
                  gemm_small(C, Y + (size_t)NLAT * 512, 512, (const f16*)(ws + W_BR) + (size_t)br * 1024 * 512, 512, NLAT, 1024, 512, Eb); }
            }
        }
        GSYNC(); PH_END(8); }
        { PH_BEGIN(9);
        { CTX(); EpiWout E{&C, l}; gemm_rows(C, (const f16*)(ws + A_MERGED), D, (const f16*)(ws + W_OUT), D, mrows, 1024, D, E); }
        GSYNC(); PH_END(9); }
        { PH_BEGIN(10);
        { CTX(); (void)ws; phase_p10(C, l, mrows); }
        GSYNC(); PH_END(10); }
        { PH_BEGIN(11);
        { CTX(); EpiUp E{(f16*)(ws + A_HID)}; gemm_rows(C, (const f16*)(ws + A_H), D, (const f16*)(ws + W_UP), D, mrows, DFF, D, E); }
        GSYNC(); PH_END(11); }
        { PH_BEGIN(12);
        { CTX(); EpiDown E{&C, l}; gemm_rows(C, (const f16*)(ws + A_HID), DFF, (const f16*)(ws + W_DOWN), DFF, mrows, 1024, DFF, E); }
        GSYNC(); PH_END(12); }
        { PH_BEGIN(13);
        if (l == 0) { CTX(); (void)ws; if (C.nblk > 128) { if (C.bid < 64) phase_s5tab(C, 1); else phase_cvt(C, 1, 64); } else { phase_s5tab(C, 1); __syncthreads(); phase_cvt(C, 1, 0); } }
        { CTX(); (void)ws; phase_p13(C, l, mrows); }
        if (l == 0) GSYNC(); PH_END(13); }
}
__global__ void __launch_bounds__(NTHREADS, 2) fwd_all(Args args) {
    cg::grid_group grid = cg::this_grid();
    extern __shared__ __attribute__((aligned(16))) unsigned char lds_raw[];
    volatile LAS unsigned* MISC = (volatile LAS unsigned*)((LAS unsigned char*)lds_raw + MISC_OFF);
    if (threadIdx.x < 64) MISC[threadIdx.x] = 0u;
    __syncthreads();
    Env env; env.t_acc = 0; env.wid = __builtin_amdgcn_readfirstlane(threadIdx.x >> 6);
    env.bar = xcd_barrier_post((unsigned*)(args.ws + WS_CTL) + CW_BAR, MISC + 8);
    { CTX(); (void)ws; if (C.nblk > 128) { if (C.bid < 64) phase_s5tab(C, 0); else { phase_setup(C, 64); __syncthreads(); phase_cvt(C, 0, 64); } } else { phase_setup(C, 0); __syncthreads(); phase_s5tab(C, 0); __syncthreads(); phase_cvt(C, 0, 0); } }
    asm volatile("s_waitcnt vmcnt(0)" ::: "memory");
    grid.sync();
    __builtin_amdgcn_fence(__ATOMIC_ACQUIRE, "agent");
    asm volatile("s_waitcnt vmcnt(0)" ::: "memory");
    layer_body<0>(env);
    layer_body<1>(env);
    if (PROBE_PH >= 0 && blockIdx.x == 0) { const unsigned long long t0 = __builtin_amdgcn_s_memrealtime(); while (__builtin_amdgcn_s_memrealtime() - t0 < 8ull * env.t_acc) __builtin_amdgcn_s_sleep(8); }
}

extern "C" void kernel_launch(void* const* d_in, const int* in_sizes, int n_in, void* d_out, int out_size, void* d_ws, size_t ws_size, hipStream_t stream) {
    static int grid_blocks = 0;
    if (grid_blocks == 0) {
        if (n_in != 32 || out_size != NLAT * D || ws_size < WS_NEED) { fprintf(stderr, "kernel_launch: unexpected shapes n_in %d out %d ws %zu (need %zu)\n", n_in, out_size, ws_size, (size_t)WS_NEED); grid_blocks = -1; return; }
        int dev = 0, cus = 0, per_cu = 0;
        hipGetDevice(&dev);
        hipDeviceGetAttribute(&cus, hipDeviceAttributeMultiprocessorCount, dev);
        if (hipFuncSetAttribute((const void*)fwd_all, hipFuncAttributeMaxDynamicSharedMemorySize, LDS_BYTES) != hipSuccess) { fprintf(stderr, "kernel_launch: hipFuncSetAttribute failed\n"); grid_blocks = -1; return; }
        hipOccupancyMaxActiveBlocksPerMultiprocessor(&per_cu, (const void*)fwd_all, NTHREADS, LDS_BYTES);
        if (per_cu < 1) { fprintf(stderr, "kernel_launch: occupancy query says %d blocks per CU\n", per_cu); grid_blocks = -1; return; }
        grid_blocks = cus;
    }
    if (grid_blocks < 0) return;
    Args a{};
    for (int i = 0; i < 32; ++i) a.in[i] = (const float*)d_in[i];
    a.out = (float*)d_out; a.ws = (unsigned char*)d_ws;
    if (hipMemsetAsync((char*)d_ws + WS_CTL, 0, 1 * MiB, stream) != hipSuccess) { fprintf(stderr, "kernel_launch: hipMemsetAsync failed\n"); return; }
    void* kargs[] = {&a};
    const hipError_t e = hipLaunchCooperativeKernel((const void*)fwd_all, dim3(grid_blocks), dim3(NTHREADS), kargs, LDS_BYTES, stream);
    if (e != hipSuccess) fprintf(stderr, "kernel_launch: cooperative launch failed: %s (grid %d)\n", hipGetErrorString(e), grid_blocks);
}
```

```cpp
#include <hip/hip_runtime.h>
#include <hip/hip_cooperative_groups.h>
#include <cstdio>
#include <cstdint>
#include <cmath>

namespace cg = cooperative_groups;

#define LAS __attribute__((address_space(3)))
typedef _Float16 f16;
typedef _Float16 f16x8 __attribute__((ext_vector_type(8)));
typedef _Float16 f16x4 __attribute__((ext_vector_type(4)));
typedef float f32x4 __attribute__((ext_vector_type(4)));
typedef float f32x16 __attribute__((ext_vector_type(16)));

constexpr int D = 1024, NB = 4, SEQ = 4096, CTX = 256, NLAT = NB * SEQ, NCTX = NB * CTX, MALL = NLAT + NCTX;
constexpr int NKEY = CTX + SEQ;
constexpr int OFF_AK = 0, OFF_AV = 128, OFF_CKV = 256, OFF_CKR = 512, OFF_U = 544, OFF_AQ = 1056, OFF_CQ = 1568, OFF_GATE = 2336, N_IN = 5408;
constexpr int GC_AV = 128, GC_CKV = 256, GC_CKR = 512, GC_PAD = 544, GC_U = 768, GC_AQ = 1280, GC_CQ = 1792;
constexpr int PC_AK = 0, PC_CKV = 128, PC_CKR = 384, PC_AQ = 416, PC_CQ = 928, PLD2 = 1696;
constexpr int DFF = 4096;
constexpr float EPS = 1e-6f;
constexpr float ALPHA = 1.4142135623730951f;
constexpr float LOG2E = 1.4426950408889634f;
constexpr float QSCALE_A = 0.125f * LOG2E;
constexpr float QSCALE_C = 0.10206207261596575f * LOG2E;

constexpr size_t MiB = 1u << 20;
constexpr size_t WS_CTL = 0;
constexpr size_t WS_MOD = 1 * MiB;
constexpr size_t WS_ROPE = 1 * MiB + 512 * 1024;
constexpr size_t WS_W16 = 2 * MiB;
constexpr size_t W_INA = WS_W16;
constexpr size_t W_GATE = W_INA + (size_t)2560 * 1024 * 2;
constexpr size_t W_QB = W_GATE + (size_t)3072 * 1024 * 2;
constexpr size_t W_KVB = W_QB + (size_t)768 * 768 * 2;
constexpr size_t W_GLU = W_KVB + (size_t)1024 * 256 * 2;
constexpr size_t W_BR = W_GLU + (size_t)1024 * 512 * 2;
constexpr size_t W_OUT = W_BR + (size_t)3 * 1024 * 512 * 2;
constexpr size_t W_UP = W_OUT + (size_t)1024 * 1024 * 2;
constexpr size_t W_DOWN = W_UP + (size_t)4096 * 1024 * 2;
constexpr size_t W_END = W_DOWN + (size_t)1024 * 4096 * 2;
constexpr size_t WS_TACTX = 37 * MiB;
constexpr size_t WS_ACT = 41 * MiB;
static_assert(W_END <= WS_TACTX, "weights fit");
constexpr size_t A_H = WS_ACT + 0 * MiB;
constexpr size_t A_PROJ = WS_ACT + 34 * MiB;
constexpr size_t A_YC = WS_ACT + 34 * MiB;
constexpr size_t A_T1H = WS_ACT + 34 * MiB;
constexpr size_t A_G = WS_ACT + 68 * MiB;
constexpr size_t A_YS = WS_ACT + 51 * MiB;
constexpr size_t A_HID = WS_ACT + 68 * MiB;
constexpr size_t A_QA = WS_ACT + 91 * MiB;
constexpr size_t A_YA = A_QA;
constexpr size_t A_QC = WS_ACT + 108 * MiB;
constexpr size_t A_S5X = WS_ACT + 51 * MiB;
constexpr size_t A_GATE = WS_ACT + 108 * MiB;
constexpr size_t A_KA = WS_ACT + 134 * MiB;
constexpr size_t A_VA = A_KA + (size_t)NB * 2 * NKEY * 64 * 2;
constexpr size_t A_U = WS_ACT + 143 * MiB;
constexpr size_t A_MERGED = WS_ACT + 143 * MiB;
constexpr size_t A_KC = WS_ACT + 160 * MiB;
constexpr size_t A_VC = WS_ACT + 186 * MiB;
constexpr size_t WS_ST1 = 1 * MiB + 768 * 1024;
constexpr size_t T_K = WS_ACT + 205 * MiB;
constexpr size_t T_E = T_K + (size_t)64 * 17 * 256 * 2;
constexpr size_t T_M = T_E + (size_t)64 * 16 * 16 * 128 * 2;
constexpr size_t WS_NEED = WS_ACT + 215 * MiB;
static_assert(T_M + (size_t)64 * 128 * 256 * 2 <= WS_NEED, "s5 tables");
static_assert(A_PROJ + (size_t)MALL * PLD2 * 2 <= A_QA && A_VA + (size_t)NB * 2 * NKEY * 64 * 2 <= A_U && A_VC + 17 * MiB <= T_K && A_HID + 136 * MiB <= T_K && A_MERGED + 34 * MiB <= T_K && A_GATE + 34 * MiB <= A_MERGED, "ws map");
static_assert(WS_NEED <= 256 * MiB, "ws budget");

constexpr int LDS_BYTES = 147456;
constexpr int NTHREADS = 512, NWAVES = 8;

struct Args {
    const float* in[32];
    float* out;
    unsigned char* ws;
    int ph_lo, ph_hi;
};
enum { I_X = 0, I_C, I_CTX, I_CCTX, I_WMOD, I_BMOD, I_WIN, I_AQG, I_AKG, I_CQG, I_CKVG, I_WQB, I_WKVB, I_SARE, I_SAIM, I_SLDT, I_SBRE, I_SBIM, I_SCRE, I_SCIM,
       I_SD, I_WGLU, I_WBA, I_WBS, I_WBC, I_WOUT, I_LN1G, I_LN1B, I_WUP, I_WDOWN, I_LN2G, I_LN2B };

template <int CTRL> __device__ __forceinline__ float dpp_mov(float v) { return __builtin_bit_cast(float, __builtin_amdgcn_update_dpp(0, __builtin_bit_cast(int, v), CTRL, 0xF, 0xF, true)); }
__device__ __forceinline__ float lane_bcast(float v, int l) { return __builtin_bit_cast(float, __builtin_amdgcn_readlane(__builtin_bit_cast(int, v), l)); }
__device__ __forceinline__ float wave_sum(float v) {
    v += dpp_mov<0xB1>(v); v += dpp_mov<0x4E>(v); v += dpp_mov<0x141>(v); v += dpp_mov<0x140>(v);
    return (lane_bcast(v, 0) + lane_bcast(v, 16)) + (lane_bcast(v, 32) + lane_bcast(v, 48));
}
__device__ __forceinline__ float wave_max(float v) {
#pragma unroll
    for (int o = 1; o < 64; o <<= 1) v = fmaxf(v, __shfl_xor(v, o));
    return v;
}
__device__ __forceinline__ float sigmoidf_(float x) { return 1.0f / (1.0f + __expf(-x)); }
__device__ __forceinline__ float gelu_tanh(float x) {
    const float u = 0.7978845608028654f * (x + 0.044715f * x * x * x);
    const float e = __expf(2.0f * u);
    const float t = 1.0f - 2.0f / (e + 1.0f);
    return 0.5f * x * (1.0f + t);
}
__device__ __forceinline__ f16x8 pack8(f32x4 lo, f32x4 hi) {
    f16x8 r; r[0] = (f16)lo[0]; r[1] = (f16)lo[1]; r[2] = (f16)lo[2]; r[3] = (f16)lo[3]; r[4] = (f16)hi[0]; r[5] = (f16)hi[1]; r[6] = (f16)hi[2]; r[7] = (f16)hi[3]; return r;
}
__device__ __forceinline__ f16x4 pack4(f32x4 v) { f16x4 r; r[0] = (f16)v[0]; r[1] = (f16)v[1]; r[2] = (f16)v[2]; r[3] = (f16)v[3]; return r; }

struct RowInfo { int b, t, pos, lat, mrow; };
__device__ __forceinline__ RowInfo row_info(int r) {
    RowInfo o;
    if (r < NLAT) { o.lat = 1; o.b = r >> 12; o.t = r & 4095; o.pos = CTX + o.t; o.mrow = o.b; }
    else { const int rr = r - NLAT; o.lat = 0; o.b = rr >> 8; o.t = rr & 255; o.pos = o.t; o.mrow = 4; }
    return o;
}

#define CAS __attribute__((address_space(4)))
struct Ctx {
    const CAS unsigned char* kp; LAS unsigned char* lds;
    int tid, lane, wid, nblk, bid;
    __device__ __forceinline__ const float* in(int i) const { return *(const float* const CAS*)(kp + 8 * i); }
    __device__ __forceinline__ float* out() const { return *(float* const CAS*)(kp + 256); }
    __device__ __forceinline__ unsigned char* ws() const { return *(unsigned char* const CAS*)(kp + 264); }
    __device__ __forceinline__ const float* mod(int l, int mrow, int which) const { return (const float*)(ws() + WS_MOD) + ((size_t)(l * 5 + mrow) * 6 + which) * D; }
    __device__ __forceinline__ const float* xsrc(int l, int r) const {
        if (l == 0) return r < NLAT ? in(I_X) + (size_t)r * D : in(I_CTX) + (size_t)(r - NLAT) * D;
        return r < NLAT ? out() + (size_t)r * D : (const float*)(ws() + WS_TACTX) + (size_t)(r - NLAT) * D;
    }
    __device__ __forceinline__ float* ta(int r) const { return r < NLAT ? out() + (size_t)r * D : (float*)(ws() + WS_TACTX) + (size_t)(r - NLAT) * D; }
};
__device__ __forceinline__ Ctx make_ctx(int wid) {
    extern __shared__ __attribute__((aligned(16))) unsigned char lds_raw[];
    Ctx C;
    const CAS unsigned char* kp = (const CAS unsigned char*)__builtin_amdgcn_kernarg_segment_ptr();
    asm volatile("" : "+s"(kp));
    C.kp = kp; C.lds = (LAS unsigned char*)lds_raw;
    int lane = __builtin_amdgcn_mbcnt_hi(~0u, __builtin_amdgcn_mbcnt_lo(~0u, 0u)); asm volatile("" : "+v"(lane));
    asm volatile("" : "+s"(wid));
    C.tid = wid * 64 + lane; C.lane = lane; C.wid = wid;
    int bid = blockIdx.x; asm volatile("" : "+s"(bid));
    C.bid = bid; C.nblk = gridDim.x;
    return C;
}

__device__ __forceinline__ void phase_setup(const Ctx& C, int b0) {
    LAS float* sv = (LAS float*)C.lds;
    LAS float* red = sv + 5 * 1024;
    for (int i = C.tid; i < 5 * 1024; i += NTHREADS) {
        const int mr = i >> 10, k = i & 1023;
        const float v = mr < 4 ? C.in(I_C)[mr * D + k] : C.in(I_CCTX)[k];
        sv[i] = v / (1.0f + __expf(-v));
    }
    __syncthreads();
    for (int u = C.bid - b0; u < 192; u += C.nblk - b0) {
        const int l = u / 96, n0 = (u % 96) * 64;
        const float* W = C.in(I_WMOD) + (size_t)l * D * 6144 + n0 + C.lane;
        float acc[5] = {0.f, 0.f, 0.f, 0.f, 0.f};
        const int kb = C.wid * 128;
#pragma unroll 8
        for (int k = 0; k < 128; ++k) {
            const float w = W[(size_t)(kb + k) * 6144];
#pragma unroll
            for (int m = 0; m < 5; ++m) acc[m] += sv[m * 1024 + kb + k] * w;
        }
#pragma unroll
        for (int m = 0; m < 5; ++m) red[(C.wid * 5 + m) * 64 + C.lane] = acc[m];
        __syncthreads();
        if (C.tid < 320) {
            const int m = C.tid >> 6, c = C.tid & 63; float s = 0.f;
#pragma unroll
            for (int w = 0; w < 8; ++w) s += red[(w * 5 + m) * 64 + c];
            ((float*)(C.ws() + WS_MOD))[(size_t)(l * 5 + m) * 6144 + n0 + c] = s + C.in(I_BMOD)[l * 6144 + n0 + c];
        }
        __syncthreads();
    }
    if (C.bid == C.nblk - 1) {
        float* ra = (float*)(C.ws() + WS_ROPE);
        for (int i = C.tid; i < 1024; i += NTHREADS) {
            const int pos = i >> 4, f = i & 15;
            const float inv = powf(10000.0f, -(float)(2 * f) / 32.0f);
            const float ang = (float)pos * inv;
            ra[i] = cosf(ang); ra[1024 + i] = sinf(ang);
        }
        for (int i = C.tid; i < 512; i += NTHREADS) {
            const int pos = i >> 3, f = i & 7;
            const float inv = powf(10000.0f, -(float)(2 * f) / 16.0f);
            const float ang = (float)pos * inv;
            ra[2048 + i] = cosf(ang); ra[2048 + 512 + i] = sinf(ang);
        }
    }
}

__device__ __forceinline__ int glu_row(int n) { const int isg = n >= 512, j = n & 511; return 8 * (j >> 2) + 4 * isg + (j & 3); }
__device__ __forceinline__ void cvt_load(const float* W, int ldw, int coff, int nblk, int item, int lane, f32x4 (&v)[8]) {
    const int kb = item / nblk, nb = item % nblk, k0 = 64 * kb, n0 = 32 * nb;
#pragma unroll
    for (int i = 0; i < 8; ++i) v[i] = *(const f32x4*)(W + (size_t)(k0 + 8 * i + (lane >> 3)) * ldw + coff + n0 + 4 * (lane & 7));
}
__device__ __forceinline__ void cvt_store(const f32x4 (&v)[8], int K, int nblk, f16* WT, int mode, LAS float* scr, int item, int lane) {
    const int kb = item / nblk, nb = item % nblk, k0 = 64 * kb, n0 = 32 * nb;
#pragma unroll
    for (int i = 0; i < 8; ++i) { LAS float* d = scr + (8 * i + (lane >> 3)) * 33 + 4 * (lane & 7); d[0] = v[i][0]; d[1] = v[i][1]; d[2] = v[i][2]; d[3] = v[i][3]; }
    asm volatile("s_waitcnt lgkmcnt(0)" ::: "memory");
    const int c = lane & 7;
#pragma unroll
    for (int j = 0; j < 4; ++j) {
        const int n = (lane >> 3) + 8 * j; const LAS float* sp = scr + (8 * c) * 33 + n;
        f16x8 o;
#pragma unroll
        for (int e = 0; e < 8; ++e) o[e] = (f16)sp[e * 33];
        const int nn = n0 + n; const int row = mode ? glu_row(nn) : nn;
        *(f16x8*)(WT + (size_t)row * K + k0 + 8 * c) = o;
    }
    asm volatile("s_waitcnt lgkmcnt(0)" ::: "memory");
}
__device__ __forceinline__ void cvt_mat(const Ctx& C, const float* src, int ldw, int coff, int K, int N, size_t dst, int mode, int& base, int b0) {
    LAS float* scr = (LAS float*)C.lds + C.wid * (64 * 33);
    const int gw = (C.bid - b0) * NWAVES + C.wid, ngw = (C.nblk - b0) * NWAVES;
    const int nblk = N / 32, items = (K / 64) * nblk;
    int first = gw - (base % ngw); if (first < 0) first += ngw;
    f16* WT = (f16*)(C.ws() + dst);
    f32x4 va[8], vb[8];
    if (first < items) cvt_load(src, ldw, coff, nblk, first, C.lane, va);
    for (int it = first; it < items; it += 2 * ngw) {
        const int it2 = it + ngw, it3 = it + 2 * ngw;
        if (it2 < items) cvt_load(src, ldw, coff, nblk, it2, C.lane, vb);
        cvt_store(va, K, nblk, WT, mode, scr, it, C.lane);
        if (it3 < items) cvt_load(src, ldw, coff, nblk, it3, C.lane, va);
        if (it2 < items) cvt_store(vb, K, nblk, WT, mode, scr, it2, C.lane);
    }
    base += items;
}
__device__ __forceinline__ void phase_cvt(const Ctx& C, int l, int b0) {
    int base = 0;
    cvt_mat(C, C.in(I_WIN) + (size_t)l * D * N_IN, N_IN, 0, D, GC_PAD, W_INA, 0, base, b0);
    cvt_mat(C, C.in(I_WIN) + (size_t)l * D * N_IN, N_IN, GC_PAD, D, OFF_GATE - GC_PAD, W_INA + (size_t)GC_U * 1024 * 2, 0, base, b0);
    cvt_mat(C, C.in(I_WIN) + (size_t)l * D * N_IN, N_IN, OFF_GATE, D, 3072, W_GATE, 0, base, b0);
    cvt_mat(C, C.in(I_WQB) + (size_t)l * 768 * 768, 768, 0, 768, 768, W_QB, 0, base, b0);
    cvt_mat(C, C.in(I_WKVB) + (size_t)l * 256 * 1024, 1024, 0, 256, 1024, W_KVB, 0, base, b0);
    cvt_mat(C, C.in(I_WGLU) + (size_t)l * 512 * 1024, 1024, 0, 512, 1024, W_GLU, 1, base, b0);
    cvt_mat(C, C.in(I_WBA) + (size_t)l * 512 * 1024, 1024, 0, 512, 1024, W_BR, 0, base, b0);
    cvt_mat(C, C.in(I_WBS) + (size_t)l * 512 * 1024, 1024, 0, 512, 1024, W_BR + (size_t)1024 * 512 * 2, 0, base, b0);
    cvt_mat(C, C.in(I_WBC) + (size_t)l * 512 * 1024, 1024, 0, 512, 1024, W_BR + (size_t)2 * 1024 * 512 * 2, 0, base, b0);
    cvt_mat(C, C.in(I_WOUT) + (size_t)l * 1024 * 1024, 1024, 0, 1024, 1024, W_OUT, 0, base, b0);
    cvt_mat(C, C.in(I_WUP) + (size_t)l * 1024 * 4096, 4096, 0, 1024, 4096, W_UP, 0, base, b0);
    cvt_mat(C, C.in(I_WDOWN) + (size_t)l * 4096 * 1024, 1024, 0, 4096, 1024, W_DOWN, 0, base, b0);
    f16* pad = (f16*)(C.ws() + W_INA) + (size_t)GC_PAD * 1024;
    const f16x8 z = {0, 0, 0, 0, 0, 0, 0, 0};
    for (int i = (C.bid - b0) * NTHREADS + C.tid; i < (GC_U - GC_PAD) * 1024 / 8; i += (C.nblk - b0) * NTHREADS) ((f16x8*)pad)[i] = z;
}

__device__ __forceinline__ void row_load(const float* p, int lane, f32x4 (&v)[4]) {
#pragma unroll
    for (int j = 0; j < 4; ++j) v[j] = ((const f32x4*)p)[lane + 64 * j];
}
__device__ __forceinline__ void row_ln(f32x4 (&v)[4]) {
    float s = 0.f;
#pragma unroll
    for (int j = 0; j < 4; ++j) s += (v[j][0] + v[j][1]) + (v[j][2] + v[j][3]);
    const float mean = wave_sum(s) * (1.0f / D);
    float q = 0.f;
#pragma unroll
    for (int j = 0; j < 4; ++j) { v[j] = v[j] - mean; q += (v[j][0] * v[j][0] + v[j][1] * v[j][1]) + (v[j][2] * v[j][2] + v[j][3] * v[j][3]); }
    const float rstd = 1.0f / sqrtf(wave_sum(q) * (1.0f / D) + EPS);
#pragma unroll
    for (int j = 0; j < 4; ++j) v[j] = v[j] * rstd;
}
__device__ __forceinline__ void row_ln_stats(f32x4 (&v)[4], float& mean, float& rstd) {
    float s = 0.f;
#pragma unroll
    for (int j = 0; j < 4; ++j) s += (v[j][0] + v[j][1]) + (v[j][2] + v[j][3]);
    mean = wave_sum(s) * (1.0f / D);
    float q = 0.f;
#pragma unroll
    for (int j = 0; j < 4; ++j) { v[j] = v[j] - mean; q += (v[j][0] * v[j][0] + v[j][1] * v[j][1]) + (v[j][2] * v[j][2] + v[j][3] * v[j][3]); }
    rstd = 1.0f / sqrtf(wave_sum(q) * (1.0f / D) + EPS);
#pragma unroll
    for (int j = 0; j < 4; ++j) v[j] = v[j] * rstd;
}
__device__ __forceinline__ void row_load_h(const f16* p, int lane, f32x4 (&v)[4]) {
#pragma unroll
    for (int j = 0; j < 4; ++j) { const f16x4 h = ((const f16x4*)p)[lane + 64 * j]; v[j] = (f32x4){(float)h[0], (float)h[1], (float)h[2], (float)h[3]}; }
}
__device__ __forceinline__ void row_modulate_store(const f32x4 (&v)[4], const float* sh, const float* sc, f16* o, int lane) {
#pragma unroll
    for (int j = 0; j < 4; ++j) {
        const f32x4 s = ((const f32x4*)sc)[lane + 64 * j], t = ((const f32x4*)sh)[lane + 64 * j];
        const f32x4 y = v[j] * (s + 1.0f) + t;
        ((f16x4*)o)[lane + 64 * j] = pack4(y);
    }
}
__device__ __forceinline__ void phase_p1(const Ctx& C, int l) {
    f16* H = (f16*)(C.ws() + A_H);
    const int nw = C.nblk * NWAVES;
    for (int r = C.bid * NWAVES + C.wid; r < MALL; r += 2 * nw) {
        const int r2 = r + nw; const bool has2 = r2 < MALL;
        f32x4 v[4], w[4]; row_load(C.xsrc(l, r), C.lane, v); if (has2) row_load(C.xsrc(l, r2), C.lane, w);
        { const RowInfo ri = row_info(r); row_ln(v); row_modulate_store(v, C.mod(l, ri.mrow, 0), C.mod(l, ri.mrow, 1), H + (size_t)r * D, C.lane); }
        if (has2) { const RowInfo ri = row_info(r2); row_ln(w); row_modulate_store(w, C.mod(l, ri.mrow, 0), C.mod(l, ri.mrow, 1), H + (size_t)r2 * D, C.lane); }
    }
}
__device__ __forceinline__ void phase_p10(const Ctx& C, int l, int nrows) {
    const f16* T1 = (const f16*)(C.ws() + A_T1H); f16* H = (f16*)(C.ws() + A_H); float* ST = (float*)(C.ws() + WS_ST1);
    f32x4 gv[4], bv[4];
#pragma unroll
    for (int j = 0; j < 4; ++j) { gv[j] = ((const f32x4*)(C.in(I_LN1G) + l * D))[C.lane + 64 * j]; bv[j] = ((const f32x4*)(C.in(I_LN1B) + l * D))[C.lane + 64 * j]; }
    const int nw = C.nblk * NWAVES;
    for (int r0 = C.bid * NWAVES + C.wid; r0 < nrows; r0 += 4 * nw) {
        f32x4 v[4][4];
#pragma unroll
        for (int q = 0; q < 4; ++q) { const int r = r0 + q * nw; if (r < nrows) row_load_h(T1 + (size_t)r * D, C.lane, v[q]); }
#pragma unroll
        for (int q = 0; q < 4; ++q) { const int r = r0 + q * nw;
            if (r < nrows) {
                const RowInfo ri = row_info(r);
                float mean, rstd; row_ln_stats(v[q], mean, rstd);
                if (C.lane == 0) { ST[2 * r] = mean; ST[2 * r + 1] = rstd; }
#pragma unroll
                for (int j = 0; j < 4; ++j) v[q][j] = v[q][j] * gv[j] + bv[j];
                row_ln(v[q]);
                row_modulate_store(v[q], C.mod(l, ri.mrow, 3), C.mod(l, ri.mrow, 4), H + (size_t)r * D, C.lane);
            } }
    }
}
__device__ __forceinline__ void p13_row(const Ctx& C, int l, int r, f32x4 (&v)[4], const float* g, const float* bb) {
    f16* H = (f16*)(C.ws() + A_H); float* t = C.ta(r);
    row_ln(v);
#pragma unroll
    for (int j = 0; j < 4; ++j) { v[j] = v[j] * ((const f32x4*)g)[C.lane + 64 * j] + ((const f32x4*)bb)[C.lane + 64 * j]; ((f32x4*)t)[C.lane + 64 * j] = v[j]; }
    if (l == 0) {
        const RowInfo ri = row_info(r);
        row_ln(v);
        row_modulate_store(v, C.mod(1, ri.mrow, 0), C.mod(1, ri.mrow, 1), H + (size_t)r * D, C.lane);
    }
}
__device__ __forceinline__ void phase_p13(const Ctx& C, int l, int nrows) {
    const float* g = C.in(I_LN2G) + l * D; const float* bb = C.in(I_LN2B) + l * D; const f16* T2 = (const f16*)(C.ws() + A_T1H);
    const int nw = C.nblk * NWAVES;
    for (int r = C.bid * NWAVES + C.wid; r < nrows; r += 2 * nw) {
        const int r2 = r + nw; const bool has2 = r2 < nrows;
        f32x4 v[4], w[4]; row_load_h(T2 + (size_t)r * D, C.lane, v); if (has2) row_load_h(T2 + (size_t)r2 * D, C.lane, w);
        p13_row(C, l, r, v, g, bb);
        if (has2) p13_row(C, l, r2, w, g, bb);
    }
}
__device__ __forceinline__ void phase_hre(const Ctx& C, int l, int nrows) {
    f16* H = (f16*)(C.ws() + A_H);
    const int nw = C.nblk * NWAVES;
    for (int r = C.bid * NWAVES + C.wid; r < nrows; r += 2 * nw) {
        const int r2 = r + nw; const bool has2 = r2 < nrows;
        f32x4 v[4], w[4]; row_load(C.xsrc(l, r), C.lane, v); if (has2) row_load(C.xsrc(l, r2), C.lane, w);
        { const RowInfo ri = row_info(r); row_ln(v); row_modulate_store(v, C.mod(l, ri.mrow, 0), C.mod(l, ri.mrow, 1), H + (size_t)r * D, C.lane); }
        if (has2) { const RowInfo ri = row_info(r2); row_ln(w); row_modulate_store(w, C.mod(l, ri.mrow, 0), C.mod(l, ri.mrow, 1), H + (size_t)r2 * D, C.lane); }
    }
}

__device__ __forceinline__ size_t u3_off(int g, int nb, int sx, int half, int n) { return ((((size_t)(g * 34 + nb) * 16 + sx) * 2 + half) * 32 + n) * 8; }
__device__ __forceinline__ size_t x3_off(int dirg, int nb, int kk, int half, int n) { return ((((size_t)(dirg * 34 + nb) * 8 + kk) * 2 + half) * 32 + n) * 8; }
__device__ __forceinline__ size_t m3_off(int dirg, int mb, int sx, int half, int p32) { return ((((size_t)(dirg * 4 + mb) * 16 + sx) * 2 + half) * 32 + p32) * 8; }
__device__ __forceinline__ void phase_p3(const Ctx& C, int l) {
    f16* PROJ = (f16*)(C.ws() + A_PROJ);
    f16* KA = (f16*)(C.ws() + A_KA); f16* KC = (f16*)(C.ws() + A_KC);
    f16* QA = (f16*)(C.ws() + A_QA);
    const float* ropeA = (const float*)(C.ws() + WS_ROPE); const float* ropeC = ropeA + 2048;
    const int lane = C.lane, d32 = lane & 31;
    const float akg = C.in(I_AKG)[l * 64 + lane], aqg = C.in(I_AQG)[l * 64 + lane];
    const f32x4 ckvg = *(const f32x4*)(C.in(I_CKVG) + l * 256 + 4 * lane);
    f32x4 cqg[3];
#pragma unroll
    for (int i = 0; i < 3; ++i) cqg[i] = *(const f32x4*)(C.in(I_CQG) + l * 768 + 256 * i + 4 * lane);
    for (int r = C.bid * NWAVES + C.wid; r < MALL; r += C.nblk * NWAVES) {
        const RowInfo ri = row_info(r);
        f16* prow = PROJ + (size_t)r * PLD2;
        const bool needq = ri.lat || l == 0;
        f16 xak[2], xaq[8]; f16x4 cq4[3];
#pragma unroll
        for (int hd = 0; hd < 2; ++hd) xak[hd] = prow[PC_AK + hd * 64 + lane];
        const f16x4 ckv4 = *(const f16x4*)(prow + PC_CKV + 4 * lane);
        const f16 xckr = prow[PC_CKR + d32];
        if (needq) {
#pragma unroll
            for (int h = 0; h < 8; ++h) xaq[h] = prow[PC_AQ + h * 64 + lane];
#pragma unroll
            for (int i = 0; i < 3; ++i) cq4[i] = *(const f16x4*)(prow + PC_CQ + 256 * i + 4 * lane);
        } else {
#pragma unroll
            for (int h = 0; h < 8; ++h) xaq[h] = (f16)0.f;
#pragma unroll
            for (int i = 0; i < 3; ++i) cq4[i] = (f16x4){0, 0, 0, 0};
        }
        const int prow_i = ri.t >> 6, pcol_i = ri.t & 63;
        float cA = 1.f, sA = 0.f, cc = 1.f, sc = 0.f;
        if (ri.lat) {
            { const int part = lane >> 5, j = lane & 15, pi = part ? pcol_i : prow_i; cA = ropeA[pi * 16 + j]; sA = ropeA[1024 + pi * 16 + j]; if (!((lane >> 4) & 1)) sA = -sA; }
            { const int part = d32 >> 4, j = d32 & 7, pi = part ? pcol_i : prow_i; cc = ropeC[pi * 8 + j]; sc = ropeC[512 + pi * 8 + j]; if (!((d32 >> 3) & 1)) sc = -sc; }
        }
        float ss[12];
#pragma unroll
        for (int hd = 0; hd < 2; ++hd) { const float x = (float)xak[hd]; ss[hd] = x * x; }
#pragma unroll
        for (int h = 0; h < 8; ++h) { const float x = (float)xaq[h]; ss[2 + h] = x * x; }
        { float q = 0.f;
#pragma unroll
          for (int e = 0; e < 4; ++e) { const float x = (float)ckv4[e]; q += x * x; }
          ss[10] = q; q = 0.f;
#pragma unroll
          for (int i = 0; i < 3; ++i)
#pragma unroll
              for (int e = 0; e < 4; ++e) { const float x = (float)cq4[i][e]; q += x * x; }
          ss[11] = q; }
#pragma unroll
        for (int i = 0; i < 12; ++i) ss[i] = wave_sum(ss[i]);
#pragma unroll
        for (int hd = 0; hd < 2; ++hd) {
            float y = (float)xak[hd] * (1.0f / sqrtf(ss[hd] * (1.0f / 64.0f) + EPS)) * akg;
            const float p = __shfl_xor(y, 16);
            y = y * cA + p * sA;
            KA[((size_t)(ri.b * 2 + hd) * NKEY + ri.pos) * 64 + lane] = (f16)y;
        }
        { const float rs = 1.0f / sqrtf(ss[10] * (1.0f / 256.0f) + EPS); f16x4 o4;
#pragma unroll
          for (int e = 0; e < 4; ++e) o4[e] = (f16)((float)ckv4[e] * rs * ckvg[e]);
          *(f16x4*)(prow + PC_CKV + 4 * lane) = o4; }
        { float x = (float)xckr; const float p = __shfl_xor(x, 8); x = x * cc + p * sc;
          if (lane < 32) {
#pragma unroll
              for (int h = 0; h < 8; ++h) KC[((size_t)(ri.b * 8 + h) * NKEY + ri.pos) * 96 + 64 + d32] = (f16)x;
          } }
        if (needq) {
            f16* qdst = QA + (size_t)r * 512; const size_t hstride = 64;
#pragma unroll
            for (int h = 0; h < 8; ++h) {
                float y = (float)xaq[h] * (1.0f / sqrtf(ss[2 + h] * (1.0f / 64.0f) + EPS)) * aqg;
                const float p = __shfl_xor(y, 16);
                y = (y * cA + p * sA) * QSCALE_A;
                qdst[h * hstride + lane] = (f16)y;
            }
            const float rs = 1.0f / sqrtf(ss[11] * (1.0f / 768.0f) + EPS);
#pragma unroll
            for (int i = 0; i < 3; ++i) { f16x4 o4;
#pragma unroll
                for (int e = 0; e < 4; ++e) o4[e] = (f16)((float)cq4[i][e] * rs * cqg[i][e]);
                *(f16x4*)(prow + PC_CQ + 256 * i + 4 * lane) = o4; }
        }
    }
}

namespace pg8 {
#define PG8_LAS __attribute__((address_space(3)))
typedef _Float16 bf16_t;
typedef _Float16 bf16x8 __attribute__((ext_vector_type(8)));
constexpr int BM = 256, BK = 64, HALF = 128, HTB = HALF * BK * 2  , STAGE_BYTES = 8 * HTB, NXCD = 8, WGM = 8;

__host__ __device__ __forceinline__ int lds_byte(int r, int c) { const int st = (r >> 4) * 2 + (c >> 5), rr = r & 15, cc = c & 31, ob = rr * 64 + cc * 2; return st * 1024 + (ob ^ (((ob >> 9) & 1) << 5)); }
__host__ __device__ __forceinline__ void stage_rc(int b, int& R, int& C) { const int st = b / 1024, sb = b % 1024, swz = sb ^ (((sb >> 9) & 1) << 5); R = (st >> 1) * 16 + swz / 64; C = (st & 1) * 32 + (swz % 64) / 2; }
__host__ __device__ __forceinline__ int perm32(int rho) { const int n = rho >> 4, i = rho & 15; return 8 * (i >> 2) + 4 * n + (i & 3); }
struct Unit { int pm, pn; };
struct Gemm { const bf16_t* A; const bf16_t* Bt; int M, N, K, lda, ldb; };

struct StaticOrder {
    int nM, nN, nwg, G, c;
    __host__ __device__ void init(int M, int N, int G_, int c_) { nM = M / BM; nN = N / BM; nwg = nM * nN; G = G_; c = c_; }
    __host__ __device__ bool next(int i, Unit& u) const {
        const long L = (long)i * G + c; if (L >= nwg) return false;
        int wgid = (int)L; { const int q = nwg / NXCD, r = nwg % NXCD, xcd = wgid % NXCD, off = wgid / NXCD; wgid = (xcd < r ? xcd * (q + 1) : r * (q + 1) + (xcd - r) * q) + off; }
        const int nig = WGM * nN, gid = wgid / nig, fm = gid * WGM, gsz = (nM - fm) < WGM ? (nM - fm) : WGM;
        u.pm = fm + ((wgid % nig) % gsz); u.pn = (wgid % nig) / gsz; return true;
    }
    __device__ __forceinline__ void a_ready(const Unit&) const {}
    __device__ __forceinline__ void done(const Unit&) const {}
};

template <class F> struct EpiFn { static constexpr bool PERM = true, AFTER_DRAIN = false; F f;
    __device__ __forceinline__ void operator()(const f32x4 (&acc)[2][2][4][2], const Unit& u, int wr, int wc, int fr, int fq) const {
        typename F::Pre pre[2][2];
        const int col0 = u.pn * BM + wc * 32 + 8 * fq, rowb = u.pm * BM + wr * 64 + fr;
#pragma unroll
        for (int bj = 0; bj < 2; ++bj) pre[0][bj] = f.pre(rowb, col0 + bj * HALF);
#pragma unroll
        for (int gi = 0; gi < 8; ++gi) {
            const int ai = gi >> 2, m = gi & 3, row = rowb + ai * HALF + m * 16;
            if (gi + 1 < 8) { const int ai2 = (gi + 1) >> 2, m2 = (gi + 1) & 3;
#pragma unroll
                for (int bj = 0; bj < 2; ++bj) pre[(gi + 1) & 1][bj] = f.pre(rowb + ai2 * HALF + m2 * 16, col0 + bj * HALF); }
#pragma unroll
            for (int bj = 0; bj < 2; ++bj) f(row, col0 + bj * HALF, acc[ai][bj][m][0], acc[ai][bj][m][1], pre[gi & 1][bj]);
            asm volatile("" ::: "memory");
        }
    } };

template <class Epi, class Sched, bool ALIGN_EPI = false, bool SP2 = false, bool CH_IN = false, bool CH_OUT = false>
__device__ __forceinline__ void gemm_phase(PG8_LAS unsigned char* lds, const Gemm g, const Sched& S, const Epi& E, const int tid, const Gemm ng = Gemm{}) {
    static_assert(!(CH_IN || CH_OUT) || (SP2 && ALIGN_EPI), "chaining is written for the SP2 + ALIGN_EPI loop");
    const int wid = __builtin_amdgcn_readfirstlane(tid >> 6), lane = tid & 63, wr = wid >> 2, wc = wid & 3, fr = lane & 15, fq = lane >> 4;
    const int K = g.K, nt = K / BK;
    unsigned voffA[2], voffB[2];
#pragma unroll
    for (int i = 0; i < 2; ++i) { int R, C; stage_rc(tid * 16 + i * 8192, R, C); const int Rb = Epi::PERM ? ((R & ~31) + perm32(R & 31)) : R;
        voffA[i] = (unsigned)(R * g.lda + C) * 2u; voffB[i] = (unsigned)(Rb * g.ldb + C) * 2u; }
    unsigned nvA[2] = {0u, 0u}, nvB[2] = {0u, 0u}; size_t n_hstepA = 0, n_hstepB = 0;
    if constexpr (CH_OUT) {
#pragma unroll
        for (int i = 0; i < 2; ++i) { int R, C; stage_rc(tid * 16 + i * 8192, R, C); const int Rb = Epi::PERM ? ((R & ~31) + perm32(R & 31)) : R;
            nvA[i] = (unsigned)(R * ng.lda + C) * 2u; nvB[i] = (unsigned)(Rb * ng.ldb + C) * 2u; }
        n_hstepA = (size_t)HALF * ng.lda * 2; n_hstepB = (size_t)HALF * ng.ldb * 2;
    }
    const size_t kstep = (size_t)(BK * 2);
    const size_t hstepA = (size_t)HALF * g.lda * 2, hstepB = (size_t)HALF * g.ldb * 2;
    const size_t tstepA = 2 * hstepA, tstepB = 2 * hstepB;
    const unsigned ldsw = (unsigned)wid * 1024u;
    const int aoff = lds_byte(wr * 64 + fr, fq * 8), boff = lds_byte(wc * 32 + fr, fq * 8);
#define PG8_SA(b, h) (((b) * 2 + (h)) * HTB)
#define PG8_SB(b, h) ((4 + (b) * 2 + (h)) * HTB)
#define PG8_STAGE(bufoff, gbase, voff) do { _Pragma("unroll") for (int _i = 0; _i < 2; ++_i) \
        __builtin_amdgcn_global_load_lds((const unsigned*)((const char*)(gbase) + (voff)[_i]), (PG8_LAS unsigned*)(lds + (bufoff) + ldsw + _i * 8192), 16, 0, 0); } while (0)
#define PG8_LDA(dst, b, h) do { _Pragma("unroll") for (int m = 0; m < 4; ++m) _Pragma("unroll") for (int k = 0; k < 2; ++k) dst[m][k] = *(const PG8_LAS bf16x8*)(lds + PG8_SA(b, h) + aoff + m * 2048 + k * 1024); } while (0)
#define PG8_LDB(dst, b, h) do { _Pragma("unroll") for (int n = 0; n < 2; ++n) _Pragma("unroll") for (int k = 0; k < 2; ++k) dst[n][k] = *(const PG8_LAS bf16x8*)(lds + PG8_SB(b, h) + boff + n * 2048 + k * 1024); } while (0)
#define PG8_MMA(ai, bj, At, Bt) do { __builtin_amdgcn_s_setprio(1); _Pragma("unroll") for (int m = 0; m < 4; ++m) _Pragma("unroll") for (int n = 0; n < 2; ++n) _Pragma("unroll") for (int k = 0; k < 2; ++k) \
        acc[ai][bj][m][n] = __builtin_amdgcn_mfma_f32_16x16x32_f16(Bt[n][k], At[m][k], acc[ai][bj][m][n], 0, 0, 0); __builtin_amdgcn_s_setprio(0); } while (0)
#define PG8_WAIT_V(n) asm volatile("s_waitcnt vmcnt(" #n ")" ::: "memory")
#define PG8_WAIT_L(n) asm volatile("s_waitcnt lgkmcnt(" #n ")" ::: "memory")
#define PG8_BAR __builtin_amdgcn_s_barrier()
#define PG8_SCHED __builtin_amdgcn_sched_barrier(0)
    Unit cur, nxt; int ui = 0;
    if (!S.next(0, cur)) return;
    f32x4 acc[2][2][4][2];
#pragma unroll
    for (int a = 0; a < 2; ++a)
#pragma unroll
        for (int b = 0; b < 2; ++b)
#pragma unroll
            for (int m = 0; m < 4; ++m)
#pragma unroll
                for (int n = 0; n < 2; ++n) acc[a][b][m][n] = (f32x4){0.f, 0.f, 0.f, 0.f};
    bf16x8 At[4][2], B0[2][2], B1[2][2];
    const char* cA = (const char*)g.A + (size_t)cur.pm * tstepA; const char* cB = (const char*)g.Bt + (size_t)cur.pn * tstepB;
    S.a_ready(cur);
    if constexpr (CH_IN) {   } else
    if constexpr (SP2) {
        PG8_STAGE(PG8_SB(0, 0), cB, voffB); PG8_STAGE(PG8_SB(0, 1), cB + hstepB, voffB); PG8_STAGE(PG8_SA(0, 0), cA, voffA); PG8_STAGE(PG8_SA(0, 1), cA + hstepA, voffA);
        if (wr == 1) PG8_BAR;
        PG8_WAIT_V(2); PG8_BAR;
        PG8_STAGE(PG8_SB(1, 0), cB + kstep, voffB); PG8_STAGE(PG8_SA(1, 0), cA + kstep, voffA); PG8_STAGE(PG8_SB(1, 1), cB + hstepB + kstep, voffB);
        PG8_WAIT_V(6); PG8_BAR;
    } else {
        PG8_STAGE(PG8_SB(0, 0), cB, voffB); PG8_STAGE(PG8_SA(0, 0), cA, voffA); PG8_STAGE(PG8_SB(0, 1), cB + hstepB, voffB); PG8_STAGE(PG8_SA(0, 1), cA + hstepA, voffA);
        if (wr == 1) PG8_BAR;
        PG8_WAIT_V(4); PG8_BAR;
        PG8_STAGE(PG8_SB(1, 0), cB + kstep, voffB); PG8_STAGE(PG8_SA(1, 0), cA + kstep, voffA); PG8_STAGE(PG8_SB(1, 1), cB + hstepB + kstep, voffB);
        PG8_WAIT_V(6); PG8_BAR;
    }
    for (;;) {
        const bool has_next = S.next(ui + 1, nxt);
        Unit u0; (void)S.next(0, u0);
        const char* nA = has_next ? (const char*)g.A + (size_t)nxt.pm * tstepA : (CH_OUT ? (const char*)ng.A + (size_t)u0.pm * 2 * n_hstepA : cA);
        const char* nB = has_next ? (const char*)g.Bt + (size_t)nxt.pn * tstepB : (CH_OUT ? (const char*)ng.Bt + (size_t)u0.pn * 2 * n_hstepB : cB);
#pragma unroll 1
        for (int t = 0; t < nt; t += 2) {
            const bool last = (t == nt - 2);
            const char* a1 = cA + (size_t)(t + 1) * kstep;
            const char* a2 = last ? nA : cA + (size_t)(t + 2) * kstep; const char* b2 = last ? nB : cB + (size_t)(t + 2) * kstep;
            const char* a3 = a2 + kstep; const char* b3 = b2 + kstep;
            const bool xg = CH_OUT && last && !has_next;
            unsigned vA2[2], vB2[2];
#pragma unroll
            for (int i = 0; i < 2; ++i) { vA2[i] = xg ? nvA[i] : voffA[i]; vB2[i] = xg ? nvB[i] : voffB[i]; }
            const size_t hA2 = xg ? n_hstepA : hstepA, hB2 = xg ? n_hstepB : hstepB;
            if (last && has_next) S.a_ready(nxt);
            if constexpr (SP2) {
            PG8_LDB(B0, 0, 0); PG8_LDB(B1, 0, 1); PG8_SCHED; PG8_LDA(At, 0, 0); PG8_STAGE(PG8_SA(1, 1), a1 + hstepA, voffA);
            PG8_WAIT_V(8); PG8_WAIT_L(0); PG8_BAR; PG8_MMA(0, 0, At, B0); PG8_MMA(0, 1, At, B1); PG8_BAR; PG8_SCHED;
            PG8_LDA(At, 0, 1); PG8_STAGE(PG8_SB(0, 0), b2, vB2); PG8_STAGE(PG8_SB(0, 1), b2 + hB2, vB2); PG8_STAGE(PG8_SA(0, 0), a2, vA2);
            PG8_WAIT_V(8); PG8_WAIT_L(0); PG8_BAR; PG8_MMA(1, 0, At, B0); PG8_MMA(1, 1, At, B1); PG8_BAR; PG8_SCHED;
            PG8_LDB(B0, 1, 0); PG8_LDB(B1, 1, 1); PG8_SCHED; PG8_LDA(At, 1, 0); PG8_STAGE(PG8_SA(0, 1), a2 + hA2, vA2);
            PG8_WAIT_V(8); PG8_WAIT_L(0); PG8_BAR; PG8_MMA(0, 0, At, B0); PG8_MMA(0, 1, At, B1); PG8_BAR; PG8_SCHED;
            PG8_LDA(At, 1, 1); PG8_STAGE(PG8_SB(1, 0), b3, vB2); PG8_STAGE(PG8_SB(1, 1), b3 + hB2, vB2); PG8_STAGE(PG8_SA(1, 0), a3, vA2);
            PG8_WAIT_V(8); PG8_WAIT_L(0); PG8_BAR; PG8_MMA(1, 0, At, B0); PG8_MMA(1, 1, At, B1); PG8_BAR; PG8_SCHED;
            } else {
            PG8_LDB(B0, 0, 0); PG8_SCHED; PG8_LDA(At, 0, 0); PG8_STAGE(PG8_SA(1, 1), a1 + hstepA, voffA);
            PG8_WAIT_L(8); PG8_BAR; PG8_WAIT_L(0); PG8_MMA(0, 0, At, B0); PG8_BAR; PG8_SCHED;
            PG8_LDB(B1, 0, 1); PG8_STAGE(PG8_SB(0, 0), b2, voffB);
            PG8_BAR; PG8_WAIT_L(0); PG8_MMA(0, 1, At, B1); PG8_BAR;
            PG8_LDA(At, 0, 1); PG8_STAGE(PG8_SA(0, 0), a2, voffA);
            PG8_BAR; PG8_WAIT_L(0); PG8_MMA(1, 0, At, B0); PG8_BAR; PG8_SCHED;
            PG8_STAGE(PG8_SB(0, 1), b2 + hstepB, voffB);
            PG8_WAIT_V(6); PG8_BAR; PG8_MMA(1, 1, At, B1); PG8_BAR;
            PG8_LDB(B0, 1, 0); PG8_SCHED; PG8_LDA(At, 1, 0); PG8_STAGE(PG8_SA(0, 1), a2 + hstepA, voffA);
            PG8_WAIT_L(8); PG8_BAR; PG8_WAIT_L(0); PG8_MMA(0, 0, At, B0); PG8_BAR; PG8_SCHED;
            PG8_LDB(B1, 1, 1); PG8_STAGE(PG8_SB(1, 0), b3, voffB);
            PG8_BAR; PG8_WAIT_L(0); PG8_MMA(0, 1, At, B1); PG8_BAR;
            PG8_LDA(At, 1, 1); PG8_STAGE(PG8_SA(1, 0), a3, voffA);
            PG8_BAR; PG8_WAIT_L(0); PG8_MMA(1, 0, At, B0); PG8_BAR; PG8_SCHED;
            PG8_STAGE(PG8_SB(1, 1), b3 + hstepB, voffB);
            PG8_WAIT_V(6); PG8_BAR; PG8_MMA(1, 1, At, B1); PG8_BAR;
            }
        }
        if constexpr (ALIGN_EPI) { if (wr == 0) PG8_BAR; }
        if constexpr (!Epi::AFTER_DRAIN) { E(acc, cur, wr, wc, fr, fq); S.done(cur); }
        if (!has_next) break;
#pragma unroll
        for (int a = 0; a < 2; ++a)
#pragma unroll
            for (int b = 0; b < 2; ++b)
#pragma unroll
                for (int m = 0; m < 4; ++m)
#pragma unroll
                    for (int n = 0; n < 2; ++n) acc[a][b][m][n] = (f32x4){0.f, 0.f, 0.f, 0.f};
        cur = nxt; cA = nA; cB = nB; ++ui;
        if constexpr (ALIGN_EPI) { if (wr == 1) PG8_BAR; }
    }
    if constexpr (CH_OUT) { if (wr == 1) PG8_BAR; return; }
    PG8_WAIT_V(0);
    if constexpr (!ALIGN_EPI) { if (wr == 0) PG8_BAR; }
    PG8_BAR;
    if constexpr (Epi::AFTER_DRAIN) { E.fused(acc, cur, wr, wc, fr, fq, lds, wid, lane); S.done(cur); }
#undef PG8_SA
#undef PG8_SB
#undef PG8_STAGE
#undef PG8_LDA
#undef PG8_LDB
#undef PG8_MMA
#undef PG8_WAIT_V
#undef PG8_WAIT_L
#undef PG8_BAR
#undef PG8_SCHED
}
}

template <bool CH_IN, bool CH_OUT, class F>
__device__ __forceinline__ void gemm_pg8c(const Ctx& C, const f16* A, int lda, const f16* Bt, int ldb, int M, int N, int K, const F& f, const f16* nA, int nlda, const f16* nBt, int nldb) {
    pg8::Gemm g{A, Bt, M, N, K, lda, ldb}; pg8::Gemm ng{nA, nBt, M, N, 0, nlda, nldb}; pg8::StaticOrder S; S.init(M, N, C.nblk, C.bid);
    pg8::EpiFn<F> E{f};
    pg8::gemm_phase<pg8::EpiFn<F>, pg8::StaticOrder, true, true, CH_IN, CH_OUT>(C.lds, g, S, E, C.tid, ng);
}
template <class F>
__device__ __forceinline__ void gemm_pg8(const Ctx& C, const f16* A, int lda, const f16* Bt, int ldb, int M, int N, int K, const F& f) {
    pg8::Gemm g{A, Bt, M, N, K, lda, ldb}; pg8::StaticOrder S; S.init(M, N, C.nblk, C.bid);
    pg8::EpiFn<F> E{f};
    pg8::gemm_phase<pg8::EpiFn<F>, pg8::StaticOrder, true, true>(C.lds, g, S, E, C.tid);
}
template <class F>
__device__ __forceinline__ void gemm_small(const Ctx& C, const f16* A, int lda, const f16* Bt, int ldb, int row0, int N, int K, const F& f) {
    constexpr int PST = 68;
    LAS float* part = (LAS float*)C.lds;
    const int fr = C.lane & 15, fq = C.lane >> 4;
    const int tilesN = N / 64, ntiles = 16 * tilesN, kw = K / 8;
    for (int tile = C.bid; tile < ntiles; tile += C.nblk) {
        const int tm = tile / tilesN, tn = tile - tm * tilesN, m0 = tm * 64, n0 = tn * 64;
        f32x4 acc[4][4];
#pragma unroll
        for (int a = 0; a < 4; ++a)
#pragma unroll
            for (int b = 0; b < 4; ++b) acc[a][b] = (f32x4){0.f, 0.f, 0.f, 0.f};
        const f16* ap = A + (size_t)(m0 + fr) * lda + C.wid * kw + fq * 8;
        const f16* bp = Bt + (size_t)(n0 + fr) * ldb + C.wid * kw + fq * 8;
#pragma unroll 4
        for (int k0 = 0; k0 < kw; k0 += 32) {
            f16x8 av[4], bv[4];
#pragma unroll
            for (int a = 0; a < 4; ++a) av[a] = *(const f16x8*)(ap + (size_t)(a * 16) * lda + k0);
#pragma unroll
            for (int b = 0; b < 4; ++b) bv[b] = *(const f16x8*)(bp + (size_t)(b * 16) * ldb + k0);
#pragma unroll
            for (int a = 0; a < 4; ++a)
#pragma unroll
                for (int b = 0; b < 4; ++b) acc[a][b] = __builtin_amdgcn_mfma_f32_16x16x32_f16(bv[b], av[a], acc[a][b], 0, 0, 0);
        }
        __syncthreads();
        LAS float* pw = part + (size_t)C.wid * 64 * PST;
#pragma unroll
        for (int a = 0; a < 4; ++a)
#pragma unroll
            for (int b = 0; b < 4; ++b) *(LAS f32x4*)(pw + (a * 16 + fr) * PST + b * 16 + 4 * fq) = acc[a][b];
        __syncthreads();
        const int rl = 8 * C.wid + (C.lane & 7), c8 = ((C.lane >> 4) & 1) | (((C.lane >> 5) & 1) << 1) | (((C.lane >> 3) & 1) << 2);
        f32x4 lo = (f32x4){0.f, 0.f, 0.f, 0.f}, hi = lo;
#pragma unroll
        for (int w = 0; w < 8; ++w) { const LAS float* pr = part + ((size_t)w * 64 + rl) * PST + 8 * c8; lo = lo + *(const LAS f32x4*)pr; hi = hi + *(const LAS f32x4*)(pr + 4); }
        f(row0 + m0 + rl, n0 + 8 * c8, lo, hi, f.pre(row0 + m0 + rl, n0 + 8 * c8));
    }
    __syncthreads();
}
template <class F>
__device__ __forceinline__ void gemm_pg8s(const Ctx& C, const f16* A, int lda, const f16* Bt, int ldb, int M, int N, int K, const F& f) {
    pg8::Gemm g{A, Bt, M, N, K, lda, ldb}; pg8::StaticOrder S; S.init(M, N, C.nblk, C.bid);
    pg8::EpiFn<F> E{f};
    pg8::gemm_phase<pg8::EpiFn<F>, pg8::StaticOrder, false, true>(C.lds, g, S, E, C.tid);
}
template <class F>
__device__ __forceinline__ void gemm_rows(const Ctx& C, const f16* A, int lda, const f16* Bt, int ldb, int mrows, int N, int K, const F& f) {
    if (N == 1024) gemm_pg8s(C, A, lda, Bt, ldb, NLAT, N, K, f); else gemm_pg8(C, A, lda, Bt, ldb, NLAT, N, K, f);
    if (mrows > NLAT) gemm_small(C, A + (size_t)NLAT * lda, lda, Bt, ldb, NLAT, N, K, f);
}
struct NoPre {};
#define NOPRE typedef NoPre Pre; __device__ __forceinline__ NoPre pre(int, int) const { return NoPre{}; }
struct EpiProj { f16* P; f16* VA; f16* U3;
    NOPRE
    __device__ __forceinline__ void operator()(int row, int col, f32x4 lo, f32x4 hi, NoPre) const {
        const f16x8 v = pack8(lo, hi); f16* pr = P + (size_t)row * PLD2;
        if (col < GC_AV) *(f16x8*)(pr + PC_AK + col) = v;
        else if (col < GC_CKV) { const RowInfo ri = row_info(row); const int c = col - GC_AV; *(f16x8*)(VA + ((size_t)(ri.b * 2 + (c >> 6)) * NKEY + ri.pos) * 64 + (c & 63)) = v; }
        else if (col < GC_CKR) *(f16x8*)(pr + PC_CKV + (col - GC_CKV)) = v;
        else if (col < GC_PAD) *(f16x8*)(pr + PC_CKR + (col - GC_CKR)) = v;
        else if (col < GC_U) { }
        else if (col < GC_AQ) { const int c = col - GC_U; *(f16x8*)(U3 + u3_off(c >> 4, row >> 9, row & 15, (c >> 3) & 1, (row >> 4) & 31)) = v; }
        else if (col < GC_CQ) *(f16x8*)(pr + PC_AQ + (col - GC_AQ)) = v;
        else *(f16x8*)(pr + PC_CQ + (col - GC_CQ)) = v;
    } };
struct EpiKvUp { f16* KC; f16* VC;
    NOPRE
    __device__ __forceinline__ void operator()(int row, int col, f32x4 lo, f32x4 hi, NoPre) const {
        const RowInfo ri = row_info(row); const int h = col >> 7, w = col & 127;
        if (w < 64) *(f16x8*)(KC + ((size_t)(ri.b * 8 + h) * NKEY + ri.pos) * 96 + w) = pack8(lo, hi);
        else *(f16x8*)(VC + ((size_t)(ri.b * 8 + h) * NKEY + ri.pos) * 64 + (w - 64)) = pack8(lo, hi);
    } };
struct EpiQUp { f16* QC; const float* ropeC;
    NOPRE
    __device__ __forceinline__ void operator()(int row, int col, f32x4 lo, f32x4 hi, NoPre) const {
        const RowInfo ri = row_info(row); const int h = col / 96, w = col - h * 96;
        if (w >= 64) {
            f32x4 plo, phi;
#pragma unroll
            for (int e = 0; e < 4; ++e) { plo[e] = __shfl_xor(lo[e], 16); phi[e] = __shfl_xor(hi[e], 16); }
            if (ri.lat) {
                const int j0 = w - 64, part = j0 >> 4, second = (j0 >> 3) & 1, pi = part ? (ri.t & 63) : (ri.t >> 6);
                const float* cc = ropeC + pi * 8; const float* ss = ropeC + 512 + pi * 8;
#pragma unroll
                for (int e = 0; e < 4; ++e) {
                    const float s0 = second ? ss[e] : -ss[e], s1 = second ? ss[4 + e] : -ss[4 + e];
                    lo[e] = lo[e] * cc[e] + plo[e] * s0; hi[e] = hi[e] * cc[4 + e] + phi[e] * s1; }
            }
        }
        lo = lo * QSCALE_C; hi = hi * QSCALE_C;
        f16* dst = ri.lat ? QC + ((size_t)(ri.b * 8 + h) * SEQ + ri.t) * 96 + w : QC + (size_t)NB * 8 * SEQ * 96 + ((size_t)(ri.b * 8 + h) * CTX + ri.t) * 96 + w;
        *(f16x8*)dst = pack8(lo, hi);
    } };
struct EpiGlu { f16* YS;
    NOPRE
    __device__ __forceinline__ void operator()(int row, int col, f32x4 lo, f32x4 hi, NoPre) const {
        f32x4 o;
#pragma unroll
        for (int e = 0; e < 4; ++e) o[e] = lo[e] * sigmoidf_(hi[e]);
        *(f16x4*)(YS + (size_t)row * 512 + (col >> 1)) = pack4(o);
    } };
struct EpiGate { f16* G;
    NOPRE
    __device__ __forceinline__ void operator()(int row, int col, f32x4 lo, f32x4 hi, NoPre) const {
#pragma unroll
        for (int e = 0; e < 4; ++e) { lo[e] = sigmoidf_(lo[e]); hi[e] = sigmoidf_(hi[e]); }
        *(f16x8*)(G + (size_t)row * 1024 + col) = pack8(lo, hi);
    } };
struct EpiBranch { const f16* G; f16* Mg; int first;
    struct Pre { f16x8 g, m; };
    __device__ __forceinline__ Pre pre(int row, int col) const { Pre p; p.g = *(const f16x8*)(G + (size_t)row * 1024 + col);
        if (!first) p.m = *(const f16x8*)(Mg + (size_t)row * 1024 + col); else p.m = (f16x8){0, 0, 0, 0, 0, 0, 0, 0}; return p; }
    __device__ __forceinline__ void operator()(int row, int col, f32x4 lo, f32x4 hi, const Pre& p) const {
#pragma unroll
        for (int e = 0; e < 4; ++e) { lo[e] = (float)p.m[e] + (float)p.g[e] * lo[e]; hi[e] = (float)p.m[4 + e] + (float)p.g[4 + e] * hi[e]; }
        *(f16x8*)(Mg + (size_t)row * 1024 + col) = pack8(lo, hi);
    } };
struct EpiWout { const Ctx* C; int l;
    struct Pre { f32x4 x0, x1, g0, g1; };
    __device__ __forceinline__ Pre pre(int row, int col) const { const RowInfo ri = row_info(row); const float* x = C->xsrc(l, row) + col; const float* g = C->mod(l, ri.mrow, 2) + col;
        Pre p; p.x0 = *(const f32x4*)x; p.x1 = *(const f32x4*)(x + 4); p.g0 = *(const f32x4*)g; p.g1 = *(const f32x4*)(g + 4); return p; }
    __device__ __forceinline__ void operator()(int row, int col, f32x4 lo, f32x4 hi, const Pre& p) const {
        *(f16x8*)((f16*)(C->ws() + A_T1H) + (size_t)row * D + col) = pack8(p.x0 * ALPHA + p.g0 * lo, p.x1 * ALPHA + p.g1 * hi);
    } };
struct EpiUp { f16* Hd;
    NOPRE
    __device__ __forceinline__ void operator()(int row, int col, f32x4 lo, f32x4 hi, NoPre) const {
#pragma unroll
        for (int e = 0; e < 4; ++e) { const float a = fmaxf(lo[e], 0.f), b = fmaxf(hi[e], 0.f); lo[e] = a * a; hi[e] = b * b; }
        *(f16x8*)(Hd + (size_t)row * DFF + col) = pack8(lo, hi);
    } };
struct EpiDown { const Ctx* C; int l;
    struct Pre { f16x8 t1; float mean, rstd; };
    __device__ __forceinline__ Pre pre(int row, int col) const { Pre p; p.t1 = *(const f16x8*)((const f16*)(C->ws() + A_T1H) + (size_t)row * D + col);
        const float* st = (const float*)(C->ws() + WS_ST1) + 2 * row; p.mean = st[0]; p.rstd = st[1]; return p; }
    __device__ __forceinline__ void operator()(int row, int col, f32x4 lo, f32x4 hi, const Pre& p) const {
        const RowInfo ri = row_info(row); const float* g = C->mod(l, ri.mrow, 5) + col; f16* t = (f16*)(C->ws() + A_T1H) + (size_t)row * D + col;
        const float* lg = C->in(I_LN1G) + l * D + col; const float* lb = C->in(I_LN1B) + l * D + col;
        const f32x4 g0 = *(const f32x4*)g, g1 = *(const f32x4*)(g + 4);
        const f32x4 a0 = *(const f32x4*)lg, a1 = *(const f32x4*)(lg + 4), b0 = *(const f32x4*)lb, b1 = *(const f32x4*)(lb + 4);
        f32x4 x0, x1;
#pragma unroll
        for (int e = 0; e < 4; ++e) { x0[e] = ((float)p.t1[e] - p.mean) * p.rstd * a0[e] + b0[e]; x1[e] = ((float)p.t1[4 + e] - p.mean) * p.rstd * a1[e] + b1[e]; }
        *(f16x8*)t = pack8(x0 * ALPHA + g0 * lo, x1 * ALPHA + g1 * hi);
    } };

namespace fa64 {
using bf16=_Float16;
using bf16x8=__attribute__((ext_vector_type(8)))_Float16;
using sh8=__attribute__((ext_vector_type(8)))short;
using s16x4=__attribute__((ext_vector_type(4)))short;
using u32x4=__attribute__((ext_vector_type(4)))unsigned;
constexpr int D=64;
constexpr int NW=8,QBLK=32,QB=QBLK*NW,KVBLK=64;
__device__ __forceinline__ int crow(int r,int hi){return (r&3)+8*(r>>2)+4*hi;}
#define SBAR() __builtin_amdgcn_sched_barrier(0)
constexpr int NSLOT=3, SLOTB=8192;
constexpr int LDS_K=0, LDS_V=NSLOT*SLOTB, LDS_WS=2*NSLOT*SLOTB, LDS_OST=LDS_WS+NW*64*4, LDS_BYTES=LDS_OST+NW*4096;
__device__ __forceinline__ void glds16(const void*gsrc,unsigned lds_dst){unsigned keep;
  asm volatile("s_mov_b32 %0, m0\n\ts_mov_b32 m0, %2\n\ts_nop 0\n\tglobal_load_lds_dwordx4 %1, off\n\ts_mov_b32 m0, %0":"=&s"(keep):"v"(gsrc),"s"(lds_dst):"memory");}
__device__ __forceinline__ float max3f(float a,float b,float c){float r;asm("v_max3_f32 %0, %1, %2, %3":"=v"(r):"v"(a),"v"(b),"v"(c));return r;}
__device__ __forceinline__ float max2f(float a,float b){float r;asm("v_max_f32_e32 %0, %1, %2":"=v"(r):"v"(a),"v"(b));return r;}
__device__ __forceinline__ float fadd_s(float a,float b){float r;asm("v_add_f32_e32 %0, %1, %2":"=v"(r):"v"(a),"v"(b));return r;}
__device__ __forceinline__ float fsub_s(float a,float b){float r;asm("v_sub_f32_e32 %0, %1, %2":"=v"(r):"v"(a),"v"(b));return r;}
typedef float f32x2_t __attribute__((ext_vector_type(2))); typedef _Float16 bf16x2_t __attribute__((ext_vector_type(2)));
__device__ __forceinline__ unsigned cvtpk_s(float lo,float hi){f32x2_t v={lo,hi};bf16x2_t b=__builtin_convertvector(v,bf16x2_t);return __builtin_bit_cast(unsigned,b);}
#define WAIT_BAR(N) asm volatile("s_waitcnt vmcnt(" #N ") lgkmcnt(0)\n\ts_barrier":::"memory")

__device__ __forceinline__ void qkt(f32x16&p0,f32x16&p1,const char*Kslot,const bf16x8*qr,const f32x16&negm,int r32,int hi){
  const char*kb=Kslot+hi*1024+r32*16;
  #pragma unroll
  for(int d0=0;d0<4;++d0){
    const bf16x8 b0=*reinterpret_cast<const bf16x8*>(kb+d0*2048);
    const bf16x8 b1=*reinterpret_cast<const bf16x8*>(kb+d0*2048+512);
    if(d0==0){p0=__builtin_amdgcn_mfma_f32_32x32x16_f16(b0,qr[0],negm,0,0,0);p1=__builtin_amdgcn_mfma_f32_32x32x16_f16(b1,qr[0],negm,0,0,0);}
    else{p0=__builtin_amdgcn_mfma_f32_32x32x16_f16(b0,qr[d0],p0,0,0,0);p1=__builtin_amdgcn_mfma_f32_32x32x16_f16(b1,qr[d0],p1,0,0,0);}}
}
typedef __attribute__((address_space(3))) const char* lds_cptr;
typedef short v4i16_t __attribute__((ext_vector_type(4)));
__device__ __forceinline__ void kload8(bf16x8*kf,lds_cptr kp){
  kf[0]=*(const __attribute__((address_space(3))) bf16x8*)(kp);      kf[1]=*(const __attribute__((address_space(3))) bf16x8*)(kp+512);
  kf[2]=*(const __attribute__((address_space(3))) bf16x8*)(kp+2048); kf[3]=*(const __attribute__((address_space(3))) bf16x8*)(kp+2560);
  kf[4]=*(const __attribute__((address_space(3))) bf16x8*)(kp+4096); kf[5]=*(const __attribute__((address_space(3))) bf16x8*)(kp+4608);
  kf[6]=*(const __attribute__((address_space(3))) bf16x8*)(kp+6144); kf[7]=*(const __attribute__((address_space(3))) bf16x8*)(kp+6656);
}
__device__ __forceinline__ void kload2(bf16x8*kf,lds_cptr kp,int j){ kf[2*j]=*(const __attribute__((address_space(3))) bf16x8*)(kp+j*2048); kf[2*j+1]=*(const __attribute__((address_space(3))) bf16x8*)(kp+j*2048+512); }
__device__ __forceinline__ s16x4 vtr(lds_cptr p){ return __builtin_bit_cast(s16x4,__builtin_amdgcn_ds_read_tr16_b64_v4i16((__attribute__((address_space(3))) v4i16_t*)p)); }
__device__ __forceinline__ float rowmax(const f32x16&p0,const f32x16&p1){
  float a=max3f(p0[0],p0[1],p1[0]),b=max3f(p0[2],p0[3],p1[1]);a=max3f(a,p1[2],p1[3]);
  #pragma unroll
  for(int r=4;r<16;r+=4){a=max3f(a,p0[r],p0[r+1]);b=max3f(b,p0[r+2],p0[r+3]);a=max3f(a,p1[r],p1[r+1]);b=max3f(b,p1[r+2],p1[r+3]);}
  const float m=max2f(a,b);
  auto rr=__builtin_amdgcn_permlane32_swap(__float_as_uint(m),__float_as_uint(m),false,false);
  return max2f(__uint_as_float(rr[0]),__uint_as_float(rr[1]));
}
__device__ __forceinline__ void pv(f32x16*o,int vb,bf16x8 pa0,bf16x8 pa1,bf16x8 pa2,bf16x8 pa3){
  #pragma unroll
  for(int d0=0;d0<2;++d0){s16x4 lo[4],hi[4];
    #pragma unroll
    for(int ks=0;ks<4;++ks){
      asm volatile("ds_read_b64_tr_b16 %0,%1 offset:%c2":"=&v"(lo[ks]):"v"(vb),"i"(d0*4096+ks*1024):"memory");
      asm volatile("ds_read_b64_tr_b16 %0,%1 offset:%c2":"=&v"(hi[ks]):"v"(vb),"i"(d0*4096+ks*1024+512):"memory");}
    asm volatile("s_waitcnt lgkmcnt(0)":::"memory");SBAR();
    #define PK(k) __builtin_bit_cast(bf16x8,(sh8){lo[k][0],lo[k][1],lo[k][2],lo[k][3],hi[k][0],hi[k][1],hi[k][2],hi[k][3]})
    o[d0]=__builtin_amdgcn_mfma_f32_32x32x16_f16(pa0,PK(0),o[d0],0,0,0);
    o[d0]=__builtin_amdgcn_mfma_f32_32x32x16_f16(pa1,PK(1),o[d0],0,0,0);
    o[d0]=__builtin_amdgcn_mfma_f32_32x32x16_f16(pa2,PK(2),o[d0],0,0,0);
    o[d0]=__builtin_amdgcn_mfma_f32_32x32x16_f16(pa3,PK(3),o[d0],0,0,0);
    #undef PK
  }
}

#ifndef ATTN_STORE16
#define ATTN_STORE16(p,v) (*(u32x4*)(p)=(v))
#endif
template<int THRL,int DMQ,int DMK,int DMO> __device__ __forceinline__ void attn_unit(const bf16*Qu,const bf16*__restrict__ Kh,const bf16*__restrict__ Vh,bf16*Ou,int nkeys,char*shm,const int tid){
  constexpr int DM=DMK;
  const int lane=tid&63,r32=lane&31,hi=lane>>5; const int wid=__builtin_amdgcn_readfirstlane(tid>>6);
  const bf16*Qw=Qu+(long)(wid*QBLK)*DMQ;
  const unsigned lds0=(unsigned)(uintptr_t)shm;
  float*wsf=(float*)(shm+LDS_WS)+wid*64;
  const bf16*ksrc=Kh+(long)lane*DM+wid*8;
  const bf16*vsrc=Vh+(long)(16*(wid&3)+(lane>>2))*DM+(wid>>2)*32+(lane&3)*8;
  const unsigned kdst=lds0+LDS_K+wid*1024, vdst=lds0+LDS_V+wid*1024;
  #define DMA_K(t,slot) glds16(ksrc+(long)(t)*KVBLK*DM,(unsigned)__builtin_amdgcn_readfirstlane(kdst+(slot)))
  #define DMA_V(t,slot) glds16(vsrc+(long)(t)*KVBLK*DM,(unsigned)__builtin_amdgcn_readfirstlane(vdst+(slot)))
  const int vb0=(int)(lds0+LDS_V)+((lane>>4)&1)*32+(lane&3)*8+(4*hi+((lane&15)>>2))*64;
  const char*Kbase=shm+LDS_K; bf16x8 kf[8];
  const lds_cptr shm3=(lds_cptr)shm; const lds_cptr kp0=shm3+LDS_K+hi*1024+r32*16; const lds_cptr vp0=shm3+LDS_V+((lane>>4)&1)*32+(lane&3)*8+(4*hi+((lane&15)>>2))*64;
  const int NT=nkeys/KVBLK;
  DMA_K(0,0);DMA_V(0,0);DMA_K(1,SLOTB);
  bf16x8 qr[4];
  #pragma unroll
  for(int d0=0;d0<4;++d0)qr[d0]=*reinterpret_cast<const bf16x8*>(&Qw[(long)r32*DMQ+d0*16+hi*8]);
  float mhat=0.f,l_reg=0.f;f32x16 o[2];o[0]=f32x16{};o[1]=f32x16{};f32x16 negm=f32x16{};asm volatile("":"+v"(negm));
  #define CMASK(P0,P1,t) do{}while(0)
  bool resc=false;
  #define START(P0,P1) do{ const float rm=rowmax(P0,P1); resc=false; \
    { const float dl=rm; mhat=fadd_s(mhat,dl); \
      _Pragma("unroll") for(int r=0;r<16;++r){P0[r]=fsub_s(P0[r],dl);P1[r]=fsub_s(P1[r],dl);} \
      _Pragma("unroll") for(int r=0;r<16;++r)negm[r]=-mhat; asm volatile("":"+v"(negm)); } \
    _Pragma("unroll") for(int r=0;r<16;++r)P0[r]=__builtin_amdgcn_exp2f(P0[r]); }while(0)
  #define RESC() do{ if(resc){ asm volatile("s_waitcnt lgkmcnt(0)":::"memory"); \
      _Pragma("unroll") for(int d_=0;d_<2;++d_) _Pragma("unroll") for(int r=0;r<16;++r)o[d_][r]*=wsf[crow(r,hi)]; } }while(0)
  f32x16 pA0,pA1,pB0,pB1;
  int sl_prev=0,sl_cur=0,sl_next=SLOTB;
  #define ROT() do{sl_prev=sl_cur;sl_cur=sl_next;sl_next=(sl_next==(NSLOT-1)*SLOTB)?0:sl_next+SLOTB;}while(0)
  DMA_K(2,2*SLOTB);
  WAIT_BAR(3);
  qkt(pA0,pA1,Kbase,qr,negm,r32,hi);asm volatile("s_nop 15\n\ts_nop 7":"+v"(pA0),"+v"(pA1));CMASK(pA0,pA1,0);
  START(pA0,pA1);
  _Pragma("unroll") for(int r=0;r<16;++r)pA1[r]=__builtin_amdgcn_exp2f(pA1[r]);
  WAIT_BAR(0);
  DMA_K(3,0);DMA_V(1,SLOTB);
  ROT();
  kload8(kf,kp0+sl_cur);
  WAIT_BAR(2);
  s16x4 vlo[8],vhi[8]; u32x4 pw0,pw1,pw2,pw3;
  #define PKW(P,B) cvtpk_s(P[B],P[B+1])
  #define PAF(k) __builtin_bit_cast(bf16x8,pw##k)
  #define VFR(i) __builtin_bit_cast(bf16x8,(sh8){vlo[i][0],vlo[i][1],vlo[i][2],vlo[i][3],vhi[i][0],vhi[i][1],vhi[i][2],vhi[i][3]})
  #define PIN(x) asm volatile("":"+v"(x))
  #define MX3(a,b,c) __builtin_fmaxf(__builtin_fmaxf((a),(b)),(c))
  #define GAPA(MF,A0,A1,A2,A3,W0,W1,PW) do{ MF; sacc+=A0; sacc+=A1; sacc+=A2; sacc+=A3; PIN(sacc); W0; W1; PIN(PW); SBAR(); }while(0)
  #define EX(v) __builtin_amdgcn_exp2f(v)
  #define GAPB(MF,X,B) do{ MF; X[B]=EX(X[B]); X[B+1]=EX(X[B+1]); X[B+2]=EX(X[B+2]); X[B+3]=EX(X[B+3]); PIN(X); SBAR(); }while(0)
  #define VRD(i) do{ vlo[i]=vtr(vp_+(((i)>>2)*4096+((i)&3)*1024)); vhi[i]=vtr(vp_+(((i)>>2)*4096+((i)&3)*1024+512)); }while(0)
  #define KRD(G,j) do{ if(G){ kload2(kf,kp0+sl_next,j); SBAR(); } }while(0)
  #define STEP(C0,C1,P0,P1,t,GK,GV,GL) do{ SBAR(); \
    const lds_cptr vp_=vp0+sl_prev; \
    VRD(0); SBAR(); float sacc=(P0[0]+P0[1]); \
    GAPA(C0=__builtin_amdgcn_mfma_f32_32x32x16_f16(kf[0],qr[0],negm,0,0,0), P0[2],P0[3],P0[4],P0[5],     pw0[0]=PKW(P0,0), pw0[1]=PKW(P0,2), pw0); \
    VRD(4); SBAR(); GAPA(C1=__builtin_amdgcn_mfma_f32_32x32x16_f16(kf[1],qr[0],negm,0,0,0), P0[6],P0[7],P0[8],P0[9],     pw0[2]=PKW(P0,4), pw0[3]=PKW(P0,6), pw0); \
    VRD(1); SBAR(); GAPA(C0=__builtin_amdgcn_mfma_f32_32x32x16_f16(kf[2],qr[1],C0,0,0,0),   P0[10],P0[11],P0[12],P0[13], pw1[0]=PKW(P0,8), pw1[1]=PKW(P0,10), pw1); \
    VRD(5); SBAR(); GAPA(C1=__builtin_amdgcn_mfma_f32_32x32x16_f16(kf[3],qr[1],C1,0,0,0),   P0[14],P0[15],P1[0],P1[1],   pw1[2]=PKW(P0,12),pw1[3]=PKW(P0,14), pw1); \
    VRD(2); SBAR(); GAPA(C0=__builtin_amdgcn_mfma_f32_32x32x16_f16(kf[4],qr[2],C0,0,0,0),   P1[2],P1[3],P1[4],P1[5],     pw2[0]=PKW(P1,0), pw2[1]=PKW(P1,2), pw2); \
    VRD(6); SBAR(); GAPA(C1=__builtin_amdgcn_mfma_f32_32x32x16_f16(kf[5],qr[2],C1,0,0,0),   P1[6],P1[7],P1[8],P1[9],     pw2[2]=PKW(P1,4), pw2[3]=PKW(P1,6), pw2); \
    VRD(3); SBAR(); GAPA(C0=__builtin_amdgcn_mfma_f32_32x32x16_f16(kf[6],qr[3],C0,0,0,0),   P1[10],P1[11],P1[12],P1[13], pw3[0]=PKW(P1,8), pw3[1]=PKW(P1,10), pw3); \
    VRD(7); SBAR(); GAPA(C1=__builtin_amdgcn_mfma_f32_32x32x16_f16(kf[7],qr[3],C1,0,0,0),   P1[14],P1[15],0.f,0.f,       pw3[2]=PKW(P1,12),pw3[3]=PKW(P1,14), pw3); \
    l_reg+=sacc; \
    if(GK){DMA_K((t)+3,sl_cur);} if(GV){DMA_V((t)+1,sl_next);} \
    CMASK(C0,C1,t); \
    { float a=MX3(C0[0],C0[1],C1[0]),b=MX3(C0[2],C0[3],C1[1]); a=MX3(a,C1[2],C1[3]); \
      _Pragma("unroll") for(int r=4;r<16;r+=4){a=MX3(a,C0[r],C0[r+1]);b=MX3(b,C0[r+2],C0[r+3]);a=MX3(a,C1[r],C1[r+1]);b=MX3(b,C1[r+2],C1[r+3]);} \
      float rm=__builtin_fmaxf(a,b); { auto rr=__builtin_amdgcn_permlane32_swap(__float_as_uint(rm),__float_as_uint(rm),false,false); rm=__builtin_fmaxf(__uint_as_float(rr[0]),__uint_as_float(rr[1])); } \
      resc=false; \
      if(__builtin_expect(__any(rm>(float)THRL),0)){ const float dl=__builtin_fmaxf(rm,0.f); mhat+=dl; \
        _Pragma("unroll") for(int r=0;r<16;++r){C0[r]-=dl;C1[r]-=dl;} \
        _Pragma("unroll") for(int r=0;r<16;++r)negm[r]=-mhat; asm volatile("":"+v"(negm)); \
        const float f=__builtin_amdgcn_exp2f(-dl); l_reg*=f; if(hi==0)wsf[r32]=f; resc=true; } } \
    SBAR(); \
    GAPB(o[0]=__builtin_amdgcn_mfma_f32_32x32x16_f16(PAF(0),VFR(0),o[0],0,0,0), C0,0); \
    GAPB(o[1]=__builtin_amdgcn_mfma_f32_32x32x16_f16(PAF(0),VFR(4),o[1],0,0,0), C0,4); \
    KRD(GL,0); GAPB(o[0]=__builtin_amdgcn_mfma_f32_32x32x16_f16(PAF(1),VFR(1),o[0],0,0,0), C0,8); \
    KRD(GL,1); GAPB(o[1]=__builtin_amdgcn_mfma_f32_32x32x16_f16(PAF(1),VFR(5),o[1],0,0,0), C0,12); \
    KRD(GL,2); GAPB(o[0]=__builtin_amdgcn_mfma_f32_32x32x16_f16(PAF(2),VFR(2),o[0],0,0,0), C1,0); \
    KRD(GL,3); GAPB(o[1]=__builtin_amdgcn_mfma_f32_32x32x16_f16(PAF(2),VFR(6),o[1],0,0,0), C1,4); \
    GAPB(o[0]=__builtin_amdgcn_mfma_f32_32x32x16_f16(PAF(3),VFR(3),o[0],0,0,0), C1,8); \
    GAPB(o[1]=__builtin_amdgcn_mfma_f32_32x32x16_f16(PAF(3),VFR(7),o[1],0,0,0), C1,12); \
    }while(0)
  int t=1;
  #undef CMASK
  #define CMASK(P0,P1,t) do{}while(0)
  for(;t+5<NT;t+=2){
    STEP(pB0,pB1,pA0,pA1,t,true,true,true);     WAIT_BAR(2); RESC(); ROT();
    STEP(pA0,pA1,pB0,pB1,t+1,true,true,true);   WAIT_BAR(2); RESC(); ROT();
  }
  #undef CMASK
  #define CMASK(P0,P1,t) do{}while(0)
  #define ENDW(tt) do{ if((tt)+3<NT){WAIT_BAR(2);} else if((tt)+2<NT){WAIT_BAR(1);} else {WAIT_BAR(0);} }while(0)
  for(;t+1<NT;t+=2){
    STEP(pB0,pB1,pA0,pA1,t,(t+3<NT),(t+1<NT),(t+1<NT));       ENDW(t);   RESC(); ROT();
    STEP(pA0,pA1,pB0,pB1,t+1,(t+4<NT),(t+2<NT),(t+2<NT));     ENDW(t+1); RESC(); ROT();
  }
  STEP(pB0,pB1,pA0,pA1,NT-1,false,false,false); RESC();
  { float sacc=pB0[0]+pB0[1]; _Pragma("unroll") for(int r=2;r<16;++r)sacc+=pB0[r]; _Pragma("unroll") for(int r=0;r<16;++r)sacc+=pB1[r]; l_reg+=sacc;
    pw0=(u32x4){PKW(pB0,0),PKW(pB0,2),PKW(pB0,4),PKW(pB0,6)};pw1=(u32x4){PKW(pB0,8),PKW(pB0,10),PKW(pB0,12),PKW(pB0,14)};pw2=(u32x4){PKW(pB1,0),PKW(pB1,2),PKW(pB1,4),PKW(pB1,6)};pw3=(u32x4){PKW(pB1,8),PKW(pB1,10),PKW(pB1,12),PKW(pB1,14)};
    SBAR(); pv(o,vb0+sl_cur,PAF(0),PAF(1),PAF(2),PAF(3)); }
  #undef PKW
  #undef PAF
  #undef VFR
  #undef PIN
  #undef MX3
  #undef GAPA
  #undef GAPB
  #undef EX
  #undef VRD
  #undef KRD
  #undef STEP
  #undef ENDW
  {auto rr=__builtin_amdgcn_permlane32_swap(__float_as_uint(l_reg),__float_as_uint(l_reg),false,false);l_reg=__uint_as_float(rr[0])+__uint_as_float(rr[1]);}
  if(hi==0)wsf[32+r32]=l_reg;asm volatile("s_waitcnt lgkmcnt(0)":::"memory");
  float rli[16];
  #pragma unroll
  for(int r=0;r<16;++r)rli[r]=__builtin_amdgcn_rcpf(wsf[32+crow(r,hi)]);
  bf16*Ow=Ou+(long)(wid*QBLK)*DMO;
  { bf16*stg=(bf16*)(shm+LDS_OST)+wid*2048;
    #pragma unroll
    for(int r=0;r<16;++r){const int orow=crow(r,hi);
      #pragma unroll
      for(int d0=0;d0<2;++d0)stg[orow*64+d0*32+r32]=(bf16)(o[d0][r]*rli[r]);}
    asm volatile("s_waitcnt lgkmcnt(0)":::"memory");
    #pragma unroll
    for(int i=0;i<4;++i){const int row=i*8+(lane>>3),ch=lane&7; const u32x4 v=*(const u32x4*)(stg+row*64+ch*8); ATTN_STORE16(Ow+(long)row*DMO+ch*8,v);} }
  asm volatile("s_waitcnt lgkmcnt(0)\n\ts_barrier":::"memory");
  #undef DMA_K
  #undef DMA_V
  #undef CMASK
  #undef START
  #undef RESC
  #undef ROT
}
#undef SBAR
#undef WAIT_BAR
}
namespace fa {
typedef _Float16 h2 __attribute__((ext_vector_type(2)));
typedef float f2 __attribute__((ext_vector_type(2)));
typedef short s16x4 __attribute__((ext_vector_type(4)));
typedef unsigned u32x4 __attribute__((ext_vector_type(4)));
#define FA_SBAR() __builtin_amdgcn_sched_barrier(0)
constexpr float THR = 8.f;
constexpr int SHM_V = 64 * 64 * 2;
template <int DQK> struct Cfg { static constexpr int KROWB = DQK == 64 ? 128 : 256, SHM_K = 64 * KROWB, NCH = DQK / 8; };
template <int DQK> __device__ __forceinline__ int kswz(int row, int ch) {
    if constexpr (DQK == 64) return row * 128 + ((ch ^ ((row >> 1) & 7)) << 4);
    else return row * 256 + ((ch ^ (row & 15)) << 4);
}
__device__ __forceinline__ int crow(int r, int hi) { return (r & 3) + 8 * (r >> 2) + 4 * hi; }
__device__ __forceinline__ unsigned cvtpk(float lo, float hi) { f2 v = {lo, hi}; h2 h = __builtin_convertvector(v, h2); return __builtin_bit_cast(unsigned, h); }
__device__ __forceinline__ void partialSM(f32x16& p0, f32x16& p1, float& m_reg, float& mn, float& alpha) {
    float pmax = p0[0];
#pragma unroll
    for (int r = 1; r < 16; ++r) pmax = fmaxf(pmax, p0[r]);
#pragma unroll
    for (int r = 0; r < 16; ++r) pmax = fmaxf(pmax, p1[r]);
    { auto rr = __builtin_amdgcn_permlane32_swap(__float_as_uint(pmax), __float_as_uint(pmax), false, false);
      pmax = fmaxf(__uint_as_float(rr[0]), __uint_as_float(rr[1])); }
    if (__builtin_expect(__all(pmax - m_reg <= THR), 1)) { mn = m_reg; alpha = 1.f; }
    else { mn = fmaxf(m_reg, pmax); alpha = __builtin_amdgcn_exp2f(m_reg - mn); m_reg = mn; }
#pragma unroll
    for (int r = 0; r < 16; ++r) { p0[r] = p0[r] - mn; p1[r] = p1[r] - mn; }
#pragma unroll
    for (int r = 0; r < 16; ++r) p0[r] = __builtin_amdgcn_exp2f(p0[r]);
}
__device__ __forceinline__ void finishSM(f32x16& p0, f32x16& p1, float alpha, float& l_reg, f16x8& pa0, f16x8& pa1, f16x8& pa2, f16x8& pa3) {
#pragma unroll
    for (int r = 0; r < 16; ++r) p1[r] = __builtin_amdgcn_exp2f(p1[r]);
    float ps = 0;
#pragma unroll
    for (int r = 0; r < 16; ++r) ps += p0[r];
#pragma unroll
    for (int r = 0; r < 16; ++r) ps += p1[r];
    { auto rr = __builtin_amdgcn_permlane32_swap(__float_as_uint(ps), __float_as_uint(ps), false, false);
      ps = __uint_as_float(rr[0]) + __uint_as_float(rr[1]); }
    l_reg = l_reg * alpha + ps;
#define FA_PK4(P, BASE, OUT) do { unsigned a0 = cvtpk(P[BASE + 0], P[BASE + 1]), a1 = cvtpk(P[BASE + 2], P[BASE + 3]);   \
    unsigned b0 = cvtpk(P[BASE + 4], P[BASE + 5]), b1 = cvtpk(P[BASE + 6], P[BASE + 7]);                              \
    auto r0 = __builtin_amdgcn_permlane32_swap(a0, b0, false, false); auto r1 = __builtin_amdgcn_permlane32_swap(a1, b1, false, false); \
    u32x4 w = {r0[0], r1[0], r0[1], r1[1]}; OUT = __builtin_bit_cast(f16x8, w); } while (0)
    FA_PK4(p0, 0, pa0); FA_PK4(p0, 8, pa1); FA_PK4(p1, 0, pa2); FA_PK4(p1, 8, pa3);
#undef FA_PK4
}
template <int DQK>
__device__ __forceinline__ void qkt(f32x16& p0, f32x16& p1, const LAS unsigned char* Ks, const f16x8* qr, int r32, int hi) {
    p0 = f32x16{}; p1 = f32x16{};
#pragma unroll
    for (int d0 = 0; d0 < DQK / 16; ++d0) {
        const f16x8 b0 = *(const LAS f16x8*)(Ks + kswz<DQK>(r32, d0 * 2 + hi));
        const f16x8 b1 = *(const LAS f16x8*)(Ks + kswz<DQK>(32 + r32, d0 * 2 + hi));
        p0 = __builtin_amdgcn_mfma_f32_32x32x16_f16(b0, qr[d0], p0, 0, 0, 0);
        p1 = __builtin_amdgcn_mfma_f32_32x32x16_f16(b1, qr[d0], p1, 0, 0, 0);
    }
}
__device__ __forceinline__ int v_st(int k, int c) { const int kk = (k & ~0xC) | ((k & 4) << 1) | ((k & 8) >> 1); return ((kk >> 3) * 2 + (c >> 5)) * 512 + ((kk & 7) * 32 + (c & 31)) * 2; }
__device__ __forceinline__ int v_rd_base(int lane) { return ((lane & 3) << 3) | (((lane >> 2) & 3) << 6) | (((lane >> 4) & 1) << 5) | (((lane >> 5) & 1) << 8); }
constexpr int v_rd_off(int d0, int ks, int half) { return d0 * 512 + ks * 2048 + half * 1024; }
template <int OFF> __device__ __forceinline__ s16x4 tr_read(int vb) {
    s16x4 r; asm volatile("ds_read_b64_tr_b16 %0, %1 offset:%2" : "=&v"(r) : "v"(vb), "i"(OFF) : "memory"); return r;
}
template <int D0> __device__ __forceinline__ void pv_one(f32x16& od, int vb, f16x8 pa0, f16x8 pa1, f16x8 pa2, f16x8 pa3) {
    const s16x4 l0 = tr_read<v_rd_off(D0, 0, 0)>(vb), h0 = tr_read<v_rd_off(D0, 0, 1)>(vb), l1 = tr_read<v_rd_off(D0, 1, 0)>(vb), h1 = tr_read<v_rd_off(D0, 1, 1)>(vb);
    const s16x4 l2 = tr_read<v_rd_off(D0, 2, 0)>(vb), h2_ = tr_read<v_rd_off(D0, 2, 1)>(vb), l3 = tr_read<v_rd_off(D0, 3, 0)>(vb), h3 = tr_read<v_rd_off(D0, 3, 1)>(vb);
    asm volatile("s_waitcnt lgkmcnt(0)" ::: "memory"); FA_SBAR();
#define FA_PK(L, H) __builtin_bit_cast(f16x8, (short __attribute__((ext_vector_type(8)))){L[0], L[1], L[2], L[3], H[0], H[1], H[2], H[3]})
    od = __builtin_amdgcn_mfma_f32_32x32x16_f16(pa0, FA_PK(l0, h0), od, 0, 0, 0);
    od = __builtin_amdgcn_mfma_f32_32x32x16_f16(pa1, FA_PK(l1, h1), od, 0, 0, 0);
    od = __builtin_amdgcn_mfma_f32_32x32x16_f16(pa2, FA_PK(l2, h2_), od, 0, 0, 0);
    od = __builtin_amdgcn_mfma_f32_32x32x16_f16(pa3, FA_PK(l3, h3), od, 0, 0, 0);
#undef FA_PK
}
__device__ __forceinline__ void pv_d0(f32x16* o, int vb, f16x8 pa0, f16x8 pa1, f16x8 pa2, f16x8 pa3) {
    pv_one<0>(o[0], vb, pa0, pa1, pa2, pa3); pv_one<1>(o[1], vb, pa0, pa1, pa2, pa3);
}
template <int DQK>
__device__ __forceinline__ void attn_unit(const f16* Qb, int qstride, const f16* __restrict__ Kh, const f16* __restrict__ Vh, f16* Ob, int nkeys, LAS unsigned char* lds, const int tid) {
    constexpr int SHM_K = Cfg<DQK>::SHM_K, NCH = Cfg<DQK>::NCH, ND0 = DQK / 16;
    const int wid = tid >> 6, lane = tid & 63, r32 = lane & 31, hi = lane >> 5;
    LAS unsigned char* V_lds = lds; LAS unsigned char* K_lds = lds + 3 * SHM_V;
    LAS float* wsx = (LAS float*)(lds + 3 * SHM_V + 2 * SHM_K) + wid * 64; LAS float* li_l = wsx; LAS float* al_l = wsx + 32;
    float m_reg = -1e30f, l_reg = 0; f32x16 o[2] = {}; f16x8 qr[ND0];
    const f16* Qw = Qb + (size_t)(wid * 32 + r32) * qstride + hi * 8;
#pragma unroll
    for (int d0 = 0; d0 < ND0; ++d0) qr[d0] = *(const f16x8*)(Qw + d0 * 16);
    const int vr = tid >> 3, vc = (tid & 7) * 8, vst = v_st(vr, vc);
    const int k0id = tid, k1id = (tid + 512 < 64 * NCH) ? tid + 512 : tid;
    const int k0r = k0id / NCH, k0c = k0id % NCH, k1r = k1id / NCH, k1c = k1id % NCH;
    const bool k1on = (NCH > 8) && (tid + 512 < 64 * NCH);
    const int vb0 = (int)(uintptr_t)V_lds + v_rd_base(lane);
    struct { f16x8 vs, ks0, ks1; } sr_[2];
#define FA_SLOAD(i, kk0) do { sr_[i].vs = *(const f16x8*)(Vh + (size_t)((kk0) + vr) * 64 + vc); sr_[i].ks0 = *(const f16x8*)(Kh + (size_t)((kk0) + k0r) * DQK + k0c * 8); \
    if (NCH > 8) sr_[i].ks1 = *(const f16x8*)(Kh + (size_t)((kk0) + k1r) * DQK + k1c * 8); } while (0)
#define FA_SWRITE(b, vbo, i) do { *(LAS f16x8*)(V_lds + (vbo) + vst) = sr_[i].vs; *(LAS f16x8*)(K_lds + (b) * SHM_K + kswz<DQK>(k0r, k0c)) = sr_[i].ks0; \
    if (k1on) *(LAS f16x8*)(K_lds + (b) * SHM_K + kswz<DQK>(k1r, k1c)) = sr_[i].ks1; } while (0)
#define FA_SWAIT() do { if (NCH > 8) asm volatile("s_waitcnt vmcnt(3)" ::: "memory"); else asm volatile("s_waitcnt vmcnt(2)" ::: "memory"); } while (0)
#define FA_RESC(a) do { if (__any((a) < 1.f)) { if (hi == 0) al_l[r32] = (a); asm volatile("s_waitcnt lgkmcnt(0)" ::: "memory"); \
    _Pragma("unroll") for (int d = 0; d < 2; ++d) _Pragma("unroll") for (int r = 0; r < 16; ++r) o[d][r] *= al_l[crow(r, hi)]; } } while (0)
    f32x16 pA0, pA1, pB0, pB1; float mnA, mnB, alA, alB; f16x8 pa0, pa1, pa2, pa3; const int NT = nkeys / 64;
    constexpr int SE = 0, SO = 1;
    int vp = 0, vc_ = SHM_V, vn = 2 * SHM_V;
#define FA_VROT() do { const int t_ = vp; vp = vc_; vc_ = vn; vn = t_; } while (0)
    FA_SLOAD(SE, 0); FA_SLOAD(SO, 64);
    FA_SWAIT(); FA_SWRITE(0, 0, SE); __syncthreads();
    qkt<DQK>(pA0, pA1, K_lds, qr, r32, hi); partialSM(pA0, pA1, m_reg, mnA, alA);
    if (2 < NT) FA_SLOAD(SE, 128);
    FA_SWAIT(); FA_SWRITE(1, SHM_V, SO); __syncthreads();
    for (int j = 1; j + 1 < NT; j += 2) {
        FA_SBAR(); qkt<DQK>(pB0, pB1, K_lds + SHM_K, qr, r32, hi);
        finishSM(pA0, pA1, alA, l_reg, pa0, pa1, pa2, pa3); FA_SBAR();
        FA_SLOAD(SO, (j + 2) * 64); FA_SBAR();
        pv_d0(o, vb0 + vp, pa0, pa1, pa2, pa3); partialSM(pB0, pB1, m_reg, mnB, alB);
        FA_SWAIT(); FA_SWRITE(0, vn, SE);
        FA_RESC(alB); __syncthreads(); FA_VROT();
        FA_SBAR(); qkt<DQK>(pA0, pA1, K_lds, qr, r32, hi);
        finishSM(pB0, pB1, alB, l_reg, pa0, pa1, pa2, pa3); FA_SBAR();
        if (j + 3 < NT) FA_SLOAD(SE, (j + 3) * 64);
        FA_SBAR();
        pv_d0(o, vb0 + vp, pa0, pa1, pa2, pa3); partialSM(pA0, pA1, m_reg, mnA, alA);
        FA_SWAIT(); FA_SWRITE(1, vn, SO);
        FA_RESC(alA); __syncthreads(); FA_VROT();
    }
    FA_SBAR(); qkt<DQK>(pB0, pB1, K_lds + SHM_K, qr, r32, hi);
    finishSM(pA0, pA1, alA, l_reg, pa0, pa1, pa2, pa3); FA_SBAR();
    pv_d0(o, vb0 + vp, pa0, pa1, pa2, pa3); partialSM(pB0, pB1, m_reg, mnB, alB);
    FA_RESC(alB);
    finishSM(pB0, pB1, alB, l_reg, pa0, pa1, pa2, pa3); FA_SBAR();
    pv_d0(o, vb0 + vc_, pa0, pa1, pa2, pa3);
    if (hi == 0) li_l[r32] = l_reg;
    asm volatile("s_waitcnt lgkmcnt(0)" ::: "memory");
    float rli[16];
#pragma unroll
    for (int r = 0; r < 16; ++r) rli[r] = __builtin_amdgcn_rcpf(li_l[crow(r, hi)]);
    f16* Ow = Ob + (size_t)(wid * 32) * 512;
#pragma unroll
    for (int r = 0; r < 16; ++r) { const int orow = crow(r, hi);
#pragma unroll
        for (int d0 = 0; d0 < 2; ++d0) Ow[(size_t)orow * 512 + d0 * 32 + r32] = (f16)(o[d0][r] * rli[r]); }
#undef FA_SLOAD
#undef FA_SWRITE
#undef FA_SWAIT
#undef FA_RESC
#undef FA_VROT
}
}
__device__ __forceinline__ void phase_attn_a(const Ctx& C, int l) {
    f16* QA = (f16*)(C.ws() + A_QA); const f16* KA = (const f16*)(C.ws() + A_KA); const f16* VA = (const f16*)(C.ws() + A_VA);
    const int vcu = (C.nblk % 8 == 0) ? (C.bid % 8) * (C.nblk / 8) + C.bid / 8 : C.bid;
    const int total = 512 + (l == 0 ? 32 : 0);
    for (int u = vcu; u < total; u += C.nblk) {
        __syncthreads();
        int b, h, nkeys; size_t orow;
        if (u < 512) { b = u >> 7; h = (u >> 4) & 7; orow = (size_t)b * SEQ + (u & 15) * 256; nkeys = NKEY; }
        else { const int v = u - 512; b = v >> 3; h = v & 7; orow = (size_t)NLAT + b * CTX; nkeys = CTX; }
        fa64::attn_unit<8, 512, 64, 512>(QA + orow * 512 + h * 64, KA + (size_t)(b * 2 + (h >> 2)) * NKEY * 64, VA + (size_t)(b * 2 + (h >> 2)) * NKEY * 64, QA + orow * 512 + h * 64, nkeys, (char*)C.lds, C.tid);
    }
    __syncthreads();
}
__device__ __forceinline__ void phase_attn_c(const Ctx& C, int l) {
    const f16* QC = (const f16*)(C.ws() + A_QC); const f16* KC = (const f16*)(C.ws() + A_KC); const f16* VC = (const f16*)(C.ws() + A_VC); f16* YC = (f16*)(C.ws() + A_YC);
    const int vcu = (C.nblk % 8 == 0) ? (C.bid % 8) * (C.nblk / 8) + C.bid / 8 : C.bid;
    const int total = 512 + (l == 0 ? 32 : 0);
    for (int u = vcu; u < total; u += C.nblk) {
        __syncthreads();
        int b, h, nkeys; size_t qrow, orow;
        if (u < 512) { b = u >> 7; h = (u >> 4) & 7; const int qb = u & 15; qrow = (size_t)(b * 8 + h) * SEQ + qb * 256; orow = (size_t)b * SEQ + qb * 256; nkeys = NKEY; }
        else { const int v = u - 512; b = v >> 3; h = v & 7; qrow = (size_t)NB * 8 * SEQ + (size_t)(b * 8 + h) * CTX; orow = (size_t)NLAT + b * CTX; nkeys = CTX; }
        fa::attn_unit<96>(QC + qrow * 96, 96, KC + (size_t)(b * 8 + h) * NKEY * 96, VC + (size_t)(b * 8 + h) * NKEY * 64, YC + orow * 512 + h * 64, nkeys, C.lds, C.tid);
    }
    __syncthreads();
}

constexpr float S5SC = 1024.0f, S5ISC = 1.0f / 1024.0f;
__device__ __forceinline__ void qp_split(int qp, int& b, int& nmem) { if (qp < 1024) { b = qp >> 8; nmem = 16 + (qp & 255); } else { b = (qp - 1024) >> 4; nmem = (qp - 1024) & 15; } }
__device__ __forceinline__ void phase_s5tab(const Ctx& C, int l) {
    LAS float* ApR = (LAS float*)C.lds; LAS float* ApI = ApR + 17 * 64; LAS float* BbR = ApI + 17 * 64; LAS float* BbI = BbR + 1024; LAS float* CR = BbI + 1024; LAS float* CI = CR + 1024;
    for (int u = C.bid; u < 64; u += C.nblk) {
        const int dir = u >> 5, g = u & 31; const size_t gi = (size_t)(l * 2 + dir) * 32 + g;
        const float dt = expf(C.in(I_SLDT)[gi]);
        __syncthreads();
        for (int i = C.tid; i < 17 * 64; i += NTHREADS) {
            const int p = i & 63, k = i >> 6; const float are = C.in(I_SARE)[gi * 64 + p], aim = C.in(I_SAIM)[gi * 64 + p];
            const float mag = expf(are * dt * (float)k), ang = (aim * dt) * (float)k;
            ApR[i] = mag * cosf(ang); ApI[i] = mag * sinf(ang);
        }
        for (int i = C.tid; i < 1024; i += NTHREADS) {
            const int p = i >> 4, c = i & 15; const float are = C.in(I_SARE)[gi * 64 + p], aim = C.in(I_SAIM)[gi * 64 + p];
            const float mag = expf(are * dt), th = aim * dt, abr = mag * cosf(th), abi = mag * sinf(th);
            const float den = are * are + aim * aim, nr = abr - 1.0f, cr = (nr * are + abi * aim) / den, ci = (abi * are - nr * aim) / den;
            const float br = C.in(I_SBRE)[(gi * 64 + p) * 16 + c], bi = C.in(I_SBIM)[(gi * 64 + p) * 16 + c];
            BbR[i] = cr * br - ci * bi; BbI[i] = cr * bi + ci * br;
            CR[i] = C.in(I_SCRE)[gi * 1024 + i]; CI[i] = C.in(I_SCIM)[gi * 1024 + i];
        }
        __syncthreads();
        f16* Et = (f16*)(C.ws() + T_E) + (size_t)u * 16 * 16 * 128; f16* Mt = (f16*)(C.ws() + T_M); f16* Kt = (f16*)(C.ws() + T_K) + (size_t)u * 17 * 256;
        for (int i = C.tid; i < 16384; i += NTHREADS) {
            { const int t = i >> 10, c = (i >> 6) & 15, p = i & 63, k = dir == 0 ? t + 1 : 16 - t;
              const float cr = CR[c * 64 + p], ci = CI[c * 64 + p], ar = ApR[k * 64 + p], ai = ApI[k * 64 + p];
              Et[(size_t)(t * 16 + c) * 128 + p] = (f16)((cr * ar - ci * ai) * S5SC); Et[(size_t)(t * 16 + c) * 128 + 64 + p] = (f16)(-(cr * ai + ci * ar) * S5SC); }
            { const int p = i >> 8, sx = (i >> 4) & 15, c = i & 15, k = dir == 0 ? 15 - sx : sx;
              const float ar = ApR[k * 64 + p], ai = ApI[k * 64 + p], br = BbR[p * 16 + c], bi = BbI[p * 16 + c];
              Mt[m3_off(u, p >> 5, sx, c >> 3, p & 31) + (c & 7)] = (f16)((ar * br - ai * bi) * S5SC);
              Mt[m3_off(u, 2 + (p >> 5), sx, c >> 3, p & 31) + (c & 7)] = (f16)((ar * bi + ai * br) * S5SC); }
        }
        for (int i = C.tid; i < 17 * 256; i += NTHREADS) {
            const int tau = (i >> 8) - 1, c = (i >> 4) & 15, cp = i & 15; float acc = 0.f;
            if (tau >= 0) {
#pragma unroll 8
                for (int p = 0; p < 64; ++p) {
                    const float cr = CR[c * 64 + p], ci = CI[c * 64 + p], ar = ApR[tau * 64 + p], ai = ApI[tau * 64 + p];
                    acc += (cr * ar - ci * ai) * BbR[p * 16 + cp] - (cr * ai + ci * ar) * BbI[p * 16 + cp]; }
            }
            Kt[i] = (f16)(acc * S5SC);
        }
    }
}
__device__ __forceinline__ void phase_s5ab(const Ctx& C, int l) {
    constexpr int SST = 273;
    const f16* U = (const f16*)(C.ws() + A_U); f16* X = (f16*)(C.ws() + A_S5X); const f16* Mt = (const f16*)(C.ws() + T_M);
    LAS float* Sl = (LAS float*)C.lds;
    LAS float* ex = Sl + 128 * SST;
    const int r32 = C.lane & 31, hi = C.lane >> 5;
    for (int item = C.bid; item < 256; item += C.nblk) {
        const int db = item, dirg = db >> 2, b = db & 3, dir = dirg >> 5, g = dirg & 31; const size_t gi = (size_t)(l * 2 + dir) * 32 + g;
        __syncthreads();
        for (int idx = C.wid; idx < 36; idx += NWAVES) {
            const int cb = idx >> 2, mb = idx & 3, nb = cb < 8 ? 8 * b + cb : 32 + (b >> 1);
            int bq, nmem; qp_split(nb * 32 + r32, bq, nmem);
            f16x8 uf[16], af[16];
#pragma unroll
            for (int sx = 0; sx < 16; ++sx) { uf[sx] = *(const f16x8*)(U + u3_off(g, nb, sx, hi, r32)); af[sx] = *(const f16x8*)(Mt + m3_off(dirg, mb, sx, hi, r32)); }
            f32x16 acc = {};
#pragma unroll
            for (int sx = 0; sx < 16; ++sx) acc = __builtin_amdgcn_mfma_f32_32x32x16_f16(af[sx], uf[sx], acc, 0, 0, 0);
            if (bq == b) {
#pragma unroll
                for (int r = 0; r < 16; ++r) Sl[(mb * 32 + fa::crow(r, hi)) * SST + nmem] = acc[r] * S5ISC;
            }
        }
        __syncthreads();
        const int p = C.lane, w = C.wid;
        const float are = C.in(I_SARE)[gi * 64 + p], aim = C.in(I_SAIM)[gi * 64 + p], dt = expf(C.in(I_SLDT)[gi]);
        const float mag = expf(are * dt * 16.0f), ang = (aim * dt) * 16.0f, ar = mag * cosf(ang), ai = mag * sinf(ang);
        const float mag32 = expf(are * dt * 512.0f), ang32 = (aim * dt) * 512.0f, br_ = mag32 * cosf(ang32), bi_ = mag32 * sinf(ang32);
        const LAS float* sr = Sl + p * SST; const LAS float* si = Sl + (64 + p) * SST;
        const int kkr = p >> 4, hf = (p >> 3) & 1, jj = p & 7;
        const int lo = dir == 0 ? 16 + 32 * w : 16 + 32 * (7 - w);
        float xr = 0.f, xi = 0.f;
#pragma unroll 4
        for (int e = 0; e < 16; ++e) {
            const int nmem = dir == 0 ? e : 15 - e;
            if (w == 0) { const int qp = 1024 + b * 16 + nmem;
                X[x3_off(dirg, qp >> 5, kkr, hf, qp & 31) + jj] = (f16)xr; X[x3_off(dirg, qp >> 5, 4 + kkr, hf, qp & 31) + jj] = (f16)xi; }
            const float sre = sr[nmem], sim = si[nmem];
            const float nxr = ar * xr - ai * xi + sre, nxi = ar * xi + ai * xr + sim; xr = nxr; xi = nxi;
        }
        const float c0r = xr, c0i = xi;
        xr = 0.f; xi = 0.f;
#pragma unroll 8
        for (int e = 0; e < 32; ++e) {
            const int nmem = lo + (dir == 0 ? e : 31 - e);
            const float sre = sr[nmem], sim = si[nmem];
            const float nxr = ar * xr - ai * xi + sre, nxi = ar * xi + ai * xr + sim; xr = nxr; xi = nxi;
        }
        ex[w * 128 + p] = xr; ex[w * 128 + 64 + p] = xi;
        __syncthreads();
        xr = c0r; xi = c0i;
        for (int v = 0; v < w; ++v) { const float er = ex[v * 128 + p], ei = ex[v * 128 + 64 + p];
            const float nxr = br_ * xr - bi_ * xi + er, nxi = br_ * xi + bi_ * xr + ei; xr = nxr; xi = nxi; }
#pragma unroll 8
        for (int e = 0; e < 32; ++e) {
            const int nmem = lo + (dir == 0 ? e : 31 - e), qp = b * 256 + nmem - 16;
            X[x3_off(dirg, qp >> 5, kkr, hf, qp & 31) + jj] = (f16)xr; X[x3_off(dirg, qp >> 5, 4 + kkr, hf, qp & 31) + jj] = (f16)xi;
            const float sre = sr[nmem], sim = si[nmem];
            const float nxr = ar * xr - ai * xi + sre, nxi = ar * xi + ai * xr + sim; xr = nxr; xi = nxi;
        }
    }
    __syncthreads();
}
__device__ __forceinline__ void phase_s5c(const Ctx& C, int l) {
    const f16* U = (const f16*)(C.ws() + A_U); const f16* X = (const f16*)(C.ws() + A_S5X); f16* G = (f16*)(C.ws() + A_G);
    const int r32 = C.lane & 31, hi = C.lane >> 5, t0 = 2 * C.wid, trow = t0 + (r32 >> 4), crw = r32 & 15;
    const int nnb = l == 0 ? 34 : 32;
    LAS f16* Kl = (LAS f16*)C.lds;
    int cur_g = -1; f16x8 ef[2][8];
    for (int u = C.bid; u < 32 * nnb; u += C.nblk) {
        const int g = u & 31, nb = u >> 5;
        const int row0 = (nb * 32 + r32) * 16;
        f16x8 uf[16], xf[2][8]; f16x4 u4[2][2];
#pragma unroll
        for (int sx = 0; sx < 16; ++sx) uf[sx] = *(const f16x8*)(U + u3_off(g, nb, sx, hi, r32));
#pragma unroll
        for (int dir = 0; dir < 2; ++dir)
#pragma unroll
            for (int kk = 0; kk < 8; ++kk) xf[dir][kk] = *(const f16x8*)(X + x3_off(dir * 32 + g, nb, kk, hi, r32));
#pragma unroll
        for (int tl = 0; tl < 2; ++tl)
#pragma unroll
            for (int gp = 0; gp < 2; ++gp) u4[tl][gp] = *(const f16x4*)(U + u3_off(g, nb, t0 + tl, gp, r32) + 4 * hi);
        if (g != cur_g) {
            __syncthreads();
            for (int i = C.tid; i < 2 * 17 * 256 / 8; i += NTHREADS) {
                const int dir = i / (17 * 32), j = i - dir * (17 * 32);
                *(LAS f16x8*)(Kl + (size_t)i * 8) = *(const f16x8*)((const f16*)(C.ws() + T_K) + (size_t)(dir * 32 + g) * 17 * 256 + j * 8);
            }
#pragma unroll
            for (int dir = 0; dir < 2; ++dir)
#pragma unroll
                for (int kk = 0; kk < 8; ++kk) ef[dir][kk] = *(const f16x8*)((const f16*)(C.ws() + T_E) + (size_t)(dir * 32 + g) * 16 * 16 * 128 + (size_t)(trow * 16 + crw) * 128 + kk * 16 + 8 * hi);
            __syncthreads();
            cur_g = g;
        }
        f32x16 acc = {};
        const LAS f16* kb = Kl + crw * 16 + 8 * hi;
#pragma unroll
        for (int sx = 0; sx < 16; ++sx) {
            if (sx <= t0 + 1) { const f16x8 af = *(const LAS f16x8*)(kb + (trow - sx + 1) * 256); acc = __builtin_amdgcn_mfma_f32_32x32x16_f16(af, uf[sx], acc, 0, 0, 0); }
            if (sx >= t0) { const f16x8 af = *(const LAS f16x8*)(kb + (17 + sx - trow + 1) * 256); acc = __builtin_amdgcn_mfma_f32_32x32x16_f16(af, uf[sx], acc, 0, 0, 0); }
        }
#pragma unroll
        for (int dir = 0; dir < 2; ++dir)
#pragma unroll
            for (int kk = 0; kk < 8; ++kk) acc = __builtin_amdgcn_mfma_f32_32x32x16_f16(ef[dir][kk], xf[dir][kk], acc, 0, 0, 0);
#pragma unroll
        for (int tl = 0; tl < 2; ++tl)
#pragma unroll
            for (int gp = 0; gp < 2; ++gp) {
                const size_t off = (size_t)(row0 + t0 + tl) * 512 + g * 16 + 4 * hi + 8 * gp;
                const f32x4 d4 = *(const f32x4*)(C.in(I_SD) + l * 512 + g * 16 + 4 * hi + 8 * gp);
                f32x4 y;
#pragma unroll
                for (int e = 0; e < 4; ++e) y[e] = gelu_tanh(acc[8 * tl + 4 * gp + e] * S5ISC + d4[e] * (float)u4[tl][gp][e]);
                *(f16x4*)(G + off) = pack4(y);
            }
    }
}

typedef __attribute__((address_space(1))) unsigned gu32;
#define XB_TMO      128
#define XB_XCNT(j)  (256  + 64 * (j))
#define XB_XSUB(j)  (1280 + 64 * (j))
#define XB_XGEN(j)  (2304 + 64 * (j))
#define XB_TOP      3328
#define XB_TOPGEN   3392
#define XCD_BAR_WORDS 3456
#define XB_SPIN_CAP (1u << 26)

__device__ __forceinline__ unsigned xb_ld(unsigned* p)              { return __hip_atomic_load(p, __ATOMIC_RELAXED, __HIP_MEMORY_SCOPE_AGENT); }
__device__ __forceinline__ unsigned xb_add(unsigned* p, unsigned v) { return __hip_atomic_fetch_add(p, v, __ATOMIC_RELAXED, __HIP_MEMORY_SCOPE_AGENT); }
__device__ __forceinline__ unsigned xb_xcc_id() { return (unsigned)__builtin_amdgcn_s_getreg((3 << 11) | 20) & 0xFu; }
#define XB_SPIN(cond, bar) do { unsigned _sp = 0; while (cond) { __builtin_amdgcn_s_sleep(1); \
    if ((++_sp & 255u) == 0u) { if (xb_ld(&(bar)[XB_TMO])) break; if (_sp > XB_SPIN_CAP) { atomicAdd(&(bar)[XB_TMO], 1u); break; } } } } while (0)

struct XcdBarrier {
    unsigned* bar; unsigned x;
    volatile LAS unsigned* st;
};

__device__ __forceinline__ XcdBarrier xcd_barrier_post(unsigned* bar, volatile LAS unsigned* st) {
    XcdBarrier b; b.bar = bar; b.x = xb_xcc_id(); b.st = st;
    if (threadIdx.x == 0) (void)xb_add(&bar[XB_XCNT(b.x)], 1u);
    return b;
}
__device__ __forceinline__ void xcd_barrier_complete(unsigned* bar, unsigned x, unsigned& nloc, unsigned& nx) {
    const unsigned G = gridDim.x * gridDim.y * gridDim.z;
    unsigned sum, cnt, mine, sp = 0u;
    for (;;) {
        sum = 0u; cnt = 0u; mine = 0u;
#pragma unroll
        for (unsigned j = 0; j < 16; ++j) { const unsigned c = xb_ld(&bar[XB_XCNT(j)]); sum += c; cnt += (c > 0u) ? 1u : 0u; mine = (j == x) ? c : mine; }
        if (sum == G) break;
        __builtin_amdgcn_s_sleep(1);
        if ((++sp & 255u) == 0u) { if (xb_ld(&bar[XB_TMO])) break; if (sp > XB_SPIN_CAP) { atomicAdd(&bar[XB_TMO], 1u); break; } }
    }
    nloc = mine > 0u ? mine : 1u; nx = cnt > 0u ? cnt : 1u;
}

__device__ __forceinline__ void xcd_barrier(const XcdBarrier& b, const bool t0) {
    asm volatile("s_waitcnt vmcnt(0)" ::: "memory");
    __syncthreads();
    if (t0) {
        unsigned* bar = b.bar;
        __builtin_amdgcn_s_waitcnt(0);
        unsigned nloc = b.st[0], nx = b.st[1];
        if (nloc == 0u) { xcd_barrier_complete(bar, b.x, nloc, nx); b.st[0] = nloc; b.st[1] = nx; }
        const unsigned old = xb_add(&bar[XB_XSUB(b.x)], 1u);
        const unsigned gen = old / nloc;
        if (old + 1u == (gen + 1u) * nloc) {
            __builtin_amdgcn_fence(__ATOMIC_RELEASE, "agent");
            asm volatile("s_waitcnt vmcnt(0)" ::: "memory");
            const unsigned og = xb_add(&bar[XB_TOP], 1u);
            const unsigned tg = og / nx;
            if (og + 1u == (tg + 1u) * nx) xb_add(&bar[XB_TOPGEN], 1u);
            else XB_SPIN(xb_ld(&bar[XB_TOPGEN]) == tg, bar);
            __builtin_amdgcn_fence(__ATOMIC_ACQUIRE, "agent");
            xb_add(&bar[XB_XGEN(b.x)], 1u);
            asm volatile("s_waitcnt vmcnt(0)" ::: "memory");
        } else {
            XB_SPIN(xb_ld(&bar[XB_XGEN(b.x)]) == gen, bar);
            __builtin_amdgcn_fence(__ATOMIC_ACQUIRE, "agent");
            asm volatile("s_waitcnt vmcnt(0)" ::: "memory");
        }
    }
    __syncthreads();
}

#ifndef PROBE_PH
#define PROBE_PH -1
#endif
struct Env { XcdBarrier bar; int wid; unsigned long long t_acc; };
#ifndef PROBE_L
#define PROBE_L -1
#endif
#define PH_BEGIN(k) unsigned long long _t0 = 0; if (PROBE_PH == (k) && (PROBE_L < 0 || PROBE_L == l)) _t0 = __builtin_amdgcn_s_memrealtime()
#define PH_END(k) if (PROBE_PH == (k) && (PROBE_L < 0 || PROBE_L == l)) env.t_acc += __builtin_amdgcn_s_memrealtime() - _t0
#define GSYNC() do { const Ctx Cb = make_ctx(env.wid); xcd_barrier(env.bar, Cb.tid == 0); } while (0)
constexpr int MISC_OFF = LDS_BYTES - 256;
constexpr int CW_BAR = 4096;
#define CTX() const Ctx C = make_ctx(env.wid); unsigned char* ws = C.ws()
template <int l>
__device__ __forceinline__ void layer_body(Env& env) {
        const int mrows = l == 0 ? MALL : NLAT;
        if (l == 0) { PH_BEGIN(0);
        { CTX(); (void)ws; phase_p1(C, 0); }
        GSYNC(); PH_END(0); }
        { PH_BEGIN(1);
        { CTX(); EpiProj E{(f16*)(ws + A_PROJ), (f16*)(ws + A_VA), (f16*)(ws + A_U)};
          gemm_pg8(C, (const f16*)(ws + A_H), D, (const f16*)(ws + W_INA), D, MALL, 2560, D, E); }
        GSYNC(); PH_END(1); }
        { PH_BEGIN(2);
        { CTX(); (void)ws; phase_p3(C, l); }
        GSYNC(); PH_END(2); }
        { PH_BEGIN(3);
        { CTX(); EpiKvUp E1{(f16*)(ws + A_KC), (f16*)(ws + A_VC)};
          gemm_rows(C, (const f16*)(ws + A_PROJ) + PC_CKV, PLD2, (const f16*)(ws + W_KVB), 256, MALL, 1024, 256, E1); }
        { CTX(); EpiQUp E2{(f16*)(ws + A_QC), (const float*)(ws + WS_ROPE) + 2048};
          gemm_pg8(C, (const f16*)(ws + A_PROJ) + PC_CQ, PLD2, (const f16*)(ws + W_QB), 768, mrows, 768, 768, E2); }
        GSYNC(); PH_END(3); }
        { PH_BEGIN(4);
        { CTX(); (void)ws; phase_s5ab(C, l); }
        { CTX(); (void)ws; phase_attn_a(C, l); }
        { CTX(); (void)ws; phase_attn_c(C, l); }
        GSYNC(); PH_END(4); }
        { PH_BEGIN(6);
        { CTX(); (void)ws; phase_s5c(C, l); }
        GSYNC(); PH_END(6); }
        { PH_BEGIN(7);
        { CTX(); EpiGlu E{(f16*)(ws + A_YS)};
          gemm_rows(C, (const f16*)(ws + A_G), 512, (const f16*)(ws + W_GLU), 512, mrows, 1024, 512, E); }
        GSYNC(); PH_END(7); }
        { PH_BEGIN(8);
        {
            CTX();
            const f16* Hh = (const f16*)(ws + A_H); const f16* Wg = (const f16*)(ws + W_GATE); const f16* Wb = (const f16*)(ws + W_BR);
            const f16* Y0 = (const f16*)(ws + A_YA); const f16* Y1 = (const f16*)(ws + A_YS); const f16* Y2 = (const f16*)(ws + A_YC);
            EpiGate Eg{(f16*)(ws + A_GATE)}; EpiBranch Eb0{(const f16*)(ws + A_GATE), (f16*)(ws + A_MERGED), 1}; EpiBranch Eb{(const f16*)(ws + A_GATE), (f16*)(ws + A_MERGED), 0};
            constexpr size_t WGS = (size_t)1024 * 1024, WBS = (size_t)1024 * 512;
            gemm_pg8c<false, true>(C, Hh, D, Wg, D, NLAT, 1024, D, Eg, Y0, 512, Wb, 512);
            gemm_pg8c<true, true>(C, Y0, 512, Wb, 512, NLAT, 1024, 512, Eb0, Hh, D, Wg + WGS, D);
            gemm_pg8c<true, true>(C, Hh, D, Wg + WGS, D, NLAT, 1024, D, Eg, Y1, 512, Wb + WBS, 512);
            gemm_pg8c<true, true>(C, Y1, 512, Wb + WBS, 512, NLAT, 1024, 512, Eb, Hh, D, Wg + 2 * WGS, D);
            gemm_pg8c<true, true>(C, Hh, D, Wg + 2 * WGS, D, NLAT, 1024, D, Eg, Y2, 512, Wb + 2 * WBS, 512);
            gemm_pg8c<true, false>(C, Y2, 512, Wb + 2 * WBS, 512, NLAT, 1024, 512, Eb, Hh, D, Wg, D);
        }
        if (mrows > NLAT) {
#pragma unroll
            for (int br = 0; br < 3; ++br) {
                { CTX(); EpiGate Eg{(f16*)(ws + A_GATE)};
                  gemm_small(C, (const f16*)(ws + A_H) + (size_t)NLAT * D, D, (const f16*)(ws + W_GATE) + (size_t)br * 1024 * 1024, D, NLAT, 1024, D, Eg); }
                { CTX(); const f16* Y = (const f16*)(ws + (br == 0 ? A_YA : br == 1 ? A_YS : A_YC));
                  EpiBranch Eb{(const f16*)(ws + A_GATE), (f16*)(ws + A_MERGED), br == 0};
                  gemm_small(C, Y + (size_t)NLAT * 512, 512, (const f16*)(ws + W_BR) + (size_t)br * 1024 * 512, 512, NLAT, 1024, 512, Eb); }
            }
        }
        GSYNC(); PH_END(8); }
        { PH_BEGIN(9);
        { CTX(); EpiWout E{&C, l}; gemm_rows(C, (const f16*)(ws + A_MERGED), D, (const f16*)(ws + W_OUT), D, mrows, 1024, D, E); }
        GSYNC(); PH_END(9); }
        { PH_BEGIN(10);
        { CTX(); (void)ws; phase_p10(C, l, mrows); }
        GSYNC(); PH_END(10); }
        { PH_BEGIN(11);
        { CTX(); EpiUp E{(f16*)(ws + A_HID)}; gemm_rows(C, (const f16*)(ws + A_H), D, (const f16*)(ws + W_UP), D, mrows, DFF, D, E); }
        GSYNC(); PH_END(11); }
        { PH_BEGIN(12);
        { CTX(); EpiDown E{&C, l}; gemm_rows(C, (const f16*)(ws + A_HID), DFF, (const f16*)(ws + W_DOWN), DFF, mrows, 1024, DFF, E); }
        GSYNC(); PH_END(12); }
        { PH_BEGIN(13);
        if (l == 0) { CTX(); (void)ws; if (C.nblk > 128) { if (C.bid < 64) phase_s5tab(C, 1); else phase_cvt(C, 1, 64); } else { phase_s5tab(C, 1); __syncthreads(); phase_cvt(C, 1, 0); } }
        { CTX(); (void)ws; phase_p13(C, l, mrows); }
        if (l == 0) GSYNC(); PH_END(13); }
}
__global__ void __launch_bounds__(NTHREADS, 2) fwd_all(Args args) {
    cg::grid_group grid = cg::this_grid();
    extern __shared__ __attribute__((aligned(16))) unsigned char lds_raw[];
    volatile LAS unsigned* MISC = (volatile LAS unsigned*)((LAS unsigned char*)lds_raw + MISC_OFF);
    if (threadIdx.x < 64) MISC[threadIdx.x] = 0u;
    __syncthreads();
    Env env; env.t_acc = 0; env.wid = __builtin_amdgcn_readfirstlane(threadIdx.x >> 6);
    env.bar = xcd_barrier_post((unsigned*)(args.ws + WS_CTL) + CW_BAR, MISC + 8);
    { CTX(); (void)ws; if (C.nblk > 128) { if (C.bid < 64) phase_s5tab(C, 0); else { phase_setup(C, 64); __syncthreads(); phase_cvt(C, 0, 64); } } else { phase_setup(C, 0); __syncthreads(); phase_s5tab(C, 0); __syncthreads(); phase_cvt(C, 0, 0); } }
    asm volatile("s_waitcnt vmcnt(0)" ::: "memory");
    grid.sync();
    __builtin_amdgcn_fence(__ATOMIC_ACQUIRE, "agent");
    asm volatile("s_waitcnt vmcnt(0)" ::: "memory");
    layer_body<0>(env);
    layer_body<1>(env);
    if (PROBE_PH >= 0 && blockIdx.x == 0) { const unsigned long long t0 = __builtin_amdgcn_s_memrealtime(); while (__builtin_amdgcn_s_memrealtime() - t0 < 8ull * env.t_acc) __builtin_amdgcn_s_sleep(8); }
}

extern "C" void kernel_launch(void* const* d_in, const int* in_sizes, int n_in, void* d_out, int out_size, void* d_ws, size_t ws_size, hipStream_t stream) {
    static int grid_blocks = 0;
    if (grid_blocks == 0) {
        if (n_in != 32 || out_size != NLAT * D || ws_size < WS_NEED) { fprintf(stderr, "kernel_launch: unexpected shapes n_in %d out %d ws %zu (need %zu)\n", n_in, out_size, ws_size, (size_t)WS_NEED); grid_blocks = -1; return; }
        int dev = 0, cus = 0, per_cu = 0;
        hipGetDevice(&dev);
        hipDeviceGetAttribute(&cus, hipDeviceAttributeMultiprocessorCount, dev);
        if (hipFuncSetAttribute((const void*)fwd_all, hipFuncAttributeMaxDynamicSharedMemorySize, LDS_BYTES) != hipSuccess) { fprintf(stderr, "kernel_launch: hipFuncSetAttribute failed\n"); grid_blocks = -1; return; }
        hipOccupancyMaxActiveBlocksPerMultiprocessor(&per_cu, (const void*)fwd_all, NTHREADS, LDS_BYTES);
        if (per_cu < 1) { fprintf(stderr, "kernel_launch: occupancy query says %d blocks per CU\n", per_cu); grid_blocks = -1; return; }
        grid_blocks = cus;
    }
    if (grid_blocks < 0) return;
    Args a{};
    for (int i = 0; i < 32; ++i) a.in[i] = (const float*)d_in[i];
    a.out = (float*)d_out; a.ws = (unsigned char*)d_ws;
    if (hipMemsetAsync((char*)d_ws + WS_CTL, 0, 1 * MiB, stream) != hipSuccess) { fprintf(stderr, "kernel_launch: hipMemsetAsync failed\n"); return; }
    void* kargs[] = {&a};
    const hipError_t e = hipLaunchCooperativeKernel((const void*)fwd_all, dim3(grid_blocks), dim3(NTHREADS), kargs, LDS_BYTES, stream);
    if (e != hipSuccess) fprintf(stderr, "kernel_launch: cooperative launch failed: %s (grid %d)\n", hipGetErrorString(e), grid_blocks);
}
```

```cpp
#include <hip/hip_runtime.h>
#include <hip/hip_cooperative_groups.h>
#include <cstdio>
#include <cstdint>
#include <cmath>

namespace cg = cooperative_groups;

#define LAS __attribute__((address_space(3)))
typedef _Float16 f16;
typedef _Float16 f16x8 __attribute__((ext_vector_type(8)));
typedef _Float16 f16x4 __attribute__((ext_vector_type(4)));
typedef float f32x4 __attribute__((ext_vector_type(4)));
typedef float f32x16 __attribute__((ext_vector_type(16)));

constexpr int D = 1024, NB = 4, SEQ = 4096, CTX = 256, NLAT = NB * SEQ, NCTX = NB * CTX, MALL = NLAT + NCTX;
constexpr int NKEY = CTX + SEQ;
constexpr int OFF_AK = 0, OFF_AV = 128, OFF_CKV = 256, OFF_CKR = 512, OFF_U = 544, OFF_AQ = 1056, OFF_CQ = 1568, OFF_GATE = 2336, N_IN = 5408;
constexpr int GC_AV = 128, GC_CKV = 256, GC_CKR = 512, GC_PAD = 544, GC_U = 768, GC_AQ = 1280, GC_CQ = 1792;
constexpr int PC_AK = 0, PC_CKV = 128, PC_CKR = 384, PC_AQ = 416, PC_CQ = 928, PLD2 = 1696;
constexpr int DFF = 4096;
constexpr float EPS = 1e-6f;
constexpr float ALPHA = 1.4142135623730951f;
constexpr float LOG2E = 1.4426950408889634f;
constexpr float QSCALE_A = 0.125f * LOG2E;
constexpr float QSCALE_C = 0.10206207261596575f * LOG2E;

constexpr size_t MiB = 1u << 20;
constexpr size_t WS_CTL = 0;
constexpr size_t WS_MOD = 1 * MiB;
constexpr size_t WS_ROPE = 1 * MiB + 512 * 1024;
constexpr size_t WS_W16 = 2 * MiB;
constexpr size_t W_INA = WS_W16;
constexpr size_t W_GATE = W_INA + (size_t)2560 * 1024 * 2;
constexpr size_t W_QB = W_GATE + (size_t)3072 * 1024 * 2;
constexpr size_t W_KVB = W_QB + (size_t)768 * 768 * 2;
constexpr size_t W_GLU = W_KVB + (size_t)1024 * 256 * 2;
constexpr size_t W_BR = W_GLU + (size_t)1024 * 512 * 2;
constexpr size_t W_OUT = W_BR + (size_t)3 * 1024 * 512 * 2;
constexpr size_t W_UP = W_OUT + (size_t)1024 * 1024 * 2;
constexpr size_t W_DOWN = W_UP + (size_t)4096 * 1024 * 2;
constexpr size_t W_END = W_DOWN + (size_t)1024 * 4096 * 2;
constexpr size_t WS_TACTX = 37 * MiB;
constexpr size_t WS_ACT = 41 * MiB;
static_assert(W_END <= WS_TACTX, "weights fit");
constexpr size_t A_H = WS_ACT + 0 * MiB;
constexpr size_t A_PROJ = WS_ACT + 34 * MiB;
constexpr size_t A_YC = WS_ACT + 34 * MiB;
constexpr size_t A_T1H = WS_ACT + 34 * MiB;
constexpr size_t A_G = WS_ACT + 68 * MiB;
constexpr size_t A_YS = WS_ACT + 51 * MiB;
constexpr size_t A_HID = WS_ACT + 68 * MiB;
constexpr size_t A_QA = WS_ACT + 91 * MiB;
constexpr size_t A_YA = A_QA;
constexpr size_t A_QC = WS_ACT + 108 * MiB;
constexpr size_t A_S5X = WS_ACT + 51 * MiB;
constexpr size_t A_GATE = WS_ACT + 108 * MiB;
constexpr size_t A_KA = WS_ACT + 134 * MiB;
constexpr size_t A_VA = A_KA + (size_t)NB * 2 * NKEY * 64 * 2;
constexpr size_t A_U = WS_ACT + 143 * MiB;
constexpr size_t A_MERGED = WS_ACT + 143 * MiB;
constexpr size_t A_KC = WS_ACT + 160 * MiB;
constexpr size_t A_VC = WS_ACT + 186 * MiB;
constexpr size_t WS_ST1 = 1 * MiB + 768 * 1024;
constexpr size_t T_K = WS_ACT + 205 * MiB;
constexpr size_t T_E = T_K + (size_t)64 * 17 * 256 * 2;
constexpr size_t T_M = T_E + (size_t)64 * 16 * 16 * 128 * 2;
constexpr size_t WS_NEED = WS_ACT + 215 * MiB;
static_assert(T_M + (size_t)64 * 128 * 256 * 2 <= WS_NEED, "s5 tables");
static_assert(A_PROJ + (size_t)MALL * PLD2 * 2 <= A_QA && A_VA + (size_t)NB * 2 * NKEY * 64 * 2 <= A_U && A_VC + 17 * MiB <= T_K && A_HID + 136 * MiB <= T_K && A_MERGED + 34 * MiB <= T_K && A_GATE + 34 * MiB <= A_MERGED, "ws map");
static_assert(WS_NEED <= 256 * MiB, "ws budget");

constexpr int LDS_BYTES = 147456;
constexpr int NTHREADS = 512, NWAVES = 8;

struct Args {
    const float* in[32];
    float* out;
    unsigned char* ws;
    int ph_lo, ph_hi;
};
enum { I_X = 0, I_C, I_CTX, I_CCTX, I_WMOD, I_BMOD, I_WIN, I_AQG, I_AKG, I_CQG, I_CKVG, I_WQB, I_WKVB, I_SARE, I_SAIM, I_SLDT, I_SBRE, I_SBIM, I_SCRE, I_SCIM,
       I_SD, I_WGLU, I_WBA, I_WBS, I_WBC, I_WOUT, I_LN1G, I_LN1B, I_WUP, I_WDOWN, I_LN2G, I_LN2B };

template <int CTRL> __device__ __forceinline__ float dpp_mov(float v) { return __builtin_bit_cast(float, __builtin_amdgcn_update_dpp(0, __builtin_bit_cast(int, v), CTRL, 0xF, 0xF, true)); }
__device__ __forceinline__ float lane_bcast(float v, int l) { return __builtin_bit_cast(float, __builtin_amdgcn_readlane(__builtin_bit_cast(int, v), l)); }
__device__ __forceinline__ float wave_sum(float v) {
    v += dpp_mov<0xB1>(v); v += dpp_mov<0x4E>(v); v += dpp_mov<0x141>(v); v += dpp_mov<0x140>(v);
    return (lane_bcast(v, 0) + lane_bcast(v, 16)) + (lane_bcast(v, 32) + lane_bcast(v, 48));
}
__device__ __forceinline__ float shflx(float v, int k, int lane) { return __builtin_bit_cast(float, __builtin_amdgcn_ds_bpermute((lane ^ k) << 2, __builtin_bit_cast(int, v))); }
__device__ __forceinline__ float sigmoidf_(float x) { return 1.0f / (1.0f + __expf(-x)); }
__device__ __forceinline__ float gelu_tanh(float x) {
    const float u = 0.7978845608028654f * (x + 0.044715f * x * x * x);
    const float e = __expf(2.0f * u);
    const float t = 1.0f - 2.0f / (e + 1.0f);
    return 0.5f * x * (1.0f + t);
}
__device__ __forceinline__ f16x8 pack8(f32x4 lo, f32x4 hi) {
    f16x8 r; r[0] = (f16)lo[0]; r[1] = (f16)lo[1]; r[2] = (f16)lo[2]; r[3] = (f16)lo[3]; r[4] = (f16)hi[0]; r[5] = (f16)hi[1]; r[6] = (f16)hi[2]; r[7] = (f16)hi[3]; return r;
}
__device__ __forceinline__ f16x4 pack4(f32x4 v) { f16x4 r; r[0] = (f16)v[0]; r[1] = (f16)v[1]; r[2] = (f16)v[2]; r[3] = (f16)v[3]; return r; }

struct RowInfo { int b, t, pos, lat, mrow; };
__device__ __forceinline__ RowInfo row_info(int r) {
    RowInfo o;
    if (r < NLAT) { o.lat = 1; o.b = r >> 12; o.t = r & 4095; o.pos = CTX + o.t; o.mrow = o.b; }
    else { const int rr = r - NLAT; o.lat = 0; o.b = rr >> 8; o.t = rr & 255; o.pos = o.t; o.mrow = 4; }
    return o;
}

#define CAS __attribute__((address_space(4)))
struct Ctx {
    const CAS unsigned char* kp; LAS unsigned char* lds;
    int tid, lane, wid, nblk, bid;
    __device__ __forceinline__ const float* in(int i) const { return *(const float* const CAS*)(kp + 8 * i); }
    __device__ __forceinline__ float* out() const { return *(float* const CAS*)(kp + 256); }
    __device__ __forceinline__ unsigned char* ws() const { return *(unsigned char* const CAS*)(kp + 264); }
    __device__ __forceinline__ const float* mod(int l, int mrow, int which) const { return (const float*)(ws() + WS_MOD) + ((size_t)(l * 5 + mrow) * 6 + which) * D; }
    __device__ __forceinline__ const float* xsrc(int l, int r) const {
        if (l == 0) return r < NLAT ? in(I_X) + (size_t)r * D : in(I_CTX) + (size_t)(r - NLAT) * D;
        return r < NLAT ? out() + (size_t)r * D : (const float*)(ws() + WS_TACTX) + (size_t)(r - NLAT) * D;
    }
    __device__ __forceinline__ float* ta(int r) const { return r < NLAT ? out() + (size_t)r * D : (float*)(ws() + WS_TACTX) + (size_t)(r - NLAT) * D; }
};
__device__ __forceinline__ Ctx make_ctx(int wid) {
    extern __shared__ __attribute__((aligned(16))) unsigned char lds_raw[];
    Ctx C;
    const CAS unsigned char* kp = (const CAS unsigned char*)__builtin_amdgcn_kernarg_segment_ptr();
    asm volatile("" : "+s"(kp));
    C.kp = kp; C.lds = (LAS unsigned char*)lds_raw;
    unsigned z0 = 0u; asm volatile("" : "+v"(z0));
    int lane = __builtin_amdgcn_mbcnt_hi(~0u, __builtin_amdgcn_mbcnt_lo(~0u, z0)); asm volatile("" : "+v"(lane));
    asm volatile("" : "+s"(wid));
    C.tid = wid * 64 + lane; C.lane = lane; C.wid = wid;
    int bid = blockIdx.x; asm volatile("" : "+s"(bid));
    C.bid = bid; C.nblk = gridDim.x;
    return C;
}

__device__ __forceinline__ void phase_setup(const Ctx& C, int b0) {
    LAS float* sv = (LAS float*)C.lds;
    LAS float* red = sv + 5 * 1024;
    for (int i = C.tid; i < 5 * 1024; i += NTHREADS) {
        const int mr = i >> 10, k = i & 1023;
        const float v = mr < 4 ? C.in(I_C)[mr * D + k] : C.in(I_CCTX)[k];
        sv[i] = v / (1.0f + __expf(-v));
    }
    __syncthreads();
    for (int u = C.bid - b0; u < 192; u += C.nblk - b0) {
        const int l = u / 96, n0 = (u % 96) * 64;
        const float* W = C.in(I_WMOD) + (size_t)l * D * 6144 + n0 + C.lane;
        float acc[5] = {0.f, 0.f, 0.f, 0.f, 0.f};
        const int kb = C.wid * 128;
#pragma unroll 8
        for (int k = 0; k < 128; ++k) {
            const float w = W[(size_t)(kb + k) * 6144];
#pragma unroll
            for (int m = 0; m < 5; ++m) acc[m] += sv[m * 1024 + kb + k] * w;
        }
#pragma unroll
        for (int m = 0; m < 5; ++m) red[(C.wid * 5 + m) * 64 + C.lane] = acc[m];
        __syncthreads();
        if (C.tid < 320) {
            const int m = C.tid >> 6, c = C.tid & 63; float s = 0.f;
#pragma unroll
            for (int w = 0; w < 8; ++w) s += red[(w * 5 + m) * 64 + c];
            ((float*)(C.ws() + WS_MOD))[(size_t)(l * 5 + m) * 6144 + n0 + c] = s + C.in(I_BMOD)[l * 6144 + n0 + c];
        }
        __syncthreads();
    }
    if (C.bid == C.nblk - 1) {
        float* ra = (float*)(C.ws() + WS_ROPE);
        for (int i = C.tid; i < 1024; i += NTHREADS) {
            const int pos = i >> 4, f = i & 15;
            const float inv = powf(10000.0f, -(float)(2 * f) / 32.0f);
            const float ang = (float)pos * inv;
            ra[i] = cosf(ang); ra[1024 + i] = sinf(ang);
        }
        for (int i = C.tid; i < 512; i += NTHREADS) {
            const int pos = i >> 3, f = i & 7;
            const float inv = powf(10000.0f, -(float)(2 * f) / 16.0f);
            const float ang = (float)pos * inv;
            ra[2048 + i] = cosf(ang); ra[2048 + 512 + i] = sinf(ang);
        }
    }
}

__device__ __forceinline__ int glu_row(int n) { const int isg = n >= 512, j = n & 511; return 8 * (j >> 2) + 4 * isg + (j & 3); }
__device__ __forceinline__ void cvt_load(const float* W, int ldw, int coff, int nblk, int item, int lane, f32x4 (&v)[8]) {
    const int kb = item / nblk, nb = item % nblk, k0 = 64 * kb, n0 = 32 * nb;
#pragma unroll
    for (int i = 0; i < 8; ++i) v[i] = *(const f32x4*)(W + (size_t)(k0 + 8 * i + (lane >> 3)) * ldw + coff + n0 + 4 * (lane & 7));
}
__device__ __forceinline__ void cvt_store(const f32x4 (&v)[8], int K, int nblk, f16* WT, int mode, LAS float* scr, int item, int lane) {
    const int kb = item / nblk, nb = item % nblk, k0 = 64 * kb, n0 = 32 * nb;
#pragma unroll
    for (int i = 0; i < 8; ++i) { LAS float* d = scr + (8 * i + (lane >> 3)) * 33 + 4 * (lane & 7); d[0] = v[i][0]; d[1] = v[i][1]; d[2] = v[i][2]; d[3] = v[i][3]; }
    asm volatile("s_waitcnt lgkmcnt(0)" ::: "memory");
    const int c = lane & 7;
#pragma unroll
    for (int j = 0; j < 4; ++j) {
        const int n = (lane >> 3) + 8 * j; const LAS float* sp = scr + (8 * c) * 33 + n;
        f16x8 o;
#pragma unroll
        for (int e = 0; e < 8; ++e) o[e] = (f16)sp[e * 33];
        const int nn = n0 + n; const int row = mode ? glu_row(nn) : nn;
        *(f16x8*)(WT + (size_t)row * K + k0 + 8 * c) = o;
    }
    asm volatile("s_waitcnt lgkmcnt(0)" ::: "memory");
}
__device__ __forceinline__ void cvt_mat(const Ctx& C, const float* src, int ldw, int coff, int K, int N, size_t dst, int mode, int& base, int b0) {
    LAS float* scr = (LAS float*)C.lds + C.wid * (64 * 33);
    const int gw = (C.bid - b0) * NWAVES + C.wid, ngw = (C.nblk - b0) * NWAVES;
    const int nblk = N / 32, items = (K / 64) * nblk;
    int first = gw - (base % ngw); if (first < 0) first += ngw;
    f16* WT = (f16*)(C.ws() + dst);
    f32x4 va[8], vb[8];
    if (first < items) cvt_load(src, ldw, coff, nblk, first, C.lane, va);
    for (int it = first; it < items; it += 2 * ngw) {
        const int it2 = it + ngw, it3 = it + 2 * ngw;
        if (it2 < items) cvt_load(src, ldw, coff, nblk, it2, C.lane, vb);
        cvt_store(va, K, nblk, WT, mode, scr, it, C.lane);
        if (it3 < items) cvt_load(src, ldw, coff, nblk, it3, C.lane, va);
        if (it2 < items) cvt_store(vb, K, nblk, WT, mode, scr, it2, C.lane);
    }
    base += items;
}
__device__ __forceinline__ void phase_cvt(const Ctx& C, int l, int b0) {
    int base = 0;
    cvt_mat(C, C.in(I_WIN) + (size_t)l * D * N_IN, N_IN, 0, D, GC_PAD, W_INA, 0, base, b0);
    cvt_mat(C, C.in(I_WIN) + (size_t)l * D * N_IN, N_IN, GC_PAD, D, OFF_GATE - GC_PAD, W_INA + (size_t)GC_U * 1024 * 2, 0, base, b0);
    cvt_mat(C, C.in(I_WIN) + (size_t)l * D * N_IN, N_IN, OFF_GATE, D, 3072, W_GATE, 0, base, b0);
    cvt_mat(C, C.in(I_WQB) + (size_t)l * 768 * 768, 768, 0, 768, 768, W_QB, 0, base, b0);
    cvt_mat(C, C.in(I_WKVB) + (size_t)l * 256 * 1024, 1024, 0, 256, 1024, W_KVB, 0, base, b0);
    cvt_mat(C, C.in(I_WGLU) + (size_t)l * 512 * 1024, 1024, 0, 512, 1024, W_GLU, 1, base, b0);
    cvt_mat(C, C.in(I_WBA) + (size_t)l * 512 * 1024, 1024, 0, 512, 1024, W_BR, 0, base, b0);
    cvt_mat(C, C.in(I_WBS) + (size_t)l * 512 * 1024, 1024, 0, 512, 1024, W_BR + (size_t)1024 * 512 * 2, 0, base, b0);
    cvt_mat(C, C.in(I_WBC) + (size_t)l * 512 * 1024, 1024, 0, 512, 1024, W_BR + (size_t)2 * 1024 * 512 * 2, 0, base, b0);
    cvt_mat(C, C.in(I_WOUT) + (size_t)l * 1024 * 1024, 1024, 0, 1024, 1024, W_OUT, 0, base, b0);
    cvt_mat(C, C.in(I_WUP) + (size_t)l * 1024 * 4096, 4096, 0, 1024, 4096, W_UP, 0, base, b0);
    cvt_mat(C, C.in(I_WDOWN) + (size_t)l * 4096 * 1024, 1024, 0, 4096, 1024, W_DOWN, 0, base, b0);
    f16* pad = (f16*)(C.ws() + W_INA) + (size_t)GC_PAD * 1024;
    const f16x8 z = {0, 0, 0, 0, 0, 0, 0, 0};
    for (int i = (C.bid - b0) * NTHREADS + C.tid; i < (GC_U - GC_PAD) * 1024 / 8; i += (C.nblk - b0) * NTHREADS) ((f16x8*)pad)[i] = z;
}

__device__ __forceinline__ void row_load(const float* p, int lane, f32x4 (&v)[4]) {
#pragma unroll
    for (int j = 0; j < 4; ++j) v[j] = ((const f32x4*)p)[lane + 64 * j];
}
__device__ __forceinline__ void row_ln(f32x4 (&v)[4]) {
    float s = 0.f;
#pragma unroll
    for (int j = 0; j < 4; ++j) s += (v[j][0] + v[j][1]) + (v[j][2] + v[j][3]);
    const float mean = wave_sum(s) * (1.0f / D);
    float q = 0.f;
#pragma unroll
    for (int j = 0; j < 4; ++j) { v[j] = v[j] - mean; q += (v[j][0] * v[j][0] + v[j][1] * v[j][1]) + (v[j][2] * v[j][2] + v[j][3] * v[j][3]); }
    const float rstd = 1.0f / sqrtf(wave_sum(q) * (1.0f / D) + EPS);
#pragma unroll
    for (int j = 0; j < 4; ++j) v[j] = v[j] * rstd;
}
__device__ __forceinline__ void row_ln_stats(f32x4 (&v)[4], float& mean, float& rstd) {
    float s = 0.f;
#pragma unroll
    for (int j = 0; j < 4; ++j) s += (v[j][0] + v[j][1]) + (v[j][2] + v[j][3]);
    mean = wave_sum(s) * (1.0f / D);
    float q = 0.f;
#pragma unroll
    for (int j = 0; j < 4; ++j) { v[j] = v[j] - mean; q += (v[j][0] * v[j][0] + v[j][1] * v[j][1]) + (v[j][2] * v[j][2] + v[j][3] * v[j][3]); }
    rstd = 1.0f / sqrtf(wave_sum(q) * (1.0f / D) + EPS);
#pragma unroll
    for (int j = 0; j < 4; ++j) v[j] = v[j] * rstd;
}
__device__ __forceinline__ void row_load_h(const f16* p, int lane, f32x4 (&v)[4]) {
#pragma unroll
    for (int j = 0; j < 4; ++j) { const f16x4 h = ((const f16x4*)p)[lane + 64 * j]; v[j] = (f32x4){(float)h[0], (float)h[1], (float)h[2], (float)h[3]}; }
}
__device__ __forceinline__ void row_modulate_store(const f32x4 (&v)[4], const float* sh, const float* sc, f16* o, int lane) {
#pragma unroll
    for (int j = 0; j < 4; ++j) {
        const f32x4 s = ((const f32x4*)sc)[lane + 64 * j], t = ((const f32x4*)sh)[lane + 64 * j];
        const f32x4 y = v[j] * (s + 1.0f) + t;
        ((f16x4*)o)[lane + 64 * j] = pack4(y);
    }
}
__device__ __forceinline__ void phase_p1(const Ctx& C, int l) {
    f16* H = (f16*)(C.ws() + A_H);
    const int nw = C.nblk * NWAVES;
    for (int r = C.bid * NWAVES + C.wid; r < MALL; r += 2 * nw) {
        const int r2 = r + nw; const bool has2 = r2 < MALL;
        f32x4 v[4], w[4]; row_load(C.xsrc(l, r), C.lane, v); if (has2) row_load(C.xsrc(l, r2), C.lane, w);
        { const RowInfo ri = row_info(r); row_ln(v); row_modulate_store(v, C.mod(l, ri.mrow, 0), C.mod(l, ri.mrow, 1), H + (size_t)r * D, C.lane); }
        if (has2) { const RowInfo ri = row_info(r2); row_ln(w); row_modulate_store(w, C.mod(l, ri.mrow, 0), C.mod(l, ri.mrow, 1), H + (size_t)r2 * D, C.lane); }
    }
}
__device__ __forceinline__ void phase_p10(const Ctx& C, int l, int nrows) {
    const f16* T1 = (const f16*)(C.ws() + A_T1H); f16* H = (f16*)(C.ws() + A_H); float* ST = (float*)(C.ws() + WS_ST1);
    f32x4 gv[4], bv[4];
#pragma unroll
    for (int j = 0; j < 4; ++j) { gv[j] = ((const f32x4*)(C.in(I_LN1G) + l * D))[C.lane + 64 * j]; bv[j] = ((const f32x4*)(C.in(I_LN1B) + l * D))[C.lane + 64 * j]; }
    const int nw = C.nblk * NWAVES;
    for (int r0 = C.bid * NWAVES + C.wid; r0 < nrows; r0 += 4 * nw) {
        f32x4 v[4][4];
#pragma unroll
        for (int q = 0; q < 4; ++q) { const int r = r0 + q * nw; if (r < nrows) row_load_h(T1 + (size_t)r * D, C.lane, v[q]); }
#pragma unroll
        for (int q = 0; q < 4; ++q) { const int r = r0 + q * nw;
            if (r < nrows) {
                const RowInfo ri = row_info(r);
                float mean, rstd; row_ln_stats(v[q], mean, rstd);
                if (C.lane == 0) { ST[2 * r] = mean; ST[2 * r + 1] = rstd; }
#pragma unroll
                for (int j = 0; j < 4; ++j) v[q][j] = v[q][j] * gv[j] + bv[j];
                row_ln(v[q]);
                row_modulate_store(v[q], C.mod(l, ri.mrow, 3), C.mod(l, ri.mrow, 4), H + (size_t)r * D, C.lane);
            } }
    }
}
__device__ __forceinline__ void p13_row(const Ctx& C, int l, int r, f32x4 (&v)[4], const float* g, const float* bb) {
    f16* H = (f16*)(C.ws() + A_H); float* t = C.ta(r);
    row_ln(v);
#pragma unroll
    for (int j = 0; j < 4; ++j) { v[j] = v[j] * ((const f32x4*)g)[C.lane + 64 * j] + ((const f32x4*)bb)[C.lane + 64 * j]; ((f32x4*)t)[C.lane + 64 * j] = v[j]; }
    if (l == 0) {
        const RowInfo ri = row_info(r);
        row_ln(v);
        row_modulate_store(v, C.mod(1, ri.mrow, 0), C.mod(1, ri.mrow, 1), H + (size_t)r * D, C.lane);
    }
}
__device__ __forceinline__ void phase_p13(const Ctx& C, int l, int nrows) {
    const float* g = C.in(I_LN2G) + l * D; const float* bb = C.in(I_LN2B) + l * D; const f16* T2 = (const f16*)(C.ws() + A_T1H);
    const int nw = C.nblk * NWAVES;
    for (int r = C.bid * NWAVES + C.wid; r < nrows; r += 2 * nw) {
        const int r2 = r + nw; const bool has2 = r2 < nrows;
        f32x4 v[4], w[4]; row_load_h(T2 + (size_t)r * D, C.lane, v); if (has2) row_load_h(T2 + (size_t)r2 * D, C.lane, w);
        p13_row(C, l, r, v, g, bb);
        if (has2) p13_row(C, l, r2, w, g, bb);
    }
}
__device__ __forceinline__ void phase_hre(const Ctx& C, int l, int nrows) {
    f16* H = (f16*)(C.ws() + A_H);
    const int nw = C.nblk * NWAVES;
    for (int r = C.bid * NWAVES + C.wid; r < nrows; r += 2 * nw) {
        const int r2 = r + nw; const bool has2 = r2 < nrows;
        f32x4 v[4], w[4]; row_load(C.xsrc(l, r), C.lane, v); if (has2) row_load(C.xsrc(l, r2), C.lane, w);
        { const RowInfo ri = row_info(r); row_ln(v); row_modulate_store(v, C.mod(l, ri.mrow, 0), C.mod(l, ri.mrow, 1), H + (size_t)r * D, C.lane); }
        if (has2) { const RowInfo ri = row_info(r2); row_ln(w); row_modulate_store(w, C.mod(l, ri.mrow, 0), C.mod(l, ri.mrow, 1), H + (size_t)r2 * D, C.lane); }
    }
}

__device__ __forceinline__ size_t u3_off(int g, int nb, int sx, int half, int n) { return ((((size_t)(g * 34 + nb) * 16 + sx) * 2 + half) * 32 + n) * 8; }
__device__ __forceinline__ size_t x3_off(int dirg, int nb, int kk, int half, int n) { return ((((size_t)(dirg * 34 + nb) * 8 + kk) * 2 + half) * 32 + n) * 8; }
__device__ __forceinline__ size_t m3_off(int dirg, int mb, int sx, int half, int p32) { return ((((size_t)(dirg * 4 + mb) * 16 + sx) * 2 + half) * 32 + p32) * 8; }
__device__ __forceinline__ void phase_p3(const Ctx& C, int l) {
    f16* PROJ = (f16*)(C.ws() + A_PROJ);
    f16* KA = (f16*)(C.ws() + A_KA); f16* KC = (f16*)(C.ws() + A_KC);
    f16* QA = (f16*)(C.ws() + A_QA);
    const float* ropeA = (const float*)(C.ws() + WS_ROPE); const float* ropeC = ropeA + 2048;
    const int lane = C.lane, d32 = lane & 31;
    const float akg = C.in(I_AKG)[l * 64 + lane], aqg = C.in(I_AQG)[l * 64 + lane];
    const f32x4 ckvg = *(const f32x4*)(C.in(I_CKVG) + l * 256 + 4 * lane);
    f32x4 cqg[3];
#pragma unroll
    for (int i = 0; i < 3; ++i) cqg[i] = *(const f32x4*)(C.in(I_CQG) + l * 768 + 256 * i + 4 * lane);
    for (int r = C.bid * NWAVES + C.wid; r < MALL; r += C.nblk * NWAVES) {
        const RowInfo ri = row_info(r);
        f16* prow = PROJ + (size_t)r * PLD2;
        const bool needq = ri.lat || l == 0;
        f16 xak[2], xaq[8]; f16x4 cq4[3];
#pragma unroll
        for (int hd = 0; hd < 2; ++hd) xak[hd] = prow[PC_AK + hd * 64 + lane];
        const f16x4 ckv4 = *(const f16x4*)(prow + PC_CKV + 4 * lane);
        const f16 xckr = prow[PC_CKR + d32];
        if (needq) {
#pragma unroll
            for (int h = 0; h < 8; ++h) xaq[h] = prow[PC_AQ + h * 64 + lane];
#pragma unroll
            for (int i = 0; i < 3; ++i) cq4[i] = *(const f16x4*)(prow + PC_CQ + 256 * i + 4 * lane);
        } else {
#pragma unroll
            for (int h = 0; h < 8; ++h) xaq[h] = (f16)0.f;
#pragma unroll
            for (int i = 0; i < 3; ++i) cq4[i] = (f16x4){0, 0, 0, 0};
        }
        const int prow_i = ri.t >> 6, pcol_i = ri.t & 63;
        float cA = 1.f, sA = 0.f, cc = 1.f, sc = 0.f;
        if (ri.lat) {
            { const int part = lane >> 5, j = lane & 15, pi = part ? pcol_i : prow_i; cA = ropeA[pi * 16 + j]; sA = ropeA[1024 + pi * 16 + j]; if (!((lane >> 4) & 1)) sA = -sA; }
            { const int part = d32 >> 4, j = d32 & 7, pi = part ? pcol_i : prow_i; cc = ropeC[pi * 8 + j]; sc = ropeC[512 + pi * 8 + j]; if (!((d32 >> 3) & 1)) sc = -sc; }
        }
        float ss[12];
#pragma unroll
        for (int hd = 0; hd < 2; ++hd) { const float x = (float)xak[hd]; ss[hd] = x * x; }
#pragma unroll
        for (int h = 0; h < 8; ++h) { const float x = (float)xaq[h]; ss[2 + h] = x * x; }
        { float q = 0.f;
#pragma unroll
          for (int e = 0; e < 4; ++e) { const float x = (float)ckv4[e]; q += x * x; }
          ss[10] = q; q = 0.f;
#pragma unroll
          for (int i = 0; i < 3; ++i)
#pragma unroll
              for (int e = 0; e < 4; ++e) { const float x = (float)cq4[i][e]; q += x * x; }
          ss[11] = q; }
#pragma unroll
        for (int i = 0; i < 12; ++i) ss[i] = wave_sum(ss[i]);
#pragma unroll
        for (int hd = 0; hd < 2; ++hd) {
            float y = (float)xak[hd] * (1.0f / sqrtf(ss[hd] * (1.0f / 64.0f) + EPS)) * akg;
            const float p = shflx(y, 16, lane);
            y = y * cA + p * sA;
            KA[((size_t)(ri.b * 2 + hd) * NKEY + ri.pos) * 64 + lane] = (f16)y;
        }
        { const float rs = 1.0f / sqrtf(ss[10] * (1.0f / 256.0f) + EPS); f16x4 o4;
#pragma unroll
          for (int e = 0; e < 4; ++e) o4[e] = (f16)((float)ckv4[e] * rs * ckvg[e]);
          *(f16x4*)(prow + PC_CKV + 4 * lane) = o4; }
        { float x = (float)xckr; const float p = shflx(x, 8, lane); x = x * cc + p * sc;
          if (lane < 32) {
#pragma unroll
              for (int h = 0; h < 8; ++h) KC[((size_t)(ri.b * 8 + h) * NKEY + ri.pos) * 96 + 64 + d32] = (f16)x;
          } }
        if (needq) {
            f16* qdst = QA + (size_t)r * 512; const size_t hstride = 64;
#pragma unroll
            for (int h = 0; h < 8; ++h) {
                float y = (float)xaq[h] * (1.0f / sqrtf(ss[2 + h] * (1.0f / 64.0f) + EPS)) * aqg;
                const float p = shflx(y, 16, lane);
                y = (y * cA + p * sA) * QSCALE_A;
                qdst[h * hstride + lane] = (f16)y;
            }
            const float rs = 1.0f / sqrtf(ss[11] * (1.0f / 768.0f) + EPS);
#pragma unroll
            for (int i = 0; i < 3; ++i) { f16x4 o4;
#pragma unroll
                for (int e = 0; e < 4; ++e) o4[e] = (f16)((float)cq4[i][e] * rs * cqg[i][e]);
                *(f16x4*)(prow + PC_CQ + 256 * i + 4 * lane) = o4; }
        }
    }
}

namespace pg8 {
#define PG8_LAS __attribute__((address_space(3)))
typedef _Float16 bf16_t;
typedef _Float16 bf16x8 __attribute__((ext_vector_type(8)));
constexpr int BM = 256, BK = 64, HALF = 128, HTB = HALF * BK * 2  , STAGE_BYTES = 8 * HTB, NXCD = 8, WGM = 8;

__host__ __device__ __forceinline__ int lds_byte(int r, int c) { const int st = (r >> 4) * 2 + (c >> 5), rr = r & 15, cc = c & 31, ob = rr * 64 + cc * 2; return st * 1024 + (ob ^ (((ob >> 9) & 1) << 5)); }
__host__ __device__ __forceinline__ void stage_rc(int b, int& R, int& C) { const int st = b / 1024, sb = b % 1024, swz = sb ^ (((sb >> 9) & 1) << 5); R = (st >> 1) * 16 + swz / 64; C = (st & 1) * 32 + (swz % 64) / 2; }
__host__ __device__ __forceinline__ int perm32(int rho) { const int n = rho >> 4, i = rho & 15; return 8 * (i >> 2) + 4 * n + (i & 3); }
struct Unit { int pm, pn; };
struct Gemm { const bf16_t* A; const bf16_t* Bt; int M, N, K, lda, ldb; };

struct StaticOrder {
    int nM, nN, nwg, G, c;
    __host__ __device__ void init(int M, int N, int G_, int c_) { nM = M / BM; nN = N / BM; nwg = nM * nN; G = G_; c = c_; }
    __host__ __device__ bool next(int i, Unit& u) const {
        const long L = (long)i * G + c; if (L >= nwg) return false;
        int wgid = (int)L; { const int q = nwg / NXCD, r = nwg % NXCD, xcd = wgid % NXCD, off = wgid / NXCD; wgid = (xcd < r ? xcd * (q + 1) : r * (q + 1) + (xcd - r) * q) + off; }
        const int nig = WGM * nN, gid = wgid / nig, fm = gid * WGM, gsz = (nM - fm) < WGM ? (nM - fm) : WGM;
        u.pm = fm + ((wgid % nig) % gsz); u.pn = (wgid % nig) / gsz; return true;
    }
    __device__ __forceinline__ void a_ready(const Unit&) const {}
    __device__ __forceinline__ void done(const Unit&) const {}
};

template <class F> struct EpiFn { static constexpr bool PERM = true, AFTER_DRAIN = false; F f;
    __device__ __forceinline__ void operator()(const f32x4 (&acc)[2][2][4][2], const Unit& u, int wr, int wc, int fr, int fq) const {
        typename F::Pre pre[2][2];
        const int col0 = u.pn * BM + wc * 32 + 8 * fq, rowb = u.pm * BM + wr * 64 + fr;
#pragma unroll
        for (int bj = 0; bj < 2; ++bj) pre[0][bj] = f.pre(rowb, col0 + bj * HALF);
#pragma unroll
        for (int gi = 0; gi < 8; ++gi) {
            const int ai = gi >> 2, m = gi & 3, row = rowb + ai * HALF + m * 16;
            if (gi + 1 < 8) { const int ai2 = (gi + 1) >> 2, m2 = (gi + 1) & 3;
#pragma unroll
                for (int bj = 0; bj < 2; ++bj) pre[(gi + 1) & 1][bj] = f.pre(rowb + ai2 * HALF + m2 * 16, col0 + bj * HALF); }
#pragma unroll
            for (int bj = 0; bj < 2; ++bj) f(row, col0 + bj * HALF, acc[ai][bj][m][0], acc[ai][bj][m][1], pre[gi & 1][bj]);
            asm volatile("" ::: "memory");
        }
    } };

template <class Epi, class Sched, bool ALIGN_EPI = false, bool SP2 = false, bool CH_IN = false, bool CH_OUT = false>
__device__ __forceinline__ void gemm_phase(PG8_LAS unsigned char* lds, const Gemm g, const Sched& S, const Epi& E, const int tid, const Gemm ng = Gemm{}) {
    static_assert(!(CH_IN || CH_OUT) || (SP2 && ALIGN_EPI), "chaining is written for the SP2 + ALIGN_EPI loop");
    const int wid = __builtin_amdgcn_readfirstlane(tid >> 6), lane = tid & 63, wr = wid >> 2, wc = wid & 3, fr = lane & 15, fq = lane >> 4;
    const int K = g.K, nt = K / BK;
    unsigned voffA[2], voffB[2];
#pragma unroll
    for (int i = 0; i < 2; ++i) { int R, C; stage_rc(tid * 16 + i * 8192, R, C); const int Rb = Epi::PERM ? ((R & ~31) + perm32(R & 31)) : R;
        voffA[i] = (unsigned)(R * g.lda + C) * 2u; voffB[i] = (unsigned)(Rb * g.ldb + C) * 2u; }
    unsigned nvA[2] = {0u, 0u}, nvB[2] = {0u, 0u}; size_t n_hstepA = 0, n_hstepB = 0;
    if constexpr (CH_OUT) {
#pragma unroll
        for (int i = 0; i < 2; ++i) { int R, C; stage_rc(tid * 16 + i * 8192, R, C); const int Rb = Epi::PERM ? ((R & ~31) + perm32(R & 31)) : R;
            nvA[i] = (unsigned)(R * ng.lda + C) * 2u; nvB[i] = (unsigned)(Rb * ng.ldb + C) * 2u; }
        n_hstepA = (size_t)HALF * ng.lda * 2; n_hstepB = (size_t)HALF * ng.ldb * 2;
    }
    const size_t kstep = (size_t)(BK * 2);
    const size_t hstepA = (size_t)HALF * g.lda * 2, hstepB = (size_t)HALF * g.ldb * 2;
    const size_t tstepA = 2 * hstepA, tstepB = 2 * hstepB;
    const unsigned ldsw = (unsigned)wid * 1024u;
    const int aoff = lds_byte(wr * 64 + fr, fq * 8), boff = lds_byte(wc * 32 + fr, fq * 8);
#define PG8_SA(b, h) (((b) * 2 + (h)) * HTB)
#define PG8_SB(b, h) ((4 + (b) * 2 + (h)) * HTB)
#define PG8_STAGE(bufoff, gbase, voff) do { _Pragma("unroll") for (int _i = 0; _i < 2; ++_i) \
        __builtin_amdgcn_global_load_lds((const unsigned*)((const char*)(gbase) + (voff)[_i]), (PG8_LAS unsigned*)(lds + (bufoff) + ldsw + _i * 8192), 16, 0, 0); } while (0)
#define PG8_LDA(dst, b, h) do { _Pragma("unroll") for (int m = 0; m < 4; ++m) _Pragma("unroll") for (int k = 0; k < 2; ++k) dst[m][k] = *(const PG8_LAS bf16x8*)(lds + PG8_SA(b, h) + aoff + m * 2048 + k * 1024); } while (0)
#define PG8_LDB(dst, b, h) do { _Pragma("unroll") for (int n = 0; n < 2; ++n) _Pragma("unroll") for (int k = 0; k < 2; ++k) dst[n][k] = *(const PG8_LAS bf16x8*)(lds + PG8_SB(b, h) + boff + n * 2048 + k * 1024); } while (0)
#define PG8_MMA(ai, bj, At, Bt) do { __builtin_amdgcn_s_setprio(1); _Pragma("unroll") for (int m = 0; m < 4; ++m) _Pragma("unroll") for (int n = 0; n < 2; ++n) _Pragma("unroll") for (int k = 0; k < 2; ++k) \
        acc[ai][bj][m][n] = __builtin_amdgcn_mfma_f32_16x16x32_f16(Bt[n][k], At[m][k], acc[ai][bj][m][n], 0, 0, 0); __builtin_amdgcn_s_setprio(0); } while (0)
#define PG8_WAIT_V(n) asm volatile("s_waitcnt vmcnt(" #n ")" ::: "memory")
#define PG8_WAIT_L(n) asm volatile("s_waitcnt lgkmcnt(" #n ")" ::: "memory")
#define PG8_BAR __builtin_amdgcn_s_barrier()
#define PG8_SCHED __builtin_amdgcn_sched_barrier(0)
    Unit cur, nxt; int ui = 0;
    if (!S.next(0, cur)) return;
    f32x4 acc[2][2][4][2];
#pragma unroll
    for (int a = 0; a < 2; ++a)
#pragma unroll
        for (int b = 0; b < 2; ++b)
#pragma unroll
            for (int m = 0; m < 4; ++m)
#pragma unroll
                for (int n = 0; n < 2; ++n) acc[a][b][m][n] = (f32x4){0.f, 0.f, 0.f, 0.f};
    bf16x8 At[4][2], B0[2][2], B1[2][2];
    const char* cA = (const char*)g.A + (size_t)cur.pm * tstepA; const char* cB = (const char*)g.Bt + (size_t)cur.pn * tstepB;
    S.a_ready(cur);
    if constexpr (CH_IN) {   } else
    if constexpr (SP2) {
        PG8_STAGE(PG8_SB(0, 0), cB, voffB); PG8_STAGE(PG8_SB(0, 1), cB + hstepB, voffB); PG8_STAGE(PG8_SA(0, 0), cA, voffA); PG8_STAGE(PG8_SA(0, 1), cA + hstepA, voffA);
        if (wr == 1) PG8_BAR;
        PG8_WAIT_V(2); PG8_BAR;
        PG8_STAGE(PG8_SB(1, 0), cB + kstep, voffB); PG8_STAGE(PG8_SA(1, 0), cA + kstep, voffA); PG8_STAGE(PG8_SB(1, 1), cB + hstepB + kstep, voffB);
        PG8_WAIT_V(6); PG8_BAR;
    } else {
        PG8_STAGE(PG8_SB(0, 0), cB, voffB); PG8_STAGE(PG8_SA(0, 0), cA, voffA); PG8_STAGE(PG8_SB(0, 1), cB + hstepB, voffB); PG8_STAGE(PG8_SA(0, 1), cA + hstepA, voffA);
        if (wr == 1) PG8_BAR;
        PG8_WAIT_V(4); PG8_BAR;
        PG8_STAGE(PG8_SB(1, 0), cB + kstep, voffB); PG8_STAGE(PG8_SA(1, 0), cA + kstep, voffA); PG8_STAGE(PG8_SB(1, 1), cB + hstepB + kstep, voffB);
        PG8_WAIT_V(6); PG8_BAR;
    }
    for (;;) {
        const bool has_next = S.next(ui + 1, nxt);
        Unit u0; (void)S.next(0, u0);
        const char* nA = has_next ? (const char*)g.A + (size_t)nxt.pm * tstepA : (CH_OUT ? (const char*)ng.A + (size_t)u0.pm * 2 * n_hstepA : cA);
        const char* nB = has_next ? (const char*)g.Bt + (size_t)nxt.pn * tstepB : (CH_OUT ? (const char*)ng.Bt + (size_t)u0.pn * 2 * n_hstepB : cB);
#pragma unroll 1
        for (int t = 0; t < nt; t += 2) {
            const bool last = (t == nt - 2);
            const char* a1 = cA + (size_t)(t + 1) * kstep;
            const char* a2 = last ? nA : cA + (size_t)(t + 2) * kstep; const char* b2 = last ? nB : cB + (size_t)(t + 2) * kstep;
            const char* a3 = a2 + kstep; const char* b3 = b2 + kstep;
            const bool xg = CH_OUT && last && !has_next;
            unsigned vA2[2], vB2[2];
#pragma unroll
            for (int i = 0; i < 2; ++i) { vA2[i] = xg ? nvA[i] : voffA[i]; vB2[i] = xg ? nvB[i] : voffB[i]; }
            const size_t hA2 = xg ? n_hstepA : hstepA, hB2 = xg ? n_hstepB : hstepB;
            if (last && has_next) S.a_ready(nxt);
            if constexpr (SP2) {
            PG8_LDB(B0, 0, 0); PG8_LDB(B1, 0, 1); PG8_SCHED; PG8_LDA(At, 0, 0); PG8_STAGE(PG8_SA(1, 1), a1 + hstepA, voffA);
            PG8_WAIT_V(8); PG8_WAIT_L(0); PG8_BAR; PG8_MMA(0, 0, At, B0); PG8_MMA(0, 1, At, B1); PG8_BAR; PG8_SCHED;
            PG8_LDA(At, 0, 1); PG8_STAGE(PG8_SB(0, 0), b2, vB2); PG8_STAGE(PG8_SB(0, 1), b2 + hB2, vB2); PG8_STAGE(PG8_SA(0, 0), a2, vA2);
            PG8_WAIT_V(8); PG8_WAIT_L(0); PG8_BAR; PG8_MMA(1, 0, At, B0); PG8_MMA(1, 1, At, B1); PG8_BAR; PG8_SCHED;
            PG8_LDB(B0, 1, 0); PG8_LDB(B1, 1, 1); PG8_SCHED; PG8_LDA(At, 1, 0); PG8_STAGE(PG8_SA(0, 1), a2 + hA2, vA2);
            PG8_WAIT_V(8); PG8_WAIT_L(0); PG8_BAR; PG8_MMA(0, 0, At, B0); PG8_MMA(0, 1, At, B1); PG8_BAR; PG8_SCHED;
            PG8_LDA(At, 1, 1); PG8_STAGE(PG8_SB(1, 0), b3, vB2); PG8_STAGE(PG8_SB(1, 1), b3 + hB2, vB2); PG8_STAGE(PG8_SA(1, 0), a3, vA2);
            PG8_WAIT_V(8); PG8_WAIT_L(0); PG8_BAR; PG8_MMA(1, 0, At, B0); PG8_MMA(1, 1, At, B1); PG8_BAR; PG8_SCHED;
            } else {
            PG8_LDB(B0, 0, 0); PG8_SCHED; PG8_LDA(At, 0, 0); PG8_STAGE(PG8_SA(1, 1), a1 + hstepA, voffA);
            PG8_WAIT_L(8); PG8_BAR; PG8_WAIT_L(0); PG8_MMA(0, 0, At, B0); PG8_BAR; PG8_SCHED;
            PG8_LDB(B1, 0, 1); PG8_STAGE(PG8_SB(0, 0), b2, voffB);
            PG8_BAR; PG8_WAIT_L(0); PG8_MMA(0, 1, At, B1); PG8_BAR;
            PG8_LDA(At, 0, 1); PG8_STAGE(PG8_SA(0, 0), a2, voffA);
            PG8_BAR; PG8_WAIT_L(0); PG8_MMA(1, 0, At, B0); PG8_BAR; PG8_SCHED;
            PG8_STAGE(PG8_SB(0, 1), b2 + hstepB, voffB);
            PG8_WAIT_V(6); PG8_BAR; PG8_MMA(1, 1, At, B1); PG8_BAR;
            PG8_LDB(B0, 1, 0); PG8_SCHED; PG8_LDA(At, 1, 0); PG8_STAGE(PG8_SA(0, 1), a2 + hstepA, voffA);
            PG8_WAIT_L(8); PG8_BAR; PG8_WAIT_L(0); PG8_MMA(0, 0, At, B0); PG8_BAR; PG8_SCHED;
            PG8_LDB(B1, 1, 1); PG8_STAGE(PG8_SB(1, 0), b3, voffB);
            PG8_BAR; PG8_WAIT_L(0); PG8_MMA(0, 1, At, B1); PG8_BAR;
            PG8_LDA(At, 1, 1); PG8_STAGE(PG8_SA(1, 0), a3, voffA);
            PG8_BAR; PG8_WAIT_L(0); PG8_MMA(1, 0, At, B0); PG8_BAR; PG8_SCHED;
            PG8_STAGE(PG8_SB(1, 1), b3 + hstepB, voffB);
            PG8_WAIT_V(6); PG8_BAR; PG8_MMA(1, 1, At, B1); PG8_BAR;
            }
        }
        if constexpr (ALIGN_EPI) { if (wr == 0) PG8_BAR; }
        if constexpr (!Epi::AFTER_DRAIN) { E(acc, cur, wr, wc, fr, fq); S.done(cur); }
        if (!has_next) break;
#pragma unroll
        for (int a = 0; a < 2; ++a)
#pragma unroll
            for (int b = 0; b < 2; ++b)
#pragma unroll
                for (int m = 0; m < 4; ++m)
#pragma unroll
                    for (int n = 0; n < 2; ++n) acc[a][b][m][n] = (f32x4){0.f, 0.f, 0.f, 0.f};
        cur = nxt; cA = nA; cB = nB; ++ui;
        if constexpr (ALIGN_EPI) { if (wr == 1) PG8_BAR; }
    }
    if constexpr (CH_OUT) { if (wr == 1) PG8_BAR; return; }
    PG8_WAIT_V(0);
    if constexpr (!ALIGN_EPI) { if (wr == 0) PG8_BAR; }
    PG8_BAR;
    if constexpr (Epi::AFTER_DRAIN) { E.fused(acc, cur, wr, wc, fr, fq, lds, wid, lane); S.done(cur); }
#undef PG8_SA
#undef PG8_SB
#undef PG8_STAGE
#undef PG8_LDA
#undef PG8_LDB
#undef PG8_MMA
#undef PG8_WAIT_V
#undef PG8_WAIT_L
#undef PG8_BAR
#undef PG8_SCHED
}
}

template <bool CH_IN, bool CH_OUT, class F>
__device__ __forceinline__ void gemm_pg8c(const Ctx& C, const f16* A, int lda, const f16* Bt, int ldb, int M, int N, int K, const F& f, const f16* nA, int nlda, const f16* nBt, int nldb) {
    pg8::Gemm g{A, Bt, M, N, K, lda, ldb}; pg8::Gemm ng{nA, nBt, M, N, 0, nlda, nldb}; pg8::StaticOrder S; S.init(M, N, C.nblk, C.bid);
    pg8::EpiFn<F> E{f};
    pg8::gemm_phase<pg8::EpiFn<F>, pg8::StaticOrder, true, true, CH_IN, CH_OUT>(C.lds, g, S, E, C.tid, ng);
}
template <class F>
__device__ __forceinline__ void gemm_pg8(const Ctx& C, const f16* A, int lda, const f16* Bt, int ldb, int M, int N, int K, const F& f) {
    pg8::Gemm g{A, Bt, M, N, K, lda, ldb}; pg8::StaticOrder S; S.init(M, N, C.nblk, C.bid);
    pg8::EpiFn<F> E{f};
    pg8::gemm_phase<pg8::EpiFn<F>, pg8::StaticOrder, true, true>(C.lds, g, S, E, C.tid);
}
template <class F>
__device__ __forceinline__ void gemm_small(const Ctx& C, const f16* A, int lda, const f16* Bt, int ldb, int row0, int N, int K, const F& f) {
    constexpr int PST = 68;
    LAS float* part = (LAS float*)C.lds;
    const int fr = C.lane & 15, fq = C.lane >> 4;
    const int tilesN = N / 64, ntiles = 16 * tilesN, kw = K / 8;
    for (int tile = C.bid; tile < ntiles; tile += C.nblk) {
        const int tm = tile / tilesN, tn = tile - tm * tilesN, m0 = tm * 64, n0 = tn * 64;
        f32x4 acc[4][4];
#pragma unroll
        for (int a = 0; a < 4; ++a)
#pragma unroll
            for (int b = 0; b < 4; ++b) acc[a][b] = (f32x4){0.f, 0.f, 0.f, 0.f};
        const f16* ap = A + (size_t)(m0 + fr) * lda + C.wid * kw + fq * 8;
        const f16* bp = Bt + (size_t)(n0 + fr) * ldb + C.wid * kw + fq * 8;
#pragma unroll 4
        for (int k0 = 0; k0 < kw; k0 += 32) {
            f16x8 av[4], bv[4];
#pragma unroll
            for (int a = 0; a < 4; ++a) av[a] = *(const f16x8*)(ap + (size_t)(a * 16) * lda + k0);
#pragma unroll
            for (int b = 0; b < 4; ++b) bv[b] = *(const f16x8*)(bp + (size_t)(b * 16) * ldb + k0);
#pragma unroll
            for (int a = 0; a < 4; ++a)
#pragma unroll
                for (int b = 0; b < 4; ++b) acc[a][b] = __builtin_amdgcn_mfma_f32_16x16x32_f16(bv[b], av[a], acc[a][b], 0, 0, 0);
        }
        __syncthreads();
        LAS float* pw = part + (size_t)C.wid * 64 * PST;
#pragma unroll
        for (int a = 0; a < 4; ++a)
#pragma unroll
            for (int b = 0; b < 4; ++b) *(LAS f32x4*)(pw + (a * 16 + fr) * PST + b * 16 + 4 * fq) = acc[a][b];
        __syncthreads();
        const int rl = 8 * C.wid + (C.lane & 7), c8 = ((C.lane >> 4) & 1) | (((C.lane >> 5) & 1) << 1) | (((C.lane >> 3) & 1) << 2);
        f32x4 lo = (f32x4){0.f, 0.f, 0.f, 0.f}, hi = lo;
#pragma unroll
        for (int w = 0; w < 8; ++w) { const LAS float* pr = part + ((size_t)w * 64 + rl) * PST + 8 * c8; lo = lo + *(const LAS f32x4*)pr; hi = hi + *(const LAS f32x4*)(pr + 4); }
        f(row0 + m0 + rl, n0 + 8 * c8, lo, hi, f.pre(row0 + m0 + rl, n0 + 8 * c8));
    }
    __syncthreads();
}
template <class F>
__device__ __forceinline__ void gemm_pg8s(const Ctx& C, const f16* A, int lda, const f16* Bt, int ldb, int M, int N, int K, const F& f) {
    pg8::Gemm g{A, Bt, M, N, K, lda, ldb}; pg8::StaticOrder S; S.init(M, N, C.nblk, C.bid);
    pg8::EpiFn<F> E{f};
    pg8::gemm_phase<pg8::EpiFn<F>, pg8::StaticOrder, false, true>(C.lds, g, S, E, C.tid);
}
template <class F>
__device__ __forceinline__ void gemm_rows(const Ctx& C, const f16* A, int lda, const f16* Bt, int ldb, int mrows, int N, int K, const F& f) {
    if (N == 1024) gemm_pg8s(C, A, lda, Bt, ldb, NLAT, N, K, f); else gemm_pg8(C, A, lda, Bt, ldb, NLAT, N, K, f);
    if (mrows > NLAT) gemm_small(C, A + (size_t)NLAT * lda, lda, Bt, ldb, NLAT, N, K, f);
}
struct NoPre {};
#define NOPRE typedef NoPre Pre; __device__ __forceinline__ NoPre pre(int, int) const { return NoPre{}; }
struct EpiProj { f16* P; f16* VA; f16* U3;
    NOPRE
    __device__ __forceinline__ void operator()(int row, int col, f32x4 lo, f32x4 hi, NoPre) const {
        const f16x8 v = pack8(lo, hi); f16* pr = P + (size_t)row * PLD2;
        if (col < GC_AV) *(f16x8*)(pr + PC_AK + col) = v;
        else if (col < GC_CKV) { const RowInfo ri = row_info(row); const int c = col - GC_AV; *(f16x8*)(VA + ((size_t)(ri.b * 2 + (c >> 6)) * NKEY + ri.pos) * 64 + (c & 63)) = v; }
        else if (col < GC_CKR) *(f16x8*)(pr + PC_CKV + (col - GC_CKV)) = v;
        else if (col < GC_PAD) *(f16x8*)(pr + PC_CKR + (col - GC_CKR)) = v;
        else if (col < GC_U) { }
        else if (col < GC_AQ) { const int c = col - GC_U; *(f16x8*)(U3 + u3_off(c >> 4, row >> 9, row & 15, (c >> 3) & 1, (row >> 4) & 31)) = v; }
        else if (col < GC_CQ) *(f16x8*)(pr + PC_AQ + (col - GC_AQ)) = v;
        else *(f16x8*)(pr + PC_CQ + (col - GC_CQ)) = v;
    } };
struct EpiKvUp { f16* KC; f16* VC;
    NOPRE
    __device__ __forceinline__ void operator()(int row, int col, f32x4 lo, f32x4 hi, NoPre) const {
        const RowInfo ri = row_info(row); const int h = col >> 7, w = col & 127;
        if (w < 64) *(f16x8*)(KC + ((size_t)(ri.b * 8 + h) * NKEY + ri.pos) * 96 + w) = pack8(lo, hi);
        else *(f16x8*)(VC + ((size_t)(ri.b * 8 + h) * NKEY + ri.pos) * 64 + (w - 64)) = pack8(lo, hi);
    } };
struct EpiQUp { f16* QC; const float* ropeC; int lane;
    NOPRE
    __device__ __forceinline__ void operator()(int row, int col, f32x4 lo, f32x4 hi, NoPre) const {
        const RowInfo ri = row_info(row); const int h = col / 96, w = col - h * 96;
        if (w >= 64) {
            f32x4 plo, phi;
#pragma unroll
            for (int e = 0; e < 4; ++e) { plo[e] = shflx(lo[e], 16, lane); phi[e] = shflx(hi[e], 16, lane); }
            if (ri.lat) {
                const int j0 = w - 64, part = j0 >> 4, second = (j0 >> 3) & 1, pi = part ? (ri.t & 63) : (ri.t >> 6);
                const float* cc = ropeC + pi * 8; const float* ss = ropeC + 512 + pi * 8;
#pragma unroll
                for (int e = 0; e < 4; ++e) {
                    const float s0 = second ? ss[e] : -ss[e], s1 = second ? ss[4 + e] : -ss[4 + e];
                    lo[e] = lo[e] * cc[e] + plo[e] * s0; hi[e] = hi[e] * cc[4 + e] + phi[e] * s1; }
            }
        }
        lo = lo * QSCALE_C; hi = hi * QSCALE_C;
        f16* dst = ri.lat ? QC + ((size_t)(ri.b * 8 + h) * SEQ + ri.t) * 96 + w : QC + (size_t)NB * 8 * SEQ * 96 + ((size_t)(ri.b * 8 + h) * CTX + ri.t) * 96 + w;
        *(f16x8*)dst = pack8(lo, hi);
    } };
struct EpiGlu { f16* YS;
    NOPRE
    __device__ __forceinline__ void operator()(int row, int col, f32x4 lo, f32x4 hi, NoPre) const {
        f32x4 o;
#pragma unroll
        for (int e = 0; e < 4; ++e) o[e] = lo[e] * sigmoidf_(hi[e]);
        *(f16x4*)(YS + (size_t)row * 512 + (col >> 1)) = pack4(o);
    } };
struct EpiGate { f16* G;
    NOPRE
    __device__ __forceinline__ void operator()(int row, int col, f32x4 lo, f32x4 hi, NoPre) const {
#pragma unroll
        for (int e = 0; e < 4; ++e) { lo[e] = sigmoidf_(lo[e]); hi[e] = sigmoidf_(hi[e]); }
        *(f16x8*)(G + (size_t)row * 1024 + col) = pack8(lo, hi);
    } };
struct EpiBranch { const f16* G; f16* Mg; int first;
    struct Pre { f16x8 g, m; };
    __device__ __forceinline__ Pre pre(int row, int col) const { Pre p; p.g = *(const f16x8*)(G + (size_t)row * 1024 + col);
        if (!first) p.m = *(const f16x8*)(Mg + (size_t)row * 1024 + col); else p.m = (f16x8){0, 0, 0, 0, 0, 0, 0, 0}; return p; }
    __device__ __forceinline__ void operator()(int row, int col, f32x4 lo, f32x4 hi, const Pre& p) const {
#pragma unroll
        for (int e = 0; e < 4; ++e) { lo[e] = (float)p.m[e] + (float)p.g[e] * lo[e]; hi[e] = (float)p.m[4 + e] + (float)p.g[4 + e] * hi[e]; }
        *(f16x8*)(Mg + (size_t)row * 1024 + col) = pack8(lo, hi);
    } };
struct EpiWout { const Ctx* C; int l;
    struct Pre { f32x4 x0, x1, g0, g1; };
    __device__ __forceinline__ Pre pre(int row, int col) const { const RowInfo ri = row_info(row); const float* x = C->xsrc(l, row) + col; const float* g = C->mod(l, ri.mrow, 2) + col;
        Pre p; p.x0 = *(const f32x4*)x; p.x1 = *(const f32x4*)(x + 4); p.g0 = *(const f32x4*)g; p.g1 = *(const f32x4*)(g + 4); return p; }
    __device__ __forceinline__ void operator()(int row, int col, f32x4 lo, f32x4 hi, const Pre& p) const {
        *(f16x8*)((f16*)(C->ws() + A_T1H) + (size_t)row * D + col) = pack8(p.x0 * ALPHA + p.g0 * lo, p.x1 * ALPHA + p.g1 * hi);
    } };
struct EpiUp { f16* Hd;
    NOPRE
    __device__ __forceinline__ void operator()(int row, int col, f32x4 lo, f32x4 hi, NoPre) const {
#pragma unroll
        for (int e = 0; e < 4; ++e) { const float a = fmaxf(lo[e], 0.f), b = fmaxf(hi[e], 0.f); lo[e] = a * a; hi[e] = b * b; }
        *(f16x8*)(Hd + (size_t)row * DFF + col) = pack8(lo, hi);
    } };
struct EpiDown { const Ctx* C; int l;
    struct Pre { f16x8 t1; float mean, rstd; };
    __device__ __forceinline__ Pre pre(int row, int col) const { Pre p; p.t1 = *(const f16x8*)((const f16*)(C->ws() + A_T1H) + (size_t)row * D + col);
        const float* st = (const float*)(C->ws() + WS_ST1) + 2 * row; p.mean = st[0]; p.rstd = st[1]; return p; }
    __device__ __forceinline__ void operator()(int row, int col, f32x4 lo, f32x4 hi, const Pre& p) const {
        const RowInfo ri = row_info(row); const float* g = C->mod(l, ri.mrow, 5) + col; f16* t = (f16*)(C->ws() + A_T1H) + (size_t)row * D + col;
        const float* lg = C->in(I_LN1G) + l * D + col; const float* lb = C->in(I_LN1B) + l * D + col;
        const f32x4 g0 = *(const f32x4*)g, g1 = *(const f32x4*)(g + 4);
        const f32x4 a0 = *(const f32x4*)lg, a1 = *(const f32x4*)(lg + 4), b0 = *(const f32x4*)lb, b1 = *(const f32x4*)(lb + 4);
        f32x4 x0, x1;
#pragma unroll
        for (int e = 0; e < 4; ++e) { x0[e] = ((float)p.t1[e] - p.mean) * p.rstd * a0[e] + b0[e]; x1[e] = ((float)p.t1[4 + e] - p.mean) * p.rstd * a1[e] + b1[e]; }
        *(f16x8*)t = pack8(x0 * ALPHA + g0 * lo, x1 * ALPHA + g1 * hi);
    } };

namespace fa64 {
using bf16=_Float16;
using bf16x8=__attribute__((ext_vector_type(8)))_Float16;
using sh8=__attribute__((ext_vector_type(8)))short;
using s16x4=__attribute__((ext_vector_type(4)))short;
using u32x4=__attribute__((ext_vector_type(4)))unsigned;
constexpr int D=64;
constexpr int NW=8,QBLK=32,QB=QBLK*NW,KVBLK=64;
__device__ __forceinline__ int crow(int r,int hi){return (r&3)+8*(r>>2)+4*hi;}
#define SBAR() __builtin_amdgcn_sched_barrier(0)
constexpr int NSLOT=3, SLOTB=8192;
constexpr int LDS_K=0, LDS_V=NSLOT*SLOTB, LDS_WS=2*NSLOT*SLOTB, LDS_OST=LDS_WS+NW*64*4, LDS_BYTES=LDS_OST+NW*4096;
__device__ __forceinline__ void glds16(const void*gsrc,unsigned lds_dst){unsigned keep;
  asm volatile("s_mov_b32 %0, m0\n\ts_mov_b32 m0, %2\n\ts_nop 0\n\tglobal_load_lds_dwordx4 %1, off\n\ts_mov_b32 m0, %0":"=&s"(keep):"v"(gsrc),"s"(lds_dst):"memory");}
__device__ __forceinline__ float max3f(float a,float b,float c){float r;asm("v_max3_f32 %0, %1, %2, %3":"=v"(r):"v"(a),"v"(b),"v"(c));return r;}
__device__ __forceinline__ float max2f(float a,float b){float r;asm("v_max_f32_e32 %0, %1, %2":"=v"(r):"v"(a),"v"(b));return r;}
__device__ __forceinline__ float fadd_s(float a,float b){float r;asm("v_add_f32_e32 %0, %1, %2":"=v"(r):"v"(a),"v"(b));return r;}
__device__ __forceinline__ float fsub_s(float a,float b){float r;asm("v_sub_f32_e32 %0, %1, %2":"=v"(r):"v"(a),"v"(b));return r;}
typedef float f32x2_t __attribute__((ext_vector_type(2))); typedef _Float16 bf16x2_t __attribute__((ext_vector_type(2)));
__device__ __forceinline__ unsigned cvtpk_s(float lo,float hi){f32x2_t v={lo,hi};bf16x2_t b=__builtin_convertvector(v,bf16x2_t);return __builtin_bit_cast(unsigned,b);}
#define WAIT_BAR(N) asm volatile("s_waitcnt vmcnt(" #N ") lgkmcnt(0)\n\ts_barrier":::"memory")

__device__ __forceinline__ void qkt(f32x16&p0,f32x16&p1,const char*Kslot,const bf16x8*qr,const f32x16&negm,int r32,int hi){
  const char*kb=Kslot+hi*1024+r32*16;
  #pragma unroll
  for(int d0=0;d0<4;++d0){
    const bf16x8 b0=*reinterpret_cast<const bf16x8*>(kb+d0*2048);
    const bf16x8 b1=*reinterpret_cast<const bf16x8*>(kb+d0*2048+512);
    if(d0==0){p0=__builtin_amdgcn_mfma_f32_32x32x16_f16(b0,qr[0],negm,0,0,0);p1=__builtin_amdgcn_mfma_f32_32x32x16_f16(b1,qr[0],negm,0,0,0);}
    else{p0=__builtin_amdgcn_mfma_f32_32x32x16_f16(b0,qr[d0],p0,0,0,0);p1=__builtin_amdgcn_mfma_f32_32x32x16_f16(b1,qr[d0],p1,0,0,0);}}
}
typedef __attribute__((address_space(3))) const char* lds_cptr;
typedef short v4i16_t __attribute__((ext_vector_type(4)));
__device__ __forceinline__ void kload8(bf16x8*kf,lds_cptr kp){
  kf[0]=*(const __attribute__((address_space(3))) bf16x8*)(kp);      kf[1]=*(const __attribute__((address_space(3))) bf16x8*)(kp+512);
  kf[2]=*(const __attribute__((address_space(3))) bf16x8*)(kp+2048); kf[3]=*(const __attribute__((address_space(3))) bf16x8*)(kp+2560);
  kf[4]=*(const __attribute__((address_space(3))) bf16x8*)(kp+4096); kf[5]=*(const __attribute__((address_space(3))) bf16x8*)(kp+4608);
  kf[6]=*(const __attribute__((address_space(3))) bf16x8*)(kp+6144); kf[7]=*(const __attribute__((address_space(3))) bf16x8*)(kp+6656);
}
__device__ __forceinline__ void kload2(bf16x8*kf,lds_cptr kp,int j){ kf[2*j]=*(const __attribute__((address_space(3))) bf16x8*)(kp+j*2048); kf[2*j+1]=*(const __attribute__((address_space(3))) bf16x8*)(kp+j*2048+512); }
__device__ __forceinline__ s16x4 vtr(lds_cptr p){ return __builtin_bit_cast(s16x4,__builtin_amdgcn_ds_read_tr16_b64_v4i16((__attribute__((address_space(3))) v4i16_t*)p)); }
__device__ __forceinline__ float rowmax(const f32x16&p0,const f32x16&p1){
  float a=max3f(p0[0],p0[1],p1[0]),b=max3f(p0[2],p0[3],p1[1]);a=max3f(a,p1[2],p1[3]);
  #pragma unroll
  for(int r=4;r<16;r+=4){a=max3f(a,p0[r],p0[r+1]);b=max3f(b,p0[r+2],p0[r+3]);a=max3f(a,p1[r],p1[r+1]);b=max3f(b,p1[r+2],p1[r+3]);}
  const float m=max2f(a,b);
  auto rr=__builtin_amdgcn_permlane32_swap(__float_as_uint(m),__float_as_uint(m),false,false);
  return max2f(__uint_as_float(rr[0]),__uint_as_float(rr[1]));
}
__device__ __forceinline__ void pv(f32x16*o,int vb,bf16x8 pa0,bf16x8 pa1,bf16x8 pa2,bf16x8 pa3){
  #pragma unroll
  for(int d0=0;d0<2;++d0){s16x4 lo[4],hi[4];
    #pragma unroll
    for(int ks=0;ks<4;++ks){
      asm volatile("ds_read_b64_tr_b16 %0,%1 offset:%c2":"=&v"(lo[ks]):"v"(vb),"i"(d0*4096+ks*1024):"memory");
      asm volatile("ds_read_b64_tr_b16 %0,%1 offset:%c2":"=&v"(hi[ks]):"v"(vb),"i"(d0*4096+ks*1024+512):"memory");}
    asm volatile("s_waitcnt lgkmcnt(0)":::"memory");SBAR();
    #define PK(k) __builtin_bit_cast(bf16x8,(sh8){lo[k][0],lo[k][1],lo[k][2],lo[k][3],hi[k][0],hi[k][1],hi[k][2],hi[k][3]})
    o[d0]=__builtin_amdgcn_mfma_f32_32x32x16_f16(pa0,PK(0),o[d0],0,0,0);
    o[d0]=__builtin_amdgcn_mfma_f32_32x32x16_f16(pa1,PK(1),o[d0],0,0,0);
    o[d0]=__builtin_amdgcn_mfma_f32_32x32x16_f16(pa2,PK(2),o[d0],0,0,0);
    o[d0]=__builtin_amdgcn_mfma_f32_32x32x16_f16(pa3,PK(3),o[d0],0,0,0);
    #undef PK
  }
}

#ifndef ATTN_STORE16
#define ATTN_STORE16(p,v) (*(u32x4*)(p)=(v))
#endif
template<int THRL,int DMQ,int DMK,int DMO> __device__ __forceinline__ void attn_unit(const bf16*Qu,const bf16*__restrict__ Kh,const bf16*__restrict__ Vh,bf16*Ou,int nkeys,char*shm,const int tid){
  constexpr int DM=DMK;
  const int lane=tid&63,r32=lane&31,hi=lane>>5; const int wid=__builtin_amdgcn_readfirstlane(tid>>6);
  const bf16*Qw=Qu+(long)(wid*QBLK)*DMQ;
  const unsigned lds0=(unsigned)(uintptr_t)shm;
  float*wsf=(float*)(shm+LDS_WS)+wid*64;
  const bf16*ksrc=Kh+(long)lane*DM+wid*8;
  const bf16*vsrc=Vh+(long)(16*(wid&3)+(lane>>2))*DM+(wid>>2)*32+(lane&3)*8;
  const unsigned kdst=lds0+LDS_K+wid*1024, vdst=lds0+LDS_V+wid*1024;
  #define DMA_K(t,slot) glds16(ksrc+(long)(t)*KVBLK*DM,(unsigned)__builtin_amdgcn_readfirstlane(kdst+(slot)))
  #define DMA_V(t,slot) glds16(vsrc+(long)(t)*KVBLK*DM,(unsigned)__builtin_amdgcn_readfirstlane(vdst+(slot)))
  const int vb0=(int)(lds0+LDS_V)+((lane>>4)&1)*32+(lane&3)*8+(4*hi+((lane&15)>>2))*64;
  const char*Kbase=shm+LDS_K; bf16x8 kf[8];
  const lds_cptr shm3=(lds_cptr)shm; const lds_cptr kp0=shm3+LDS_K+hi*1024+r32*16; const lds_cptr vp0=shm3+LDS_V+((lane>>4)&1)*32+(lane&3)*8+(4*hi+((lane&15)>>2))*64;
  const int NT=nkeys/KVBLK;
  DMA_K(0,0);DMA_V(0,0);DMA_K(1,SLOTB);
  bf16x8 qr[4];
  #pragma unroll
  for(int d0=0;d0<4;++d0)qr[d0]=*reinterpret_cast<const bf16x8*>(&Qw[(long)r32*DMQ+d0*16+hi*8]);
  float mhat=0.f,l_reg=0.f;f32x16 o[2];o[0]=f32x16{};o[1]=f32x16{};f32x16 negm=f32x16{};asm volatile("":"+v"(negm));
  #define CMASK(P0,P1,t) do{}while(0)
  bool resc=false;
  #define START(P0,P1) do{ const float rm=rowmax(P0,P1); resc=false; \
    { const float dl=rm; mhat=fadd_s(mhat,dl); \
      _Pragma("unroll") for(int r=0;r<16;++r){P0[r]=fsub_s(P0[r],dl);P1[r]=fsub_s(P1[r],dl);} \
      _Pragma("unroll") for(int r=0;r<16;++r)negm[r]=-mhat; asm volatile("":"+v"(negm)); } \
    _Pragma("unroll") for(int r=0;r<16;++r)P0[r]=__builtin_amdgcn_exp2f(P0[r]); }while(0)
  #define RESC() do{ if(resc){ asm volatile("s_waitcnt lgkmcnt(0)":::"memory"); \
      _Pragma("unroll") for(int d_=0;d_<2;++d_) _Pragma("unroll") for(int r=0;r<16;++r)o[d_][r]*=wsf[crow(r,hi)]; } }while(0)
  f32x16 pA0,pA1,pB0,pB1;
  int sl_prev=0,sl_cur=0,sl_next=SLOTB;
  #define ROT() do{sl_prev=sl_cur;sl_cur=sl_next;sl_next=(sl_next==(NSLOT-1)*SLOTB)?0:sl_next+SLOTB;}while(0)
  DMA_K(2,2*SLOTB);
  WAIT_BAR(3);
  qkt(pA0,pA1,Kbase,qr,negm,r32,hi);asm volatile("s_nop 15\n\ts_nop 7":"+v"(pA0),"+v"(pA1));CMASK(pA0,pA1,0);
  START(pA0,pA1);
  _Pragma("unroll") for(int r=0;r<16;++r)pA1[r]=__builtin_amdgcn_exp2f(pA1[r]);
  WAIT_BAR(0);
  DMA_K(3,0);DMA_V(1,SLOTB);
  ROT();
  kload8(kf,kp0+sl_cur);
  WAIT_BAR(2);
  s16x4 vlo[8],vhi[8]; u32x4 pw0,pw1,pw2,pw3;
  #define PKW(P,B) cvtpk_s(P[B],P[B+1])
  #define PAF(k) __builtin_bit_cast(bf16x8,pw##k)
  #define VFR(i) __builtin_bit_cast(bf16x8,(sh8){vlo[i][0],vlo[i][1],vlo[i][2],vlo[i][3],vhi[i][0],vhi[i][1],vhi[i][2],vhi[i][3]})
  #define PIN(x) asm volatile("":"+v"(x))
  #define MX3(a,b,c) __builtin_fmaxf(__builtin_fmaxf((a),(b)),(c))
  #define GAPA(MF,A0,A1,A2,A3,W0,W1,PW) do{ MF; sacc+=A0; sacc+=A1; sacc+=A2; sacc+=A3; PIN(sacc); W0; W1; PIN(PW); SBAR(); }while(0)
  #define EX(v) __builtin_amdgcn_exp2f(v)
  #define GAPB(MF,X,B) do{ MF; X[B]=EX(X[B]); X[B+1]=EX(X[B+1]); X[B+2]=EX(X[B+2]); X[B+3]=EX(X[B+3]); PIN(X); SBAR(); }while(0)
  #define VRD(i) do{ vlo[i]=vtr(vp_+(((i)>>2)*4096+((i)&3)*1024)); vhi[i]=vtr(vp_+(((i)>>2)*4096+((i)&3)*1024+512)); }while(0)
  #define KRD(G,j) do{ if(G){ kload2(kf,kp0+sl_next,j); SBAR(); } }while(0)
  #define STEP(C0,C1,P0,P1,t,GK,GV,GL) do{ SBAR(); \
    const lds_cptr vp_=vp0+sl_prev; \
    VRD(0); SBAR(); float sacc=(P0[0]+P0[1]); \
    GAPA(C0=__builtin_amdgcn_mfma_f32_32x32x16_f16(kf[0],qr[0],negm,0,0,0), P0[2],P0[3],P0[4],P0[5],     pw0[0]=PKW(P0,0), pw0[1]=PKW(P0,2), pw0); \
    VRD(4); SBAR(); GAPA(C1=__builtin_amdgcn_mfma_f32_32x32x16_f16(kf[1],qr[0],negm,0,0,0), P0[6],P0[7],P0[8],P0[9],     pw0[2]=PKW(P0,4), pw0[3]=PKW(P0,6), pw0); \
    VRD(1); SBAR(); GAPA(C0=__builtin_amdgcn_mfma_f32_32x32x16_f16(kf[2],qr[1],C0,0,0,0),   P0[10],P0[11],P0[12],P0[13], pw1[0]=PKW(P0,8), pw1[1]=PKW(P0,10), pw1); \
    VRD(5); SBAR(); GAPA(C1=__builtin_amdgcn_mfma_f32_32x32x16_f16(kf[3],qr[1],C1,0,0,0),   P0[14],P0[15],P1[0],P1[1],   pw1[2]=PKW(P0,12),pw1[3]=PKW(P0,14), pw1); \
    VRD(2); SBAR(); GAPA(C0=__builtin_amdgcn_mfma_f32_32x32x16_f16(kf[4],qr[2],C0,0,0,0),   P1[2],P1[3],P1[4],P1[5],     pw2[0]=PKW(P1,0), pw2[1]=PKW(P1,2), pw2); \
    VRD(6); SBAR(); GAPA(C1=__builtin_amdgcn_mfma_f32_32x32x16_f16(kf[5],qr[2],C1,0,0,0),   P1[6],P1[7],P1[8],P1[9],     pw2[2]=PKW(P1,4), pw2[3]=PKW(P1,6), pw2); \
    VRD(3); SBAR(); GAPA(C0=__builtin_amdgcn_mfma_f32_32x32x16_f16(kf[6],qr[3],C0,0,0,0),   P1[10],P1[11],P1[12],P1[13], pw3[0]=PKW(P1,8), pw3[1]=PKW(P1,10), pw3); \
    VRD(7); SBAR(); GAPA(C1=__builtin_amdgcn_mfma_f32_32x32x16_f16(kf[7],qr[3],C1,0,0,0),   P1[14],P1[15],0.f,0.f,       pw3[2]=PKW(P1,12),pw3[3]=PKW(P1,14), pw3); \
    l_reg+=sacc; \
    if(GK){DMA_K((t)+3,sl_cur);} if(GV){DMA_V((t)+1,sl_next);} \
    CMASK(C0,C1,t); \
    { float a=MX3(C0[0],C0[1],C1[0]),b=MX3(C0[2],C0[3],C1[1]); a=MX3(a,C1[2],C1[3]); \
      _Pragma("unroll") for(int r=4;r<16;r+=4){a=MX3(a,C0[r],C0[r+1]);b=MX3(b,C0[r+2],C0[r+3]);a=MX3(a,C1[r],C1[r+1]);b=MX3(b,C1[r+2],C1[r+3]);} \
      float rm=__builtin_fmaxf(a,b); { auto rr=__builtin_amdgcn_permlane32_swap(__float_as_uint(rm),__float_as_uint(rm),false,false); rm=__builtin_fmaxf(__uint_as_float(rr[0]),__uint_as_float(rr[1])); } \
      resc=false; \
      if(__builtin_expect(__any(rm>(float)THRL),0)){ const float dl=__builtin_fmaxf(rm,0.f); mhat+=dl; \
        _Pragma("unroll") for(int r=0;r<16;++r){C0[r]-=dl;C1[r]-=dl;} \
        _Pragma("unroll") for(int r=0;r<16;++r)negm[r]=-mhat; asm volatile("":"+v"(negm)); \
        const float f=__builtin_amdgcn_exp2f(-dl); l_reg*=f; if(hi==0)wsf[r32]=f; resc=true; } } \
    SBAR(); \
    GAPB(o[0]=__builtin_amdgcn_mfma_f32_32x32x16_f16(PAF(0),VFR(0),o[0],0,0,0), C0,0); \
    GAPB(o[1]=__builtin_amdgcn_mfma_f32_32x32x16_f16(PAF(0),VFR(4),o[1],0,0,0), C0,4); \
    KRD(GL,0); GAPB(o[0]=__builtin_amdgcn_mfma_f32_32x32x16_f16(PAF(1),VFR(1),o[0],0,0,0), C0,8); \
    KRD(GL,1); GAPB(o[1]=__builtin_amdgcn_mfma_f32_32x32x16_f16(PAF(1),VFR(5),o[1],0,0,0), C0,12); \
    KRD(GL,2); GAPB(o[0]=__builtin_amdgcn_mfma_f32_32x32x16_f16(PAF(2),VFR(2),o[0],0,0,0), C1,0); \
    KRD(GL,3); GAPB(o[1]=__builtin_amdgcn_mfma_f32_32x32x16_f16(PAF(2),VFR(6),o[1],0,0,0), C1,4); \
    GAPB(o[0]=__builtin_amdgcn_mfma_f32_32x32x16_f16(PAF(3),VFR(3),o[0],0,0,0), C1,8); \
    GAPB(o[1]=__builtin_amdgcn_mfma_f32_32x32x16_f16(PAF(3),VFR(7),o[1],0,0,0), C1,12); \
    }while(0)
  int t=1;
  #undef CMASK
  #define CMASK(P0,P1,t) do{}while(0)
  for(;t+5<NT;t+=2){
    STEP(pB0,pB1,pA0,pA1,t,true,true,true);     WAIT_BAR(2); RESC(); ROT();
    STEP(pA0,pA1,pB0,pB1,t+1,true,true,true);   WAIT_BAR(2); RESC(); ROT();
  }
  #undef CMASK
  #define CMASK(P0,P1,t) do{}while(0)
  #define ENDW(tt) do{ if((tt)+3<NT){WAIT_BAR(2);} else if((tt)+2<NT){WAIT_BAR(1);} else {WAIT_BAR(0);} }while(0)
  for(;t+1<NT;t+=2){
    STEP(pB0,pB1,pA0,pA1,t,(t+3<NT),(t+1<NT),(t+1<NT));       ENDW(t);   RESC(); ROT();
    STEP(pA0,pA1,pB0,pB1,t+1,(t+4<NT),(t+2<NT),(t+2<NT));     ENDW(t+1); RESC(); ROT();
  }
  STEP(pB0,pB1,pA0,pA1,NT-1,false,false,false); RESC();
  { float sacc=pB0[0]+pB0[1]; _Pragma("unroll") for(int r=2;r<16;++r)sacc+=pB0[r]; _Pragma("unroll") for(int r=0;r<16;++r)sacc+=pB1[r]; l_reg+=sacc;
    pw0=(u32x4){PKW(pB0,0),PKW(pB0,2),PKW(pB0,4),PKW(pB0,6)};pw1=(u32x4){PKW(pB0,8),PKW(pB0,10),PKW(pB0,12),PKW(pB0,14)};pw2=(u32x4){PKW(pB1,0),PKW(pB1,2),PKW(pB1,4),PKW(pB1,6)};pw3=(u32x4){PKW(pB1,8),PKW(pB1,10),PKW(pB1,12),PKW(pB1,14)};
    SBAR(); pv(o,vb0+sl_cur,PAF(0),PAF(1),PAF(2),PAF(3)); }
  #undef PKW
  #undef PAF
  #undef VFR
  #undef PIN
  #undef MX3
  #undef GAPA
  #undef GAPB
  #undef EX
  #undef VRD
  #undef KRD
  #undef STEP
  #undef ENDW
  {auto rr=__builtin_amdgcn_permlane32_swap(__float_as_uint(l_reg),__float_as_uint(l_reg),false,false);l_reg=__uint_as_float(rr[0])+__uint_as_float(rr[1]);}
  if(hi==0)wsf[32+r32]=l_reg;asm volatile("s_waitcnt lgkmcnt(0)":::"memory");
  float rli[16];
  #pragma unroll
  for(int r=0;r<16;++r)rli[r]=__builtin_amdgcn_rcpf(wsf[32+crow(r,hi)]);
  bf16*Ow=Ou+(long)(wid*QBLK)*DMO;
  { bf16*stg=(bf16*)(shm+LDS_OST)+wid*2048;
    #pragma unroll
    for(int r=0;r<16;++r){const int orow=crow(r,hi);
      #pragma unroll
      for(int d0=0;d0<2;++d0)stg[orow*64+d0*32+r32]=(bf16)(o[d0][r]*rli[r]);}
    asm volatile("s_waitcnt lgkmcnt(0)":::"memory");
    #pragma unroll
    for(int i=0;i<4;++i){const int row=i*8+(lane>>3),ch=lane&7; const u32x4 v=*(const u32x4*)(stg+row*64+ch*8); ATTN_STORE16(Ow+(long)row*DMO+ch*8,v);} }
  asm volatile("s_waitcnt lgkmcnt(0)\n\ts_barrier":::"memory");
  #undef DMA_K
  #undef DMA_V
  #undef CMASK
  #undef START
  #undef RESC
  #undef ROT
}
#undef SBAR
#undef WAIT_BAR
}
namespace fa96 {
using bf16=_Float16;
using bf16x8=__attribute__((ext_vector_type(8)))_Float16;
using sh8=__attribute__((ext_vector_type(8)))short;
using s16x4=__attribute__((ext_vector_type(4)))short;
using u32x4=__attribute__((ext_vector_type(4)))unsigned;
constexpr int D=64;
constexpr int NW=8,QBLK=32,QB=QBLK*NW,KVBLK=64;
__device__ __forceinline__ int crow(int r,int hi){return (r&3)+8*(r>>2)+4*hi;}
#define SBAR() __builtin_amdgcn_sched_barrier(0)
constexpr int NSLOT=3, SLOTB=12288;
constexpr int LDS_K=0, LDS_V=NSLOT*SLOTB, LDS_WS=2*NSLOT*SLOTB, LDS_OST=LDS_WS+NW*64*4, LDS_BYTES=LDS_OST+NW*4096;
__device__ __forceinline__ void glds16(const void*gsrc,unsigned lds_dst){unsigned keep;
  asm volatile("s_mov_b32 %0, m0\n\ts_mov_b32 m0, %2\n\ts_nop 0\n\tglobal_load_lds_dwordx4 %1, off\n\ts_mov_b32 m0, %0":"=&s"(keep):"v"(gsrc),"s"(lds_dst):"memory");}
__device__ __forceinline__ float max3f(float a,float b,float c){float r;asm("v_max3_f32 %0, %1, %2, %3":"=v"(r):"v"(a),"v"(b),"v"(c));return r;}
__device__ __forceinline__ float max2f(float a,float b){float r;asm("v_max_f32_e32 %0, %1, %2":"=v"(r):"v"(a),"v"(b));return r;}
__device__ __forceinline__ float fadd_s(float a,float b){float r;asm("v_add_f32_e32 %0, %1, %2":"=v"(r):"v"(a),"v"(b));return r;}
__device__ __forceinline__ float fsub_s(float a,float b){float r;asm("v_sub_f32_e32 %0, %1, %2":"=v"(r):"v"(a),"v"(b));return r;}
typedef float f32x2_t __attribute__((ext_vector_type(2))); typedef _Float16 bf16x2_t __attribute__((ext_vector_type(2)));
__device__ __forceinline__ unsigned cvtpk_s(float lo,float hi){f32x2_t v={lo,hi};bf16x2_t b=__builtin_convertvector(v,bf16x2_t);return __builtin_bit_cast(unsigned,b);}
#define WAIT_BAR(N) asm volatile("s_waitcnt vmcnt(" #N ") lgkmcnt(0)\n\ts_barrier":::"memory")

__device__ __forceinline__ void qkt(f32x16&p0,f32x16&p1,const char*Kslot,const bf16x8*qr,const f32x16&negm,int r32,int hi){
  const char*kb=Kslot+hi*1024+r32*16;
  #pragma unroll
  for(int d0=0;d0<6;++d0){
    const bf16x8 b0=*reinterpret_cast<const bf16x8*>(kb+d0*2048);
    const bf16x8 b1=*reinterpret_cast<const bf16x8*>(kb+d0*2048+512);
    if(d0==0){p0=__builtin_amdgcn_mfma_f32_32x32x16_f16(b0,qr[0],negm,0,0,0);p1=__builtin_amdgcn_mfma_f32_32x32x16_f16(b1,qr[0],negm,0,0,0);}
    else{p0=__builtin_amdgcn_mfma_f32_32x32x16_f16(b0,qr[d0],p0,0,0,0);p1=__builtin_amdgcn_mfma_f32_32x32x16_f16(b1,qr[d0],p1,0,0,0);}}
}
typedef __attribute__((address_space(3))) const char* lds_cptr;
typedef short v4i16_t __attribute__((ext_vector_type(4)));
__device__ __forceinline__ void kload8(bf16x8*kf,lds_cptr kp){
  kf[0]=*(const __attribute__((address_space(3))) bf16x8*)(kp);      kf[1]=*(const __attribute__((address_space(3))) bf16x8*)(kp+512);
  kf[2]=*(const __attribute__((address_space(3))) bf16x8*)(kp+2048); kf[3]=*(const __attribute__((address_space(3))) bf16x8*)(kp+2560);
  kf[4]=*(const __attribute__((address_space(3))) bf16x8*)(kp+4096); kf[5]=*(const __attribute__((address_space(3))) bf16x8*)(kp+4608);
  kf[6]=*(const __attribute__((address_space(3))) bf16x8*)(kp+6144); kf[7]=*(const __attribute__((address_space(3))) bf16x8*)(kp+6656);
  kf[8]=*(const __attribute__((address_space(3))) bf16x8*)(kp+8192); kf[9]=*(const __attribute__((address_space(3))) bf16x8*)(kp+8704);
  kf[10]=*(const __attribute__((address_space(3))) bf16x8*)(kp+10240); kf[11]=*(const __attribute__((address_space(3))) bf16x8*)(kp+10752);
}
__device__ __forceinline__ void kload2(bf16x8*kf,lds_cptr kp,int j){ kf[2*j]=*(const __attribute__((address_space(3))) bf16x8*)(kp+j*2048); kf[2*j+1]=*(const __attribute__((address_space(3))) bf16x8*)(kp+j*2048+512); }
__device__ __forceinline__ s16x4 vtr(lds_cptr p){ return __builtin_bit_cast(s16x4,__builtin_amdgcn_ds_read_tr16_b64_v4i16((__attribute__((address_space(3))) v4i16_t*)p)); }
__device__ __forceinline__ float rowmax(const f32x16&p0,const f32x16&p1){
  float a=max3f(p0[0],p0[1],p1[0]),b=max3f(p0[2],p0[3],p1[1]);a=max3f(a,p1[2],p1[3]);
  #pragma unroll
  for(int r=4;r<16;r+=4){a=max3f(a,p0[r],p0[r+1]);b=max3f(b,p0[r+2],p0[r+3]);a=max3f(a,p1[r],p1[r+1]);b=max3f(b,p1[r+2],p1[r+3]);}
  const float m=max2f(a,b);
  auto rr=__builtin_amdgcn_permlane32_swap(__float_as_uint(m),__float_as_uint(m),false,false);
  return max2f(__uint_as_float(rr[0]),__uint_as_float(rr[1]));
}
__device__ __forceinline__ void pv(f32x16*o,int vb,bf16x8 pa0,bf16x8 pa1,bf16x8 pa2,bf16x8 pa3){
  #pragma unroll
  for(int d0=0;d0<2;++d0){s16x4 lo[4],hi[4];
    #pragma unroll
    for(int ks=0;ks<4;++ks){
      asm volatile("ds_read_b64_tr_b16 %0,%1 offset:%c2":"=&v"(lo[ks]):"v"(vb),"i"(d0*4096+ks*1024):"memory");
      asm volatile("ds_read_b64_tr_b16 %0,%1 offset:%c2":"=&v"(hi[ks]):"v"(vb),"i"(d0*4096+ks*1024+512):"memory");}
    asm volatile("s_waitcnt lgkmcnt(0)":::"memory");SBAR();
    #define PK(k) __builtin_bit_cast(bf16x8,(sh8){lo[k][0],lo[k][1],lo[k][2],lo[k][3],hi[k][0],hi[k][1],hi[k][2],hi[k][3]})
    o[d0]=__builtin_amdgcn_mfma_f32_32x32x16_f16(pa0,PK(0),o[d0],0,0,0);
    o[d0]=__builtin_amdgcn_mfma_f32_32x32x16_f16(pa1,PK(1),o[d0],0,0,0);
    o[d0]=__builtin_amdgcn_mfma_f32_32x32x16_f16(pa2,PK(2),o[d0],0,0,0);
    o[d0]=__builtin_amdgcn_mfma_f32_32x32x16_f16(pa3,PK(3),o[d0],0,0,0);
    #undef PK
  }
}

#ifndef ATTN_STORE16
#define ATTN_STORE16(p,v) (*(u32x4*)(p)=(v))
#endif
template<int THRL,int DMQ,int DMK,int DMV,int DMO> __device__ __forceinline__ void attn_unit(const bf16*Qu,const bf16*__restrict__ Kh,const bf16*__restrict__ Vh,bf16*Ou,int nkeys,char*shm,const int tid){
  constexpr int DM=DMK;
  const int lane=tid&63,r32=lane&31,hi=lane>>5; const int wid=__builtin_amdgcn_readfirstlane(tid>>6);
  const bf16*Qw=Qu+(long)(wid*QBLK)*DMQ;
  const unsigned lds0=(unsigned)(uintptr_t)shm;
  float*wsf=(float*)(shm+LDS_WS)+wid*64;
  const bf16*ksrc=Kh+(long)lane*DM+wid*8;
  const bf16*vsrc=Vh+(long)(16*(wid&3)+(lane>>2))*DMV+(wid>>2)*32+(lane&3)*8;
  const int koff2=(8+(wid&3)-wid)*8;
  const unsigned kdst=lds0+LDS_K+wid*1024, kdst2=lds0+LDS_K+(8+(wid&3))*1024, vdst=lds0+LDS_V+wid*1024;
  #define DMA_K(t,slot) do{ glds16(ksrc+(long)(t)*KVBLK*DM,(unsigned)__builtin_amdgcn_readfirstlane(kdst+(slot))); { int ko_=koff2; asm volatile("":"+s"(ko_)); glds16(ksrc+(long)(t)*KVBLK*DM+ko_,(unsigned)__builtin_amdgcn_readfirstlane(kdst2+(slot))); } }while(0)
  #define DMA_V(t,slot) glds16(vsrc+(long)(t)*KVBLK*DMV,(unsigned)__builtin_amdgcn_readfirstlane(vdst+(slot)))
  const char*Kbase=shm+LDS_K; bf16x8 kf[12];
  const lds_cptr shm3=(lds_cptr)shm; const lds_cptr kp0=shm3+LDS_K+hi*1024+r32*16; const lds_cptr vp0=shm3+LDS_V+((lane>>4)&1)*32+(lane&3)*8+(4*hi+((lane&15)>>2))*64;
  const int NT=nkeys/KVBLK;
  DMA_K(0,0);DMA_V(0,0);DMA_K(1,SLOTB);
  bf16x8 qr[6];
  #pragma unroll
  for(int d0=0;d0<6;++d0)qr[d0]=*reinterpret_cast<const bf16x8*>(&Qw[(long)r32*DMQ+d0*16+hi*8]);
  float mhat=0.f,l_reg=0.f;f32x16 o[2];o[0]=f32x16{};o[1]=f32x16{};const f32x16 negm=f32x16{};
  #define CMASK(P0,P1,t) do{}while(0)
  bool resc=false;
  #define START(P0,P1) do{ const float rm=rowmax(P0,P1); resc=false; \
    { const float dl=rm; mhat=fadd_s(mhat,dl); \
      _Pragma("unroll") for(int r=0;r<16;++r){P0[r]=fsub_s(P0[r],dl);P1[r]=fsub_s(P1[r],dl);} \
    } \
    _Pragma("unroll") for(int r=0;r<16;++r)P0[r]=__builtin_amdgcn_exp2f(P0[r]); }while(0)
  #define RESC() do{ if(resc){ asm volatile("s_waitcnt lgkmcnt(0)":::"memory"); \
      _Pragma("unroll") for(int d_=0;d_<2;++d_) _Pragma("unroll") for(int r=0;r<16;++r)o[d_][r]*=wsf[crow(r,hi)]; } }while(0)
  f32x16 pA0,pA1,pB0,pB1;
  int sl_prev=0,sl_cur=0,sl_next=SLOTB;
  #define ROT() do{sl_prev=sl_cur;sl_cur=sl_next;sl_next=(sl_next==(NSLOT-1)*SLOTB)?0:sl_next+SLOTB;}while(0)
  DMA_K(2,2*SLOTB);
  WAIT_BAR(3);
  qkt(pA0,pA1,Kbase,qr,negm,r32,hi);asm volatile("s_nop 15\n\ts_nop 7":"+v"(pA0),"+v"(pA1));CMASK(pA0,pA1,0);
  START(pA0,pA1);
  _Pragma("unroll") for(int r=0;r<16;++r)pA1[r]=__builtin_amdgcn_exp2f(pA1[r]);
  WAIT_BAR(0);
  DMA_K(3,0);DMA_V(1,SLOTB);
  ROT();
  kload8(kf,kp0+sl_cur);
  WAIT_BAR(3);
  s16x4 vlo[8],vhi[8]; u32x4 pw0,pw1,pw2,pw3;
  #define PKW(P,B) cvtpk_s(P[B],P[B+1])
  #define PAF(k) __builtin_bit_cast(bf16x8,pw##k)
  #define VFR(i) __builtin_bit_cast(bf16x8,(sh8){vlo[i][0],vlo[i][1],vlo[i][2],vlo[i][3],vhi[i][0],vhi[i][1],vhi[i][2],vhi[i][3]})
  #define PIN(x) asm volatile("":"+v"(x))
  #define MX3(a,b,c) __builtin_fmaxf(__builtin_fmaxf((a),(b)),(c))
  #define GAPA(MF,A0,A1,A2,A3,W0,W1,PW) do{ MF; sacc+=A0; sacc+=A1; sacc+=A2; sacc+=A3; PIN(sacc); W0; W1; PIN(PW); SBAR(); }while(0)
  #define EX(v) __builtin_amdgcn_exp2f(v)
  #define GAPB(MF,X,B) do{ MF; X[B]=EX(X[B]); X[B+1]=EX(X[B+1]); X[B+2]=EX(X[B+2]); X[B+3]=EX(X[B+3]); PIN(X); SBAR(); }while(0)
  #define VRD(i) do{ vlo[i]=vtr(vp_+(((i)>>2)*4096+((i)&3)*1024)); vhi[i]=vtr(vp_+(((i)>>2)*4096+((i)&3)*1024+512)); }while(0)
  #define KRD(G,j) do{ if(G){ kload2(kf,kp0+sl_next,j); SBAR(); } }while(0)
  #define STEP(C0,C1,P0,P1,t,GK,GV,GL) do{ SBAR(); \
    const lds_cptr vp_=vp0+sl_prev; \
    VRD(0); SBAR(); float sacc=(P0[0]+P0[1]); \
    GAPA(C0=__builtin_amdgcn_mfma_f32_32x32x16_f16(kf[0],qr[0],negm,0,0,0), P0[2],P0[3],P0[4],P0[5],     pw0[0]=PKW(P0,0), pw0[1]=PKW(P0,2), pw0); \
    VRD(4); SBAR(); GAPA(C1=__builtin_amdgcn_mfma_f32_32x32x16_f16(kf[1],qr[0],negm,0,0,0), P0[6],P0[7],P0[8],P0[9],     pw0[2]=PKW(P0,4), pw0[3]=PKW(P0,6), pw0); \
    VRD(1); SBAR(); GAPA(C0=__builtin_amdgcn_mfma_f32_32x32x16_f16(kf[2],qr[1],C0,0,0,0),   P0[10],P0[11],P0[12],P0[13], pw1[0]=PKW(P0,8), pw1[1]=PKW(P0,10), pw1); \
    VRD(5); SBAR(); GAPA(C1=__builtin_amdgcn_mfma_f32_32x32x16_f16(kf[3],qr[1],C1,0,0,0),   P0[14],P0[15],P1[0],P1[1],   pw1[2]=PKW(P0,12),pw1[3]=PKW(P0,14), pw1); \
    VRD(2); SBAR(); GAPA(C0=__builtin_amdgcn_mfma_f32_32x32x16_f16(kf[4],qr[2],C0,0,0,0),   P1[2],P1[3],P1[4],P1[5],     pw2[0]=PKW(P1,0), pw2[1]=PKW(P1,2), pw2); \
    VRD(6); SBAR(); GAPA(C1=__builtin_amdgcn_mfma_f32_32x32x16_f16(kf[5],qr[2],C1,0,0,0),   P1[6],P1[7],P1[8],P1[9],     pw2[2]=PKW(P1,4), pw2[3]=PKW(P1,6), pw2); \
    VRD(3); SBAR(); GAPA(C0=__builtin_amdgcn_mfma_f32_32x32x16_f16(kf[6],qr[3],C0,0,0,0),   P1[10],P1[11],P1[12],P1[13], pw3[0]=PKW(P1,8), pw3[1]=PKW(P1,10), pw3); \
    VRD(7); SBAR(); GAPA(C1=__builtin_amdgcn_mfma_f32_32x32x16_f16(kf[7],qr[3],C1,0,0,0),   P1[14],P1[15],0.f,0.f,       pw3[2]=PKW(P1,12),pw3[3]=PKW(P1,14), pw3); \
    C0=__builtin_amdgcn_mfma_f32_32x32x16_f16(kf[8],qr[4],C0,0,0,0); C1=__builtin_amdgcn_mfma_f32_32x32x16_f16(kf[9],qr[4],C1,0,0,0); \
    C0=__builtin_amdgcn_mfma_f32_32x32x16_f16(kf[10],qr[5],C0,0,0,0); C1=__builtin_amdgcn_mfma_f32_32x32x16_f16(kf[11],qr[5],C1,0,0,0); SBAR(); \
    l_reg+=sacc; \
    if(GK){DMA_K((t)+3,sl_cur);} if(GV){DMA_V((t)+1,sl_next);} \
    _Pragma("unroll") for(int r=0;r<16;++r){C0[r]-=mhat;C1[r]-=mhat;} \
    { float a=MX3(C0[0],C0[1],C1[0]),b=MX3(C0[2],C0[3],C1[1]); a=MX3(a,C1[2],C1[3]); \
      _Pragma("unroll") for(int r=4;r<16;r+=4){a=MX3(a,C0[r],C0[r+1]);b=MX3(b,C0[r+2],C0[r+3]);a=MX3(a,C1[r],C1[r+1]);b=MX3(b,C1[r+2],C1[r+3]);} \
      float rm=__builtin_fmaxf(a,b); { auto rr=__builtin_amdgcn_permlane32_swap(__float_as_uint(rm),__float_as_uint(rm),false,false); rm=__builtin_fmaxf(__uint_as_float(rr[0]),__uint_as_float(rr[1])); } \
      resc=false; \
      if(__builtin_expect(__any(rm>(float)THRL),0)){ const float dl=__builtin_fmaxf(rm,0.f); mhat+=dl; \
        _Pragma("unroll") for(int r=0;r<16;++r){C0[r]-=dl;C1[r]-=dl;} \
        const float f=__builtin_amdgcn_exp2f(-dl); l_reg*=f; if(hi==0)wsf[r32]=f; resc=true; } } \
    SBAR(); \
    GAPB(o[0]=__builtin_amdgcn_mfma_f32_32x32x16_f16(PAF(0),VFR(0),o[0],0,0,0), C0,0); \
    GAPB(o[1]=__builtin_amdgcn_mfma_f32_32x32x16_f16(PAF(0),VFR(4),o[1],0,0,0), C0,4); \
    KRD(GL,0); GAPB(o[0]=__builtin_amdgcn_mfma_f32_32x32x16_f16(PAF(1),VFR(1),o[0],0,0,0), C0,8); \
    KRD(GL,1); GAPB(o[1]=__builtin_amdgcn_mfma_f32_32x32x16_f16(PAF(1),VFR(5),o[1],0,0,0), C0,12); \
    KRD(GL,2); GAPB(o[0]=__builtin_amdgcn_mfma_f32_32x32x16_f16(PAF(2),VFR(2),o[0],0,0,0), C1,0); \
    KRD(GL,3); GAPB(o[1]=__builtin_amdgcn_mfma_f32_32x32x16_f16(PAF(2),VFR(6),o[1],0,0,0), C1,4); \
    KRD(GL,4); GAPB(o[0]=__builtin_amdgcn_mfma_f32_32x32x16_f16(PAF(3),VFR(3),o[0],0,0,0), C1,8); \
    KRD(GL,5); GAPB(o[1]=__builtin_amdgcn_mfma_f32_32x32x16_f16(PAF(3),VFR(7),o[1],0,0,0), C1,12); \
    }while(0)
  int t=1;
  #undef CMASK
  #define CMASK(P0,P1,t) do{}while(0)
  for(;t+5<NT;t+=2){
    STEP(pB0,pB1,pA0,pA1,t,true,true,true);     WAIT_BAR(3); RESC(); ROT();
    STEP(pA0,pA1,pB0,pB1,t+1,true,true,true);   WAIT_BAR(3); RESC(); ROT();
  }
  #undef CMASK
  #define CMASK(P0,P1,t) do{}while(0)
  #define ENDW(tt) do{ if((tt)+3<NT){WAIT_BAR(3);} else if((tt)+2<NT){WAIT_BAR(1);} else {WAIT_BAR(0);} }while(0)
  for(;t+1<NT;t+=2){
    STEP(pB0,pB1,pA0,pA1,t,(t+3<NT),(t+1<NT),(t+1<NT));       ENDW(t);   RESC(); ROT();
    STEP(pA0,pA1,pB0,pB1,t+1,(t+4<NT),(t+2<NT),(t+2<NT));     ENDW(t+1); RESC(); ROT();
  }
  STEP(pB0,pB1,pA0,pA1,NT-1,false,false,false); RESC();
  { float sacc=pB0[0]+pB0[1]; _Pragma("unroll") for(int r=2;r<16;++r)sacc+=pB0[r]; _Pragma("unroll") for(int r=0;r<16;++r)sacc+=pB1[r]; l_reg+=sacc;
    pw0=(u32x4){PKW(pB0,0),PKW(pB0,2),PKW(pB0,4),PKW(pB0,6)};pw1=(u32x4){PKW(pB0,8),PKW(pB0,10),PKW(pB0,12),PKW(pB0,14)};pw2=(u32x4){PKW(pB1,0),PKW(pB1,2),PKW(pB1,4),PKW(pB1,6)};pw3=(u32x4){PKW(pB1,8),PKW(pB1,10),PKW(pB1,12),PKW(pB1,14)};
    SBAR(); pv(o,(int)(unsigned)(uintptr_t)vp0+sl_cur,PAF(0),PAF(1),PAF(2),PAF(3)); }
  #undef PKW
  #undef PAF
  #undef VFR
  #undef PIN
  #undef MX3
  #undef GAPA
  #undef GAPB
  #undef EX
  #undef VRD
  #undef KRD
  #undef STEP
  #undef ENDW
  {auto rr=__builtin_amdgcn_permlane32_swap(__float_as_uint(l_reg),__float_as_uint(l_reg),false,false);l_reg=__uint_as_float(rr[0])+__uint_as_float(rr[1]);}
  if(hi==0)wsf[32+r32]=l_reg;asm volatile("s_waitcnt lgkmcnt(0)":::"memory");
  float rli[16];
  #pragma unroll
  for(int r=0;r<16;++r)rli[r]=__builtin_amdgcn_rcpf(wsf[32+crow(r,hi)]);
  bf16*Ow=Ou+(long)(wid*QBLK)*DMO;
  { bf16*stg=(bf16*)(shm+LDS_OST)+wid*2048;
    #pragma unroll
    for(int r=0;r<16;++r){const int orow=crow(r,hi);
      #pragma unroll
      for(int d0=0;d0<2;++d0)stg[orow*64+d0*32+r32]=(bf16)(o[d0][r]*rli[r]);}
    asm volatile("s_waitcnt lgkmcnt(0)":::"memory");
    #pragma unroll
    for(int i=0;i<4;++i){const int row=i*8+(lane>>3),ch=lane&7; const u32x4 v=*(const u32x4*)(stg+row*64+ch*8); ATTN_STORE16(Ow+(long)row*DMO+ch*8,v);} }
  asm volatile("s_waitcnt lgkmcnt(0)\n\ts_barrier":::"memory");
  #undef DMA_K
  #undef DMA_V
  #undef CMASK
  #undef START
  #undef RESC
  #undef ROT
}
#undef SBAR
#undef WAIT_BAR
}
namespace fa {
typedef _Float16 h2 __attribute__((ext_vector_type(2)));
typedef float f2 __attribute__((ext_vector_type(2)));
typedef short s16x4 __attribute__((ext_vector_type(4)));
typedef unsigned u32x4 __attribute__((ext_vector_type(4)));
#define FA_SBAR() __builtin_amdgcn_sched_barrier(0)
constexpr float THR = 8.f;
constexpr int SHM_V = 64 * 64 * 2;
template <int DQK> struct Cfg { static constexpr int KROWB = DQK == 64 ? 128 : 256, SHM_K = 64 * KROWB, NCH = DQK / 8; };
template <int DQK> __device__ __forceinline__ int kswz(int row, int ch) {
    if constexpr (DQK == 64) return row * 128 + ((ch ^ ((row >> 1) & 7)) << 4);
    else return row * 256 + ((ch ^ (row & 15)) << 4);
}
__device__ __forceinline__ int crow(int r, int hi) { return (r & 3) + 8 * (r >> 2) + 4 * hi; }
__device__ __forceinline__ unsigned cvtpk(float lo, float hi) { f2 v = {lo, hi}; h2 h = __builtin_convertvector(v, h2); return __builtin_bit_cast(unsigned, h); }
__device__ __forceinline__ void partialSM(f32x16& p0, f32x16& p1, float& m_reg, float& mn, float& alpha) {
    float pmax = p0[0];
#pragma unroll
    for (int r = 1; r < 16; ++r) pmax = fmaxf(pmax, p0[r]);
#pragma unroll
    for (int r = 0; r < 16; ++r) pmax = fmaxf(pmax, p1[r]);
    { auto rr = __builtin_amdgcn_permlane32_swap(__float_as_uint(pmax), __float_as_uint(pmax), false, false);
      pmax = fmaxf(__uint_as_float(rr[0]), __uint_as_float(rr[1])); }
    if (__builtin_expect(__all(pmax - m_reg <= THR), 1)) { mn = m_reg; alpha = 1.f; }
    else { mn = fmaxf(m_reg, pmax); alpha = __builtin_amdgcn_exp2f(m_reg - mn); m_reg = mn; }
#pragma unroll
    for (int r = 0; r < 16; ++r) { p0[r] = p0[r] - mn; p1[r] = p1[r] - mn; }
#pragma unroll
    for (int r = 0; r < 16; ++r) p0[r] = __builtin_amdgcn_exp2f(p0[r]);
}
__device__ __forceinline__ void finishSM(f32x16& p0, f32x16& p1, float alpha, float& l_reg, f16x8& pa0, f16x8& pa1, f16x8& pa2, f16x8& pa3) {
#pragma unroll
    for (int r = 0; r < 16; ++r) p1[r] = __builtin_amdgcn_exp2f(p1[r]);
    float ps = 0;
#pragma unroll
    for (int r = 0; r < 16; ++r) ps += p0[r];
#pragma unroll
    for (int r = 0; r < 16; ++r) ps += p1[r];
    { auto rr = __builtin_amdgcn_permlane32_swap(__float_as_uint(ps), __float_as_uint(ps), false, false);
      ps = __uint_as_float(rr[0]) + __uint_as_float(rr[1]); }
    l_reg = l_reg * alpha + ps;
#define FA_PK4(P, BASE, OUT) do { unsigned a0 = cvtpk(P[BASE + 0], P[BASE + 1]), a1 = cvtpk(P[BASE + 2], P[BASE + 3]);   \
    unsigned b0 = cvtpk(P[BASE + 4], P[BASE + 5]), b1 = cvtpk(P[BASE + 6], P[BASE + 7]);                              \
    auto r0 = __builtin_amdgcn_permlane32_swap(a0, b0, false, false); auto r1 = __builtin_amdgcn_permlane32_swap(a1, b1, false, false); \
    u32x4 w = {r0[0], r1[0], r0[1], r1[1]}; OUT = __builtin_bit_cast(f16x8, w); } while (0)
    FA_PK4(p0, 0, pa0); FA_PK4(p0, 8, pa1); FA_PK4(p1, 0, pa2); FA_PK4(p1, 8, pa3);
#undef FA_PK4
}
template <int DQK>
__device__ __forceinline__ void qkt(f32x16& p0, f32x16& p1, const LAS unsigned char* Ks, const f16x8* qr, int r32, int hi) {
    p0 = f32x16{}; p1 = f32x16{};
#pragma unroll
    for (int d0 = 0; d0 < DQK / 16; ++d0) {
        const f16x8 b0 = *(const LAS f16x8*)(Ks + kswz<DQK>(r32, d0 * 2 + hi));
        const f16x8 b1 = *(const LAS f16x8*)(Ks + kswz<DQK>(32 + r32, d0 * 2 + hi));
        p0 = __builtin_amdgcn_mfma_f32_32x32x16_f16(b0, qr[d0], p0, 0, 0, 0);
        p1 = __builtin_amdgcn_mfma_f32_32x32x16_f16(b1, qr[d0], p1, 0, 0, 0);
    }
}
__device__ __forceinline__ int v_st(int k, int c) { const int kk = (k & ~0xC) | ((k & 4) << 1) | ((k & 8) >> 1); return ((kk >> 3) * 2 + (c >> 5)) * 512 + ((kk & 7) * 32 + (c & 31)) * 2; }
__device__ __forceinline__ int v_rd_base(int lane) { return ((lane & 3) << 3) | (((lane >> 2) & 3) << 6) | (((lane >> 4) & 1) << 5) | (((lane >> 5) & 1) << 8); }
constexpr int v_rd_off(int d0, int ks, int half) { return d0 * 512 + ks * 2048 + half * 1024; }
template <int OFF> __device__ __forceinline__ s16x4 tr_read(int vb) {
    s16x4 r; asm volatile("ds_read_b64_tr_b16 %0, %1 offset:%2" : "=&v"(r) : "v"(vb), "i"(OFF) : "memory"); return r;
}
template <int D0> __device__ __forceinline__ void pv_one(f32x16& od, int vb, f16x8 pa0, f16x8 pa1, f16x8 pa2, f16x8 pa3) {
    const s16x4 l0 = tr_read<v_rd_off(D0, 0, 0)>(vb), h0 = tr_read<v_rd_off(D0, 0, 1)>(vb), l1 = tr_read<v_rd_off(D0, 1, 0)>(vb), h1 = tr_read<v_rd_off(D0, 1, 1)>(vb);
    const s16x4 l2 = tr_read<v_rd_off(D0, 2, 0)>(vb), h2_ = tr_read<v_rd_off(D0, 2, 1)>(vb), l3 = tr_read<v_rd_off(D0, 3, 0)>(vb), h3 = tr_read<v_rd_off(D0, 3, 1)>(vb);
    asm volatile("s_waitcnt lgkmcnt(0)" ::: "memory"); FA_SBAR();
#define FA_PK(L, H) __builtin_bit_cast(f16x8, (short __attribute__((ext_vector_type(8)))){L[0], L[1], L[2], L[3], H[0], H[1], H[2], H[3]})
    od = __builtin_amdgcn_mfma_f32_32x32x16_f16(pa0, FA_PK(l0, h0), od, 0, 0, 0);
    od = __builtin_amdgcn_mfma_f32_32x32x16_f16(pa1, FA_PK(l1, h1), od, 0, 0, 0);
    od = __builtin_amdgcn_mfma_f32_32x32x16_f16(pa2, FA_PK(l2, h2_), od, 0, 0, 0);
    od = __builtin_amdgcn_mfma_f32_32x32x16_f16(pa3, FA_PK(l3, h3), od, 0, 0, 0);
#undef FA_PK
}
__device__ __forceinline__ void pv_d0(f32x16* o, int vb, f16x8 pa0, f16x8 pa1, f16x8 pa2, f16x8 pa3) {
    pv_one<0>(o[0], vb, pa0, pa1, pa2, pa3); pv_one<1>(o[1], vb, pa0, pa1, pa2, pa3);
}
template <int DQK>
__device__ __forceinline__ void attn_unit(const f16* Qb, int qstride, const f16* __restrict__ Kh, const f16* __restrict__ Vh, f16* Ob, int nkeys, LAS unsigned char* lds, const int tid) {
    constexpr int SHM_K = Cfg<DQK>::SHM_K, NCH = Cfg<DQK>::NCH, ND0 = DQK / 16;
    const int wid = tid >> 6, lane = tid & 63, r32 = lane & 31, hi = lane >> 5;
    LAS unsigned char* V_lds = lds; LAS unsigned char* K_lds = lds + 3 * SHM_V;
    LAS float* wsx = (LAS float*)(lds + 3 * SHM_V + 2 * SHM_K) + wid * 64; LAS float* li_l = wsx; LAS float* al_l = wsx + 32;
    float m_reg = -1e30f, l_reg = 0; f32x16 o[2] = {}; f16x8 qr[ND0];
    const f16* Qw = Qb + (size_t)(wid * 32 + r32) * qstride + hi * 8;
#pragma unroll
    for (int d0 = 0; d0 < ND0; ++d0) qr[d0] = *(const f16x8*)(Qw + d0 * 16);
    const int vr = tid >> 3, vc = (tid & 7) * 8, vst = v_st(vr, vc);
    const int k0id = tid, k1id = (tid + 512 < 64 * NCH) ? tid + 512 : tid;
    const int k0r = k0id / NCH, k0c = k0id % NCH, k1r = k1id / NCH, k1c = k1id % NCH;
    const bool k1on = (NCH > 8) && (tid + 512 < 64 * NCH);
    const int vb0 = (int)(uintptr_t)V_lds + v_rd_base(lane);
    struct { f16x8 vs, ks0, ks1; } sr_[2];
#define FA_SLOAD(i, kk0) do { sr_[i].vs = *(const f16x8*)(Vh + (size_t)((kk0) + vr) * 64 + vc); sr_[i].ks0 = *(const f16x8*)(Kh + (size_t)((kk0) + k0r) * DQK + k0c * 8); \
    if (NCH > 8) sr_[i].ks1 = *(const f16x8*)(Kh + (size_t)((kk0) + k1r) * DQK + k1c * 8); } while (0)
#define FA_SWRITE(b, vbo, i) do { *(LAS f16x8*)(V_lds + (vbo) + vst) = sr_[i].vs; *(LAS f16x8*)(K_lds + (b) * SHM_K + kswz<DQK>(k0r, k0c)) = sr_[i].ks0; \
    if (k1on) *(LAS f16x8*)(K_lds + (b) * SHM_K + kswz<DQK>(k1r, k1c)) = sr_[i].ks1; } while (0)
#define FA_SWAIT() do { if (NCH > 8) asm volatile("s_waitcnt vmcnt(3)" ::: "memory"); else asm volatile("s_waitcnt vmcnt(2)" ::: "memory"); } while (0)
#define FA_RESC(a) do { if (__any((a) < 1.f)) { if (hi == 0) al_l[r32] = (a); asm volatile("s_waitcnt lgkmcnt(0)" ::: "memory"); \
    _Pragma("unroll") for (int d = 0; d < 2; ++d) _Pragma("unroll") for (int r = 0; r < 16; ++r) o[d][r] *= al_l[crow(r, hi)]; } } while (0)
    f32x16 pA0, pA1, pB0, pB1; float mnA, mnB, alA, alB; f16x8 pa0, pa1, pa2, pa3; const int NT = nkeys / 64;
    constexpr int SE = 0, SO = 1;
    int vp = 0, vc_ = SHM_V, vn = 2 * SHM_V;
#define FA_VROT() do { const int t_ = vp; vp = vc_; vc_ = vn; vn = t_; } while (0)
    FA_SLOAD(SE, 0); FA_SLOAD(SO, 64);
    FA_SWAIT(); FA_SWRITE(0, 0, SE); __syncthreads();
    qkt<DQK>(pA0, pA1, K_lds, qr, r32, hi); partialSM(pA0, pA1, m_reg, mnA, alA);
    if (2 < NT) FA_SLOAD(SE, 128);
    FA_SWAIT(); FA_SWRITE(1, SHM_V, SO); __syncthreads();
    for (int j = 1; j + 1 < NT; j += 2) {
        FA_SBAR(); qkt<DQK>(pB0, pB1, K_lds + SHM_K, qr, r32, hi);
        finishSM(pA0, pA1, alA, l_reg, pa0, pa1, pa2, pa3); FA_SBAR();
        FA_SLOAD(SO, (j + 2) * 64); FA_SBAR();
        pv_d0(o, vb0 + vp, pa0, pa1, pa2, pa3); partialSM(pB0, pB1, m_reg, mnB, alB);
        FA_SWAIT(); FA_SWRITE(0, vn, SE);
        FA_RESC(alB); __syncthreads(); FA_VROT();
        FA_SBAR(); qkt<DQK>(pA0, pA1, K_lds, qr, r32, hi);
        finishSM(pB0, pB1, alB, l_reg, pa0, pa1, pa2, pa3); FA_SBAR();
        if (j + 3 < NT) FA_SLOAD(SE, (j + 3) * 64);
        FA_SBAR();
        pv_d0(o, vb0 + vp, pa0, pa1, pa2, pa3); partialSM(pA0, pA1, m_reg, mnA, alA);
        FA_SWAIT(); FA_SWRITE(1, vn, SO);
        FA_RESC(alA); __syncthreads(); FA_VROT();
    }
    FA_SBAR(); qkt<DQK>(pB0, pB1, K_lds + SHM_K, qr, r32, hi);
    finishSM(pA0, pA1, alA, l_reg, pa0, pa1, pa2, pa3); FA_SBAR();
    pv_d0(o, vb0 + vp, pa0, pa1, pa2, pa3); partialSM(pB0, pB1, m_reg, mnB, alB);
    FA_RESC(alB);
    finishSM(pB0, pB1, alB, l_reg, pa0, pa1, pa2, pa3); FA_SBAR();
    pv_d0(o, vb0 + vc_, pa0, pa1, pa2, pa3);
    if (hi == 0) li_l[r32] = l_reg;
    asm volatile("s_waitcnt lgkmcnt(0)" ::: "memory");
    float rli[16];
#pragma unroll
    for (int r = 0; r < 16; ++r) rli[r] = __builtin_amdgcn_rcpf(li_l[crow(r, hi)]);
    f16* Ow = Ob + (size_t)(wid * 32) * 512;
#pragma unroll
    for (int r = 0; r < 16; ++r) { const int orow = crow(r, hi);
#pragma unroll
        for (int d0 = 0; d0 < 2; ++d0) Ow[(size_t)orow * 512 + d0 * 32 + r32] = (f16)(o[d0][r] * rli[r]); }
#undef FA_SLOAD
#undef FA_SWRITE
#undef FA_SWAIT
#undef FA_RESC
#undef FA_VROT
}
}
__device__ __forceinline__ void phase_attn_a(const Ctx& C, int l) {
    f16* QA = (f16*)(C.ws() + A_QA); const f16* KA = (const f16*)(C.ws() + A_KA); const f16* VA = (const f16*)(C.ws() + A_VA);
    const int vcu = (C.nblk % 8 == 0) ? (C.bid % 8) * (C.nblk / 8) + C.bid / 8 : C.bid;
    const int total = 512 + (l == 0 ? 32 : 0);
    for (int u = vcu; u < total; u += C.nblk) {
        __syncthreads();
        int b, h, nkeys; size_t orow;
        if (u < 512) { b = u >> 7; h = (u >> 4) & 7; orow = (size_t)b * SEQ + (u & 15) * 256; nkeys = NKEY; }
        else { const int v = u - 512; b = v >> 3; h = v & 7; orow = (size_t)NLAT + b * CTX; nkeys = CTX; }
        fa64::attn_unit<8, 512, 64, 512>(QA + orow * 512 + h * 64, KA + (size_t)(b * 2 + (h >> 2)) * NKEY * 64, VA + (size_t)(b * 2 + (h >> 2)) * NKEY * 64, QA + orow * 512 + h * 64, nkeys, (char*)C.lds, C.tid);
    }
    __syncthreads();
}
__device__ __forceinline__ void phase_attn_c(const Ctx& C, int l) {
    const f16* QC = (const f16*)(C.ws() + A_QC); const f16* KC = (const f16*)(C.ws() + A_KC); const f16* VC = (const f16*)(C.ws() + A_VC); f16* YC = (f16*)(C.ws() + A_YC);
    const int vcu = (C.nblk % 8 == 0) ? (C.bid % 8) * (C.nblk / 8) + C.bid / 8 : C.bid;
    const int total = 512 + (l == 0 ? 32 : 0);
    for (int u = vcu; u < total; u += C.nblk) {
        __syncthreads();
        int b, h, nkeys; size_t qrow, orow;
        if (u < 512) { b = u >> 7; h = (u >> 4) & 7; const int qb = u & 15; qrow = (size_t)(b * 8 + h) * SEQ + qb * 256; orow = (size_t)b * SEQ + qb * 256; nkeys = NKEY; }
        else { const int v = u - 512; b = v >> 3; h = v & 7; qrow = (size_t)NB * 8 * SEQ + (size_t)(b * 8 + h) * CTX; orow = (size_t)NLAT + b * CTX; nkeys = CTX; }
        fa96::attn_unit<8, 96, 96, 64, 512>(QC + qrow * 96, KC + (size_t)(b * 8 + h) * NKEY * 96, VC + (size_t)(b * 8 + h) * NKEY * 64, YC + orow * 512 + h * 64, nkeys, (char*)C.lds, C.tid);
    }
    __syncthreads();
}

constexpr float S5SC = 1024.0f, S5ISC = 1.0f / 1024.0f;
__device__ __forceinline__ void qp_split(int qp, int& b, int& nmem) { if (qp < 1024) { b = qp >> 8; nmem = 16 + (qp & 255); } else { b = (qp - 1024) >> 4; nmem = (qp - 1024) & 15; } }
__device__ __forceinline__ void phase_s5tab(const Ctx& C, int l) {
    LAS float* ApR = (LAS float*)C.lds; LAS float* ApI = ApR + 17 * 64; LAS float* BbR = ApI + 17 * 64; LAS float* BbI = BbR + 1024; LAS float* CR = BbI + 1024; LAS float* CI = CR + 1024;
    for (int u = C.bid; u < 64; u += C.nblk) {
        const int dir = u >> 5, g = u & 31; const size_t gi = (size_t)(l * 2 + dir) * 32 + g;
        const float dt = expf(C.in(I_SLDT)[gi]);
        __syncthreads();
        for (int i = C.tid; i < 17 * 64; i += NTHREADS) {
            const int p = i & 63, k = i >> 6; const float are = C.in(I_SARE)[gi * 64 + p], aim = C.in(I_SAIM)[gi * 64 + p];
            const float mag = expf(are * dt * (float)k), ang = (aim * dt) * (float)k;
            ApR[i] = mag * cosf(ang); ApI[i] = mag * sinf(ang);
        }
        for (int i = C.tid; i < 1024; i += NTHREADS) {
            const int p = i >> 4, c = i & 15; const float are = C.in(I_SARE)[gi * 64 + p], aim = C.in(I_SAIM)[gi * 64 + p];
            const float mag = expf(are * dt), th = aim * dt, abr = mag * cosf(th), abi = mag * sinf(th);
            const float den = are * are + aim * aim, nr = abr - 1.0f, cr = (nr * are + abi * aim) / den, ci = (abi * are - nr * aim) / den;
            const float br = C.in(I_SBRE)[(gi * 64 + p) * 16 + c], bi = C.in(I_SBIM)[(gi * 64 + p) * 16 + c];
            BbR[i] = cr * br - ci * bi; BbI[i] = cr * bi + ci * br;
            CR[i] = C.in(I_SCRE)[gi * 1024 + i]; CI[i] = C.in(I_SCIM)[gi * 1024 + i];
        }
        __syncthreads();
        f16* Et = (f16*)(C.ws() + T_E) + (size_t)u * 16 * 16 * 128; f16* Mt = (f16*)(C.ws() + T_M); f16* Kt = (f16*)(C.ws() + T_K) + (size_t)u * 17 * 256;
        for (int i = C.tid; i < 16384; i += NTHREADS) {
            { const int t = i >> 10, c = (i >> 6) & 15, p = i & 63, k = dir == 0 ? t + 1 : 16 - t;
              const float cr = CR[c * 64 + p], ci = CI[c * 64 + p], ar = ApR[k * 64 + p], ai = ApI[k * 64 + p];
              Et[(size_t)(t * 16 + c) * 128 + p] = (f16)((cr * ar - ci * ai) * S5SC); Et[(size_t)(t * 16 + c) * 128 + 64 + p] = (f16)(-(cr * ai + ci * ar) * S5SC); }
            { const int p = i >> 8, sx = (i >> 4) & 15, c = i & 15, k = dir == 0 ? 15 - sx : sx;
              const float ar = ApR[k * 64 + p], ai = ApI[k * 64 + p], br = BbR[p * 16 + c], bi = BbI[p * 16 + c];
              Mt[m3_off(u, p >> 5, sx, c >> 3, p & 31) + (c & 7)] = (f16)((ar * br - ai * bi) * S5SC);
              Mt[m3_off(u, 2 + (p >> 5), sx, c >> 3, p & 31) + (c & 7)] = (f16)((ar * bi + ai * br) * S5SC); }
        }
        for (int i = C.tid; i < 17 * 256; i += NTHREADS) {
            const int tau = (i >> 8) - 1, c = (i >> 4) & 15, cp = i & 15; float acc = 0.f;
            if (tau >= 0) {
#pragma unroll 8
                for (int p = 0; p < 64; ++p) {
                    const float cr = CR[c * 64 + p], ci = CI[c * 64 + p], ar = ApR[tau * 64 + p], ai = ApI[tau * 64 + p];
                    acc += (cr * ar - ci * ai) * BbR[p * 16 + cp] - (cr * ai + ci * ar) * BbI[p * 16 + cp]; }
            }
            Kt[i] = (f16)(acc * S5SC);
        }
    }
}
__device__ __forceinline__ void phase_s5ab(const Ctx& C, int l) {
    constexpr int SST = 273;
    const f16* U = (const f16*)(C.ws() + A_U); f16* X = (f16*)(C.ws() + A_S5X); const f16* Mt = (const f16*)(C.ws() + T_M);
    LAS float* Sl = (LAS float*)C.lds;
    LAS float* ex = Sl + 128 * SST;
    const int r32 = C.lane & 31, hi = C.lane >> 5;
    for (int item = C.bid; item < 256; item += C.nblk) {
        const int db = item, dirg = db >> 2, b = db & 3, dir = dirg >> 5, g = dirg & 31; const size_t gi = (size_t)(l * 2 + dir) * 32 + g;
        __syncthreads();
        for (int idx = C.wid; idx < 36; idx += NWAVES) {
            const int cb = idx >> 2, mb = idx & 3, nb = cb < 8 ? 8 * b + cb : 32 + (b >> 1);
            int bq, nmem; qp_split(nb * 32 + r32, bq, nmem);
            f16x8 uf[16], af[16];
#pragma unroll
            for (int sx = 0; sx < 16; ++sx) { uf[sx] = *(const f16x8*)(U + u3_off(g, nb, sx, hi, r32)); af[sx] = *(const f16x8*)(Mt + m3_off(dirg, mb, sx, hi, r32)); }
            f32x16 acc = {};
#pragma unroll
            for (int sx = 0; sx < 16; ++sx) acc = __builtin_amdgcn_mfma_f32_32x32x16_f16(af[sx], uf[sx], acc, 0, 0, 0);
            if (bq == b) {
#pragma unroll
                for (int r = 0; r < 16; ++r) Sl[(mb * 32 + fa::crow(r, hi)) * SST + nmem] = acc[r] * S5ISC;
            }
        }
        __syncthreads();
        const int p = C.lane, w = C.wid;
        const float are = C.in(I_SARE)[gi * 64 + p], aim = C.in(I_SAIM)[gi * 64 + p], dt = expf(C.in(I_SLDT)[gi]);
        const float mag = expf(are * dt * 16.0f), ang = (aim * dt) * 16.0f, ar = mag * cosf(ang), ai = mag * sinf(ang);
        const float mag32 = expf(are * dt * 512.0f), ang32 = (aim * dt) * 512.0f, br_ = mag32 * cosf(ang32), bi_ = mag32 * sinf(ang32);
        const LAS float* sr = Sl + p * SST; const LAS float* si = Sl + (64 + p) * SST;
        const int kkr = p >> 4, hf = (p >> 3) & 1, jj = p & 7;
        const int lo = dir == 0 ? 16 + 32 * w : 16 + 32 * (7 - w);
        float xr = 0.f, xi = 0.f;
#pragma unroll 4
        for (int e = 0; e < 16; ++e) {
            const int nmem = dir == 0 ? e : 15 - e;
            if (w == 0) { const int qp = 1024 + b * 16 + nmem;
                X[x3_off(dirg, qp >> 5, kkr, hf, qp & 31) + jj] = (f16)xr; X[x3_off(dirg, qp >> 5, 4 + kkr, hf, qp & 31) + jj] = (f16)xi; }
            const float sre = sr[nmem], sim = si[nmem];
            const float nxr = ar * xr - ai * xi + sre, nxi = ar * xi + ai * xr + sim; xr = nxr; xi = nxi;
        }
        const float c0r = xr, c0i = xi;
        xr = 0.f; xi = 0.f;
#pragma unroll 8
        for (int e = 0; e < 32; ++e) {
            const int nmem = lo + (dir == 0 ? e : 31 - e);
            const float sre = sr[nmem], sim = si[nmem];
            const float nxr = ar * xr - ai * xi + sre, nxi = ar * xi + ai * xr + sim; xr = nxr; xi = nxi;
        }
        ex[w * 128 + p] = xr; ex[w * 128 + 64 + p] = xi;
        __syncthreads();
        xr = c0r; xi = c0i;
        for (int v = 0; v < w; ++v) { const float er = ex[v * 128 + p], ei = ex[v * 128 + 64 + p];
            const float nxr = br_ * xr - bi_ * xi + er, nxi = br_ * xi + bi_ * xr + ei; xr = nxr; xi = nxi; }
#pragma unroll 8
        for (int e = 0; e < 32; ++e) {
            const int nmem = lo + (dir == 0 ? e : 31 - e), qp = b * 256 + nmem - 16;
            X[x3_off(dirg, qp >> 5, kkr, hf, qp & 31) + jj] = (f16)xr; X[x3_off(dirg, qp >> 5, 4 + kkr, hf, qp & 31) + jj] = (f16)xi;
            const float sre = sr[nmem], sim = si[nmem];
            const float nxr = ar * xr - ai * xi + sre, nxi = ar * xi + ai * xr + sim; xr = nxr; xi = nxi;
        }
    }
    __syncthreads();
}
__device__ __forceinline__ void phase_s5c(const Ctx& C, int l) {
    const f16* U = (const f16*)(C.ws() + A_U); const f16* X = (const f16*)(C.ws() + A_S5X); f16* G = (f16*)(C.ws() + A_G);
    const int r32 = C.lane & 31, hi = C.lane >> 5, t0 = 2 * C.wid, trow = t0 + (r32 >> 4), crw = r32 & 15;
    const int nnb = l == 0 ? 34 : 32;
    LAS f16* Kl = (LAS f16*)C.lds;
    int cur_g = -1; f16x8 ef[2][8];
    for (int u = C.bid; u < 32 * nnb; u += C.nblk) {
        const int g = u & 31, nb = u >> 5;
        const int row0 = (nb * 32 + r32) * 16;
        f16x8 uf[16], xf[2][8]; f16x4 u4[2][2];
#pragma unroll
        for (int sx = 0; sx < 16; ++sx) uf[sx] = *(const f16x8*)(U + u3_off(g, nb, sx, hi, r32));
#pragma unroll
        for (int dir = 0; dir < 2; ++dir)
#pragma unroll
            for (int kk = 0; kk < 8; ++kk) xf[dir][kk] = *(const f16x8*)(X + x3_off(dir * 32 + g, nb, kk, hi, r32));
#pragma unroll
        for (int tl = 0; tl < 2; ++tl)
#pragma unroll
            for (int gp = 0; gp < 2; ++gp) u4[tl][gp] = *(const f16x4*)(U + u3_off(g, nb, t0 + tl, gp, r32) + 4 * hi);
        if (g != cur_g) {
            __syncthreads();
            for (int i = C.tid; i < 2 * 17 * 256 / 8; i += NTHREADS) {
                const int dir = i / (17 * 32), j = i - dir * (17 * 32);
                *(LAS f16x8*)(Kl + (size_t)i * 8) = *(const f16x8*)((const f16*)(C.ws() + T_K) + (size_t)(dir * 32 + g) * 17 * 256 + j * 8);
            }
#pragma unroll
            for (int dir = 0; dir < 2; ++dir)
#pragma unroll
                for (int kk = 0; kk < 8; ++kk) ef[dir][kk] = *(const f16x8*)((const f16*)(C.ws() + T_E) + (size_t)(dir * 32 + g) * 16 * 16 * 128 + (size_t)(trow * 16 + crw) * 128 + kk * 16 + 8 * hi);
            __syncthreads();
            cur_g = g;
        }
        f32x16 acc = {};
        const LAS f16* kb = Kl + crw * 16 + 8 * hi;
#pragma unroll
        for (int sx = 0; sx < 16; ++sx) {
            if (sx <= t0 + 1) { const f16x8 af = *(const LAS f16x8*)(kb + (trow - sx + 1) * 256); acc = __builtin_amdgcn_mfma_f32_32x32x16_f16(af, uf[sx], acc, 0, 0, 0); }
            if (sx >= t0) { const f16x8 af = *(const LAS f16x8*)(kb + (17 + sx - trow + 1) * 256); acc = __builtin_amdgcn_mfma_f32_32x32x16_f16(af, uf[sx], acc, 0, 0, 0); }
        }
#pragma unroll
        for (int dir = 0; dir < 2; ++dir)
#pragma unroll
            for (int kk = 0; kk < 8; ++kk) acc = __builtin_amdgcn_mfma_f32_32x32x16_f16(ef[dir][kk], xf[dir][kk], acc, 0, 0, 0);
#pragma unroll
        for (int tl = 0; tl < 2; ++tl)
#pragma unroll
            for (int gp = 0; gp < 2; ++gp) {
                const size_t off = (size_t)(row0 + t0 + tl) * 512 + g * 16 + 4 * hi + 8 * gp;
                const f32x4 d4 = *(const f32x4*)(C.in(I_SD) + l * 512 + g * 16 + 4 * hi + 8 * gp);
                f32x4 y;
#pragma unroll
                for (int e = 0; e < 4; ++e) y[e] = gelu_tanh(acc[8 * tl + 4 * gp + e] * S5ISC + d4[e] * (float)u4[tl][gp][e]);
                *(f16x4*)(G + off) = pack4(y);
            }
    }
}

typedef __attribute__((address_space(1))) unsigned gu32;
#define XB_TMO      128
#define XB_XCNT(j)  (256  + 64 * (j))
#define XB_XSUB(j)  (1280 + 64 * (j))
#define XB_XGEN(j)  (2304 + 64 * (j))
#define XB_TOP      3328
#define XB_TOPGEN   3392
#define XCD_BAR_WORDS 3456
#define XB_SPIN_CAP (1u << 26)

__device__ __forceinline__ unsigned xb_ld(unsigned* p)              { return __hip_atomic_load(p, __ATOMIC_RELAXED, __HIP_MEMORY_SCOPE_AGENT); }
__device__ __forceinline__ unsigned xb_add(unsigned* p, unsigned v) { return __hip_atomic_fetch_add(p, v, __ATOMIC_RELAXED, __HIP_MEMORY_SCOPE_AGENT); }
__device__ __forceinline__ unsigned xb_xcc_id() { return (unsigned)__builtin_amdgcn_s_getreg((3 << 11) | 20) & 0xFu; }
#define XB_SPIN(cond, bar) do { unsigned _sp = 0; while (cond) { __builtin_amdgcn_s_sleep(1); \
    if ((++_sp & 255u) == 0u) { if (xb_ld(&(bar)[XB_TMO])) break; if (_sp > XB_SPIN_CAP) { atomicAdd(&(bar)[XB_TMO], 1u); break; } } } } while (0)

struct XcdBarrier {
    unsigned* bar; unsigned x;
    volatile LAS unsigned* st;
};

__device__ __forceinline__ XcdBarrier xcd_barrier_post(unsigned* bar, volatile LAS unsigned* st) {
    XcdBarrier b; b.bar = bar; b.x = xb_xcc_id(); b.st = st;
    if (threadIdx.x == 0) (void)xb_add(&bar[XB_XCNT(b.x)], 1u);
    return b;
}
__device__ __forceinline__ void xcd_barrier_complete(unsigned* bar, unsigned x, unsigned& nloc, unsigned& nx) {
    const unsigned G = gridDim.x * gridDim.y * gridDim.z;
    unsigned sum, cnt, mine, sp = 0u;
    for (;;) {
        sum = 0u; cnt = 0u; mine = 0u;
#pragma unroll
        for (unsigned j = 0; j < 16; ++j) { const unsigned c = xb_ld(&bar[XB_XCNT(j)]); sum += c; cnt += (c > 0u) ? 1u : 0u; mine = (j == x) ? c : mine; }
        if (sum == G) break;
        __builtin_amdgcn_s_sleep(1);
        if ((++sp & 255u) == 0u) { if (xb_ld(&bar[XB_TMO])) break; if (sp > XB_SPIN_CAP) { atomicAdd(&bar[XB_TMO], 1u); break; } }
    }
    nloc = mine > 0u ? mine : 1u; nx = cnt > 0u ? cnt : 1u;
}

__device__ __forceinline__ void xcd_barrier(const XcdBarrier& b, const bool t0) {
    asm volatile("s_waitcnt vmcnt(0)" ::: "memory");
    __syncthreads();
    if (t0) {
        unsigned* bar = b.bar;
        __builtin_amdgcn_s_waitcnt(0);
        unsigned nloc = b.st[0], nx = b.st[1];
        if (nloc == 0u) { xcd_barrier_complete(bar, b.x, nloc, nx); b.st[0] = nloc; b.st[1] = nx; }
        const unsigned old = xb_add(&bar[XB_XSUB(b.x)], 1u);
        const unsigned gen = old / nloc;
        if (old + 1u == (gen + 1u) * nloc) {
            __builtin_amdgcn_fence(__ATOMIC_RELEASE, "agent");
            asm volatile("s_waitcnt vmcnt(0)" ::: "memory");
            const unsigned og = xb_add(&bar[XB_TOP], 1u);
            const unsigned tg = og / nx;
            if (og + 1u == (tg + 1u) * nx) xb_add(&bar[XB_TOPGEN], 1u);
            else XB_SPIN(xb_ld(&bar[XB_TOPGEN]) == tg, bar);
            __builtin_amdgcn_fence(__ATOMIC_ACQUIRE, "agent");
            xb_add(&bar[XB_XGEN(b.x)], 1u);
            asm volatile("s_waitcnt vmcnt(0)" ::: "memory");
        } else {
            XB_SPIN(xb_ld(&bar[XB_XGEN(b.x)]) == gen, bar);
            __builtin_amdgcn_fence(__ATOMIC_ACQUIRE, "agent");
            asm volatile("s_waitcnt vmcnt(0)" ::: "memory");
        }
    }
    __syncthreads();
}

#ifndef PROBE_PH
#define PROBE_PH -1
#endif
struct Env { XcdBarrier bar; int wid; unsigned long long t_acc; };
#ifndef PROBE_L
#define PROBE_L -1
#endif
#define PH_BEGIN(k) unsigned long long _t0 = 0; if (PROBE_PH == (k) && (PROBE_L < 0 || PROBE_L == l)) _t0 = __builtin_amdgcn_s_memrealtime()
#define PH_END(k) if (PROBE_PH == (k) && (PROBE_L < 0 || PROBE_L == l)) env.t_acc += __builtin_amdgcn_s_memrealtime() - _t0
#define GSYNC() do { const Ctx Cb = make_ctx(env.wid); xcd_barrier(env.bar, Cb.tid == 0); } while (0)
constexpr int MISC_OFF = LDS_BYTES - 256;
constexpr int CW_BAR = 4096;
#define CTX() const Ctx C = make_ctx(env.wid); unsigned char* ws = C.ws()
template <int l>
__device__ __forceinline__ void layer_body(Env& env) {
        const int mrows = l == 0 ? MALL : NLAT;
        if (l == 0) { PH_BEGIN(0);
        { CTX(); (void)ws; phase_p1(C, 0); }
        GSYNC(); PH_END(0); }
        { PH_BEGIN(1);
        { CTX(); EpiProj E{(f16*)(ws + A_PROJ), (f16*)(ws + A_VA), (f16*)(ws + A_U)};
          gemm_pg8(C, (const f16*)(ws + A_H), D, (const f16*)(ws + W_INA), D, MALL, 2560, D, E); }
        GSYNC(); PH_END(1); }
        { PH_BEGIN(2);
        { CTX(); (void)ws; phase_p3(C, l); }
        GSYNC(); PH_END(2); }
        { PH_BEGIN(3);
        { CTX(); EpiKvUp E1{(f16*)(ws + A_KC), (f16*)(ws + A_VC)};
          gemm_rows(C, (const f16*)(ws + A_PROJ) + PC_CKV, PLD2, (const f16*)(ws + W_KVB), 256, MALL, 1024, 256, E1); }
        { CTX(); EpiQUp E2{(f16*)(ws + A_QC), (const float*)(ws + WS_ROPE) + 2048, C.lane};
          gemm_pg8(C, (const f16*)(ws + A_PROJ) + PC_CQ, PLD2, (const f16*)(ws + W_QB), 768, mrows, 768, 768, E2); }
        GSYNC(); PH_END(3); }
        { PH_BEGIN(4);
        { CTX(); (void)ws; phase_s5ab(C, l); }
        { CTX(); (void)ws; phase_attn_a(C, l); }
        { CTX(); (void)ws; phase_attn_c(C, l); }
        GSYNC(); PH_END(4); }
        { PH_BEGIN(6);
        { CTX(); (void)ws; phase_s5c(C, l); }
        GSYNC(); PH_END(6); }
        { PH_BEGIN(7);
        { CTX(); EpiGlu E{(f16*)(ws + A_YS)};
          gemm_rows(C, (const f16*)(ws + A_G), 512, (const f16*)(ws + W_GLU), 512, mrows, 1024, 512, E); }
        GSYNC(); PH_END(7); }
        { PH_BEGIN(8);
        {
            CTX();
            const f16* Hh = (const f16*)(ws + A_H); const f16* Wg = (const f16*)(ws + W_GATE); const f16* Wb = (const f16*)(ws + W_BR);
            const f16* Y0 = (const f16*)(ws + A_YA); const f16* Y1 = (const f16*)(ws + A_YS); const f16* Y2 = (const f16*)(ws + A_YC);
            EpiGate Eg{(f16*)(ws + A_GATE)}; EpiBranch Eb0{(const f16*)(ws + A_GATE), (f16*)(ws + A_MERGED), 1}; EpiBranch Eb{(const f16*)(ws + A_GATE), (f16*)(ws + A_MERGED), 0};
            constexpr size_t WGS = (size_t)1024 * 1024, WBS = (size_t)1024 * 512;
            gemm_pg8c<false, true>(C, Hh, D, Wg, D, NLAT, 1024, D, Eg, Y0, 512, Wb, 512);
            gemm_pg8c<true, true>(C, Y0, 512, Wb, 512, NLAT, 1024, 512, Eb0, Hh, D, Wg + WGS, D);
            gemm_pg8c<true, true>(C, Hh, D, Wg + WGS, D, NLAT, 1024, D, Eg, Y1, 512, Wb + WBS, 512);
            gemm_pg8c<true, true>(C, Y1, 512, Wb + WBS, 512, NLAT, 1024, 512, Eb, Hh, D, Wg + 2 * WGS, D);
            gemm_pg8c<true, true>(C, Hh, D, Wg + 2 * WGS, D, NLAT, 1024, D, Eg, Y2, 512, Wb + 2 * WBS, 512);
            gemm_pg8c<true, false>(C, Y2, 512, Wb + 2 * WBS, 512, NLAT, 1024, 512, Eb, Hh, D, Wg, D);
        }
        if (mrows > NLAT) {
#pragma unroll
            for (int br = 0; br < 3; ++br) {
                { CTX(); EpiGate Eg{(f16*)(ws + A_GATE)};
                  gemm_small(C, (const f16*)(ws + A_H) + (size_t)NLAT * D, D, (const f16*)(ws + W_GATE) + (size_t)br * 1024 * 1024, D, NLAT, 1024, D, Eg); }
                { CTX(); const f16* Y = (const f16*)(ws + (br == 0 ? A_YA : br == 1 ? A_YS : A_YC));
                  EpiBranch Eb{(const f16*)(ws + A_GATE), (f16*)(ws + A_MERGED), br == 0};
                  gemm_small(C, Y + (size_t)NLAT * 512, 512, (const f16*)(ws + W_BR) + (size_t)br * 1024 * 512, 512, NLAT, 1024, 512, Eb); }
            }
        }
        GSYNC(); PH_END(8); }
        { PH_BEGIN(9);
        { CTX(); EpiWout E{&C, l}; gemm_rows(C, (const f16*)(ws + A_MERGED), D, (const f16*)(ws + W_OUT), D, mrows, 1024, D, E); }
        GSYNC(); PH_END(9); }
        { PH_BEGIN(10);
        { CTX(); (void)ws; phase_p10(C, l, mrows); }
        GSYNC(); PH_END(10); }
        { PH_BEGIN(11);
        { CTX(); EpiUp E{(f16*)(ws + A_HID)}; gemm_rows(C, (const f16*)(ws + A_H), D, (const f16*)(ws + W_UP), D, mrows, DFF, D, E); }
        GSYNC(); PH_END(11); }
        { PH_BEGIN(12);
        { CTX(); EpiDown E{&C, l}; gemm_rows(C, (const f16*)(ws + A_HID), DFF, (const f16*)(ws + W_DOWN), DFF, mrows, 1024, DFF, E); }
        GSYNC(); PH_END(12); }
        { PH_BEGIN(13);
        if (l == 0) { CTX(); (void)ws; if (C.nblk > 128) { if (C.bid < 64) phase_s5tab(C, 1); else phase_cvt(C, 1, 64); } else { phase_s5tab(C, 1); __syncthreads(); phase_cvt(C, 1, 0); } }
        { CTX(); (void)ws; phase_p13(C, l, mrows); }
        if (l == 0) GSYNC(); PH_END(13); }
}
__global__ void __launch_bounds__(NTHREADS, 2) fwd_all(Args args) {
    cg::grid_group grid = cg::this_grid();
    extern __shared__ __attribute__((aligned(16))) unsigned char lds_raw[];
    volatile LAS unsigned* MISC = (volatile LAS unsigned*)((LAS unsigned char*)lds_raw + MISC_OFF);
    if (threadIdx.x < 64) MISC[threadIdx.x] = 0u;
    __syncthreads();
    Env env; env.t_acc = 0; env.wid = __builtin_amdgcn_readfirstlane(threadIdx.x >> 6);
    env.bar = xcd_barrier_post((unsigned*)(args.ws + WS_CTL) + CW_BAR, MISC + 8);
    { CTX(); (void)ws; if (C.nblk > 128) { if (C.bid < 64) phase_s5tab(C, 0); else { phase_setup(C, 64); __syncthreads(); phase_cvt(C, 0, 64); } } else { phase_setup(C, 0); __syncthreads(); phase_s5tab(C, 0); __syncthreads(); phase_cvt(C, 0, 0); } }
    asm volatile("s_waitcnt vmcnt(0)" ::: "memory");
    grid.sync();
    __builtin_amdgcn_fence(__ATOMIC_ACQUIRE, "agent");
    asm volatile("s_waitcnt vmcnt(0)" ::: "memory");
    layer_body<0>(env);
    layer_body<1>(env);
    if (PROBE_PH >= 0 && blockIdx.x == 0) { const unsigned long long t0 = __builtin_amdgcn_s_memrealtime(); while (__builtin_amdgcn_s_memrealtime() - t0 < 8ull * env.t_acc) __builtin_amdgcn_s_sleep(8); }
}

extern "C" void kernel_launch(void* const* d_in, const int* in_sizes, int n_in, void* d_out, int out_size, void* d_ws, size_t ws_size, hipStream_t stream) {
    static int grid_blocks = 0;
    if (grid_blocks == 0) {
        if (n_in != 32 || out_size != NLAT * D || ws_size < WS_NEED) { fprintf(stderr, "kernel_launch: unexpected shapes n_in %d out %d ws %zu (need %zu)\n", n_in, out_size, ws_size, (size_t)WS_NEED); grid_blocks = -1; return; }
        int dev = 0, cus = 0, per_cu = 0;
        hipGetDevice(&dev);
        hipDeviceGetAttribute(&cus, hipDeviceAttributeMultiprocessorCount, dev);
        if (hipFuncSetAttribute((const void*)fwd_all, hipFuncAttributeMaxDynamicSharedMemorySize, LDS_BYTES) != hipSuccess) { fprintf(stderr, "kernel_launch: hipFuncSetAttribute failed\n"); grid_blocks = -1; return; }
        hipOccupancyMaxActiveBlocksPerMultiprocessor(&per_cu, (const void*)fwd_all, NTHREADS, LDS_BYTES);
        if (per_cu < 1) { fprintf(stderr, "kernel_launch: occupancy query says %d blocks per CU\n", per_cu); grid_blocks = -1; return; }
        grid_blocks = cus;
    }
    if (grid_blocks < 0) return;
    Args a{};
    for (int i = 0; i < 32; ++i) a.in[i] = (const float*)d_in[i];
    a.out = (float*)d_out; a.ws = (unsigned char*)d_ws;
    if (hipMemsetAsync((char*)d_ws + WS_CTL, 0, 1 * MiB, stream) != hipSuccess) { fprintf(stderr, "kernel_launch: hipMemsetAsync failed\n"); return; }
    void* kargs[] = {&a};
    const hipError_t e = hipLaunchCooperativeKernel((const void*)fwd_all, dim3(grid_blocks), dim3(NTHREADS), kargs, LDS_BYTES, stream);
    if (e != hipSuccess) fprintf(stderr, "kernel_launch: cooperative launch failed: %s (grid %d)\n", hipGetErrorString(e), grid_blocks);
}
```
